# Optimizing an MI355X kernel written in HIP

```python
import math
import jax, jax.numpy as jnp
from jax import lax
import numpy as np

D_MODEL = 1024
BATCH = 2
SEQ = 8192
DEPTH = 2

GRID_W = 64
SSM_WIDTH = D_MODEL
SSM_GROUP = 16
SSM_GROUPS = SSM_WIDTH // SSM_GROUP
SSM_STATE = 64
SSM_DIRS = 2
LOG_STEP_MIN = math.log(1e-3)
LOG_STEP_MAX = math.log(1e-1)
N_HEADS = 16
N_KV_HEADS = 4
HEAD_DIM = D_MODEL // N_HEADS
Q_PER_KV = N_HEADS // N_KV_HEADS
ROPE_AXIS_DIM = HEAD_DIM // 2
ROPE_THETA = 10000.0
ATTN_BLOCK = 128
QKV_WIDTH = (N_HEADS + 2 * N_KV_HEADS) * HEAD_DIM
D_FF = ((8 * D_MODEL // 3 + 127) // 128) * 128
N_EXPERTS = 8
TOP_K = 2
D_FF_EXPERT = 7 * D_MODEL // 2
N_EVEN = (DEPTH + 1) // 2
N_ODD = DEPTH // 2
NORM_EPS = 1e-6

kernel_name = "hybrid_s5_axial_gqa_moe_encoder"


def rms_norm(x, gain):
    x32 = x.astype(jnp.float32)
    y = x32 * lax.rsqrt(jnp.mean(x32 * x32, axis=-1, keepdims=True) + NORM_EPS)
    return (y * gain.astype(jnp.float32)).astype(x.dtype)


def swiglu(h, w_gate, w_up, w_down):
    return (jax.nn.silu(h @ w_gate) * (h @ w_up)) @ w_down


def s5_mixer(h, w_in, lam_re, lam_im, log_step, b_re, b_im, c_re, c_im, d_skip, w_glu, w_out):
    bsz, seq, _ = h.shape
    u = h @ w_in
    uf = u.astype(jnp.float32).reshape(bsz, seq, SSM_GROUPS, SSM_GROUP)
    y = d_skip.astype(jnp.float32).reshape(SSM_GROUPS, SSM_GROUP) * uf

    def combine(e1, e2):
        a1r, a1i, b1r, b1i = e1
        a2r, a2i, b2r, b2i = e2
        return (a2r * a1r - a2i * a1i,
                a2r * a1i + a2i * a1r,
                a2r * b1r - a2i * b1i + b2r,
                a2r * b1i + a2i * b1r + b2i)

    for d in range(SSM_DIRS):
        lr = lam_re[d].astype(jnp.float32)
        li = lam_im[d].astype(jnp.float32)
        step = jnp.exp(log_step[d].astype(jnp.float32))[:, None]
        mag = jnp.exp(lr * step)
        ang = li * step
        ab_re = mag * jnp.cos(ang)
        ab_im = mag * jnp.sin(ang)
        nr, ni = ab_re - 1.0, ab_im
        den = lr * lr + li * li
        q_re = (nr * lr + ni * li) / den
        q_im = (ni * lr - nr * li) / den
        br = b_re[d].astype(jnp.float32)
        bi = b_im[d].astype(jnp.float32)
        bb_re = q_re[..., None] * br - q_im[..., None] * bi
        bb_im = q_re[..., None] * bi + q_im[..., None] * br
        bu_re = jnp.einsum('blgs,gps->blgp', uf, bb_re)
        bu_im = jnp.einsum('blgs,gps->blgp', uf, bb_im)
        a_re = jnp.broadcast_to(ab_re, bu_re.shape)
        a_im = jnp.broadcast_to(ab_im, bu_im.shape)
        _, _, xr, xi = lax.associative_scan(combine, (a_re, a_im, bu_re, bu_im),
                                            reverse=(d == 1), axis=1)
        y = y + (jnp.einsum('blgp,gsp->blgs', xr, c_re[d].astype(jnp.float32))
                 - jnp.einsum('blgp,gsp->blgs', xi, c_im[d].astype(jnp.float32)))
    y = y.reshape(bsz, seq, SSM_WIDTH).astype(h.dtype)
    g = jax.nn.gelu(y)
    g = g * jax.nn.sigmoid(g @ w_glu)
    return g @ w_out


def axial_rope_tables(seq):
    rows = seq // GRID_W
    freqs = ROPE_THETA ** (-jnp.arange(0, ROPE_AXIS_DIM, 2, dtype=jnp.float32) / ROPE_AXIS_DIM)
    n_f = freqs.shape[0]
    row_ang = jnp.arange(rows, dtype=jnp.float32)[:, None] * freqs
    col_ang = jnp.arange(GRID_W, dtype=jnp.float32)[:, None] * freqs
    ang = jnp.concatenate([
        jnp.broadcast_to(row_ang[:, None, :], (rows, GRID_W, n_f)),
        jnp.broadcast_to(col_ang[None, :, :], (rows, GRID_W, n_f))], axis=-1)
    ang = ang.reshape(seq, 2 * n_f)
    return jnp.cos(ang), jnp.sin(ang)


def apply_rope(x, cos, sin):
    x32 = x.astype(jnp.float32).reshape(*x.shape[:-1], HEAD_DIM // 2, 2)
    x1, x2 = x32[..., 0], x32[..., 1]
    c = cos[None, :, None, :]
    s = sin[None, :, None, :]
    out = jnp.stack([x1 * c - x2 * s, x1 * s + x2 * c], axis=-1)
    return out.reshape(x.shape).astype(x.dtype)


def axial_gqa_mixer(h, w_qkv, q_gain, k_gain, w_out):
    bsz, seq, _ = h.shape
    qkv = h @ w_qkv
    q = qkv[..., :N_HEADS * HEAD_DIM].reshape(bsz, seq, N_HEADS, HEAD_DIM)
    k = qkv[..., N_HEADS * HEAD_DIM:(N_HEADS + N_KV_HEADS) * HEAD_DIM].reshape(bsz, seq, N_KV_HEADS, HEAD_DIM)
    v = qkv[..., (N_HEADS + N_KV_HEADS) * HEAD_DIM:].reshape(bsz, seq, N_KV_HEADS, HEAD_DIM)
    q = rms_norm(q, q_gain)
    k = rms_norm(k, k_gain)
    cos, sin = axial_rope_tables(seq)
    q = apply_rope(q, cos, sin)
    k = apply_rope(k, cos, sin)
    n_blk = seq // ATTN_BLOCK
    qb = q.reshape(bsz, n_blk, ATTN_BLOCK, N_KV_HEADS, Q_PER_KV, HEAD_DIM).transpose(1, 0, 2, 3, 4, 5)
    scale = 1.0 / math.sqrt(HEAD_DIM)

    def attend(q_blk):
        s = jnp.einsum('bqkgd,bskd->bkgqs', q_blk, k, preferred_element_type=jnp.float32) * scale
        p = jax.nn.softmax(s, axis=-1).astype(v.dtype)
        return jnp.einsum('bkgqs,bskd->bqkgd', p, v)

    o = lax.map(attend, qb)
    o = o.transpose(1, 0, 2, 3, 4, 5).reshape(bsz, seq, N_HEADS * HEAD_DIM)
    return o @ w_out


def moe_swiglu(h, w_router, w_gate, w_up, w_down):
    bsz, seq, dm = h.shape
    hf = h.reshape(bsz * seq, dm)
    logits = (hf @ w_router).astype(jnp.float32)
    top_vals, top_idx = lax.top_k(logits, TOP_K)
    top_w = jax.nn.softmax(top_vals, axis=-1)
    gates = jnp.sum(jax.nn.one_hot(top_idx, N_EXPERTS, dtype=jnp.float32) * top_w[..., None], axis=1)
    gates = gates.astype(h.dtype)
    out = jnp.zeros_like(hf)
    for e in range(N_EXPERTS):
        out = out + gates[:, e:e + 1] * swiglu(hf, w_gate[e], w_up[e], w_down[e])
    return out.reshape(bsz, seq, dm)


def setup_inputs(seed: int = 0) -> dict:
    key = jax.random.key(seed)
    ks = iter(jax.random.split(key, 32))

    def nrm(shape, scale):
        return jax.random.normal(next(ks), shape, jnp.float32) * scale

    x = nrm((BATCH, SEQ, D_MODEL), 1.0)
    norm_gains = 1.0 + nrm((DEPTH, 4, D_MODEL), 0.1)
    ssm_w_in = nrm((N_EVEN, D_MODEL, SSM_WIDTH), D_MODEL ** -0.5)
    n_idx = jnp.arange(SSM_STATE, dtype=jnp.float32)
    ssm_lambda_re = -0.5 + nrm((N_EVEN, SSM_DIRS, SSM_GROUPS, SSM_STATE), 0.01)
    ssm_lambda_im = math.pi * n_idx + nrm((N_EVEN, SSM_DIRS, SSM_GROUPS, SSM_STATE), 0.01)
    ssm_log_step = jax.random.uniform(next(ks), (N_EVEN, SSM_DIRS, SSM_GROUPS), jnp.float32,
                                      LOG_STEP_MIN, LOG_STEP_MAX)
    b_scale = (2.0 * SSM_GROUP) ** -0.5
    c_scale = (2.0 * SSM_STATE) ** -0.5
    ssm_b_re = nrm((N_EVEN, SSM_DIRS, SSM_GROUPS, SSM_STATE, SSM_GROUP), b_scale)
    ssm_b_im = nrm((N_EVEN, SSM_DIRS, SSM_GROUPS, SSM_STATE, SSM_GROUP), b_scale)
    ssm_c_re = nrm((N_EVEN, SSM_DIRS, SSM_GROUPS, SSM_GROUP, SSM_STATE), c_scale)
    ssm_c_im = nrm((N_EVEN, SSM_DIRS, SSM_GROUPS, SSM_GROUP, SSM_STATE), c_scale)
    ssm_d = nrm((N_EVEN, SSM_WIDTH), 1.0)
    ssm_w_glu = nrm((N_EVEN, SSM_WIDTH, SSM_WIDTH), SSM_WIDTH ** -0.5)
    ssm_w_out = nrm((N_EVEN, SSM_WIDTH, D_MODEL), SSM_WIDTH ** -0.5)
    ffn_w_gate = nrm((N_EVEN, D_MODEL, D_FF), D_MODEL ** -0.5)
    ffn_w_up = nrm((N_EVEN, D_MODEL, D_FF), D_MODEL ** -0.5)
    ffn_w_down = nrm((N_EVEN, D_FF, D_MODEL), D_FF ** -0.5)
    attn_w_qkv = nrm((N_ODD, D_MODEL, QKV_WIDTH), D_MODEL ** -0.5)
    attn_q_gain = 1.0 + nrm((N_ODD, HEAD_DIM), 0.1)
    attn_k_gain = 1.0 + nrm((N_ODD, HEAD_DIM), 0.1)
    attn_w_out = nrm((N_ODD, N_HEADS * HEAD_DIM, D_MODEL), (N_HEADS * HEAD_DIM) ** -0.5)
    moe_w_router = nrm((N_ODD, D_MODEL, N_EXPERTS), D_MODEL ** -0.5)
    moe_w_gate = nrm((N_ODD, N_EXPERTS, D_MODEL, D_FF_EXPERT), D_MODEL ** -0.5)
    moe_w_up = nrm((N_ODD, N_EXPERTS, D_MODEL, D_FF_EXPERT), D_MODEL ** -0.5)
    moe_w_down = nrm((N_ODD, N_EXPERTS, D_FF_EXPERT, D_MODEL), D_FF_EXPERT ** -0.5)
    return {"x": x, "norm_gains": norm_gains,
            "ssm_w_in": ssm_w_in, "ssm_lambda_re": ssm_lambda_re, "ssm_lambda_im": ssm_lambda_im,
            "ssm_log_step": ssm_log_step, "ssm_b_re": ssm_b_re, "ssm_b_im": ssm_b_im,
            "ssm_c_re": ssm_c_re, "ssm_c_im": ssm_c_im, "ssm_d": ssm_d,
            "ssm_w_glu": ssm_w_glu, "ssm_w_out": ssm_w_out,
            "ffn_w_gate": ffn_w_gate, "ffn_w_up": ffn_w_up, "ffn_w_down": ffn_w_down,
            "attn_w_qkv": attn_w_qkv, "attn_q_gain": attn_q_gain, "attn_k_gain": attn_k_gain,
            "attn_w_out": attn_w_out,
            "moe_w_router": moe_w_router, "moe_w_gate": moe_w_gate, "moe_w_up": moe_w_up,
            "moe_w_down": moe_w_down}


def reference(x, norm_gains,
              ssm_w_in, ssm_lambda_re, ssm_lambda_im, ssm_log_step, ssm_b_re, ssm_b_im,
              ssm_c_re, ssm_c_im, ssm_d, ssm_w_glu, ssm_w_out,
              ffn_w_gate, ffn_w_up, ffn_w_down,
              attn_w_qkv, attn_q_gain, attn_k_gain, attn_w_out,
              moe_w_router, moe_w_gate, moe_w_up, moe_w_down):
    h = x
    for i in range(DEPTH):
        j = i // 2
        g = norm_gains[i]
        if i % 2 == 0:
            mix = s5_mixer(rms_norm(h, g[0]), ssm_w_in[j], ssm_lambda_re[j], ssm_lambda_im[j],
                           ssm_log_step[j], ssm_b_re[j], ssm_b_im[j], ssm_c_re[j], ssm_c_im[j],
                           ssm_d[j], ssm_w_glu[j], ssm_w_out[j])
            h = h + rms_norm(mix, g[1])
            ff = swiglu(rms_norm(h, g[2]), ffn_w_gate[j], ffn_w_up[j], ffn_w_down[j])
            h = h + rms_norm(ff, g[3])
        else:
            mix = axial_gqa_mixer(rms_norm(h, g[0]), attn_w_qkv[j], attn_q_gain[j],
                                  attn_k_gain[j], attn_w_out[j])
            h = h + rms_norm(mix, g[1])
            ff = moe_swiglu(rms_norm(h, g[2]), moe_w_router[j], moe_w_gate[j], moe_w_up[j],
                            moe_w_down[j])
            h = h + rms_norm(ff, g[3])
    return h
```

```cpp
#include <hip/hip_runtime.h>
#include <math.h>
#include <stdint.h>

constexpr int NTOK = 16384, DM = 1024, SEQ = 8192, NB = 2;
constexpr int DFF = 2816, NEXP = 8, DFE = 3584, QKVW = 1536;
constexpr float EPS = 1e-6f;

__device__ __forceinline__ float wave_sum(float v) {
#pragma unroll
    for (int o = 1; o < 64; o <<= 1) v += __shfl_xor(v, o);
    return v;
}
__device__ __forceinline__ float sigmoidf_(float x) { return 1.f / (1.f + __expf(-x)); }
__device__ __forceinline__ float gelu_tanh(float x) { return x * sigmoidf_(1.5957691216057308f * (x + 0.044715f * x * x * x)); }

__global__ void rms_k(const float* __restrict__ x, const float* __restrict__ gain, float* __restrict__ out) {
    const int row = blockIdx.x * 4 + (threadIdx.x >> 6), lane = threadIdx.x & 63;
    const float4* xr = (const float4*)(x + (size_t)row * DM);
    float4 v[4]; float s = 0.f;
#pragma unroll
    for (int j = 0; j < 4; ++j) { v[j] = xr[lane + 64 * j]; s += v[j].x * v[j].x + v[j].y * v[j].y + v[j].z * v[j].z + v[j].w * v[j].w; }
    const float r = rsqrtf(wave_sum(s) * (1.f / DM) + EPS);
    float4* o = (float4*)(out + (size_t)row * DM);
#pragma unroll
    for (int j = 0; j < 4; ++j) { const float4 g = ((const float4*)gain)[lane + 64 * j]; o[lane + 64 * j] = make_float4(v[j].x * r * g.x, v[j].y * r * g.y, v[j].z * r * g.z, v[j].w * r * g.w); }
}
__global__ void resnorm_k(const float* h, const float* __restrict__ mix, const float* __restrict__ gpost, const float* __restrict__ gpre, float* hout, float* __restrict__ xn) {
    const int row = blockIdx.x * 4 + (threadIdx.x >> 6), lane = threadIdx.x & 63;
    const float4* mr = (const float4*)(mix + (size_t)row * DM); const float4* hr = (const float4*)(h + (size_t)row * DM);
    float4 v[4], hv[4]; float s = 0.f;
#pragma unroll
    for (int j = 0; j < 4; ++j) { v[j] = mr[lane + 64 * j]; hv[j] = hr[lane + 64 * j]; s += v[j].x * v[j].x + v[j].y * v[j].y + v[j].z * v[j].z + v[j].w * v[j].w; }
    const float r = rsqrtf(wave_sum(s) * (1.f / DM) + EPS);
    float s2 = 0.f;
#pragma unroll
    for (int j = 0; j < 4; ++j) { const float4 g = ((const float4*)gpost)[lane + 64 * j];
        hv[j].x += v[j].x * r * g.x; hv[j].y += v[j].y * r * g.y; hv[j].z += v[j].z * r * g.z; hv[j].w += v[j].w * r * g.w;
        s2 += hv[j].x * hv[j].x + hv[j].y * hv[j].y + hv[j].z * hv[j].z + hv[j].w * hv[j].w; }
    float4* ho = (float4*)(hout + (size_t)row * DM);
#pragma unroll
    for (int j = 0; j < 4; ++j) ho[lane + 64 * j] = hv[j];
    if (xn) {
        const float r2 = rsqrtf(wave_sum(s2) * (1.f / DM) + EPS);
        float4* o = (float4*)(xn + (size_t)row * DM);
#pragma unroll
        for (int j = 0; j < 4; ++j) { const float4 g = ((const float4*)gpre)[lane + 64 * j]; o[lane + 64 * j] = make_float4(hv[j].x * r2 * g.x, hv[j].y * r2 * g.y, hv[j].z * r2 * g.z, hv[j].w * r2 * g.w); }
    }
}

struct EpiArgs { float* C; int ldc; const float* aux; int ldaux; const int* list; const float* wl; const int* cnt; };
template <int EPI, bool GATHER>
__global__ __launch_bounds__(256) void gemm_k(const float* __restrict__ A, int lda, const float* __restrict__ W, int ldw, int M, int N, int K, EpiArgs ea) {
    __shared__ float As[8][132]; __shared__ float Bs[8][132];
    const int m_lim = ea.cnt ? *ea.cnt : M;
    const int bm = blockIdx.y * 128, bn = blockIdx.x * 128;
    if (bm >= m_lim) return;
    const int tid = threadIdx.x, tx = tid & 15, ty = tid >> 4;
    const int arow = bm + (tid >> 1);
    const int srow = (arow < m_lim) ? (GATHER ? ea.list[arow] : arow) : (GATHER ? ea.list[0] : 0);
    const float* ap = A + (size_t)srow * lda + (tid & 1) * 4;
    const float* bp = W + (size_t)(tid >> 5) * ldw + bn + (tid & 31) * 4;
    float acc[8][8];
#pragma unroll
    for (int i = 0; i < 8; ++i)
#pragma unroll
        for (int j = 0; j < 8; ++j) acc[i][j] = 0.f;
    for (int k0 = 0; k0 < K; k0 += 8) {
        const float4 av = *(const float4*)(ap + k0);
        const float4 bv = *(const float4*)(bp + (size_t)k0 * ldw);
        __syncthreads();
        As[(tid & 1) * 4 + 0][tid >> 1] = av.x; As[(tid & 1) * 4 + 1][tid >> 1] = av.y; As[(tid & 1) * 4 + 2][tid >> 1] = av.z; As[(tid & 1) * 4 + 3][tid >> 1] = av.w;
        *(float4*)&Bs[tid >> 5][(tid & 31) * 4] = bv;
        __syncthreads();
#pragma unroll
        for (int k = 0; k < 8; ++k) {
            float a[8], b[8];
            *(float4*)&a[0] = *(const float4*)&As[k][ty * 8]; *(float4*)&a[4] = *(const float4*)&As[k][ty * 8 + 4];
            *(float4*)&b[0] = *(const float4*)&Bs[k][tx * 8]; *(float4*)&b[4] = *(const float4*)&Bs[k][tx * 8 + 4];
#pragma unroll
            for (int i = 0; i < 8; ++i)
#pragma unroll
                for (int j = 0; j < 8; ++j) acc[i][j] = fmaf(a[i], b[j], acc[i][j]);
        }
    }
#pragma unroll
    for (int i = 0; i < 8; ++i) {
        const int row = bm + ty * 8 + i;
        if (row >= m_lim) continue;
        int tok = 0; float wgt = 0.f;
        if (EPI == 3) { tok = ea.list[row]; wgt = ea.wl[row]; }
#pragma unroll
        for (int j = 0; j < 8; ++j) {
            const int col = bn + tx * 8 + j; const float v = acc[i][j];
            if (EPI == 0) ea.C[(size_t)row * ea.ldc + col] = v;
            else if (EPI == 1) ea.C[(size_t)row * ea.ldc + col] = ea.aux[(size_t)row * ea.ldaux + col] * sigmoidf_(v);
            else if (EPI == 2) { const float g = ea.aux[(size_t)row * ea.ldaux + col]; ea.C[(size_t)row * ea.ldc + col] = g * sigmoidf_(g) * v; }
            else if (EPI == 3) ea.C[(size_t)tok * ea.ldc + col] += wgt * v;
        }
    }
}

__global__ __launch_bounds__(64) void s5_scan_k(const float* __restrict__ u, const float* __restrict__ lam_re, const float* __restrict__ lam_im, const float* __restrict__ log_step,
                                                const float* __restrict__ b_re, const float* __restrict__ b_im, const float* __restrict__ c_re, const float* __restrict__ c_im, float* __restrict__ yout) {
    __shared__ float us[64][16];
    const int dir = blockIdx.x & 1, g = (blockIdx.x >> 1) & 63, b = blockIdx.x >> 7, p = threadIdx.x;
    const double step = exp((double)log_step[dir * 64 + g]);
    const double lr = lam_re[(dir * 64 + g) * 64 + p], li = lam_im[(dir * 64 + g) * 64 + p];
    const double mag = exp(lr * step), ang = li * step;
    const double ard = mag * cos(ang), aid = mag * sin(ang);
    const double nr = ard - 1.0, ni = aid, den = lr * lr + li * li;
    const double qr = (nr * lr + ni * li) / den, qi = (ni * lr - nr * li) / den;
    const float ar = (float)ard, ai = (float)aid;
    float bbr[16], bbi[16], cr[16], ci[16];
#pragma unroll
    for (int i = 0; i < 16; ++i) {
        const double br = b_re[((dir * 64 + g) * 64 + p) * 16 + i], bi = b_im[((dir * 64 + g) * 64 + p) * 16 + i];
        bbr[i] = (float)(qr * br - qi * bi); bbi[i] = (float)(qr * bi + qi * br);
        cr[i] = c_re[((dir * 64 + g) * 16 + i) * 64 + p]; ci[i] = c_im[((dir * 64 + g) * 16 + i) * 64 + p];
    }
    float xr = 0.f, xi = 0.f;
    float* yo = yout + (size_t)dir * NTOK * DM;
    for (int c = 0; c < SEQ / 64; ++c) {
        { const int s = p; const int st = c * 64 + s; const int t = dir == 0 ? st : SEQ - 1 - st;
          const float4* src = (const float4*)(u + (size_t)(b * SEQ + t) * DM + g * 16);
          __syncthreads();
#pragma unroll
          for (int q = 0; q < 4; ++q) *(float4*)&us[s][q * 4] = src[q];
          __syncthreads(); }
        for (int s = 0; s < 64; ++s) {
            const int st = c * 64 + s; const int t = dir == 0 ? st : SEQ - 1 - st;
            float bur = 0.f, bui = 0.f;
#pragma unroll
            for (int i = 0; i < 16; ++i) { const float uu = us[s][i]; bur = fmaf(bbr[i], uu, bur); bui = fmaf(bbi[i], uu, bui); }
            const float nxr = ar * xr - ai * xi + bur, nxi = ar * xi + ai * xr + bui;
            xr = nxr; xi = nxi;
            float mine = 0.f;
#pragma unroll
            for (int j = 0; j < 16; ++j) { const float v = wave_sum(cr[j] * xr - ci[j] * xi); if (p == j) mine = v; }
            if (p < 16) yo[(size_t)(b * SEQ + t) * DM + g * 16 + p] = mine;
        }
    }
}
__global__ void gelu_comb_k(const float* __restrict__ u, const float* __restrict__ dskip, const float* __restrict__ y2, float* __restrict__ g1) {
    const size_t i = (size_t)blockIdx.x * 256 + threadIdx.x;
    const int c = (int)(i & (DM - 1));
    const float y = dskip[c] * u[i] + y2[i] + y2[i + (size_t)NTOK * DM];
    g1[i] = gelu_tanh(y);
}

__global__ void qknorm_rope_k(float* __restrict__ qkv, const float* __restrict__ qg, const float* __restrict__ kg) {
    const int w = blockIdx.x * 4 + (threadIdx.x >> 6), d = threadIdx.x & 63;
    const int tok = w / 20, hs = w % 20;
    float* p = qkv + (size_t)tok * QKVW + hs * 64;
    const float v = p[d];
    const float r = rsqrtf(wave_sum(v * v) * (1.f / 64.f) + EPS);
    const float y = v * r * (hs < 16 ? qg[d] : kg[d]);
    const float partner = __shfl_xor(y, 1);
    const int pos = tok % SEQ, i = d >> 1;
    const int f = i & 15;
    const float freq = powf(10000.f, -(float)(2 * f) / 32.f);
    const float ang = (float)(i < 16 ? pos / 64 : pos % 64) * freq;
    const float c = cosf(ang), s = sinf(ang);
    const float o = (d & 1) ? (partner * s + y * c) : (y * c - partner * s);
    p[d] = o;
}

__global__ __launch_bounds__(256) void attn_k(const float* __restrict__ qkv, float* __restrict__ o) {
    __shared__ float Qs[64][65], Ks[64][65], Vs[64][65];
    float (*Ps)[65] = Ks;
    const int qb = blockIdx.x, h = blockIdx.y, b = blockIdx.z, kvh = h >> 2;
    const int tid = threadIdx.x, tx = tid & 15, ty = tid >> 4;
    const size_t rowbase = (size_t)b * SEQ;
    for (int e = tid; e < 64 * 64; e += 256) { const int r = e >> 6, d = e & 63; Qs[r][d] = qkv[(rowbase + qb * 64 + r) * QKVW + h * 64 + d] * 0.125f; }
    float m[4], l[4], oacc[4][4];
#pragma unroll
    for (int i = 0; i < 4; ++i) { m[i] = -INFINITY; l[i] = 0.f;
#pragma unroll
        for (int j = 0; j < 4; ++j) oacc[i][j] = 0.f; }
    for (int kt = 0; kt < SEQ / 64; ++kt) {
        __syncthreads();
        for (int e = tid; e < 64 * 64; e += 256) { const int r = e >> 6, d = e & 63; const size_t rr = (rowbase + kt * 64 + r) * QKVW;
            Ks[r][d] = qkv[rr + 1024 + kvh * 64 + d]; Vs[r][d] = qkv[rr + 1280 + kvh * 64 + d]; }
        __syncthreads();
        float s[4][4];
#pragma unroll
        for (int i = 0; i < 4; ++i)
#pragma unroll
            for (int j = 0; j < 4; ++j) s[i][j] = 0.f;
        for (int d = 0; d < 64; ++d) {
            float a[4], k[4];
#pragma unroll
            for (int i = 0; i < 4; ++i) { a[i] = Qs[ty * 4 + i][d]; k[i] = Ks[tx * 4 + i][d]; }
#pragma unroll
            for (int i = 0; i < 4; ++i)
#pragma unroll
                for (int j = 0; j < 4; ++j) s[i][j] = fmaf(a[i], k[j], s[i][j]);
        }
        __syncthreads();
#pragma unroll
        for (int i = 0; i < 4; ++i) {
            float mx = fmaxf(fmaxf(s[i][0], s[i][1]), fmaxf(s[i][2], s[i][3]));
#pragma unroll
            for (int of = 1; of < 16; of <<= 1) mx = fmaxf(mx, __shfl_xor(mx, of));
            const float mn = fmaxf(m[i], mx);
            const float sc = __expf(m[i] - mn);
            float ps = 0.f;
#pragma unroll
            for (int j = 0; j < 4; ++j) { const float pp = __expf(s[i][j] - mn); Ps[ty * 4 + i][tx * 4 + j] = pp; ps += pp; }
#pragma unroll
            for (int of = 1; of < 16; of <<= 1) ps += __shfl_xor(ps, of);
            l[i] = l[i] * sc + ps; m[i] = mn;
#pragma unroll
            for (int j = 0; j < 4; ++j) oacc[i][j] *= sc;
        }
        __syncthreads();
        for (int k = 0; k < 64; ++k) {
            float pp[4], vv[4];
#pragma unroll
            for (int i = 0; i < 4; ++i) { pp[i] = Ps[ty * 4 + i][k]; vv[i] = Vs[k][tx * 4 + i]; }
#pragma unroll
            for (int i = 0; i < 4; ++i)
#pragma unroll
                for (int j = 0; j < 4; ++j) oacc[i][j] = fmaf(pp[i], vv[j], oacc[i][j]);
        }
    }
#pragma unroll
    for (int i = 0; i < 4; ++i) { const float inv = 1.f / l[i];
#pragma unroll
        for (int j = 0; j < 4; ++j) o[(rowbase + qb * 64 + ty * 4 + i) * DM + h * 64 + tx * 4 + j] = oacc[i][j] * inv; }
}

__global__ void router_k(const float* __restrict__ xn, const float* __restrict__ wr, int* __restrict__ cnt, int* __restrict__ lists, float* __restrict__ wlists) {
    const int tok = blockIdx.x * 4 + (threadIdx.x >> 6), lane = threadIdx.x & 63;
    float lg[8];
#pragma unroll
    for (int e = 0; e < 8; ++e) lg[e] = 0.f;
    for (int j = 0; j < 16; ++j) { const int d = lane + 64 * j; const float x = xn[(size_t)tok * DM + d];
        const float4 w0 = *(const float4*)(wr + d * 8), w1 = *(const float4*)(wr + d * 8 + 4);
        lg[0] = fmaf(x, w0.x, lg[0]); lg[1] = fmaf(x, w0.y, lg[1]); lg[2] = fmaf(x, w0.z, lg[2]); lg[3] = fmaf(x, w0.w, lg[3]);
        lg[4] = fmaf(x, w1.x, lg[4]); lg[5] = fmaf(x, w1.y, lg[5]); lg[6] = fmaf(x, w1.z, lg[6]); lg[7] = fmaf(x, w1.w, lg[7]); }
#pragma unroll
    for (int e = 0; e < 8; ++e) lg[e] = wave_sum(lg[e]);
    int e0 = 0; float l0 = lg[0];
#pragma unroll
    for (int e = 1; e < 8; ++e) if (lg[e] > l0) { l0 = lg[e]; e0 = e; }
    int e1 = -1; float l1 = -INFINITY;
#pragma unroll
    for (int e = 0; e < 8; ++e) if (e != e0 && lg[e] > l1) { l1 = lg[e]; e1 = e; }
    const float w0 = 1.f / (1.f + expf(l1 - l0)), w1 = 1.f - w0;
    if (lane == 0) {
        const int p0 = atomicAdd(&cnt[e0], 1); lists[e0 * NTOK + p0] = tok; wlists[e0 * NTOK + p0] = w0;
        const int p1 = atomicAdd(&cnt[e1], 1); lists[e1 * NTOK + p1] = tok; wlists[e1 * NTOK + p1] = w1;
    }
}

template <int EPI, bool GATHER>
static void gemm(hipStream_t st, const float* A, int lda, const float* W, int ldw, int M, int N, int K, EpiArgs ea) {
    hipLaunchKernelGGL((gemm_k<EPI, GATHER>), dim3(N / 128, M / 128), dim3(256), 0, st, A, lda, W, ldw, M, N, K, ea);
}

extern "C" void kernel_launch(void* const* d_in, const int* in_sizes, int n_in, void* d_out, int out_size, void* d_ws, size_t ws_size, hipStream_t stream) {
    if (n_in != 24 || ws_size < (size_t)448 * 1048576) return;
    const float* x = (const float*)d_in[0]; const float* gains = (const float*)d_in[1];
    const float* ssm_w_in = (const float*)d_in[2]; const float* lam_re = (const float*)d_in[3]; const float* lam_im = (const float*)d_in[4]; const float* log_step = (const float*)d_in[5];
    const float* b_re = (const float*)d_in[6]; const float* b_im = (const float*)d_in[7]; const float* c_re = (const float*)d_in[8]; const float* c_im = (const float*)d_in[9];
    const float* ssm_d = (const float*)d_in[10]; const float* w_glu = (const float*)d_in[11]; const float* ssm_w_out = (const float*)d_in[12];
    const float* ffn_g = (const float*)d_in[13]; const float* ffn_u = (const float*)d_in[14]; const float* ffn_d = (const float*)d_in[15];
    const float* w_qkv = (const float*)d_in[16]; const float* q_gain = (const float*)d_in[17]; const float* k_gain = (const float*)d_in[18]; const float* attn_wo = (const float*)d_in[19];
    const float* w_router = (const float*)d_in[20]; const float* moe_g = (const float*)d_in[21]; const float* moe_u = (const float*)d_in[22]; const float* moe_d = (const float*)d_in[23];
    float* h = (float*)d_out;
    char* ws = (char*)d_ws; const size_t MiB = 1048576;
    float* xn = (float*)(ws + 0 * MiB);
    float* mix = (float*)(ws + 384 * MiB);
    float* u = (float*)(ws + 64 * MiB); float* y2 = (float*)(ws + 128 * MiB); float* g1 = (float*)(ws + 256 * MiB); float* g2 = (float*)(ws + 320 * MiB);
    hipLaunchKernelGGL(rms_k, dim3(NTOK / 4), dim3(256), 0, stream, x, gains + 0 * DM, xn);
    gemm<0, false>(stream, xn, DM, ssm_w_in, DM, NTOK, DM, DM, EpiArgs{u, DM, nullptr, 0, nullptr, nullptr, nullptr});
    hipLaunchKernelGGL(s5_scan_k, dim3(NB * 64 * 2), dim3(64), 0, stream, u, lam_re, lam_im, log_step, b_re, b_im, c_re, c_im, y2);
    hipLaunchKernelGGL(gelu_comb_k, dim3(NTOK * DM / 256), dim3(256), 0, stream, u, ssm_d, y2, g1);
    gemm<1, false>(stream, g1, DM, w_glu, DM, NTOK, DM, DM, EpiArgs{g2, DM, g1, DM, nullptr, nullptr, nullptr});
    gemm<0, false>(stream, g2, DM, ssm_w_out, DM, NTOK, DM, DM, EpiArgs{mix, DM, nullptr, 0, nullptr, nullptr, nullptr});
    hipLaunchKernelGGL(resnorm_k, dim3(NTOK / 4), dim3(256), 0, stream, x, mix, gains + 1 * DM, gains + 2 * DM, h, xn);
    float* G = (float*)(ws + 64 * MiB);
    gemm<0, false>(stream, xn, DM, ffn_g, DFF, NTOK, DFF, DM, EpiArgs{G, DFF, nullptr, 0, nullptr, nullptr, nullptr});
    gemm<2, false>(stream, xn, DM, ffn_u, DFF, NTOK, DFF, DM, EpiArgs{G, DFF, G, DFF, nullptr, nullptr, nullptr});
    gemm<0, false>(stream, G, DFF, ffn_d, DM, NTOK, DM, DFF, EpiArgs{mix, DM, nullptr, 0, nullptr, nullptr, nullptr});
    hipLaunchKernelGGL(resnorm_k, dim3(NTOK / 4), dim3(256), 0, stream, h, mix, gains + 3 * DM, gains + 4 * DM, h, xn);
    float* qkv = (float*)(ws + 64 * MiB); float* ob = (float*)(ws + 160 * MiB);
    gemm<0, false>(stream, xn, DM, w_qkv, QKVW, NTOK, QKVW, DM, EpiArgs{qkv, QKVW, nullptr, 0, nullptr, nullptr, nullptr});
    hipLaunchKernelGGL(qknorm_rope_k, dim3(NTOK * 20 / 4), dim3(256), 0, stream, qkv, q_gain, k_gain);
    hipLaunchKernelGGL(attn_k, dim3(SEQ / 64, 16, NB), dim3(256), 0, stream, qkv, ob);
    gemm<0, false>(stream, ob, DM, attn_wo, DM, NTOK, DM, DM, EpiArgs{mix, DM, nullptr, 0, nullptr, nullptr, nullptr});
    hipLaunchKernelGGL(resnorm_k, dim3(NTOK / 4), dim3(256), 0, stream, h, mix, gains + 5 * DM, gains + 6 * DM, h, xn);
    float* Ge = (float*)(ws + 64 * MiB);
    float* ff = (float*)(ws + 288 * MiB);
    int* cnt = (int*)(ws + 352 * MiB); int* lists = (int*)(ws + 353 * MiB); float* wlists = (float*)(ws + 354 * MiB);
    hipMemsetAsync(cnt, 0, 64, stream);
    hipMemsetAsync(ff, 0, (size_t)NTOK * DM * 4, stream);
    hipLaunchKernelGGL(router_k, dim3(NTOK / 4), dim3(256), 0, stream, xn, w_router, cnt, lists, wlists);
    for (int e = 0; e < NEXP; ++e) {
        const int* le = lists + e * NTOK; const float* we = wlists + e * NTOK;
        gemm<0, true>(stream, xn, DM, moe_g + (size_t)e * DM * DFE, DFE, NTOK, DFE, DM, EpiArgs{Ge, DFE, nullptr, 0, le, we, cnt + e});
        gemm<2, true>(stream, xn, DM, moe_u + (size_t)e * DM * DFE, DFE, NTOK, DFE, DM, EpiArgs{Ge, DFE, Ge, DFE, le, we, cnt + e});
        gemm<3, false>(stream, Ge, DFE, moe_d + (size_t)e * DFE * DM, DM, NTOK, DM, DFE, EpiArgs{ff, DM, nullptr, 0, le, we, cnt + e});
    }
    hipLaunchKernelGGL(resnorm_k, dim3(NTOK / 4), dim3(256), 0, stream, h, ff, gains + 7 * DM, gains + 7 * DM, h, (float*)nullptr);
}
```

```cpp
#include <hip/hip_runtime.h>
#include <hip/hip_bf16.h>
#include <cstdio>
#include <cstdint>
#include <cmath>
#define CUT 0
#define DUPMASK 0
#define P0DUP 0
#define EXP_GATHER 0
#define MOE_WGM 4

namespace pg8 {
#define PG8_LAS __attribute__((address_space(3)))
typedef unsigned short bf16_t;
typedef short bf16x8 __attribute__((ext_vector_type(8)));
typedef float f32x4 __attribute__((ext_vector_type(4)));
typedef unsigned u32x4 __attribute__((ext_vector_type(4)));
typedef unsigned u32x2 __attribute__((ext_vector_type(2)));
typedef int v8i32 __attribute__((ext_vector_type(8)));
constexpr int BM = 256, BK = 64, HALF = 128, HTB = HALF * BK * 2  , STAGE_BYTES = 8 * HTB, NXCD = 8, WGM = 8;

__host__ __device__ __forceinline__ int lds_byte(int r, int c) { const int st = (r >> 4) * 2 + (c >> 5), rr = r & 15, cc = c & 31, ob = rr * 64 + cc * 2; return st * 1024 + (ob ^ (((ob >> 9) & 1) << 5)); }
__host__ __device__ __forceinline__ void stage_rc(int b, int& R, int& C) { const int st = b / 1024, sb = b % 1024, swz = sb ^ (((sb >> 9) & 1) << 5); R = (st >> 1) * 16 + swz / 64; C = (st & 1) * 32 + (swz % 64) / 2; }
__host__ __device__ __forceinline__ int perm32(int rho) { const int n = rho >> 4, i = rho & 15; return 8 * (i >> 2) + 4 * n + (i & 3); }

struct Unit { int pm, pn, kofs, nt, aux; };

struct StaticOrder {
    int nM, nN, nwg, G, c, wgm;
    __host__ __device__ void init(int nM_, int nN_, int G_, int c_, int wgm_ = WGM) { nM = nM_; nN = nN_; nwg = nM * nN; G = G_; c = c_; wgm = wgm_; }
    __host__ __device__ bool next(int i, Unit& u) const {
        const long L = (long)i * G + c; if (L >= nwg) return false;
        int wgid = (int)L; { const int q = nwg / NXCD, r = nwg % NXCD, xcd = wgid % NXCD, off = wgid / NXCD; wgid = (xcd < r ? xcd * (q + 1) : r * (q + 1) + (xcd - r) * q) + off; }
        const int nig = wgm * nN, gid = wgid / nig, fm = gid * wgm, gsz = (nM - fm) < wgm ? (nM - fm) : wgm;
        u.pm = fm + ((wgid % nig) % gsz); u.pn = (wgid % nig) / gsz; return true;
    }
};

__device__ __forceinline__ unsigned cvt_pk_bf16(float lo, float hi) { unsigned r; asm volatile("v_cvt_pk_bf16_f32 %0, %1, %2" : "=v"(r) : "v"(lo), "v"(hi)); return r; }
__device__ __forceinline__ float bf_lo(unsigned w) { return __uint_as_float(w << 16); }
__device__ __forceinline__ float bf_hi(unsigned w) { return __uint_as_float(w & 0xffff0000u); }
__device__ __forceinline__ float sigm(float x) { return __builtin_amdgcn_rcpf(1.f + __builtin_amdgcn_exp2f(-1.4426950408889634f * x)); }
__device__ __forceinline__ float gelu_t(float x) { return x * sigm(1.5957691216057308f * (x + 0.044715f * x * x * x)); }
#ifndef WT_STORES
#define WT_STORES 0
#endif
__device__ __forceinline__ void st16(void* p, const u32x4& v) {
#if WT_STORES
    asm volatile("global_store_dwordx4 %0, %1, off sc1\n\ts_nop 1" :: "v"(p), "v"(v) : "memory");
#else
    *(u32x4*)p = v;
#endif
}
__device__ __forceinline__ u32x4 pack8(const f32x4& a, const f32x4& b) { u32x4 w; w.x = cvt_pk_bf16(a[0], a[1]); w.y = cvt_pk_bf16(a[2], a[3]); w.z = cvt_pk_bf16(b[0], b[1]); w.w = cvt_pk_bf16(b[2], b[3]); return w; }

struct ProbPlain {
    const char* abase; const char* Bt; int K; unsigned ldaB, ldbB; size_t bstride; int pm_per_b; StaticOrder S;
    __device__ __forceinline__ bool next(int i, Unit& u) const { u.kofs = 0; u.nt = K / BK; u.aux = 0; return S.next(i, u); }
    __device__ __forceinline__ const char* bbase(const Unit& u) const { return Bt + (size_t)(u.pm / pm_per_b) * bstride + (size_t)u.pn * 256 * ldbB; }
    __device__ __forceinline__ void aoffs(const Unit& u, const int (&R)[2], unsigned (&off)[2][2]) const {
#pragma unroll
        for (int h = 0; h < 2; ++h)
#pragma unroll
            for (int i = 0; i < 2; ++i) off[h][i] = (unsigned)(u.pm * 256 + h * 128 + R[i]) * ldaB;
    }
};
struct ProbMoE {
    const char* abase; const char* Bt; int K; unsigned ldaB, ldbB; size_t bstride; StaticOrder S;
    const int* lists; volatile PG8_LAS int* misc; bool gather;
    __device__ __forceinline__ bool next(int i, Unit& u) const {
        if (gather) { u.kofs = 0; u.nt = K / BK; u.aux = 0; return S.next(i, u); }
        const int c = S.c, x = c & 7, y = c >> 3, first_rem = misc[10];
        const int pm = 64 * i + 8 * x + (y & 7);
        if (pm < first_rem) { u.pm = pm; u.pn = y >> 3; u.kofs = 0; u.nt = K / BK; u.aux = 0; return true; }
        if (64 * i != first_rem || c >= misc[11]) return false;
        const int parts = misc[9], j = c / parts, part = c - j * parts, ntp = (K / BK) / parts;
        u.pm = first_rem + (j >> 2); u.pn = j & 3; u.nt = ntp; u.kofs = part * ntp * BK * 2; u.aux = c + 1; return true;
    }
    __device__ __forceinline__ int expert(int pm) const { int e = 0;
#pragma unroll
        for (int j = 1; j < 8; ++j) e += (pm >= misc[j]) ? 1 : 0;
        return e; }
    __device__ __forceinline__ const char* bbase(const Unit& u) const { return Bt + (size_t)__builtin_amdgcn_readfirstlane(expert(u.pm)) * bstride + (size_t)u.pn * 256 * ldbB; }
    __device__ __forceinline__ void aoffs(const Unit& u, const int (&R)[2], unsigned (&off)[2][2]) const {
        if (gather) {
            const int e = expert(u.pm), t0 = misc[e], cnt = misc[16 + e];
#pragma unroll
            for (int h = 0; h < 2; ++h)
#pragma unroll
                for (int i = 0; i < 2; ++i) { const int pos = (u.pm - t0) * 256 + h * 128 + R[i]; const int tok = pos < cnt ? lists[e * 16384 + pos] : 0; off[h][i] = (unsigned)tok * ldaB; }
        } else {
#pragma unroll
            for (int h = 0; h < 2; ++h)
#pragma unroll
                for (int i = 0; i < 2; ++i) off[h][i] = (unsigned)(u.pm * 256 + h * 128 + R[i]) * ldaB;
        }
    }
};

struct EpiF32 {
    static constexpr bool PERM = false;
    float* C; int ldc;
    __device__ __forceinline__ void operator()(const f32x4 (&acc)[2][2][4][2], const Unit& u, int wr, int wc, int fr, int fq) const {
        const int row0 = u.pm * BM + wr * 64 + fr, col0 = u.pn * BM + wc * 32 + 4 * fq;
#pragma unroll
        for (int ai = 0; ai < 2; ++ai)
#pragma unroll
            for (int m = 0; m < 4; ++m) { float* rowp = C + (size_t)(row0 + ai * HALF + m * 16) * ldc + col0;
#pragma unroll
                for (int bj = 0; bj < 2; ++bj)
#pragma unroll
                    for (int n = 0; n < 2; ++n) { const f32x4 t_ = acc[ai][bj][m][n]; st16(rowp + bj * HALF + n * 16, __builtin_bit_cast(u32x4, t_)); } }
    }
};
struct EpiBf16 {
    static constexpr bool PERM = true;
    bf16_t* O; int ldc; float scale;
    __device__ __forceinline__ void operator()(const f32x4 (&acc)[2][2][4][2], const Unit& u, int wr, int wc, int fr, int fq) const {
        const int row0 = u.pm * BM + wr * 64 + fr, col0 = u.pn * BM + wc * 32 + 8 * fq;
#pragma unroll
        for (int ai = 0; ai < 2; ++ai)
#pragma unroll
            for (int m = 0; m < 4; ++m) { bf16_t* rowp = O + (size_t)(row0 + ai * HALF + m * 16) * ldc + col0;
#pragma unroll
                for (int bj = 0; bj < 2; ++bj) st16(rowp + bj * HALF, pack8(acc[ai][bj][m][0] * scale, acc[ai][bj][m][1] * scale)); }
    }
};
struct EpiMoeDown {
    static constexpr bool PERM = true;
    bf16_t* O; bf16_t* PART; float scale;
    __device__ __forceinline__ void operator()(const f32x4 (&acc)[2][2][4][2], const Unit& u, int wr, int wc, int fr, int fq) const {
        const int r0 = wr * 64 + fr, c0 = wc * 32 + 8 * fq;
        bf16_t* base = u.aux == 0 ? O + ((size_t)u.pm * BM * 1024 + (size_t)u.pn * BM) : PART + (size_t)(u.aux - 1) * 65536;
        const int ldo = u.aux == 0 ? 1024 : 256;
#pragma unroll
        for (int ai = 0; ai < 2; ++ai)
#pragma unroll
            for (int m = 0; m < 4; ++m) { bf16_t* rowp = base + (size_t)(r0 + ai * HALF + m * 16) * ldo + c0;
#pragma unroll
                for (int bj = 0; bj < 2; ++bj) st16(rowp + bj * HALF, pack8(acc[ai][bj][m][0] * scale, acc[ai][bj][m][1] * scale)); }
    }
};
__device__ __forceinline__ unsigned pack4_fp8(float a, float b, float c, float d) {
    a = __builtin_amdgcn_fmed3f(a, -448.f, 448.f); b = __builtin_amdgcn_fmed3f(b, -448.f, 448.f); c = __builtin_amdgcn_fmed3f(c, -448.f, 448.f); d = __builtin_amdgcn_fmed3f(d, -448.f, 448.f);
    int w = __builtin_amdgcn_cvt_pk_fp8_f32(a, b, 0, false); w = __builtin_amdgcn_cvt_pk_fp8_f32(c, d, w, true); return (unsigned)w; }
struct EpiSwigluF8 {
    static constexpr bool PERM = true;
    unsigned char* O; int ldc; float sin, sout;
    __device__ __forceinline__ void operator()(const f32x4 (&acc)[2][2][4][2], const Unit& u, int wr, int wc, int fr, int fq) const {
        const int row0 = u.pm * BM + wr * 64 + fr, col0 = u.pn * HALF + wc * 32 + 8 * fq;
        const float c1 = -1.4426950408889634f * sin, kk = 1.f / (sin * sin * sout);
#pragma unroll
        for (int ai = 0; ai < 2; ++ai)
#pragma unroll
            for (int m = 0; m < 4; ++m) { f32x4 a, b;
#pragma unroll
                for (int e = 0; e < 4; ++e) {
                    const float g0 = acc[ai][0][m][0][e], g1 = acc[ai][0][m][1][e];
                    const float e0 = __builtin_amdgcn_exp2f(g0 * c1), e1 = __builtin_amdgcn_exp2f(g1 * c1);
                    a[e] = (g0 * acc[ai][1][m][0][e]) * __builtin_amdgcn_rcpf(__builtin_fmaf(e0, kk, kk)); b[e] = (g1 * acc[ai][1][m][1][e]) * __builtin_amdgcn_rcpf(__builtin_fmaf(e1, kk, kk)); }
                u32x2 w; w.x = pack4_fp8(a[0], a[1], a[2], a[3]); w.y = pack4_fp8(b[0], b[1], b[2], b[3]);
                *(u32x2*)(O + (size_t)(row0 + ai * HALF + m * 16) * ldc + col0) = w; }
    }
};
struct EpiU {
    static constexpr bool PERM = true;
    bf16_t* A2;
    __device__ __forceinline__ void operator()(const f32x4 (&acc)[2][2][4][2], const Unit& u, int wr, int wc, int fr, int fq) const {
        const int row0 = u.pm * BM + wr * 64 + fr, col0 = u.pn * BM + wc * 32 + 8 * fq;
#pragma unroll
        for (int ai = 0; ai < 2; ++ai)
#pragma unroll
            for (int m = 0; m < 4; ++m) { const int row = row0 + ai * HALF + m * 16, c = row >> 4, t = row & 15;
#pragma unroll
                for (int bj = 0; bj < 2; ++bj) { const int col = col0 + bj * HALF, g = col >> 4, i0 = col & 15;
                    st16(A2 + ((size_t)(g * 1024 + c) * 512 + t * 16 + i0), pack8(acc[ai][bj][m][0], acc[ai][bj][m][1])); } }
    }
};
struct EpiY {
    static constexpr bool PERM = true;
    bf16_t* G1;
    __device__ __forceinline__ void operator()(const f32x4 (&acc)[2][2][4][2], const Unit& u, int wr, int wc, int fr, int fq) const {
        const int row0 = u.pm * BM + wr * 64 + fr, col0 = wc * 32 + 8 * fq;
#pragma unroll
        for (int ai = 0; ai < 2; ++ai)
#pragma unroll
            for (int m = 0; m < 4; ++m) { const int row = row0 + ai * HALF + m * 16, g = row >> 10, c = row & 1023;
#pragma unroll
                for (int bj = 0; bj < 2; ++bj) { const int col = col0 + bj * HALF, t = col >> 4, j0 = col & 15;
                    f32x4 a = acc[ai][bj][m][0], b = acc[ai][bj][m][1];
#pragma unroll
                    for (int e = 0; e < 4; ++e) { a[e] = gelu_t(a[e]); b[e] = gelu_t(b[e]); }
                    st16(G1 + ((size_t)(c * 16 + t) * 1024 + g * 16 + j0), pack8(a, b)); } }
    }
};
struct EpiGlu {
    static constexpr bool PERM = true;
    const bf16_t* G1; bf16_t* G2;
    __device__ __forceinline__ void operator()(const f32x4 (&acc)[2][2][4][2], const Unit& u, int wr, int wc, int fr, int fq) const {
        const int row0 = u.pm * BM + wr * 64 + fr, col0 = u.pn * BM + wc * 32 + 8 * fq;
#pragma unroll
        for (int ai = 0; ai < 2; ++ai)
#pragma unroll
            for (int m = 0; m < 4; ++m) { const size_t ro = (size_t)(row0 + ai * HALF + m * 16) * 1024 + col0;
#pragma unroll
                for (int bj = 0; bj < 2; ++bj) { const u32x4 gv = *(const u32x4*)(G1 + ro + bj * HALF);
                    f32x4 a = acc[ai][bj][m][0], b = acc[ai][bj][m][1];
                    a[0] = bf_lo(gv.x) * sigm(a[0]); a[1] = bf_hi(gv.x) * sigm(a[1]); a[2] = bf_lo(gv.y) * sigm(a[2]); a[3] = bf_hi(gv.y) * sigm(a[3]);
                    b[0] = bf_lo(gv.z) * sigm(b[0]); b[1] = bf_hi(gv.z) * sigm(b[1]); b[2] = bf_lo(gv.w) * sigm(b[2]); b[3] = bf_hi(gv.w) * sigm(b[3]);
                    st16(G2 + ro + bj * HALF, pack8(a, b)); } }
    }
};
struct EpiSwiglu {
    static constexpr bool PERM = true;
    bf16_t* O; int ldc;
    __device__ __forceinline__ void operator()(const f32x4 (&acc)[2][2][4][2], const Unit& u, int wr, int wc, int fr, int fq) const {
        const int row0 = u.pm * BM + wr * 64 + fr, col0 = u.pn * HALF + wc * 32 + 8 * fq;
#pragma unroll
        for (int ai = 0; ai < 2; ++ai)
#pragma unroll
            for (int m = 0; m < 4; ++m) { f32x4 a, b;
#pragma unroll
                for (int e = 0; e < 4; ++e) { const float g0 = acc[ai][0][m][0][e], g1 = acc[ai][0][m][1][e]; a[e] = g0 * sigm(g0) * acc[ai][1][m][0][e]; b[e] = g1 * sigm(g1) * acc[ai][1][m][1][e]; }
                st16(O + (size_t)(row0 + ai * HALF + m * 16) * ldc + col0, pack8(a, b)); }
    }
};
struct EpiQKV {
    static constexpr bool PERM = true;
    bf16_t* base; unsigned koff, voff; const float* gtab; const float4* rope; float qscale;
    __device__ __forceinline__ void operator()(const f32x4 (&acc)[2][2][4][2], const Unit& u, int wr, int wc, int fr, int fq) const {
        const int row0 = u.pm * BM + wr * 64 + fr, pn = u.pn;
        const float* gain = gtab + (pn < 4 ? 0 : 64) + 8 * fq;
        const float sc = pn < 4 ? qscale : 1.f;
        const unsigned tbase = pn < 4 ? (unsigned)((4 * pn + wc) * 64) : (pn == 4 ? koff : voff) + (unsigned)(wc * 64);
        const int ldo = pn < 4 ? 1024 : 256;
#pragma unroll
        for (int ai = 0; ai < 2; ++ai)
#pragma unroll
            for (int m = 0; m < 4; ++m) { const int row = row0 + ai * HALF + m * 16;
                bf16_t* dst = base + ((size_t)tbase + (size_t)row * ldo + 8 * fq);
                if (pn < 5) {
                    float ss = 0.f;
#pragma unroll
                    for (int bj = 0; bj < 2; ++bj)
#pragma unroll
                        for (int n = 0; n < 2; ++n) { const f32x4 v = acc[ai][bj][m][n]; ss += (v[0] * v[0] + v[1] * v[1]) + (v[2] * v[2] + v[3] * v[3]); }
                    ss += __shfl_xor(ss, 16); ss += __shfl_xor(ss, 32);
                    const float r = rsqrtf(ss * (1.f / 64.f) + 1e-6f);
                    const int pos = row & 8191;
                    const float4* t0 = rope + (pos >> 6) * 8 + 2 * fq; const float4* t1 = rope + 1024 + (pos & 63) * 8 + 2 * fq;
#pragma unroll
                    for (int bj = 0; bj < 2; ++bj) { f32x4 o[2];
#pragma unroll
                        for (int n = 0; n < 2; ++n) { const float4 cs = bj == 0 ? t0[n] : t1[n]; const f32x4 g = *(const f32x4*)(gain + 32 * bj + 4 * n); const f32x4 v = acc[ai][bj][m][n];
                            const float x0 = v[0] * r * g[0], x1 = v[1] * r * g[1], x2 = v[2] * r * g[2], x3 = v[3] * r * g[3];
                            o[n][0] = (x0 * cs.x - x1 * cs.y) * sc; o[n][1] = (x0 * cs.y + x1 * cs.x) * sc; o[n][2] = (x2 * cs.z - x3 * cs.w) * sc; o[n][3] = (x2 * cs.w + x3 * cs.z) * sc; }
                        st16(dst + 32 * bj, pack8(o[0], o[1])); }
                } else {
#pragma unroll
                    for (int bj = 0; bj < 2; ++bj) st16(dst + 32 * bj, pack8(acc[ai][bj][m][0], acc[ai][bj][m][1]));
                }
                asm volatile("" ::: "memory"); }
    }
};

typedef int v4i32 __attribute__((ext_vector_type(4)));
template <bool F8> struct Frag;
template <> struct Frag<false> { u32x4 k[2]; };
template <> struct Frag<true> { v8i32 v; };
template <class Prob, class Epi, bool ALIGN_EPI = false, bool SP2 = false, bool FP8 = false>
__device__ __forceinline__ void gemm_phase(PG8_LAS unsigned char* lds, const Prob& P, const Epi& E) {
    const int tid = threadIdx.x, wid = __builtin_amdgcn_readfirstlane(tid >> 6), lane = tid & 63, wr = wid >> 2, wc = wid & 3, fr = lane & 15, fq = lane >> 4;
    int Rr[2]; unsigned cof[2], voffB[2];
#pragma unroll
    for (int i = 0; i < 2; ++i) { int R, C; stage_rc(tid * 16 + i * 8192, R, C); const int Rb = Epi::PERM ? ((R & ~31) + perm32(R & 31)) : R;
        Rr[i] = R; cof[i] = (unsigned)C * 2u; voffB[i] = (unsigned)Rb * P.ldbB + (unsigned)C * 2u; }
    const size_t kstep = (size_t)(BK * 2);
    const size_t hstepB = (size_t)HALF * P.ldbB;
    const unsigned ldsw = (unsigned)wid * 1024u;
    const int aoff = FP8 ? lds_byte(wr * 64 + fr, fq * 16) : lds_byte(wr * 64 + fr, fq * 8), boff = FP8 ? lds_byte(wc * 32 + fr, fq * 16) : lds_byte(wc * 32 + fr, fq * 8);

#define PG8_SA(b, h) (((b) * 2 + (h)) * HTB)
#define PG8_SB(b, h) ((4 + (b) * 2 + (h)) * HTB)
#define PG8_STAGE(bufoff, gbase, voff) do { _Pragma("unroll") for (int _i = 0; _i < 2; ++_i) \
        __builtin_amdgcn_global_load_lds((const unsigned*)((const char*)(gbase) + (voff)[_i]), (PG8_LAS unsigned*)(lds + (bufoff) + ldsw + _i * 8192), 16, 0, 0); } while (0)
#define PG8_LD1(dst, addr) do { if constexpr (FP8) { const v4i32 lo_ = *(const PG8_LAS v4i32*)(addr), hi_ = *(const PG8_LAS v4i32*)((addr) + 16); (dst).v = __builtin_shufflevector(lo_, hi_, 0, 1, 2, 3, 4, 5, 6, 7); } \
        else { _Pragma("unroll") for (int k = 0; k < 2; ++k) (dst).k[k] = *(const PG8_LAS u32x4*)((addr) + k * 1024); } } while (0)
#define PG8_LDA(dst, b, h) do { _Pragma("unroll") for (int m = 0; m < 4; ++m) PG8_LD1(dst[m], lds + PG8_SA(b, h) + aoff + m * 2048); } while (0)
#define PG8_LDB(dst, b, h) do { _Pragma("unroll") for (int n = 0; n < 2; ++n) PG8_LD1(dst[n], lds + PG8_SB(b, h) + boff + n * 2048); } while (0)
#define PG8_MMA(ai, bj, At, Bt) do { __builtin_amdgcn_s_setprio(1); _Pragma("unroll") for (int m = 0; m < 4; ++m) _Pragma("unroll") for (int n = 0; n < 2; ++n) { \
        if constexpr (FP8) asm volatile("v_mfma_scale_f32_16x16x128_f8f6f4 %0, %1, %2, %0, %3, %3 op_sel_hi:[0,0,0]" : "+v"(acc[ai][bj][m][n]) : "v"(Bt[n].v), "v"(At[m].v), "v"(f8scale_)); \
        else { _Pragma("unroll") for (int k = 0; k < 2; ++k) acc[ai][bj][m][n] = __builtin_amdgcn_mfma_f32_16x16x32_bf16(__builtin_bit_cast(bf16x8, Bt[n].k[k]), __builtin_bit_cast(bf16x8, At[m].k[k]), acc[ai][bj][m][n], 0, 0, 0); } } \
        __builtin_amdgcn_s_setprio(0); } while (0)
#define PG8_WAIT_V(n) asm volatile("s_waitcnt vmcnt(" #n ")" ::: "memory")
#define PG8_WAIT_L(n) asm volatile("s_waitcnt lgkmcnt(" #n ")" ::: "memory")
#define PG8_BAR __builtin_amdgcn_s_barrier()
#define PG8_SCHED __builtin_amdgcn_sched_barrier(0)
    const int f8scale_ = 0x7f7f7f7f;
    Unit cur, nxt; int ui = 0;
    if (!P.next(0, cur)) return;
    f32x4 acc[2][2][4][2];
#pragma unroll
    for (int a = 0; a < 2; ++a)
#pragma unroll
        for (int b = 0; b < 2; ++b)
#pragma unroll
            for (int m = 0; m < 4; ++m)
#pragma unroll
                for (int n = 0; n < 2; ++n) acc[a][b][m][n] = (f32x4){0.f, 0.f, 0.f, 0.f};
    Frag<FP8> At[4], B0[2], B1[2];
    unsigned voC[2][2], voN[2][2];
    P.aoffs(cur, Rr, voC);
#pragma unroll
    for (int h = 0; h < 2; ++h)
#pragma unroll
        for (int i = 0; i < 2; ++i) voC[h][i] += cof[i] + (unsigned)cur.kofs;
    const char* const aB = P.abase; const char* cB = P.bbase(cur) + cur.kofs;
    if constexpr (SP2) {
        PG8_STAGE(PG8_SB(0, 0), cB, voffB); PG8_STAGE(PG8_SB(0, 1), cB + hstepB, voffB); PG8_STAGE(PG8_SA(0, 0), aB, voC[0]); PG8_STAGE(PG8_SA(0, 1), aB, voC[1]);
        if (wr == 1) PG8_BAR;
        PG8_WAIT_V(2); PG8_BAR;
        PG8_STAGE(PG8_SB(1, 0), cB + kstep, voffB); PG8_STAGE(PG8_SA(1, 0), aB + kstep, voC[0]); PG8_STAGE(PG8_SB(1, 1), cB + hstepB + kstep, voffB);
        PG8_WAIT_V(6); PG8_BAR;
    } else {
        PG8_STAGE(PG8_SB(0, 0), cB, voffB); PG8_STAGE(PG8_SA(0, 0), aB, voC[0]); PG8_STAGE(PG8_SB(0, 1), cB + hstepB, voffB); PG8_STAGE(PG8_SA(0, 1), aB, voC[1]);
        if (wr == 1) PG8_BAR;
        PG8_WAIT_V(4); PG8_BAR;
        PG8_STAGE(PG8_SB(1, 0), cB + kstep, voffB); PG8_STAGE(PG8_SA(1, 0), aB + kstep, voC[0]); PG8_STAGE(PG8_SB(1, 1), cB + hstepB + kstep, voffB);
        PG8_WAIT_V(6); PG8_BAR;
    }
    for (;;) {
        const bool has_next = P.next(ui + 1, nxt);
        if (has_next) { P.aoffs(nxt, Rr, voN);
#pragma unroll
            for (int h = 0; h < 2; ++h)
#pragma unroll
                for (int i = 0; i < 2; ++i) voN[h][i] += cof[i] + (unsigned)nxt.kofs; }
        else {
#pragma unroll
            for (int h = 0; h < 2; ++h)
#pragma unroll
                for (int i = 0; i < 2; ++i) voN[h][i] = voC[h][i]; }
        const char* nB = has_next ? P.bbase(nxt) + nxt.kofs : cB;
        const int nt = cur.nt;
        for (int t = 0; t < nt; t += 2) {
            const bool last = (t == nt - 2);
            const char* a1 = aB + (size_t)(t + 1) * kstep;
            const char* a2 = last ? aB : aB + (size_t)(t + 2) * kstep; const char* b2 = last ? nB : cB + (size_t)(t + 2) * kstep;
            const char* a3 = a2 + kstep; const char* b3 = b2 + kstep;
            unsigned vo2[2][2];
#pragma unroll
            for (int h = 0; h < 2; ++h)
#pragma unroll
                for (int i = 0; i < 2; ++i) vo2[h][i] = last ? voN[h][i] : voC[h][i];
            if constexpr (SP2) {
            PG8_LDB(B0, 0, 0); PG8_LDB(B1, 0, 1); PG8_SCHED; PG8_LDA(At, 0, 0); PG8_STAGE(PG8_SA(1, 1), a1, voC[1]);
            PG8_WAIT_V(8); PG8_WAIT_L(0); PG8_BAR; PG8_MMA(0, 0, At, B0); PG8_MMA(0, 1, At, B1); PG8_BAR; PG8_SCHED;
            PG8_LDA(At, 0, 1); PG8_STAGE(PG8_SB(0, 0), b2, voffB); PG8_STAGE(PG8_SB(0, 1), b2 + hstepB, voffB); PG8_STAGE(PG8_SA(0, 0), a2, vo2[0]);
            PG8_WAIT_V(8); PG8_WAIT_L(0); PG8_BAR; PG8_MMA(1, 0, At, B0); PG8_MMA(1, 1, At, B1); PG8_BAR; PG8_SCHED;
            PG8_LDB(B0, 1, 0); PG8_LDB(B1, 1, 1); PG8_SCHED; PG8_LDA(At, 1, 0); PG8_STAGE(PG8_SA(0, 1), a2, vo2[1]);
            PG8_WAIT_V(8); PG8_WAIT_L(0); PG8_BAR; PG8_MMA(0, 0, At, B0); PG8_MMA(0, 1, At, B1); PG8_BAR; PG8_SCHED;
            PG8_LDA(At, 1, 1); PG8_STAGE(PG8_SB(1, 0), b3, voffB); PG8_STAGE(PG8_SB(1, 1), b3 + hstepB, voffB); PG8_STAGE(PG8_SA(1, 0), a3, vo2[0]);
            PG8_WAIT_V(8); PG8_WAIT_L(0); PG8_BAR; PG8_MMA(1, 0, At, B0); PG8_MMA(1, 1, At, B1); PG8_BAR; PG8_SCHED;
            } else {
            PG8_LDB(B0, 0, 0); PG8_SCHED; PG8_LDA(At, 0, 0); PG8_STAGE(PG8_SA(1, 1), a1, voC[1]);
            PG8_WAIT_L(8); PG8_BAR; PG8_WAIT_L(0); PG8_MMA(0, 0, At, B0); PG8_BAR; PG8_SCHED;
            PG8_LDB(B1, 0, 1); PG8_STAGE(PG8_SB(0, 0), b2, voffB);
            PG8_BAR; PG8_WAIT_L(0); PG8_MMA(0, 1, At, B1); PG8_BAR;
            PG8_LDA(At, 0, 1); PG8_STAGE(PG8_SA(0, 0), a2, vo2[0]);
            PG8_BAR; PG8_WAIT_L(0); PG8_MMA(1, 0, At, B0); PG8_BAR; PG8_SCHED;
            PG8_STAGE(PG8_SB(0, 1), b2 + hstepB, voffB);
            PG8_WAIT_V(6); PG8_BAR; PG8_MMA(1, 1, At, B1); PG8_BAR;
            PG8_LDB(B0, 1, 0); PG8_SCHED; PG8_LDA(At, 1, 0); PG8_STAGE(PG8_SA(0, 1), a2, vo2[1]);
            PG8_WAIT_L(8); PG8_BAR; PG8_WAIT_L(0); PG8_MMA(0, 0, At, B0); PG8_BAR; PG8_SCHED;
            PG8_LDB(B1, 1, 1); PG8_STAGE(PG8_SB(1, 0), b3, voffB);
            PG8_BAR; PG8_WAIT_L(0); PG8_MMA(0, 1, At, B1); PG8_BAR;
            PG8_LDA(At, 1, 1); PG8_STAGE(PG8_SA(1, 0), a3, vo2[0]);
            PG8_BAR; PG8_WAIT_L(0); PG8_MMA(1, 0, At, B0); PG8_BAR; PG8_SCHED;
            PG8_STAGE(PG8_SB(1, 1), b3 + hstepB, voffB);
            PG8_WAIT_V(6); PG8_BAR; PG8_MMA(1, 1, At, B1); PG8_BAR;
            }
        }
        if constexpr (ALIGN_EPI) { if (wr == 0) PG8_BAR; }
        if constexpr (FP8) asm volatile("s_nop 15\n\ts_nop 15" ::: "memory");
        E(acc, cur, wr, wc, fr, fq);
#if defined(EPI_TWICE) && EPI_TWICE
        if constexpr (FP8) { asm volatile("" ::: "memory"); E(acc, cur, wr, wc, fr, fq); }
#endif
        if (!has_next) break;
#pragma unroll
        for (int a = 0; a < 2; ++a)
#pragma unroll
            for (int b = 0; b < 2; ++b)
#pragma unroll
                for (int m = 0; m < 4; ++m)
#pragma unroll
                    for (int n = 0; n < 2; ++n) acc[a][b][m][n] = (f32x4){0.f, 0.f, 0.f, 0.f};
        cur = nxt; cB = nB; ++ui;
#pragma unroll
        for (int h = 0; h < 2; ++h)
#pragma unroll
            for (int i = 0; i < 2; ++i) voC[h][i] = voN[h][i];
        if constexpr (ALIGN_EPI) { if (wr == 1) PG8_BAR; }
    }
    PG8_WAIT_V(0);
    if constexpr (!ALIGN_EPI) { if (wr == 0) PG8_BAR; }
    PG8_BAR;
#undef PG8_SA
#undef PG8_SB
#undef PG8_STAGE
#undef PG8_LD1
#undef PG8_LDA
#undef PG8_LDB
#undef PG8_MMA
#undef PG8_WAIT_V
#undef PG8_WAIT_L
#undef PG8_BAR
#undef PG8_SCHED
}
}

#include <hip/hip_bf16.h>
#include <cmath>
namespace attn_body {
using bf16=__hip_bfloat16;
using bf16x8=__attribute__((ext_vector_type(8)))short;
using s16x4=__attribute__((ext_vector_type(4)))short;
using f32x16=__attribute__((ext_vector_type(16)))float;
using u32x4=__attribute__((ext_vector_type(4)))unsigned;
constexpr int BATCH=2,NHEAD=16,SEQ=8192,D=64,DM=NHEAD*D,KVP=256;
constexpr int NW=8,QBLK=32,QB=QBLK*NW,KVBLK=64,NQB=SEQ/QB;
constexpr int ATTN_PITCH=DM, ATTN_UNIT_ROWS=QB;
__device__ __forceinline__ int crow(int r,int hi){return (r&3)+8*(r>>2)+4*hi;}
#define SBAR() __builtin_amdgcn_sched_barrier(0)
__device__ __forceinline__ void cmask(f32x16&p0,f32x16&p1,int jb,int qrel,int hi){
  const float NEG=-INFINITY; int kb=64*jb+4*hi;
  #pragma unroll
  for(int r=0;r<16;++r){int kv=kb+(r&3)+8*(r>>2); if(kv>qrel)p0[r]=NEG; if(kv+32>qrel)p1[r]=NEG;}
}

constexpr int NSLOT=3, SLOTB=8192;
constexpr int LDS_K=0, LDS_V=NSLOT*SLOTB, LDS_WS=2*NSLOT*SLOTB, LDS_OST=LDS_WS+NW*64*4, LDS_BYTES=LDS_OST+NW*4096;
constexpr float C2=0.125f*1.4426950408889634f;
__device__ __forceinline__ void glds16(const void*gsrc,unsigned lds_dst){unsigned keep;
  asm volatile("s_mov_b32 %0, m0\n\ts_mov_b32 m0, %2\n\ts_nop 0\n\tglobal_load_lds_dwordx4 %1, off\n\ts_mov_b32 m0, %0":"=&s"(keep):"v"(gsrc),"s"(lds_dst):"memory");}
__device__ __forceinline__ float max3f(float a,float b,float c){float r;asm("v_max3_f32 %0, %1, %2, %3":"=v"(r):"v"(a),"v"(b),"v"(c));return r;}
__device__ __forceinline__ float max2f(float a,float b){float r;asm("v_max_f32_e32 %0, %1, %2":"=v"(r):"v"(a),"v"(b));return r;}
__device__ __forceinline__ float fadd_s(float a,float b){float r;asm("v_add_f32_e32 %0, %1, %2":"=v"(r):"v"(a),"v"(b));return r;}
__device__ __forceinline__ float fsub_s(float a,float b){float r;asm("v_sub_f32_e32 %0, %1, %2":"=v"(r):"v"(a),"v"(b));return r;}
typedef float f32x2_t __attribute__((ext_vector_type(2))); typedef __bf16 bf16x2_t __attribute__((ext_vector_type(2)));
__device__ __forceinline__ unsigned cvtpk_s(float lo,float hi){f32x2_t v={lo,hi};bf16x2_t b=__builtin_convertvector(v,bf16x2_t);return __builtin_bit_cast(unsigned,b);}
#define WAIT_BAR(N) asm volatile("s_waitcnt vmcnt(" #N ") lgkmcnt(0)\n\ts_barrier":::"memory")

__device__ __forceinline__ void qkt(f32x16&p0,f32x16&p1,const char*Kslot,const bf16x8*qr,const f32x16&negm,int r32,int hi){
  const char*kb=Kslot+hi*1024+r32*16;
  #pragma unroll
  for(int d0=0;d0<4;++d0){
    const bf16x8 b0=*reinterpret_cast<const bf16x8*>(kb+d0*2048);
    const bf16x8 b1=*reinterpret_cast<const bf16x8*>(kb+d0*2048+512);
    if(d0==0){p0=__builtin_amdgcn_mfma_f32_32x32x16_bf16(b0,qr[0],negm,0,0,0);p1=__builtin_amdgcn_mfma_f32_32x32x16_bf16(b1,qr[0],negm,0,0,0);}
    else{p0=__builtin_amdgcn_mfma_f32_32x32x16_bf16(b0,qr[d0],p0,0,0,0);p1=__builtin_amdgcn_mfma_f32_32x32x16_bf16(b1,qr[d0],p1,0,0,0);}}
}
typedef __attribute__((address_space(3))) const char* lds_cptr;
typedef short v4i16_t __attribute__((ext_vector_type(4)));
__device__ __forceinline__ void kload8(bf16x8*kf,lds_cptr kp){
  kf[0]=*(const __attribute__((address_space(3))) bf16x8*)(kp);      kf[1]=*(const __attribute__((address_space(3))) bf16x8*)(kp+512);
  kf[2]=*(const __attribute__((address_space(3))) bf16x8*)(kp+2048); kf[3]=*(const __attribute__((address_space(3))) bf16x8*)(kp+2560);
  kf[4]=*(const __attribute__((address_space(3))) bf16x8*)(kp+4096); kf[5]=*(const __attribute__((address_space(3))) bf16x8*)(kp+4608);
  kf[6]=*(const __attribute__((address_space(3))) bf16x8*)(kp+6144); kf[7]=*(const __attribute__((address_space(3))) bf16x8*)(kp+6656);
}
__device__ __forceinline__ void kload2(bf16x8*kf,lds_cptr kp,int j){ kf[2*j]=*(const __attribute__((address_space(3))) bf16x8*)(kp+j*2048); kf[2*j+1]=*(const __attribute__((address_space(3))) bf16x8*)(kp+j*2048+512); }
__device__ __forceinline__ s16x4 vtr(lds_cptr p){ return __builtin_bit_cast(s16x4,__builtin_amdgcn_ds_read_tr16_b64_v4i16((__attribute__((address_space(3))) v4i16_t*)p)); }
__device__ __forceinline__ float rowmax(const f32x16&p0,const f32x16&p1){
  float a=max3f(p0[0],p0[1],p1[0]),b=max3f(p0[2],p0[3],p1[1]);a=max3f(a,p1[2],p1[3]);
  #pragma unroll
  for(int r=4;r<16;r+=4){a=max3f(a,p0[r],p0[r+1]);b=max3f(b,p0[r+2],p0[r+3]);a=max3f(a,p1[r],p1[r+1]);b=max3f(b,p1[r+2],p1[r+3]);}
  const float m=max2f(a,b);
  auto rr=__builtin_amdgcn_permlane32_swap(__float_as_uint(m),__float_as_uint(m),false,false);
  return max2f(__uint_as_float(rr[0]),__uint_as_float(rr[1]));
}
__device__ __forceinline__ void pv(f32x16*o,int vb,bf16x8 pa0,bf16x8 pa1,bf16x8 pa2,bf16x8 pa3){
  #pragma unroll
  for(int d0=0;d0<2;++d0){s16x4 lo[4],hi[4];
    #pragma unroll
    for(int ks=0;ks<4;++ks){
      asm volatile("ds_read_b64_tr_b16 %0,%1 offset:%c2":"=&v"(lo[ks]):"v"(vb),"i"(d0*4096+ks*1024):"memory");
      asm volatile("ds_read_b64_tr_b16 %0,%1 offset:%c2":"=&v"(hi[ks]):"v"(vb),"i"(d0*4096+ks*1024+512):"memory");}
    asm volatile("s_waitcnt lgkmcnt(0)":::"memory");SBAR();
    #define PK(k) (bf16x8){lo[k][0],lo[k][1],lo[k][2],lo[k][3],hi[k][0],hi[k][1],hi[k][2],hi[k][3]}
    o[d0]=__builtin_amdgcn_mfma_f32_32x32x16_bf16(pa0,PK(0),o[d0],0,0,0);
    o[d0]=__builtin_amdgcn_mfma_f32_32x32x16_bf16(pa1,PK(1),o[d0],0,0,0);
    o[d0]=__builtin_amdgcn_mfma_f32_32x32x16_bf16(pa2,PK(2),o[d0],0,0,0);
    o[d0]=__builtin_amdgcn_mfma_f32_32x32x16_bf16(pa3,PK(3),o[d0],0,0,0);
    #undef PK
  }
}

#ifndef ATTN_STORE16
#define ATTN_STORE16(p,v) pg8::st16((void*)(p),(v))
#endif
template<int THRL,bool FIX> __device__ __forceinline__ void attn_unit(float refB,int b,int h,int kvh,int qb,const bf16*Q,const bf16*__restrict__ K,const bf16*__restrict__ V,bf16*O,char*shm){
  const int tid=threadIdx.x,lane=tid&63,r32=lane&31,hi=lane>>5; const int wid=__builtin_amdgcn_readfirstlane(tid>>6);
  const long rowbase=(long)b*SEQ; const int q0=qb*QB;
  const bf16*Qw=Q+(rowbase+q0+wid*QBLK)*DM+h*D;
  const bf16*Kh=K+rowbase*KVP+kvh*D,*Vh=V+rowbase*KVP+kvh*D;
  const unsigned lds0=(unsigned)(uintptr_t)shm;
  float*wsf=(float*)(shm+LDS_WS)+wid*64;
  const bf16*ksrc=Kh+(long)lane*KVP+wid*8;
  const bf16*vsrc=Vh+(long)(16*(wid&3)+(lane>>2))*KVP+(wid>>2)*32+(lane&3)*8;
  const unsigned kdst=lds0+LDS_K+wid*1024, vdst=lds0+LDS_V+wid*1024;
  #define DMA_K(t,slot) glds16(ksrc+(long)(t)*KVBLK*KVP,(unsigned)__builtin_amdgcn_readfirstlane(kdst+(slot)))
  #define DMA_V(t,slot) glds16(vsrc+(long)(t)*KVBLK*KVP,(unsigned)__builtin_amdgcn_readfirstlane(vdst+(slot)))
  const int vb0=(int)(lds0+LDS_V)+((lane>>4)&1)*32+(lane&3)*8+(4*hi+((lane&15)>>2))*64;
  const char*Kbase=shm+LDS_K; bf16x8 kf[8];
  const lds_cptr shm3=(lds_cptr)shm; const lds_cptr kp0=shm3+LDS_K+hi*1024+r32*16; const lds_cptr vp0=shm3+LDS_V+((lane>>4)&1)*32+(lane&3)*8+(4*hi+((lane&15)>>2))*64;
  const int NT=SEQ/KVBLK;
  DMA_K(0,0);DMA_V(0,0);DMA_K(1,SLOTB);
  bf16x8 qr[4];
  #pragma unroll
  for(int d0=0;d0<4;++d0)qr[d0]=*reinterpret_cast<const bf16x8*>(&Qw[(long)r32*DM+d0*16+hi*8]);
  float mhat=0.f,l_reg=0.f;f32x16 o[2];o[0]=f32x16{};o[1]=f32x16{};f32x16 negm=f32x16{}; if constexpr(FIX){ _Pragma("unroll") for(int r=0;r<16;++r)negm[r]=-refB; } asm volatile("":"+v"(negm));
  const int qrel=wid*QBLK+r32;
  #define CMASK(P0,P1,t) do{}while(0)
  bool resc=false;
  #define START(P0,P1) do{ if constexpr(!FIX){ const float rm=rowmax(P0,P1); resc=false; \
    { const float dl=rm; mhat=fadd_s(mhat,dl); \
      _Pragma("unroll") for(int r=0;r<16;++r){P0[r]=fsub_s(P0[r],dl);P1[r]=fsub_s(P1[r],dl);} \
      _Pragma("unroll") for(int r=0;r<16;++r)negm[r]=-mhat; asm volatile("":"+v"(negm)); } } \
    _Pragma("unroll") for(int r=0;r<16;++r)P0[r]=__builtin_amdgcn_exp2f(P0[r]); }while(0)
  #define RESC() do{ if constexpr(!FIX) if(resc){ asm volatile("s_waitcnt lgkmcnt(0)":::"memory"); \
      _Pragma("unroll") for(int d_=0;d_<2;++d_) _Pragma("unroll") for(int r=0;r<16;++r)o[d_][r]*=wsf[crow(r,hi)]; } }while(0)
  f32x16 pA0,pA1,pB0,pB1;
  int sl_prev=0,sl_cur=0,sl_next=SLOTB;
  #define ROT() do{sl_prev=sl_cur;sl_cur=sl_next;sl_next=(sl_next==(NSLOT-1)*SLOTB)?0:sl_next+SLOTB;}while(0)
  DMA_K(2,2*SLOTB);
  WAIT_BAR(3);
  qkt(pA0,pA1,Kbase,qr,negm,r32,hi);asm volatile("s_nop 15\n\ts_nop 7":"+v"(pA0),"+v"(pA1));CMASK(pA0,pA1,0);
  START(pA0,pA1);
  _Pragma("unroll") for(int r=0;r<16;++r)pA1[r]=__builtin_amdgcn_exp2f(pA1[r]);
  WAIT_BAR(0);
  DMA_K(3,0);DMA_V(1,SLOTB);
  ROT();
  kload8(kf,kp0+sl_cur);
  WAIT_BAR(2);
  s16x4 vlo[8],vhi[8]; u32x4 pw0,pw1,pw2,pw3;
  #define PKW(P,B) cvtpk_s(P[B],P[B+1])
  #define PAF(k) __builtin_bit_cast(bf16x8,pw##k)
  #define VFR(i) (bf16x8){vlo[i][0],vlo[i][1],vlo[i][2],vlo[i][3],vhi[i][0],vhi[i][1],vhi[i][2],vhi[i][3]}
  #define PIN(x) asm volatile("":"+v"(x))
  #define MX3(a,b,c) __builtin_fmaxf(__builtin_fmaxf((a),(b)),(c))
  #define GAPA(MF,A0,A1,A2,A3,W0,W1,PW) do{ MF; sacc+=A0; sacc+=A1; sacc+=A2; sacc+=A3; PIN(sacc); W0; W1; PIN(PW); SBAR(); }while(0)
  #define EX(v) __builtin_amdgcn_exp2f(v)
  #define GAPB(MF,X,B) do{ MF; X[B]=EX(X[B]); X[B+1]=EX(X[B+1]); X[B+2]=EX(X[B+2]); X[B+3]=EX(X[B+3]); PIN(X); SBAR(); }while(0)
  #define VRD(i) do{ vlo[i]=vtr(vp_+(((i)>>2)*4096+((i)&3)*1024)); vhi[i]=vtr(vp_+(((i)>>2)*4096+((i)&3)*1024+512)); }while(0)
  #define KRD(G,j) do{ if(G){ kload2(kf,kp0+sl_next,j); SBAR(); } }while(0)
  #define STEP(C0,C1,P0,P1,t,GK,GV,GL) do{ SBAR(); \
    const lds_cptr vp_=vp0+sl_prev; \
    VRD(0); SBAR(); float sacc=(P0[0]+P0[1]); \
    GAPA(C0=__builtin_amdgcn_mfma_f32_32x32x16_bf16(kf[0],qr[0],negm,0,0,0), P0[2],P0[3],P0[4],P0[5],     pw0[0]=PKW(P0,0), pw0[1]=PKW(P0,2), pw0); \
    VRD(4); SBAR(); GAPA(C1=__builtin_amdgcn_mfma_f32_32x32x16_bf16(kf[1],qr[0],negm,0,0,0), P0[6],P0[7],P0[8],P0[9],     pw0[2]=PKW(P0,4), pw0[3]=PKW(P0,6), pw0); \
    VRD(1); SBAR(); GAPA(C0=__builtin_amdgcn_mfma_f32_32x32x16_bf16(kf[2],qr[1],C0,0,0,0),   P0[10],P0[11],P0[12],P0[13], pw1[0]=PKW(P0,8), pw1[1]=PKW(P0,10), pw1); \
    VRD(5); SBAR(); GAPA(C1=__builtin_amdgcn_mfma_f32_32x32x16_bf16(kf[3],qr[1],C1,0,0,0),   P0[14],P0[15],P1[0],P1[1],   pw1[2]=PKW(P0,12),pw1[3]=PKW(P0,14), pw1); \
    VRD(2); SBAR(); GAPA(C0=__builtin_amdgcn_mfma_f32_32x32x16_bf16(kf[4],qr[2],C0,0,0,0),   P1[2],P1[3],P1[4],P1[5],     pw2[0]=PKW(P1,0), pw2[1]=PKW(P1,2), pw2); \
    VRD(6); SBAR(); GAPA(C1=__builtin_amdgcn_mfma_f32_32x32x16_bf16(kf[5],qr[2],C1,0,0,0),   P1[6],P1[7],P1[8],P1[9],     pw2[2]=PKW(P1,4), pw2[3]=PKW(P1,6), pw2); \
    VRD(3); SBAR(); GAPA(C0=__builtin_amdgcn_mfma_f32_32x32x16_bf16(kf[6],qr[3],C0,0,0,0),   P1[10],P1[11],P1[12],P1[13], pw3[0]=PKW(P1,8), pw3[1]=PKW(P1,10), pw3); \
    VRD(7); SBAR(); GAPA(C1=__builtin_amdgcn_mfma_f32_32x32x16_bf16(kf[7],qr[3],C1,0,0,0),   P1[14],P1[15],0.f,0.f,       pw3[2]=PKW(P1,12),pw3[3]=PKW(P1,14), pw3); \
    l_reg+=sacc; \
    if(GK){DMA_K((t)+3,sl_cur);} if(GV){DMA_V((t)+1,sl_next);} \
    CMASK(C0,C1,t); \
    if constexpr(!FIX){ float a=MX3(C0[0],C0[1],C1[0]),b=MX3(C0[2],C0[3],C1[1]); a=MX3(a,C1[2],C1[3]); \
      _Pragma("unroll") for(int r=4;r<16;r+=4){a=MX3(a,C0[r],C0[r+1]);b=MX3(b,C0[r+2],C0[r+3]);a=MX3(a,C1[r],C1[r+1]);b=MX3(b,C1[r+2],C1[r+3]);} \
      float rm=__builtin_fmaxf(a,b); { auto rr=__builtin_amdgcn_permlane32_swap(__float_as_uint(rm),__float_as_uint(rm),false,false); rm=__builtin_fmaxf(__uint_as_float(rr[0]),__uint_as_float(rr[1])); } \
      resc=false; \
      if(__builtin_expect(__any(rm>(float)THRL),0)){ const float dl=__builtin_fmaxf(rm,0.f); mhat+=dl; \
        _Pragma("unroll") for(int r=0;r<16;++r){C0[r]-=dl;C1[r]-=dl;} \
        _Pragma("unroll") for(int r=0;r<16;++r)negm[r]=-mhat; asm volatile("":"+v"(negm)); \
        const float f=__builtin_amdgcn_exp2f(-dl); l_reg*=f; if(hi==0)wsf[r32]=f; resc=true; } } \
    SBAR(); \
    GAPB(o[0]=__builtin_amdgcn_mfma_f32_32x32x16_bf16(PAF(0),VFR(0),o[0],0,0,0), C0,0); \
    GAPB(o[1]=__builtin_amdgcn_mfma_f32_32x32x16_bf16(PAF(0),VFR(4),o[1],0,0,0), C0,4); \
    KRD(GL,0); GAPB(o[0]=__builtin_amdgcn_mfma_f32_32x32x16_bf16(PAF(1),VFR(1),o[0],0,0,0), C0,8); \
    KRD(GL,1); GAPB(o[1]=__builtin_amdgcn_mfma_f32_32x32x16_bf16(PAF(1),VFR(5),o[1],0,0,0), C0,12); \
    KRD(GL,2); GAPB(o[0]=__builtin_amdgcn_mfma_f32_32x32x16_bf16(PAF(2),VFR(2),o[0],0,0,0), C1,0); \
    KRD(GL,3); GAPB(o[1]=__builtin_amdgcn_mfma_f32_32x32x16_bf16(PAF(2),VFR(6),o[1],0,0,0), C1,4); \
    GAPB(o[0]=__builtin_amdgcn_mfma_f32_32x32x16_bf16(PAF(3),VFR(3),o[0],0,0,0), C1,8); \
    GAPB(o[1]=__builtin_amdgcn_mfma_f32_32x32x16_bf16(PAF(3),VFR(7),o[1],0,0,0), C1,12); \
    }while(0)
  int t=1;
#if defined(ATTN_PRIO) && ATTN_PRIO
  if(wid>=4)__builtin_amdgcn_s_setprio(1);
#endif
  #undef CMASK
  #define CMASK(P0,P1,t) do{}while(0)
  for(;t+5<NT;t+=2){
    STEP(pB0,pB1,pA0,pA1,t,true,true,true);     WAIT_BAR(2); RESC(); ROT();
    STEP(pA0,pA1,pB0,pB1,t+1,true,true,true);   WAIT_BAR(2); RESC(); ROT();
  }
  #undef CMASK
  #define CMASK(P0,P1,t) do{}while(0)
  #define ENDW(tt) do{ if((tt)+3<NT){WAIT_BAR(2);} else if((tt)+2<NT){WAIT_BAR(1);} else {WAIT_BAR(0);} }while(0)
  for(;t+1<NT;t+=2){
    STEP(pB0,pB1,pA0,pA1,t,(t+3<NT),(t+1<NT),(t+1<NT));       ENDW(t);   RESC(); ROT();
    STEP(pA0,pA1,pB0,pB1,t+1,(t+4<NT),(t+2<NT),(t+2<NT));     ENDW(t+1); RESC(); ROT();
  }
  STEP(pB0,pB1,pA0,pA1,NT-1,false,false,false); RESC();
  { float sacc=pB0[0]+pB0[1]; _Pragma("unroll") for(int r=2;r<16;++r)sacc+=pB0[r]; _Pragma("unroll") for(int r=0;r<16;++r)sacc+=pB1[r]; l_reg+=sacc;
    pw0=(u32x4){PKW(pB0,0),PKW(pB0,2),PKW(pB0,4),PKW(pB0,6)};pw1=(u32x4){PKW(pB0,8),PKW(pB0,10),PKW(pB0,12),PKW(pB0,14)};pw2=(u32x4){PKW(pB1,0),PKW(pB1,2),PKW(pB1,4),PKW(pB1,6)};pw3=(u32x4){PKW(pB1,8),PKW(pB1,10),PKW(pB1,12),PKW(pB1,14)};
    SBAR(); pv(o,vb0+sl_cur,PAF(0),PAF(1),PAF(2),PAF(3)); }
  #undef PKW
  #undef PAF
  #undef VFR
  #undef PIN
  #undef MX3
  #undef GAPA
  #undef GAPB
  #undef EX
  #undef VRD
  #undef KRD
  #undef STEP
  #undef ENDW
#if defined(ATTN_PRIO) && ATTN_PRIO
  __builtin_amdgcn_s_setprio(0);
#endif
  {auto rr=__builtin_amdgcn_permlane32_swap(__float_as_uint(l_reg),__float_as_uint(l_reg),false,false);l_reg=__uint_as_float(rr[0])+__uint_as_float(rr[1]);}
  if(hi==0)wsf[32+r32]=l_reg;asm volatile("s_waitcnt lgkmcnt(0)":::"memory");
  float rli[16];
  #pragma unroll
  for(int r=0;r<16;++r)rli[r]=__builtin_amdgcn_rcpf(wsf[32+crow(r,hi)]);
  bf16*Ow=O+(rowbase+q0+wid*QBLK)*DM+h*D;
  { bf16*stg=(bf16*)(shm+LDS_OST)+wid*2048;
    #pragma unroll
    for(int r=0;r<16;++r){const int orow=crow(r,hi);
      #pragma unroll
      for(int d0=0;d0<2;++d0)stg[orow*64+d0*32+r32]=__float2bfloat16(o[d0][r]*rli[r]);}
    asm volatile("s_waitcnt lgkmcnt(0)":::"memory");
    #pragma unroll
    for(int i=0;i<4;++i){const int row=i*8+(lane>>3),ch=lane&7; const u32x4 v=*(const u32x4*)(stg+row*64+ch*8); ATTN_STORE16(Ow+(long)row*DM+ch*8,v);} }
  asm volatile("s_waitcnt lgkmcnt(0)\n\ts_barrier":::"memory");
  #undef DMA_K
  #undef DMA_V
  #undef CMASK
  #undef START
  #undef RESC
  #undef ROT
}
constexpr int ATTN_LDS_BYTES=LDS_BYTES;
struct AttnTensors { const bf16* Q; const bf16* K; const bf16* V; bf16* O; };
struct AttnUnit { int bh; int qb; };
struct StaticOrder {
  int vcu;
  __device__ __forceinline__ explicit StaticOrder(int grid,int block):vcu((block%8)*(grid/8)+block/8){}
  __device__ __forceinline__ bool next(int i,AttnUnit&u)const{ if(i>=4)return false; const int x=vcu>>5, j=vcu&31; const int b=x>>2, kvh=x&3; u.bh=b*16+kvh*4+i; u.qb=j; return true; }
  __device__ __forceinline__ void a_ready(const AttnUnit&)const{}
  __device__ __forceinline__ void done(const AttnUnit&)const{}
};
template<class Sched,bool FIX,int THRL=8> __device__ __forceinline__ void attn_phase(char*lds,const AttnTensors&T,const Sched&S,float refB){
  AttnUnit u;
  for(int i=0;S.next(i,u);++i){ S.a_ready(u); attn_unit<THRL,FIX>(refB,u.bh/NHEAD,u.bh%NHEAD,(u.bh%NHEAD)>>2,u.qb,T.Q,T.K,T.V,T.O,lds); S.done(u); }
}
#undef SBAR
#undef WAIT_BAR
}

#define GAS __attribute__((address_space(1)))
#define LAS __attribute__((address_space(3)))
typedef unsigned short bf16;
typedef unsigned v4u __attribute__((ext_vector_type(4)));
typedef float f32x4 __attribute__((ext_vector_type(4)));
typedef short bf16x8 __attribute__((ext_vector_type(8)));
typedef GAS unsigned gu32;
typedef GAS unsigned long long gu64;
#define RLX_AGENT __ATOMIC_RELAXED, __HIP_MEMORY_SCOPE_AGENT
#define LDS_WAIT() asm volatile("s_waitcnt lgkmcnt(0)" ::: "memory")
#define VM_WAIT() asm volatile("s_waitcnt vmcnt(0)" ::: "memory")
__device__ __forceinline__ unsigned long long rt() { return __builtin_amdgcn_s_memrealtime(); }
__device__ __forceinline__ unsigned f2bf(float f) { unsigned u = __builtin_bit_cast(unsigned, f); return (u + 0x7fffu + ((u >> 16) & 1u)) >> 16; }
__device__ __forceinline__ unsigned pk2(float lo, float hi) { return pg8::cvt_pk_bf16(lo, hi); }

#define XB_TMO      128
#define XB_XCNT(j)  (256  + 64 * (j))
#define XB_XSUB(j)  (1280 + 64 * (j))
#define XB_XGEN(j)  (2304 + 64 * (j))
#define XB_TOP      3328
#define XB_TOPGEN   3392
#define XCD_BAR_WORDS 3456
#define XB_SPIN_CAP (1u << 18)

__device__ __forceinline__ unsigned xb_ld(unsigned* p)              { return __hip_atomic_load(p, __ATOMIC_RELAXED, __HIP_MEMORY_SCOPE_AGENT); }
__device__ __forceinline__ unsigned xb_add(unsigned* p, unsigned v) { return __hip_atomic_fetch_add(p, v, __ATOMIC_RELAXED, __HIP_MEMORY_SCOPE_AGENT); }
__device__ __forceinline__ unsigned xb_xcc_id() { return (unsigned)__builtin_amdgcn_s_getreg((3 << 11) | 20) & 0xFu; }
#define XB_SPIN(cond, bar) do { unsigned _sp = 0; while (cond) { __builtin_amdgcn_s_sleep(1); \
    if ((++_sp & 255u) == 0u) { if (xb_ld(&(bar)[XB_TMO])) break; if (_sp > XB_SPIN_CAP) { atomicAdd(&(bar)[XB_TMO], 1u); break; } } } } while (0)

struct XcdBarrier {
    unsigned* bar; unsigned x;
    volatile LAS unsigned* st;
};

__device__ __forceinline__ XcdBarrier xcd_barrier_post(unsigned* bar, volatile LAS unsigned* st) {
    XcdBarrier b; b.bar = bar; b.x = xb_xcc_id(); b.st = st;
    if (threadIdx.x == 0) (void)xb_add(&bar[XB_XCNT(b.x)], 1u);
    return b;
}
__device__ __forceinline__ void xcd_barrier_complete(unsigned* bar, unsigned x, unsigned& nloc, unsigned& nx) {
    const unsigned G = gridDim.x * gridDim.y * gridDim.z;
    unsigned sum, cnt, mine, sp = 0u;
    for (;;) {
        sum = 0u; cnt = 0u; mine = 0u;
#pragma unroll
        for (unsigned j = 0; j < 16; ++j) { const unsigned c = xb_ld(&bar[XB_XCNT(j)]); sum += c; cnt += (c > 0u) ? 1u : 0u; mine = (j == x) ? c : mine; }
        if (sum == G) break;
        __builtin_amdgcn_s_sleep(1);
        if ((++sp & 255u) == 0u) { if (xb_ld(&bar[XB_TMO])) break; if (sp > XB_SPIN_CAP) { atomicAdd(&bar[XB_TMO], 1u); break; } }
    }
    nloc = mine > 0u ? mine : 1u; nx = cnt > 0u ? cnt : 1u;
}

__device__ __forceinline__ void xcd_barrier(const XcdBarrier& b) {
    asm volatile("s_waitcnt vmcnt(0)" ::: "memory");
    __syncthreads();
    if (threadIdx.x == 0) {
        unsigned* bar = b.bar;
        __builtin_amdgcn_s_waitcnt(0);
        unsigned nloc = b.st[0], nx = b.st[1];
        if (nloc == 0u) { xcd_barrier_complete(bar, b.x, nloc, nx); b.st[0] = nloc; b.st[1] = nx; }
        const unsigned old = xb_add(&bar[XB_XSUB(b.x)], 1u);
        const unsigned gen = old / nloc;
        if (old + 1u == (gen + 1u) * nloc) {
            __builtin_amdgcn_fence(__ATOMIC_RELEASE, "agent");
            asm volatile("s_waitcnt vmcnt(0)" ::: "memory");
            const unsigned og = xb_add(&bar[XB_TOP], 1u);
            const unsigned tg = og / nx;
            if (og + 1u == (tg + 1u) * nx) xb_add(&bar[XB_TOPGEN], 1u);
            else XB_SPIN(xb_ld(&bar[XB_TOPGEN]) == tg, bar);
            __builtin_amdgcn_fence(__ATOMIC_ACQUIRE, "agent");
            xb_add(&bar[XB_XGEN(b.x)], 1u);
            asm volatile("s_waitcnt vmcnt(0)" ::: "memory");
        } else {
            XB_SPIN(xb_ld(&bar[XB_XGEN(b.x)]) == gen, bar);
            __builtin_amdgcn_fence(__ATOMIC_ACQUIRE, "agent");
            asm volatile("s_waitcnt vmcnt(0)" ::: "memory");
        }
    }
    __syncthreads();
}

#ifndef MOE_FP8
#define MOE_FP8 1
#endif
#ifndef MOE_WGM
#define MOE_WGM 8
#endif
#ifndef P15_ALIGN
#define P15_ALIGN true
#endif
#ifndef P15_SP2
#define P15_SP2 true
#endif
#ifndef FFN_FP8
#define FFN_FP8 0
#endif
#ifndef MOE_CVT_IN_SCAN
#define MOE_CVT_IN_SCAN 1
#endif
#ifndef ATTN_PRIO
#define ATTN_PRIO 1
#endif
#ifndef MOE_CVT_SPLIT
#define MOE_CVT_SPLIT 16384
#endif
constexpr int NWAVES = 8;
constexpr int NTOK = 16384, DM = 1024, SEQ = 8192, NB = 2;
constexpr int DFF = 2816, NEXP = 8, DFE = 3584, QKVW = 1536;
constexpr float EPS = 1e-6f;
constexpr float QSCALE = 0.125f * 1.4426950408889634f;

constexpr size_t MiB = 1u << 20;
constexpr size_t WS_CTL = 0, CTL_ZERO_BYTES = 1 * MiB;
constexpr size_t WS_ROPE_R = 1 * MiB, WS_ROPE_C = 1 * MiB + 16384, WS_AT = 1 * MiB + 65536, WS_QKG = 1 * MiB + 131072, WS_TOKINFO = 1 * MiB + 262144;
constexpr size_t WS_LIST = 2 * MiB, WS_IDLIST = 3 * MiB;
constexpr size_t WS_BT_IN = 4 * MiB, WS_BT_GLU = 6 * MiB, WS_BT_SOUT = 8 * MiB, WS_BT_AO = 10 * MiB, WS_BT_QKV = 12 * MiB, WS_BT_GU = 16 * MiB, WS_BT_FD = 28 * MiB;
constexpr size_t WS_S5_MAIN = 34 * MiB, WS_S5_STATE = 50 * MiB;
constexpr size_t WS_A2 = 58 * MiB, WS_S = 122 * MiB, WS_G1 = 122 * MiB, WS_G2 = 154 * MiB, WS_MIX = 58 * MiB;
constexpr size_t WS_ACTF = 122 * MiB;
constexpr size_t WS_Q = 122 * MiB, WS_K = 154 * MiB, WS_V = 162 * MiB, WS_O = 170 * MiB;
constexpr size_t WS_XN = 242 * MiB;
constexpr size_t WS_ACTM = 4 * MiB;
constexpr size_t WS_BT_MGU = 280 * MiB, WS_BT_MD = 392 * MiB, WS_SLOT = 124 * MiB, WS_PART = 192 * MiB, WS_HB = 336 * MiB, WS_END = 448 * MiB;
static_assert(WS_ACTM + (size_t)34816 * DFE * 2 <= WS_XN && WS_XN + (size_t)NTOK * DM * 2 <= WS_BT_MGU && WS_BT_MGU + (size_t)8 * 7168 * 1024 * 2 == WS_BT_MD && WS_BT_MD + (size_t)8 * 1024 * 3584 * 2 == WS_END, "ws map");
static_assert(WS_S5_STATE + (size_t)64 * 256 * 256 * 2 <= WS_A2 && WS_ACTF + (size_t)NTOK * DFF * 2 <= WS_XN && WS_O + (size_t)NTOK * DM * 2 <= WS_XN && WS_SLOT + (size_t)34816 * DM * 2 <= WS_PART && WS_PART + (size_t)256 * 131072 <= WS_XN && WS_ACTM + (size_t)34816 * DFE <= WS_SLOT && WS_BT_MGU + (size_t)8 * 7168 * 1024 <= WS_HB && WS_HB + (size_t)NTOK * DM * 2 <= WS_BT_MD && MOE_FP8 == 1, "ws map 2");
constexpr int CW_TMO = 0, CW_CODE = 1, CW_BAR = 4096, CW_CNT = 8192;

constexpr int RING_OFF = 0, RING_BYTES = 131072;
constexpr int LDSCTL_OFF = RING_BYTES, MISC_OFF = LDSCTL_OFF + 320;
constexpr int LDS_BYTES = 147456;

typedef unsigned v2u __attribute__((ext_vector_type(2)));

constexpr int MOE_OFF = MISC_OFF + 256;
struct Frame {
    LAS unsigned char* lds;
    volatile LAS unsigned* MISC;
    gu32* ctl;
    int tid, lane, wave;
    int vcu, G;
};
__device__ __forceinline__ float wave_sum(float v) {
#pragma unroll
    for (int o = 1; o < 64; o <<= 1) v += __shfl_xor(v, o);
    return v;
}
constexpr int T_ISMALL = 4 * 256 + 384 + 3 * 704, T_NITEMS = T_ISMALL + 8 * 3 * 896;
struct TItem { const float* W; bf16* WT; int K, N, kind, half, item, f8; };
__device__ __forceinline__ TItem t_decode(int it, const float* const* in, unsigned char* ws) {
    constexpr int I_SQ = 256, I_FG = 704, I_QKV = 384, I_M = 896;
    TItem t; int r = it; t.kind = 0; t.half = 0; t.K = DM; t.N = DM; t.f8 = 0;
    if (r < I_SQ) { t.W = in[2]; t.WT = (bf16*)(ws + WS_BT_IN); t.item = r; return t; } r -= I_SQ;
    if (r < I_SQ) { t.W = in[11]; t.WT = (bf16*)(ws + WS_BT_GLU); t.item = r; return t; } r -= I_SQ;
    if (r < I_SQ) { t.W = in[12]; t.WT = (bf16*)(ws + WS_BT_SOUT); t.item = r; return t; } r -= I_SQ;
    if (r < I_SQ) { t.W = in[19]; t.WT = (bf16*)(ws + WS_BT_AO); t.item = r; return t; } r -= I_SQ;
    if (r < I_QKV) { t.W = in[16]; t.WT = (bf16*)(ws + WS_BT_QKV); t.N = QKVW; t.kind = 2; t.item = r; return t; } r -= I_QKV;
    if (r < I_FG) { t.W = in[13]; t.WT = (bf16*)(ws + WS_BT_GU); t.N = DFF; t.kind = 1; t.item = r; t.f8 = FFN_FP8; return t; } r -= I_FG;
    if (r < I_FG) { t.W = in[14]; t.WT = (bf16*)(ws + WS_BT_GU); t.N = DFF; t.kind = 1; t.half = 1; t.item = r; t.f8 = FFN_FP8; return t; } r -= I_FG;
    if (r < I_FG) { t.W = in[15]; t.WT = (bf16*)(ws + WS_BT_FD); t.K = DFF; t.item = r; t.f8 = FFN_FP8; return t; } r -= I_FG;
    const int e = r / (3 * I_M); r -= e * 3 * I_M; t.f8 = MOE_FP8;
    if (r < I_M) { t.W = in[21] + (size_t)e * DM * DFE; t.WT = (bf16*)(ws + WS_BT_MGU + (size_t)e * 7168 * 1024 * (MOE_FP8 ? 1 : 2)); t.N = DFE; t.kind = 1; t.item = r; return t; } r -= I_M;
    if (r < I_M) { t.W = in[22] + (size_t)e * DM * DFE; t.WT = (bf16*)(ws + WS_BT_MGU + (size_t)e * 7168 * 1024 * (MOE_FP8 ? 1 : 2)); t.N = DFE; t.kind = 1; t.half = 1; t.item = r; return t; } r -= I_M;
    t.W = in[23] + (size_t)e * DFE * DM; t.WT = (bf16*)(ws + WS_BT_MD + (size_t)e * 1024 * 3584 * (MOE_FP8 ? 1 : 2)); t.K = DFE; t.item = r; return t;
}
__device__ __forceinline__ void t_issue(const TItem& t, int lane, f32x4 (&ld)[16]) {
    const int nblk = t.N / 64, kb = t.item / nblk, nb = t.item - kb * nblk;
    const int rmul = t.f8 ? 4 : 2;
    const float* p = t.W + (size_t)(64 * kb + rmul * (lane >> 4)) * t.N + 64 * nb + 4 * (lane & 15);
#pragma unroll
    for (int i = 0; i < 16; ++i) ld[i] = *(const GAS f32x4*)(p + (size_t)(t.f8 ? 16 * (i >> 2) + (i & 3) : 8 * (i >> 1) + (i & 1)) * t.N);
}
__device__ __forceinline__ void t_finish(const TItem& t, int lane, const f32x4 (&ld)[16], LAS unsigned* T) {
    const int nblk = t.N / 64, kb = t.item / nblk, nb = t.item - kb * nblk, k0 = 64 * kb, n0 = 64 * nb;
    const int r = lane >> 4, cg = lane & 15;
    if (t.f8) {
        unsigned char* WT8 = (unsigned char*)t.WT;
#pragma unroll
        for (int mq = 0; mq < 4; ++mq) { LAS unsigned* d = T + (4 * mq + r) * 65 + 4 * cg;
            d[0] = pg8::pack4_fp8(ld[4 * mq].x * 64.f, ld[4 * mq + 1].x * 64.f, ld[4 * mq + 2].x * 64.f, ld[4 * mq + 3].x * 64.f);
            d[1] = pg8::pack4_fp8(ld[4 * mq].y * 64.f, ld[4 * mq + 1].y * 64.f, ld[4 * mq + 2].y * 64.f, ld[4 * mq + 3].y * 64.f);
            d[2] = pg8::pack4_fp8(ld[4 * mq].z * 64.f, ld[4 * mq + 1].z * 64.f, ld[4 * mq + 2].z * 64.f, ld[4 * mq + 3].z * 64.f);
            d[3] = pg8::pack4_fp8(ld[4 * mq].w * 64.f, ld[4 * mq + 1].w * 64.f, ld[4 * mq + 2].w * 64.f, ld[4 * mq + 3].w * 64.f); }
        LDS_WAIT(); asm volatile("" ::: "memory");
        const int c4 = lane & 3;
#pragma unroll
        for (int j = 0; j < 4; ++j) { const int nl = (lane >> 2) + 16 * j, n = n0 + nl;
            const int dr = t.kind == 0 ? n : 256 * (n / 128) + (n % 128) + 128 * t.half;
            const LAS unsigned* s = T + (4 * c4) * 65 + nl;
            v4u o; o.x = s[0]; o.y = s[65]; o.z = s[130]; o.w = s[195];
            *(GAS v4u*)(WT8 + (size_t)dr * t.K + k0 + 16 * c4) = o; }
        LDS_WAIT(); asm volatile("" ::: "memory");
        return;
    }
#pragma unroll
    for (int m = 0; m < 8; ++m) { LAS unsigned* d = T + (4 * m + r) * 65 + 4 * cg;
        d[0] = pk2(ld[2 * m].x, ld[2 * m + 1].x); d[1] = pk2(ld[2 * m].y, ld[2 * m + 1].y); d[2] = pk2(ld[2 * m].z, ld[2 * m + 1].z); d[3] = pk2(ld[2 * m].w, ld[2 * m + 1].w); }
    LDS_WAIT(); asm volatile("" ::: "memory");
    const int c = lane & 7;
#pragma unroll
    for (int j = 0; j < 8; ++j) { const int nl = (lane >> 3) + 8 * j, n = n0 + nl;
        const int dr = t.kind == 0 ? n : (t.kind == 1 ? 256 * (n / 128) + (n % 128) + 128 * t.half : 256 * (n / 256) + 128 * ((n % 64) / 32) + 32 * ((n % 256) / 64) + (n % 32));
        const LAS unsigned* s = T + (4 * c) * 65 + nl;
        v4u o; o.x = s[0]; o.y = s[65]; o.z = s[130]; o.w = s[195];
        *(GAS v4u*)(t.WT + (size_t)dr * t.K + k0 + 8 * c) = o; }
    LDS_WAIT(); asm volatile("" ::: "memory");
}
__device__ __forceinline__ void s5_tables_item(Frame& F, const float* const* in, unsigned char* ws, int g, int tq) {
    const float *lam_re = in[3], *lam_im = in[4], *log_step = in[5], *b_re = in[6], *b_im = in[7], *c_re = in[8], *c_im = in[9], *dsk = in[10];
    LAS float* APOW = (LAS float*)F.lds;
    LAS float* BB = APOW + 2 * 17 * 64 * 2;
    LAS float* CC = BB + 2 * 64 * 16 * 2;
    LAS float* KT = CC + 2 * 16 * 64 * 2;
    const int tid = F.tid;
    __syncthreads();
    if (tid < 128) {
        const int dir = tid >> 6, p = tid & 63;
        const double step = exp((double)log_step[dir * 64 + g]);
        const double lr = lam_re[(dir * 64 + g) * 64 + p], li = lam_im[(dir * 64 + g) * 64 + p];
        const double mag = exp(lr * step), ang = li * step;
        const double ar = mag * cos(ang), ai = mag * sin(ang);
        double pr = 1.0, pi = 0.0;
        for (int tau = 0; tau <= 16; ++tau) { APOW[((dir * 17 + tau) * 64 + p) * 2] = (float)pr; APOW[((dir * 17 + tau) * 64 + p) * 2 + 1] = (float)pi;
            const double nr = pr * ar - pi * ai, ni = pr * ai + pi * ar; pr = nr; pi = ni; if (tau == 15 && tq == 0) { ((float*)(ws + WS_AT))[((dir * 64 + g) * 64 + p) * 2] = (float)nr; ((float*)(ws + WS_AT))[((dir * 64 + g) * 64 + p) * 2 + 1] = (float)ni; } }
        const double nr = ar - 1.0, ni = ai, den = lr * lr + li * li;
        const double qr = (nr * lr + ni * li) / den, qi = (ni * lr - nr * li) / den;
        for (int i = 0; i < 16; ++i) { const double br = b_re[((dir * 64 + g) * 64 + p) * 16 + i], bi = b_im[((dir * 64 + g) * 64 + p) * 16 + i];
            BB[((dir * 64 + p) * 16 + i) * 2] = (float)(qr * br - qi * bi); BB[((dir * 64 + p) * 16 + i) * 2 + 1] = (float)(qr * bi + qi * br); }
    }
    for (int idx = tid; idx < 2048; idx += 512) { const int dir = idx >> 10, j = (idx >> 6) & 15, p = idx & 63;
        CC[idx * 2] = c_re[((dir * 64 + g) * 16 + j) * 64 + p]; CC[idx * 2 + 1] = c_im[((dir * 64 + g) * 16 + j) * 64 + p]; }
    __syncthreads();
    {
        const int dir = tid >> 8, j = (tid >> 4) & 15, i = tid & 15;
        float kt[16];
#pragma unroll
        for (int t = 0; t < 16; ++t) kt[t] = 0.f;
        for (int p = 0; p < 64; ++p) {
            const float cr = CC[((dir * 16 + j) * 64 + p) * 2], ci = CC[((dir * 16 + j) * 64 + p) * 2 + 1];
            const float br = BB[((dir * 64 + p) * 16 + i) * 2], bi = BB[((dir * 64 + p) * 16 + i) * 2 + 1];
            const float wr = cr * br - ci * bi, wi = cr * bi + ci * br;
#pragma unroll
            for (int t = 0; t < 16; ++t) { const float ar = APOW[((dir * 17 + t) * 64 + p) * 2], ai = APOW[((dir * 17 + t) * 64 + p) * 2 + 1]; kt[t] += ar * wr - ai * wi; }
        }
#pragma unroll
        for (int t = 0; t < 16; ++t) KT[(dir * 16 + t) * 256 + j * 16 + i] = kt[t];
    }
    __syncthreads();
    bf16* Bm = (bf16*)(ws + WS_S5_MAIN) + (size_t)(g * 256 + 64 * tq) * 512;
    for (int w = tid; w < 4096; w += 512) {
        const int nl = w >> 6, k0 = (w & 63) * 8, t = 4 * tq + (nl >> 4), j = nl & 15;
        float v[8];
        if (k0 < 256) { const int s = k0 >> 4, i0 = k0 & 15;
#pragma unroll
            for (int e = 0; e < 8; ++e) { const int i = i0 + e;
                v[e] = (t > s) ? KT[(0 * 16 + (t - s)) * 256 + j * 16 + i] : (s > t) ? KT[(1 * 16 + (s - t)) * 256 + j * 16 + i]
                                 : KT[j * 16 + i] + KT[16 * 256 + j * 16 + i] + (i == j ? dsk[g * 16 + j] : 0.f); }
        } else { const int dir = (k0 - 256) >> 7, p0 = ((k0 - 256) & 127) >> 1, tau = dir == 0 ? t + 1 : 16 - t;
#pragma unroll
            for (int e = 0; e < 8; ++e) { const int p = p0 + (e >> 1), ri = e & 1;
                const float cr = CC[((dir * 16 + j) * 64 + p) * 2], ci = CC[((dir * 16 + j) * 64 + p) * 2 + 1];
                const float ar = APOW[((dir * 17 + tau) * 64 + p) * 2], ai = APOW[((dir * 17 + tau) * 64 + p) * 2 + 1];
                v[e] = ri == 0 ? (cr * ar - ci * ai) : -(cr * ai + ci * ar); }
        }
        v4u o; o.x = pk2(v[0], v[1]); o.y = pk2(v[2], v[3]); o.z = pk2(v[4], v[5]); o.w = pk2(v[6], v[7]);
        *(GAS v4u*)(Bm + (size_t)nl * 512 + k0) = o;
    }
    bf16* Bs = (bf16*)(ws + WS_S5_STATE) + (size_t)(g * 256 + 64 * tq) * 256;
    { const int dir = tq >> 1;
      for (int w = tid; w < 2048; w += 512) {
        const int nl = w >> 5, p = 32 * (tq & 1) + (nl >> 1), ri = nl & 1, k0 = (w & 31) * 8, s = k0 >> 4, i0 = k0 & 15, tau = dir == 0 ? 15 - s : s;
        const float ar = APOW[((dir * 17 + tau) * 64 + p) * 2], ai = APOW[((dir * 17 + tau) * 64 + p) * 2 + 1];
        float v[8];
#pragma unroll
        for (int e = 0; e < 8; ++e) { const float br = BB[((dir * 64 + p) * 16 + i0 + e) * 2], bi = BB[((dir * 64 + p) * 16 + i0 + e) * 2 + 1];
            v[e] = ri == 0 ? (ar * br - ai * bi) : (ar * bi + ai * br); }
        v4u o; o.x = pk2(v[0], v[1]); o.y = pk2(v[2], v[3]); o.z = pk2(v[4], v[5]); o.w = pk2(v[6], v[7]);
        *(GAS v4u*)(Bs + (size_t)nl * 256 + k0) = o;
      } }
    __syncthreads();
}
__device__ __forceinline__ void rms_row_to_bf16(int lane, const float* xrow, const float* gain, bf16* orow) {
    const GAS f32x4* xr = (const GAS f32x4*)xrow + lane;
    f32x4 v[4]; float s = 0.f;
#pragma unroll
    for (int j = 0; j < 4; ++j) { v[j] = xr[64 * j]; s += (v[j].x * v[j].x + v[j].y * v[j].y) + (v[j].z * v[j].z + v[j].w * v[j].w); }
    const float r = rsqrtf(wave_sum(s) * (1.f / DM) + EPS);
    GAS v2u* o8 = (GAS v2u*)orow + lane;
#pragma unroll
    for (int j = 0; j < 4; ++j) { const f32x4 g = ((const GAS f32x4*)gain)[lane + 64 * j]; v2u o; o.x = pk2(v[j].x * r * g.x, v[j].y * r * g.y); o.y = pk2(v[j].z * r * g.z, v[j].w * r * g.w); o8[64 * j] = o; }
}
__device__ __forceinline__ void p0_prologue(Frame& F, const float* const* in, unsigned char* ws) {
#ifndef P0DUP
#define P0DUP 0
#endif
    for (int rep = 0; rep < 1 + (P0DUP & 1); ++rep)
    for (int it = blockIdx.x; it < 256; it += F.G) s5_tables_item(F, in, ws, it >> 2, it & 3);
    for (int idx = blockIdx.x * 512 + F.tid; idx < 192 * 16; idx += F.G * 512) {
        const int f = idx & 15, pos = idx < 2048 ? (idx >> 4) : ((idx - 2048) >> 4);
        const float freq = powf(10000.f, -(float)(2 * f) / 32.f), ang = (float)pos * freq;
        float* dst = idx < 2048 ? (float*)(ws + WS_ROPE_R) + idx * 2 : (float*)(ws + WS_ROPE_C) + (idx - 2048) * 2;
        dst[0] = cosf(ang); dst[1] = sinf(ang);
    }
#if defined(EXP_GATHER) && EXP_GATHER
    for (int idx = blockIdx.x * 512 + F.tid; idx < NTOK; idx += F.G * 512) ((int*)(ws + WS_IDLIST))[idx] = idx;
#endif
    if (blockIdx.x == 0 && F.tid < 128) ((float*)(ws + WS_QKG))[F.tid] = F.tid < 64 ? in[17][F.tid] : in[18][F.tid - 64];
    LAS unsigned* scr = (LAS unsigned*)(F.lds + RING_OFF + F.wave * 16384);
    const int gw = F.vcu * NWAVES + F.wave, NGW = F.G * NWAVES;
    constexpr int NITEMS = MOE_CVT_IN_SCAN ? T_ISMALL + MOE_CVT_SPLIT : T_ISMALL + 8 * 3 * 896;
    for (int rep = 0; rep < 1 + ((P0DUP >> 1) & 1); ++rep) {
        f32x4 lA[16], lB[16]; TItem tA, tB; int it = gw;
        if (it < NITEMS) { tA = t_decode(it, in, ws); t_issue(tA, F.lane, lA); }
        while (it < NITEMS) {
            const bool nb = it + NGW < NITEMS;
            if (nb) { tB = t_decode(it + NGW, in, ws); t_issue(tB, F.lane, lB); }
            t_finish(tA, F.lane, lA, scr);
            if (!nb) break;
            const bool na = it + 2 * NGW < NITEMS;
            if (na) { tA = t_decode(it + 2 * NGW, in, ws); t_issue(tA, F.lane, lA); }
            t_finish(tB, F.lane, lB, scr);
            if (!na) break;
            it += 2 * NGW;
        }
    }
    for (int rep = 0; rep < 1 + ((P0DUP >> 2) & 1); ++rep)
    for (int m = gw; m < NTOK; m += NGW) rms_row_to_bf16(F.lane, in[0] + (size_t)m * DM, in[1], (bf16*)(ws + WS_XN) + (size_t)m * DM);
}
__device__ __forceinline__ void scan_phase(Frame& F, const float* const* in, unsigned char* ws) {
    const float* S = (const float*)(ws + WS_S); bf16* A2 = (bf16*)(ws + WS_A2); const float* aT = (const float*)(ws + WS_AT);
#if MOE_CVT_IN_SCAN
    if (F.wave != 0) {
        LAS unsigned* scr = (LAS unsigned*)(F.lds + RING_OFF + F.wave * 16384);
        const int NGW = F.G * 7; int it = T_ISMALL + MOE_CVT_SPLIT + F.vcu * 7 + (F.wave - 1);
        f32x4 lA[16], lB[16]; TItem tA, tB;
        if (it < T_NITEMS) { tA = t_decode(it, in, ws); t_issue(tA, F.lane, lA); }
        while (it < T_NITEMS) {
            const bool nb = it + NGW < T_NITEMS;
            if (nb) { tB = t_decode(it + NGW, in, ws); t_issue(tB, F.lane, lB); }
            t_finish(tA, F.lane, lA, scr);
            if (!nb) break;
            const bool na = it + 2 * NGW < T_NITEMS;
            if (na) { tA = t_decode(it + 2 * NGW, in, ws); t_issue(tA, F.lane, lA); }
            t_finish(tB, F.lane, lB, scr);
            if (!na) break;
            it += 2 * NGW;
        }
        return;
    }
    typedef float f32x2s __attribute__((ext_vector_type(2)));
#ifndef SCAN_REPS
#define SCAN_REPS 1
#endif
    for (int srep_ = 0; srep_ < SCAN_REPS; ++srep_)
    for (int it = blockIdx.x; it < 256; it += F.G) {
        const int dir = it & 1, g = (it >> 1) & 63, b = it >> 7;
        const float ar = aT[((dir * 64 + g) * 64 + F.lane) * 2], ai = aT[((dir * 64 + g) * 64 + F.lane) * 2 + 1];
        const size_t row0 = (size_t)g * 1024 + b * 512;
        const float* Sp = S + row0 * 256 + dir * 128 + 2 * F.lane;
        bf16* Ap = A2 + row0 * 512 + 256 + dir * 128 + 2 * F.lane;
        float xr = 0.f, xi = 0.f;
        f32x2s X0[16], X1[16], X2[16];
#define SC_LOAD(X, k0) do { _Pragma("unroll") for (int q = 0; q < 16; ++q) { const int c = dir == 0 ? (k0) + q : 511 - (k0) - q; X[q] = *(const GAS f32x2s*)(Sp + (size_t)c * 256); } } while (0)
#define SC_STEP(X, k0) do { _Pragma("unroll") for (int q = 0; q < 16; ++q) { const int c = dir == 0 ? (k0) + q : 511 - (k0) - q; \
            *(GAS unsigned*)(Ap + (size_t)c * 512) = pk2(xr, xi); \
            const float nxr = ar * xr - ai * xi + X[q].x, nxi = ar * xi + ai * xr + X[q].y; xr = nxr; xi = nxi; } } while (0)
        SC_LOAD(X0, 0); SC_LOAD(X1, 16); SC_LOAD(X2, 32);
        for (int k0 = 0; k0 < 512; k0 += 48) {
            SC_STEP(X0, k0); if (k0 + 48 < 512) SC_LOAD(X0, k0 + 48);
            if (k0 + 16 < 512) { SC_STEP(X1, k0 + 16); if (k0 + 64 < 512) SC_LOAD(X1, k0 + 64); }
            if (k0 + 32 < 512) { SC_STEP(X2, k0 + 32); if (k0 + 80 < 512) SC_LOAD(X2, k0 + 80); }
        }
#undef SC_LOAD
#undef SC_STEP
    }
#else
    LAS float* L = (LAS float*)F.lds;
    for (int it = blockIdx.x; it < 256; it += F.G) {
        const int dir = it & 1, g = (it >> 1) & 63, b = it >> 7;
        const float ar = aT[((dir * 64 + g) * 64 + F.lane) * 2], ai = aT[((dir * 64 + g) * 64 + F.lane) * 2 + 1];
        float xr = 0.f, xi = 0.f;
        for (int hh = 0; hh < 2; ++hh) {
            const int cbase = dir == 0 ? 256 * hh : 256 * (1 - hh);
            const size_t row0 = (size_t)g * 1024 + b * 512 + cbase;
            __syncthreads();
            { f32x4 tv[16];
#pragma unroll
            for (int k = 0; k < 16; ++k) { const int idx = F.tid + 512 * k, cl = idx >> 5, q = idx & 31; tv[k] = *(const GAS f32x4*)(S + (row0 + cl) * 256 + dir * 128 + q * 4); }
#pragma unroll
            for (int k = 0; k < 16; ++k) { const int idx = F.tid + 512 * k, cl = idx >> 5, q = idx & 31; *(LAS f32x4*)(L + cl * 128 + q * 4) = tv[k]; } }
            __syncthreads();
            if (F.wave == 0) {
                for (int s0 = 0; s0 < 256; s0 += 8) { float sr[8], si[8];
#pragma unroll
                    for (int q = 0; q < 8; ++q) { const int cl = dir == 0 ? s0 + q : 255 - s0 - q; sr[q] = L[cl * 128 + 2 * F.lane]; si[q] = L[cl * 128 + 2 * F.lane + 1]; }
#pragma unroll
                    for (int q = 0; q < 8; ++q) { const int cl = dir == 0 ? s0 + q : 255 - s0 - q;
                        *(GAS unsigned*)(A2 + (row0 + cl) * 512 + 256 + dir * 128 + 2 * F.lane) = pk2(xr, xi);
                        const float nxr = ar * xr - ai * xi + sr[q], nxi = ar * xi + ai * xr + si[q]; xr = nxr; xi = nxi; } }
            }
        }
        __syncthreads();
    }
#endif
}
template <bool B16> __device__ __forceinline__ f32x4 ld_h(const void* h, int m, int lane, int j) {
    if constexpr (B16) { const v2u w = ((const GAS v2u*)((const bf16*)h + (size_t)m * DM))[lane + 64 * j]; return (f32x4){pg8::bf_lo(w.x), pg8::bf_hi(w.x), pg8::bf_lo(w.y), pg8::bf_hi(w.y)}; }
    else return ((const GAS f32x4*)((const float*)h + (size_t)m * DM))[lane + 64 * j];
}
template <bool B16> __device__ __forceinline__ void st_h(void* h, int m, int lane, int j, const f32x4& v) {
    if constexpr (B16) { v2u o; o.x = pk2(v.x, v.y); o.y = pk2(v.z, v.w); ((GAS v2u*)((bf16*)h + (size_t)m * DM))[lane + 64 * j] = o; }
    else ((GAS f32x4*)((float*)h + (size_t)m * DM))[lane + 64 * j] = v;
}
template <bool HINB> struct RowRaw { v2u mw[4]; v2u hb[4]; f32x4 hf[4]; };
template <bool HINB> __device__ __forceinline__ void row_load(RowRaw<HINB>& r, const void* hin, const bf16* mix, int m, int lane) {
    const GAS v2u* mr = (const GAS v2u*)(mix + (size_t)m * DM) + lane;
#pragma unroll
    for (int j = 0; j < 4; ++j) { r.mw[j] = mr[64 * j];
        if constexpr (HINB) r.hb[j] = ((const GAS v2u*)((const bf16*)hin + (size_t)m * DM))[lane + 64 * j]; else r.hf[j] = ((const GAS f32x4*)((const float*)hin + (size_t)m * DM))[lane + 64 * j]; }
}
template <bool HINB> __device__ __forceinline__ void row_unpack(const RowRaw<HINB>& r, f32x4 (&v)[4], f32x4 (&hv)[4]) {
#pragma unroll
    for (int j = 0; j < 4; ++j) { v[j] = (f32x4){pg8::bf_lo(r.mw[j].x), pg8::bf_hi(r.mw[j].x), pg8::bf_lo(r.mw[j].y), pg8::bf_hi(r.mw[j].y)};
        if constexpr (HINB) hv[j] = (f32x4){pg8::bf_lo(r.hb[j].x), pg8::bf_hi(r.hb[j].x), pg8::bf_lo(r.hb[j].y), pg8::bf_hi(r.hb[j].y)}; else hv[j] = r.hf[j]; }
}
template <bool XF8, bool HINB, bool HOUTB> __device__ __forceinline__ void e_phase(Frame& F, const void* hin, const bf16* mix, const float* gpost, const float* gpre, void* hout, bf16* xn) {
    const int gw = F.vcu * NWAVES + F.wave, NGW = F.G * NWAVES;
    RowRaw<HINB> R[2];
    row_load<HINB>(R[0], hin, mix, gw, F.lane);
#pragma unroll
    for (int k = 0; k < 8; ++k) { const int m = gw + k * NGW;
        if (k + 1 < 8) row_load<HINB>(R[(k + 1) & 1], hin, mix, m + NGW, F.lane);
        f32x4 v[4], hv[4]; float s = 0.f;
        row_unpack<HINB>(R[k & 1], v, hv);
#pragma unroll
        for (int j = 0; j < 4; ++j) s += (v[j].x * v[j].x + v[j].y * v[j].y) + (v[j].z * v[j].z + v[j].w * v[j].w);
        const float r = rsqrtf(wave_sum(s) * (1.f / DM) + EPS); float s2 = 0.f;
#pragma unroll
        for (int j = 0; j < 4; ++j) { const f32x4 g = ((const GAS f32x4*)gpost)[F.lane + 64 * j]; hv[j] = hv[j] + v[j] * r * g; s2 += (hv[j].x * hv[j].x + hv[j].y * hv[j].y) + (hv[j].z * hv[j].z + hv[j].w * hv[j].w); }
#pragma unroll
        for (int j = 0; j < 4; ++j) st_h<HOUTB>(hout, m, F.lane, j, hv[j]);
        if (xn) { const float r2 = rsqrtf(wave_sum(s2) * (1.f / DM) + EPS); GAS v2u* o8 = (GAS v2u*)(xn + (size_t)m * DM) + F.lane;
#pragma unroll
            for (int j = 0; j < 4; ++j) { const f32x4 g = ((const GAS f32x4*)gpre)[F.lane + 64 * j];
                if constexpr (XF8) ((GAS unsigned*)((unsigned char*)xn + (size_t)m * DM))[F.lane + 64 * j] = pg8::pack4_fp8(hv[j].x * r2 * g.x * 4.f, hv[j].y * r2 * g.y * 4.f, hv[j].z * r2 * g.z * 4.f, hv[j].w * r2 * g.w * 4.f);
                else { v2u o; o.x = pk2(hv[j].x * r2 * g.x, hv[j].y * r2 * g.y); o.y = pk2(hv[j].z * r2 * g.z, hv[j].w * r2 * g.w); o8[64 * j] = o; } } }
    }
}
__device__ __forceinline__ void e3_phase(Frame& F, const void* hin, const bf16* mix, const float* gpost, const float* gpre, void* hout, bf16* xn, const float* wrouter, unsigned char* ws) {
    LAS float* WL = (LAS float*)F.lds;
    LAS int* RI = (LAS int*)(F.lds + 32768);
    for (int idx = F.tid; idx < 8192; idx += 512) WL[(idx & 7) * 1024 + (idx >> 3)] = wrouter[idx];
    if (F.tid < 8) RI[320 + F.tid] = 0;
    __syncthreads();
    const int gw = F.vcu * NWAVES + F.wave, NGW = F.G * NWAVES;
    RowRaw<true> R[2];
    row_load<true>(R[0], hin, mix, gw, F.lane);
#pragma unroll
    for (int k = 0; k < 8; ++k) { const int m = gw + k * NGW;
        if (k + 1 < 8) row_load<true>(R[(k + 1) & 1], hin, mix, m + NGW, F.lane);
        f32x4 v[4], hv[4]; float s = 0.f;
        row_unpack<true>(R[k & 1], v, hv);
#pragma unroll
        for (int j = 0; j < 4; ++j) s += (v[j].x * v[j].x + v[j].y * v[j].y) + (v[j].z * v[j].z + v[j].w * v[j].w);
        const float r = rsqrtf(wave_sum(s) * (1.f / DM) + EPS); float s2 = 0.f;
#pragma unroll
        for (int j = 0; j < 4; ++j) { const f32x4 g = ((const GAS f32x4*)gpost)[F.lane + 64 * j]; hv[j] = hv[j] + v[j] * r * g; s2 += (hv[j].x * hv[j].x + hv[j].y * hv[j].y) + (hv[j].z * hv[j].z + hv[j].w * hv[j].w); }
#pragma unroll
        for (int j = 0; j < 4; ++j) st_h<true>(hout, m, F.lane, j, hv[j]);
        const float r2 = rsqrtf(wave_sum(s2) * (1.f / DM) + EPS); GAS v2u* o8 = (GAS v2u*)(xn + (size_t)m * DM) + F.lane;
        float lg[8];
#pragma unroll
        for (int e = 0; e < 8; ++e) lg[e] = 0.f;
#pragma unroll
        for (int j = 0; j < 4; ++j) { const f32x4 g = ((const GAS f32x4*)gpre)[F.lane + 64 * j]; const f32x4 xf = hv[j] * r2 * g;
#if MOE_FP8
            ((GAS unsigned*)((unsigned char*)xn + (size_t)m * DM))[F.lane + 64 * j] = pg8::pack4_fp8(xf.x * 4.f, xf.y * 4.f, xf.z * 4.f, xf.w * 4.f);
#else
            v2u o; o.x = pk2(xf.x, xf.y); o.y = pk2(xf.z, xf.w); o8[64 * j] = o;
#endif
#pragma unroll
            for (int e = 0; e < 8; ++e) { const f32x4 w = *(const LAS f32x4*)(WL + e * 1024 + 4 * (F.lane + 64 * j)); lg[e] += (xf.x * w.x + xf.y * w.y) + (xf.z * w.z + xf.w * w.w); } }
#pragma unroll
        for (int e = 0; e < 8; ++e) lg[e] = wave_sum(lg[e]);
        int e0 = 0; float l0 = lg[0];
#pragma unroll
        for (int e = 1; e < 8; ++e) if (lg[e] > l0) { l0 = lg[e]; e0 = e; }
        int e1 = -1; float l1 = -INFINITY;
#pragma unroll
        for (int e = 0; e < 8; ++e) if (e != e0 && lg[e] > l1) { l1 = lg[e]; e1 = e; }
        const float w0 = 1.f / (1.f + expf(l1 - l0));
        if (F.lane == 0) { const int sl = F.wave * 8 + k; RI[sl] = e0 | (e1 << 8); RI[64 + sl] = (int)__float_as_uint(w0); RI[128 + sl] = m; }
    }
    __syncthreads();
    if (F.tid < 64) { const int ee = RI[F.tid]; RI[192 + F.tid] = __hip_atomic_fetch_add(&RI[320 + (ee & 255)], 1, __ATOMIC_RELAXED, __HIP_MEMORY_SCOPE_WORKGROUP); RI[256 + F.tid] = __hip_atomic_fetch_add(&RI[320 + (ee >> 8)], 1, __ATOMIC_RELAXED, __HIP_MEMORY_SCOPE_WORKGROUP); }
    __syncthreads();
    if (F.tid < 8) RI[328 + F.tid] = (int)__hip_atomic_fetch_add(F.ctl + CW_CNT + 64 * F.tid, (unsigned)RI[320 + F.tid], RLX_AGENT);
    __syncthreads();
    if (F.tid < 64) { const int ee = RI[F.tid], e0 = ee & 255, e1 = ee >> 8, tok = RI[128 + F.tid];
        const int p0 = RI[328 + e0] + RI[192 + F.tid], p1 = RI[328 + e1] + RI[256 + F.tid];
        int* lists = (int*)(ws + WS_LIST); lists[e0 * NTOK + p0] = tok; lists[e1 * NTOK + p1] = tok;
        v4u ti; ti.x = (unsigned)ee; ti.y = (unsigned)p0; ti.z = (unsigned)p1; ti.w = (unsigned)RI[64 + F.tid];
        *(GAS v4u*)(ws + WS_TOKINFO + (size_t)tok * 16) = ti; }
    __syncthreads();
}
__device__ __forceinline__ void moe_table(Frame& F) {
    volatile LAS int* misc = (volatile LAS int*)(F.lds + MOE_OFF);
    __syncthreads();
    if (F.tid == 0) { int t = 0;
        for (int e = 0; e < 8; ++e) { const int c = (int)__hip_atomic_load(F.ctl + CW_CNT + 64 * e, RLX_AGENT); misc[e] = t; misc[16 + e] = c; t += (c + 255) >> 8; }
        misc[8] = t;
        const int first_rem = (t >> 6) << 6, urem = 4 * (t - first_rem);
        const int parts = urem == 0 ? 1 : (urem * 7 <= 256 ? 7 : (urem * 2 <= 256 ? 2 : 1));
        misc[9] = parts; misc[10] = parts == 1 ? t : first_rem; misc[11] = parts == 1 ? 0 : urem * parts; }
    __syncthreads();
}
__device__ __forceinline__ void e4_phase(Frame& F, const void* hin, const float* gpost, float* hout, unsigned char* ws) {
    volatile LAS int* misc = (volatile LAS int*)(F.lds + MOE_OFF);
    const bf16* SO = (const bf16*)(ws + WS_SLOT);
    const int gw = F.vcu * NWAVES + F.wave, NGW = F.G * NWAVES;
    const int first_rem = misc[10], parts = misc[9];
    v4u ti[8];
#pragma unroll
    for (int k = 0; k < 8; ++k) ti[k] = *(const GAS v4u*)(ws + WS_TOKINFO + (size_t)(gw + k * NGW) * 16);
    struct Raw4 { v2u a[4], b[4], h[4]; int slot0, slot1; };
    Raw4 R[2];
#define E4_ISSUE(RR, k) do { const v4u t_ = ti[k]; const int m_ = gw + (k) * NGW; \
        (RR).slot0 = __builtin_amdgcn_readfirstlane(misc[t_.x & 255] * 256 + (int)t_.y); (RR).slot1 = __builtin_amdgcn_readfirstlane(misc[(t_.x >> 8) & 255] * 256 + (int)t_.z); \
        const bool s0_ = ((RR).slot0 >> 8) >= first_rem, s1_ = ((RR).slot1 >> 8) >= first_rem; \
        const GAS v2u* a8_ = (const GAS v2u*)(SO + (size_t)(s0_ ? 0 : (RR).slot0) * DM) + F.lane; const GAS v2u* b8_ = (const GAS v2u*)(SO + (size_t)(s1_ ? 0 : (RR).slot1) * DM) + F.lane; \
        const GAS v2u* h8_ = (const GAS v2u*)((const bf16*)hin + (size_t)m_ * DM) + F.lane; \
        _Pragma("unroll") for (int j = 0; j < 4; ++j) { (RR).a[j] = a8_[64 * j]; (RR).b[j] = b8_[64 * j]; (RR).h[j] = h8_[64 * j]; } } while (0)
    E4_ISSUE(R[0], 0);
#pragma unroll
    for (int k = 0; k < 8; ++k) { const int m = gw + k * NGW;
        if (k + 1 < 8) E4_ISSUE(R[(k + 1) & 1], k + 1);
        const Raw4& C = R[k & 1];
        const float w0 = __uint_as_float(ti[k].w), w1 = 1.f - w0;
        const int slot0 = C.slot0, slot1 = C.slot1;
        const bool sp0 = (slot0 >> 8) >= first_rem, sp1 = (slot1 >> 8) >= first_rem;
        const float wa = sp0 ? 0.f : w0, wb = sp1 ? 0.f : w1;
        f32x4 v[4], hv[4]; float s = 0.f;
#pragma unroll
        for (int j = 0; j < 4; ++j) { const v2u a = C.a[j], b = C.b[j], hh = C.h[j]; hv[j] = (f32x4){pg8::bf_lo(hh.x), pg8::bf_hi(hh.x), pg8::bf_lo(hh.y), pg8::bf_hi(hh.y)};
            v[j].x = wa * pg8::bf_lo(a.x) + wb * pg8::bf_lo(b.x); v[j].y = wa * pg8::bf_hi(a.x) + wb * pg8::bf_hi(b.x); v[j].z = wa * pg8::bf_lo(a.y) + wb * pg8::bf_lo(b.y); v[j].w = wa * pg8::bf_hi(a.y) + wb * pg8::bf_hi(b.y); }
        if (sp0 || sp1) {
            const bf16* PT = (const bf16*)(ws + WS_PART);
#pragma unroll
            for (int kk = 0; kk < 2; ++kk) { const bool sp = kk == 0 ? sp0 : sp1; const int slot = kk == 0 ? slot0 : slot1; const float w = kk == 0 ? w0 : w1;
                if (sp) { const int pm = slot >> 8, rr = slot & 255;
#pragma unroll
                    for (int j = 0; j < 4; ++j) { f32x4 acc = (f32x4){0.f, 0.f, 0.f, 0.f};
                        for (int p = 0; p < parts; ++p) { const v2u a = *((const GAS v2u*)(PT + ((size_t)(((pm - first_rem) * 4 + j) * parts + p) * 65536 + (size_t)rr * 256)) + F.lane);
                            acc.x += pg8::bf_lo(a.x); acc.y += pg8::bf_hi(a.x); acc.z += pg8::bf_lo(a.y); acc.w += pg8::bf_hi(a.y); }
                        v[j] = v[j] + acc * w; } } }
        }
#pragma unroll
        for (int j = 0; j < 4; ++j) s += (v[j].x * v[j].x + v[j].y * v[j].y) + (v[j].z * v[j].z + v[j].w * v[j].w);
        const float r = rsqrtf(wave_sum(s) * (1.f / DM) + EPS);
        GAS f32x4* ho = (GAS f32x4*)(hout + (size_t)m * DM) + F.lane;
#pragma unroll
        for (int j = 0; j < 4; ++j) { const f32x4 g = ((const GAS f32x4*)gpost)[F.lane + 64 * j]; ho[64 * j] = hv[j] + v[j] * r * g; }
    }
#undef E4_ISSUE
}

#ifndef FLAT_BAR
#define FLAT_BAR 0
#endif
constexpr int FB_REPL = 8, CW_FB = 12288, CW_FBTMO = 12288 + 64 * 8;
struct FlatBar { gu32* ctl; unsigned epoch; };
__device__ __forceinline__ void flat_barrier(FlatBar& fb) {
    asm volatile("s_waitcnt vmcnt(0)" ::: "memory");
    __syncthreads();
    fb.epoch += 1u;
    if (threadIdx.x < 64) {
        const unsigned lane = threadIdx.x;
        __builtin_amdgcn_fence(__ATOMIC_RELEASE, "agent");
        asm volatile("s_waitcnt vmcnt(0)" ::: "memory");
        if (lane < FB_REPL) (void)__hip_atomic_fetch_add(fb.ctl + CW_FB + 64 * lane, 1u, RLX_AGENT);
        const unsigned target = fb.epoch * gridDim.x;
        gu32* mine = fb.ctl + CW_FB + 64 * (blockIdx.x % FB_REPL);
        unsigned sp = 0;
        while ((unsigned)__builtin_amdgcn_readfirstlane(__hip_atomic_load(mine, RLX_AGENT)) < target) {
            __builtin_amdgcn_s_sleep(1);
            if ((++sp & 1023u) == 0u) { if (__hip_atomic_load(fb.ctl + CW_FBTMO, RLX_AGENT) != 0u) break; if (sp > (1u << 20)) { if (lane == 0) __hip_atomic_store(fb.ctl + CW_FBTMO, 1u, RLX_AGENT); break; } }
        }
        __builtin_amdgcn_fence(__ATOMIC_ACQUIRE, "agent");
        asm volatile("s_waitcnt vmcnt(0)" ::: "memory");
    }
    __syncthreads();
}

#ifndef XB2
#define XB2 0
#endif
constexpr int CW_XB2 = 13312;
__device__ __forceinline__ void xcd_barrier2(const XcdBarrier& b, gu32* ctl) {
    asm volatile("s_waitcnt vmcnt(0)" ::: "memory");
    __syncthreads();
    if (threadIdx.x < 64) {
        unsigned* bar = b.bar; const unsigned lane = threadIdx.x;
        unsigned nloc = 1u, nx = 1u, old = 0u;
        if (lane == 0) {
            __builtin_amdgcn_s_waitcnt(0);
            nloc = b.st[0]; nx = b.st[1];
            if (nloc == 0u) { xcd_barrier_complete(bar, b.x, nloc, nx); b.st[0] = nloc; b.st[1] = nx; }
            old = xb_add(&bar[XB_XSUB(b.x)], 1u);
        }
        nloc = (unsigned)__builtin_amdgcn_readfirstlane((int)nloc); nx = (unsigned)__builtin_amdgcn_readfirstlane((int)nx); old = (unsigned)__builtin_amdgcn_readfirstlane((int)old);
        const unsigned gen = old / nloc;
        if (old + 1u == (gen + 1u) * nloc) {
            __builtin_amdgcn_fence(__ATOMIC_RELEASE, "agent");
            asm volatile("s_waitcnt vmcnt(0)" ::: "memory");
            if (lane < 8u) (void)__hip_atomic_fetch_add(ctl + CW_XB2 + 64 * lane, 1u, RLX_AGENT);
        }
        const unsigned target = (gen + 1u) * nx;
        gu32* mine = ctl + CW_XB2 + 64 * (blockIdx.x & 7u);
        unsigned sp = 0u;
        while ((unsigned)__builtin_amdgcn_readfirstlane((int)__hip_atomic_load(mine, RLX_AGENT)) < target) {
            __builtin_amdgcn_s_sleep(1);
            if ((++sp & 255u) == 0u) { if (xb_ld(&bar[XB_TMO])) break; if (sp > XB_SPIN_CAP) { if (lane == 0) atomicAdd(&bar[XB_TMO], 1u); break; } }
        }
        __builtin_amdgcn_fence(__ATOMIC_ACQUIRE, "agent");
        asm volatile("s_waitcnt vmcnt(0)" ::: "memory");
    }
    __syncthreads();
}

struct Args { const float* in[24]; float* out; unsigned char* ws; int ph_lo, ph_hi; };
__global__ void __launch_bounds__(NWAVES * 64, 2) mega_fwd(Args args) {
    extern __shared__ __attribute__((aligned(16))) unsigned char lds[];
    Frame F;
    F.lds = (LAS unsigned char*)lds;
    F.MISC = (volatile LAS unsigned*)(F.lds + MISC_OFF);
    F.tid = threadIdx.x; F.lane = F.tid & 63; F.wave = __builtin_amdgcn_readfirstlane(F.tid >> 6);
    F.G = gridDim.x; { const int bx = blockIdx.x; F.vcu = (F.G % 8 == 0) ? (bx % 8) * (F.G / 8) + bx / 8 : bx; }
    unsigned char* ws = args.ws;
    F.ctl = (gu32*)(ws + WS_CTL);
    for (int u = F.tid; u < (LDS_BYTES - LDSCTL_OFF) / 4; u += NWAVES * 64) ((LAS unsigned*)(F.lds + LDSCTL_OFF))[u] = 0u;
    __syncthreads();
#if FLAT_BAR
    FlatBar bar{F.ctl, 0u};
#define xcd_barrier(b) flat_barrier(b)
#else
    XcdBarrier bar = xcd_barrier_post((unsigned*)(F.ctl + CW_BAR), F.MISC + 8);
#if XB2
#define xcd_barrier(b) xcd_barrier2(b, F.ctl)
#endif
#endif
    const int lo = args.ph_lo, hi = args.ph_hi;
#ifndef PHMASK
#define PHMASK 0x3ffff
#endif
#define IN(k) (((PHMASK >> (k)) & 1) && lo <= (k) && (k) < hi)
#define SEAM(k) do { if (IN(k) && IN((k) + 1)) xcd_barrier(bar); } while (0)
#ifndef DUPMASK
#define DUPMASK 0
#endif
#define REP(k) _Pragma("unroll") for (int rep_ = 0; rep_ < (((DUPMASK) >> (k)) & 1) + 1; ++rep_)
#define REPBAR() do { if (rep_) xcd_barrier(bar); } while (0)
    const float* const* in = args.in;
    const float* gains = in[1];
    float* hbuf = args.out; void* HB = (void*)(ws + WS_HB);
    bf16* XN = (bf16*)(ws + WS_XN); bf16* MIX = (bf16*)(ws + WS_MIX);
    const int BIG = 1 << 30;
    using pg8::ProbPlain; using pg8::ProbMoE;

    if (IN(0)) REP(0) { REPBAR(); p0_prologue(F, in, ws); } SEAM(0);
#if defined(XTRA_BAR) && XTRA_BAR
    for (int xb_ = 0; xb_ < XTRA_BAR; ++xb_) xcd_barrier(bar);
#endif
    if (IN(1)) REP(1) { REPBAR();
        ProbPlain P{(const char*)XN, (const char*)(ws + WS_BT_IN), 1024, 2048u, 2048u, 0, BIG, {}}; P.S.init(64, 4, F.G, (int)blockIdx.x);
        pg8::EpiU E{(pg8::bf16_t*)(ws + WS_A2)};
        pg8::gemm_phase<ProbPlain, pg8::EpiU, true, true>(F.lds + RING_OFF, P, E);
    } SEAM(1);
    if (IN(2)) REP(2) { REPBAR();
        ProbPlain P{(const char*)(ws + WS_A2), (const char*)(ws + WS_S5_STATE), 256, 1024u, 512u, (size_t)256 * 256 * 2, 4, {}}; P.S.init(256, 1, F.G, (int)blockIdx.x);
        pg8::EpiF32 E{(float*)(ws + WS_S), 256};
        pg8::gemm_phase<ProbPlain, pg8::EpiF32, true, true>(F.lds + RING_OFF, P, E);
    } SEAM(2);
    if (IN(3)) REP(3) { REPBAR(); scan_phase(F, in, ws); } SEAM(3);
    if (IN(4)) REP(4) { REPBAR();
        ProbPlain P{(const char*)(ws + WS_A2), (const char*)(ws + WS_S5_MAIN), 512, 1024u, 1024u, (size_t)256 * 512 * 2, 4, {}}; P.S.init(256, 1, F.G, (int)blockIdx.x);
        pg8::EpiY E{(pg8::bf16_t*)(ws + WS_G1)};
        pg8::gemm_phase<ProbPlain, pg8::EpiY, true, true>(F.lds + RING_OFF, P, E);
    } SEAM(4);
    if (IN(5)) REP(5) { REPBAR();
        ProbPlain P{(const char*)(ws + WS_G1), (const char*)(ws + WS_BT_GLU), 1024, 2048u, 2048u, 0, BIG, {}}; P.S.init(64, 4, F.G, (int)blockIdx.x);
        pg8::EpiGlu E{(const pg8::bf16_t*)(ws + WS_G1), (pg8::bf16_t*)(ws + WS_G2)};
        pg8::gemm_phase<ProbPlain, pg8::EpiGlu, true, true>(F.lds + RING_OFF, P, E);
    } SEAM(5);
    if (IN(6)) REP(6) { REPBAR();
        ProbPlain P{(const char*)(ws + WS_G2), (const char*)(ws + WS_BT_SOUT), 1024, 2048u, 2048u, 0, BIG, {}}; P.S.init(64, 4, F.G, (int)blockIdx.x);
        pg8::EpiBf16 E{MIX, 1024, 1.f};
        pg8::gemm_phase<ProbPlain, pg8::EpiBf16, true, true>(F.lds + RING_OFF, P, E);
    } SEAM(6);
    if (IN(7)) REP(7) { REPBAR(); e_phase<FFN_FP8 != 0, false, true>(F, in[0], MIX, gains + 1 * DM, gains + 2 * DM, HB, XN); } SEAM(7);
    if (IN(8)) REP(8) { REPBAR();
#if FFN_FP8
        ProbPlain P{(const char*)XN, (const char*)(ws + WS_BT_GU), 512, 1024u, 1024u, 0, BIG, {}}; P.S.init(64, 22, F.G, (int)blockIdx.x);
        pg8::EpiSwigluF8 E{(unsigned char*)(ws + WS_ACTF), DFF, 1.f / 256.f, 8.f};
        pg8::gemm_phase<ProbPlain, pg8::EpiSwigluF8, true, true, true>(F.lds + RING_OFF, P, E);
#else
        ProbPlain P{(const char*)XN, (const char*)(ws + WS_BT_GU), 1024, 2048u, 2048u, 0, BIG, {}}; P.S.init(64, 22, F.G, (int)blockIdx.x);
        pg8::EpiSwiglu E{(pg8::bf16_t*)(ws + WS_ACTF), DFF};
        pg8::gemm_phase<ProbPlain, pg8::EpiSwiglu, true, true>(F.lds + RING_OFF, P, E);
#endif
    } SEAM(8);
    if (IN(9)) REP(9) { REPBAR();
#if FFN_FP8
        ProbPlain P{(const char*)(ws + WS_ACTF), (const char*)(ws + WS_BT_FD), DFF / 2, (unsigned)DFF, (unsigned)DFF, 0, BIG, {}}; P.S.init(64, 4, F.G, (int)blockIdx.x);
        pg8::EpiBf16 E{MIX, 1024, 1.f / 512.f};
        pg8::gemm_phase<ProbPlain, pg8::EpiBf16, true, true, true>(F.lds + RING_OFF, P, E);
#else
        ProbPlain P{(const char*)(ws + WS_ACTF), (const char*)(ws + WS_BT_FD), DFF, (unsigned)DFF * 2u, (unsigned)DFF * 2u, 0, BIG, {}}; P.S.init(64, 4, F.G, (int)blockIdx.x);
        pg8::EpiBf16 E{MIX, 1024, 1.f};
        pg8::gemm_phase<ProbPlain, pg8::EpiBf16, true, true>(F.lds + RING_OFF, P, E);
#endif
    } SEAM(9);
    if (IN(10)) REP(10) { REPBAR(); e_phase<false, true, true>(F, HB, MIX, gains + 3 * DM, gains + 4 * DM, HB, XN); } SEAM(10);
    if (IN(11)) REP(11) { REPBAR();
        ProbPlain P{(const char*)XN, (const char*)(ws + WS_BT_QKV), 1024, 2048u, 2048u, 0, BIG, {}}; P.S.init(64, 6, F.G, (int)blockIdx.x);
        pg8::EpiQKV E{(pg8::bf16_t*)(ws + WS_Q), (unsigned)((WS_K - WS_Q) / 2), (unsigned)((WS_V - WS_Q) / 2), (const float*)(ws + WS_QKG), (const float4*)(ws + WS_ROPE_R), QSCALE};
        pg8::gemm_phase<ProbPlain, pg8::EpiQKV, true, true>(F.lds + RING_OFF, P, E);
    } SEAM(11);
    if (IN(12)) REP(12) { REPBAR();
        static_assert(attn_body::ATTN_LDS_BYTES <= RING_BYTES, "attention body LDS");
        const attn_body::AttnTensors AT{(const attn_body::bf16*)(ws + WS_Q), (const attn_body::bf16*)(ws + WS_K), (const attn_body::bf16*)(ws + WS_V), (attn_body::bf16*)(ws + WS_O)};
        const attn_body::StaticOrder S((int)F.G, (int)blockIdx.x);
        float gq = fabsf(((const float*)(ws + WS_QKG))[F.lane]), gk = fabsf(((const float*)(ws + WS_QKG))[64 + F.lane]);
#pragma unroll
        for (int o = 1; o < 64; o <<= 1) { gq = fmaxf(gq, __shfl_xor(gq, o)); gk = fmaxf(gk, __shfl_xor(gk, o)); }
        const float refB = 11.55f * 1.02f * gq * gk;
        if (__builtin_amdgcn_readfirstlane(__float_as_uint(refB)) <= __float_as_uint(60.f)) attn_body::attn_phase<attn_body::StaticOrder, true>((char*)lds + RING_OFF, AT, S, refB);
        else attn_body::attn_phase<attn_body::StaticOrder, false>((char*)lds + RING_OFF, AT, S, 0.f);
    } SEAM(12);
    if (IN(13)) REP(13) { REPBAR();
        ProbPlain P{(const char*)(ws + WS_O), (const char*)(ws + WS_BT_AO), 1024, 2048u, 2048u, 0, BIG, {}}; P.S.init(64, 4, F.G, (int)blockIdx.x);
        pg8::EpiBf16 E{MIX, 1024, 1.f};
        pg8::gemm_phase<ProbPlain, pg8::EpiBf16, true, true>(F.lds + RING_OFF, P, E);
    } SEAM(13);
    if (IN(14)) REP(14) { REPBAR(); e3_phase(F, HB, MIX, gains + 5 * DM, gains + 6 * DM, HB, XN, in[20], ws); } SEAM(14);
    if (IN(15)) REP(15) { REPBAR();
        moe_table(F);
        volatile LAS int* misc = (volatile LAS int*)(F.lds + MOE_OFF);
#if MOE_FP8
        ProbMoE P{(const char*)XN, (const char*)(ws + WS_BT_MGU), 512, 1024u, 1024u, (size_t)7168 * 1024, {}, (const int*)(ws + WS_LIST), misc, true}; P.S.init(misc[8], 28, F.G, (int)blockIdx.x, MOE_WGM);
        pg8::EpiSwigluF8 E{(unsigned char*)(ws + WS_ACTM), DFE, 1.f / 256.f, 8.f};
        pg8::gemm_phase<ProbMoE, pg8::EpiSwigluF8, P15_ALIGN, P15_SP2, true>(F.lds + RING_OFF, P, E);
#else
        ProbMoE P{(const char*)XN, (const char*)(ws + WS_BT_MGU), 1024, 2048u, 2048u, (size_t)7168 * 1024 * 2, {}, (const int*)(ws + WS_LIST), misc, true}; P.S.init(misc[8], 28, F.G, (int)blockIdx.x);
        pg8::EpiSwiglu E{(pg8::bf16_t*)(ws + WS_ACTM), DFE};
        pg8::gemm_phase<ProbMoE, pg8::EpiSwiglu, true, true>(F.lds + RING_OFF, P, E);
#endif
    } SEAM(15);
    if (IN(16)) REP(16) { REPBAR();
        moe_table(F);
        volatile LAS int* misc = (volatile LAS int*)(F.lds + MOE_OFF);
#if MOE_FP8
        ProbMoE P{(const char*)(ws + WS_ACTM), (const char*)(ws + WS_BT_MD), DFE / 2, (unsigned)DFE, (unsigned)DFE, (size_t)1024 * 3584, {}, (const int*)(ws + WS_LIST), misc, false}; P.S.init(misc[8], 4, F.G, (int)blockIdx.x);
        pg8::EpiMoeDown E{(pg8::bf16_t*)(ws + WS_SLOT), (pg8::bf16_t*)(ws + WS_PART), 1.f / 512.f};
        pg8::gemm_phase<ProbMoE, pg8::EpiMoeDown, true, true, true>(F.lds + RING_OFF, P, E);
#else
        ProbMoE P{(const char*)(ws + WS_ACTM), (const char*)(ws + WS_BT_MD), DFE, (unsigned)DFE * 2u, (unsigned)DFE * 2u, (size_t)1024 * 3584 * 2, {}, (const int*)(ws + WS_LIST), misc, false}; P.S.init(misc[8], 4, F.G, (int)blockIdx.x);
        pg8::EpiMoeDown E{(pg8::bf16_t*)(ws + WS_SLOT), (pg8::bf16_t*)(ws + WS_PART), 1.f};
        pg8::gemm_phase<ProbMoE, pg8::EpiMoeDown, true, true>(F.lds + RING_OFF, P, E);
#endif
    } SEAM(16);
    if (IN(17)) REP(17) { REPBAR(); moe_table(F); e4_phase(F, HB, gains + 7 * DM, hbuf, ws); }
#undef IN
#undef SEAM
#if FLAT_BAR || XB2
#undef xcd_barrier
#endif
}


#ifndef CUT
#define CUT 0
#endif
#if CUT
namespace nv {
__device__ __forceinline__ float sigmoidf_(float x) { return 1.f / (1.f + __expf(-x)); }
__device__ __forceinline__ float gelu_tanh(float x) { return x * sigmoidf_(1.5957691216057308f * (x + 0.044715f * x * x * x)); }

__global__ void rms_k(const float* __restrict__ x, const float* __restrict__ gain, float* __restrict__ out) {
    const int row = blockIdx.x * 4 + (threadIdx.x >> 6), lane = threadIdx.x & 63;
    const float4* xr = (const float4*)(x + (size_t)row * DM);
    float4 v[4]; float s = 0.f;
#pragma unroll
    for (int j = 0; j < 4; ++j) { v[j] = xr[lane + 64 * j]; s += v[j].x * v[j].x + v[j].y * v[j].y + v[j].z * v[j].z + v[j].w * v[j].w; }
    const float r = rsqrtf(wave_sum(s) * (1.f / DM) + EPS);
    float4* o = (float4*)(out + (size_t)row * DM);
#pragma unroll
    for (int j = 0; j < 4; ++j) { const float4 g = ((const float4*)gain)[lane + 64 * j]; o[lane + 64 * j] = make_float4(v[j].x * r * g.x, v[j].y * r * g.y, v[j].z * r * g.z, v[j].w * r * g.w); }
}
__global__ void resnorm_k(const float* h, const float* __restrict__ mix, const float* __restrict__ gpost, const float* __restrict__ gpre, float* hout, float* __restrict__ xn) {
    const int row = blockIdx.x * 4 + (threadIdx.x >> 6), lane = threadIdx.x & 63;
    const float4* mr = (const float4*)(mix + (size_t)row * DM); const float4* hr = (const float4*)(h + (size_t)row * DM);
    float4 v[4], hv[4]; float s = 0.f;
#pragma unroll
    for (int j = 0; j < 4; ++j) { v[j] = mr[lane + 64 * j]; hv[j] = hr[lane + 64 * j]; s += v[j].x * v[j].x + v[j].y * v[j].y + v[j].z * v[j].z + v[j].w * v[j].w; }
    const float r = rsqrtf(wave_sum(s) * (1.f / DM) + EPS);
    float s2 = 0.f;
#pragma unroll
    for (int j = 0; j < 4; ++j) { const float4 g = ((const float4*)gpost)[lane + 64 * j];
        hv[j].x += v[j].x * r * g.x; hv[j].y += v[j].y * r * g.y; hv[j].z += v[j].z * r * g.z; hv[j].w += v[j].w * r * g.w;
        s2 += hv[j].x * hv[j].x + hv[j].y * hv[j].y + hv[j].z * hv[j].z + hv[j].w * hv[j].w; }
    float4* ho = (float4*)(hout + (size_t)row * DM);
#pragma unroll
    for (int j = 0; j < 4; ++j) ho[lane + 64 * j] = hv[j];
    if (xn) {
        const float r2 = rsqrtf(wave_sum(s2) * (1.f / DM) + EPS);
        float4* o = (float4*)(xn + (size_t)row * DM);
#pragma unroll
        for (int j = 0; j < 4; ++j) { const float4 g = ((const float4*)gpre)[lane + 64 * j]; o[lane + 64 * j] = make_float4(hv[j].x * r2 * g.x, hv[j].y * r2 * g.y, hv[j].z * r2 * g.z, hv[j].w * r2 * g.w); }
    }
}

struct EpiArgs { float* C; int ldc; int pad0; const float* aux; int ldaux; int pad1; const int* list; const float* wl; const int* cnt;
  EpiArgs(float* C_, int ldc_, const float* aux_, int ldaux_, const int* l, const float* w, const int* c) : C(C_), ldc(ldc_), pad0(0), aux(aux_), ldaux(ldaux_), pad1(0), list(l), wl(w), cnt(c) {} };
template <int EPI, bool GATHER>
__global__ __launch_bounds__(256) void gemm_k(const float* __restrict__ A, int lda, const float* __restrict__ W, int ldw, int M, int N, int K, EpiArgs ea) {
    __shared__ float As[8][132]; __shared__ float Bs[8][132];
    const int m_lim = ea.cnt ? *ea.cnt : M;
    const int bm = blockIdx.y * 128, bn = blockIdx.x * 128;
    if (bm >= m_lim) return;
    const int tid = threadIdx.x, tx = tid & 15, ty = tid >> 4;
    const int arow = bm + (tid >> 1);
    const int srow = (arow < m_lim) ? (GATHER ? ea.list[arow] : arow) : (GATHER ? ea.list[0] : 0);
    const float* ap = A + (size_t)srow * lda + (tid & 1) * 4;
    const float* bp = W + (size_t)(tid >> 5) * ldw + bn + (tid & 31) * 4;
    float acc[8][8];
#pragma unroll
    for (int i = 0; i < 8; ++i)
#pragma unroll
        for (int j = 0; j < 8; ++j) acc[i][j] = 0.f;
    for (int k0 = 0; k0 < K; k0 += 8) {
        const float4 av = *(const float4*)(ap + k0);
        const float4 bv = *(const float4*)(bp + (size_t)k0 * ldw);
        __syncthreads();
        As[(tid & 1) * 4 + 0][tid >> 1] = av.x; As[(tid & 1) * 4 + 1][tid >> 1] = av.y; As[(tid & 1) * 4 + 2][tid >> 1] = av.z; As[(tid & 1) * 4 + 3][tid >> 1] = av.w;
        *(float4*)&Bs[tid >> 5][(tid & 31) * 4] = bv;
        __syncthreads();
#pragma unroll
        for (int k = 0; k < 8; ++k) {
            float a[8], b[8];
            *(float4*)&a[0] = *(const float4*)&As[k][ty * 8]; *(float4*)&a[4] = *(const float4*)&As[k][ty * 8 + 4];
            *(float4*)&b[0] = *(const float4*)&Bs[k][tx * 8]; *(float4*)&b[4] = *(const float4*)&Bs[k][tx * 8 + 4];
#pragma unroll
            for (int i = 0; i < 8; ++i)
#pragma unroll
                for (int j = 0; j < 8; ++j) acc[i][j] = fmaf(a[i], b[j], acc[i][j]);
        }
    }
#pragma unroll
    for (int i = 0; i < 8; ++i) {
        const int row = bm + ty * 8 + i;
        if (row >= m_lim) continue;
        int tok = 0; float wgt = 0.f;
        if (EPI == 3) { tok = ea.list[row]; wgt = ea.wl[row]; }
#pragma unroll
        for (int j = 0; j < 8; ++j) {
            const int col = bn + tx * 8 + j; const float v = acc[i][j];
            if (EPI == 0) ea.C[(size_t)row * ea.ldc + col] = v;
            else if (EPI == 1) ea.C[(size_t)row * ea.ldc + col] = ea.aux[(size_t)row * ea.ldaux + col] * sigmoidf_(v);
            else if (EPI == 2) { const float g = ea.aux[(size_t)row * ea.ldaux + col]; ea.C[(size_t)row * ea.ldc + col] = g * sigmoidf_(g) * v; }
            else if (EPI == 3) ea.C[(size_t)tok * ea.ldc + col] += wgt * v;
        }
    }
}

__global__ __launch_bounds__(64) void s5_scan_k(const float* __restrict__ u, const float* __restrict__ lam_re, const float* __restrict__ lam_im, const float* __restrict__ log_step,
                                                const float* __restrict__ b_re, const float* __restrict__ b_im, const float* __restrict__ c_re, const float* __restrict__ c_im, float* __restrict__ yout) {
    __shared__ float us[64][16];
    const int dir = blockIdx.x & 1, g = (blockIdx.x >> 1) & 63, b = blockIdx.x >> 7, p = threadIdx.x;
    const double step = exp((double)log_step[dir * 64 + g]);
    const double lr = lam_re[(dir * 64 + g) * 64 + p], li = lam_im[(dir * 64 + g) * 64 + p];
    const double mag = exp(lr * step), ang = li * step;
    const double ard = mag * cos(ang), aid = mag * sin(ang);
    const double nr = ard - 1.0, ni = aid, den = lr * lr + li * li;
    const double qr = (nr * lr + ni * li) / den, qi = (ni * lr - nr * li) / den;
    const float ar = (float)ard, ai = (float)aid;
    float bbr[16], bbi[16], cr[16], ci[16];
#pragma unroll
    for (int i = 0; i < 16; ++i) {
        const double br = b_re[((dir * 64 + g) * 64 + p) * 16 + i], bi = b_im[((dir * 64 + g) * 64 + p) * 16 + i];
        bbr[i] = (float)(qr * br - qi * bi); bbi[i] = (float)(qr * bi + qi * br);
        cr[i] = c_re[((dir * 64 + g) * 16 + i) * 64 + p]; ci[i] = c_im[((dir * 64 + g) * 16 + i) * 64 + p];
    }
    float xr = 0.f, xi = 0.f;
    float* yo = yout + (size_t)dir * NTOK * DM;
    for (int c = 0; c < SEQ / 64; ++c) {
        { const int s = p; const int st = c * 64 + s; const int t = dir == 0 ? st : SEQ - 1 - st;
          const float4* src = (const float4*)(u + (size_t)(b * SEQ + t) * DM + g * 16);
          __syncthreads();
#pragma unroll
          for (int q = 0; q < 4; ++q) *(float4*)&us[s][q * 4] = src[q];
          __syncthreads(); }
        for (int s = 0; s < 64; ++s) {
            const int st = c * 64 + s; const int t = dir == 0 ? st : SEQ - 1 - st;
            float bur = 0.f, bui = 0.f;
#pragma unroll
            for (int i = 0; i < 16; ++i) { const float uu = us[s][i]; bur = fmaf(bbr[i], uu, bur); bui = fmaf(bbi[i], uu, bui); }
            const float nxr = ar * xr - ai * xi + bur, nxi = ar * xi + ai * xr + bui;
            xr = nxr; xi = nxi;
            float mine = 0.f;
#pragma unroll
            for (int j = 0; j < 16; ++j) { const float v = wave_sum(cr[j] * xr - ci[j] * xi); if (p == j) mine = v; }
            if (p < 16) yo[(size_t)(b * SEQ + t) * DM + g * 16 + p] = mine;
        }
    }
}
__global__ void gelu_comb_k(const float* __restrict__ u, const float* __restrict__ dskip, const float* __restrict__ y2, float* __restrict__ g1) {
    const size_t i = (size_t)blockIdx.x * 256 + threadIdx.x;
    const int c = (int)(i & (DM - 1));
    const float y = dskip[c] * u[i] + y2[i] + y2[i + (size_t)NTOK * DM];
    g1[i] = gelu_tanh(y);
}

__global__ void qknorm_rope_k(float* __restrict__ qkv, const float* __restrict__ qg, const float* __restrict__ kg) {
    const int w = blockIdx.x * 4 + (threadIdx.x >> 6), d = threadIdx.x & 63;
    const int tok = w / 20, hs = w % 20;
    float* p = qkv + (size_t)tok * QKVW + hs * 64;
    const float v = p[d];
    const float r = rsqrtf(wave_sum(v * v) * (1.f / 64.f) + EPS);
    const float y = v * r * (hs < 16 ? qg[d] : kg[d]);
    const float partner = __shfl_xor(y, 1);
    const int pos = tok % SEQ, i = d >> 1;
    const int f = i & 15;
    const float freq = powf(10000.f, -(float)(2 * f) / 32.f);
    const float ang = (float)(i < 16 ? pos / 64 : pos % 64) * freq;
    const float c = cosf(ang), s = sinf(ang);
    const float o = (d & 1) ? (partner * s + y * c) : (y * c - partner * s);
    p[d] = o;
}

__global__ __launch_bounds__(256) void attn_k(const float* __restrict__ qkv, float* __restrict__ o) {
    __shared__ float Qs[64][65], Ks[64][65], Vs[64][65];
    float (*Ps)[65] = Ks;
    const int qb = blockIdx.x, h = blockIdx.y, b = blockIdx.z, kvh = h >> 2;
    const int tid = threadIdx.x, tx = tid & 15, ty = tid >> 4;
    const size_t rowbase = (size_t)b * SEQ;
    for (int e = tid; e < 64 * 64; e += 256) { const int r = e >> 6, d = e & 63; Qs[r][d] = qkv[(rowbase + qb * 64 + r) * QKVW + h * 64 + d] * 0.125f; }
    float m[4], l[4], oacc[4][4];
#pragma unroll
    for (int i = 0; i < 4; ++i) { m[i] = -INFINITY; l[i] = 0.f;
#pragma unroll
        for (int j = 0; j < 4; ++j) oacc[i][j] = 0.f; }
    for (int kt = 0; kt < SEQ / 64; ++kt) {
        __syncthreads();
        for (int e = tid; e < 64 * 64; e += 256) { const int r = e >> 6, d = e & 63; const size_t rr = (rowbase + kt * 64 + r) * QKVW;
            Ks[r][d] = qkv[rr + 1024 + kvh * 64 + d]; Vs[r][d] = qkv[rr + 1280 + kvh * 64 + d]; }
        __syncthreads();
        float s[4][4];
#pragma unroll
        for (int i = 0; i < 4; ++i)
#pragma unroll
            for (int j = 0; j < 4; ++j) s[i][j] = 0.f;
        for (int d = 0; d < 64; ++d) {
            float a[4], k[4];
#pragma unroll
            for (int i = 0; i < 4; ++i) { a[i] = Qs[ty * 4 + i][d]; k[i] = Ks[tx * 4 + i][d]; }
#pragma unroll
            for (int i = 0; i < 4; ++i)
#pragma unroll
                for (int j = 0; j < 4; ++j) s[i][j] = fmaf(a[i], k[j], s[i][j]);
        }
        __syncthreads();
#pragma unroll
        for (int i = 0; i < 4; ++i) {
            float mx = fmaxf(fmaxf(s[i][0], s[i][1]), fmaxf(s[i][2], s[i][3]));
#pragma unroll
            for (int of = 1; of < 16; of <<= 1) mx = fmaxf(mx, __shfl_xor(mx, of));
            const float mn = fmaxf(m[i], mx);
            const float sc = __expf(m[i] - mn);
            float ps = 0.f;
#pragma unroll
            for (int j = 0; j < 4; ++j) { const float pp = __expf(s[i][j] - mn); Ps[ty * 4 + i][tx * 4 + j] = pp; ps += pp; }
#pragma unroll
            for (int of = 1; of < 16; of <<= 1) ps += __shfl_xor(ps, of);
            l[i] = l[i] * sc + ps; m[i] = mn;
#pragma unroll
            for (int j = 0; j < 4; ++j) oacc[i][j] *= sc;
        }
        __syncthreads();
        for (int k = 0; k < 64; ++k) {
            float pp[4], vv[4];
#pragma unroll
            for (int i = 0; i < 4; ++i) { pp[i] = Ps[ty * 4 + i][k]; vv[i] = Vs[k][tx * 4 + i]; }
#pragma unroll
            for (int i = 0; i < 4; ++i)
#pragma unroll
                for (int j = 0; j < 4; ++j) oacc[i][j] = fmaf(pp[i], vv[j], oacc[i][j]);
        }
    }
#pragma unroll
    for (int i = 0; i < 4; ++i) { const float inv = 1.f / l[i];
#pragma unroll
        for (int j = 0; j < 4; ++j) o[(rowbase + qb * 64 + ty * 4 + i) * DM + h * 64 + tx * 4 + j] = oacc[i][j] * inv; }
}

__global__ void router_k(const float* __restrict__ xn, const float* __restrict__ wr, int* __restrict__ cnt, int* __restrict__ lists, float* __restrict__ wlists) {
    const int tok = blockIdx.x * 4 + (threadIdx.x >> 6), lane = threadIdx.x & 63;
    float lg[8];
#pragma unroll
    for (int e = 0; e < 8; ++e) lg[e] = 0.f;
    for (int j = 0; j < 16; ++j) { const int d = lane + 64 * j; const float x = xn[(size_t)tok * DM + d];
        const float4 w0 = *(const float4*)(wr + d * 8), w1 = *(const float4*)(wr + d * 8 + 4);
        lg[0] = fmaf(x, w0.x, lg[0]); lg[1] = fmaf(x, w0.y, lg[1]); lg[2] = fmaf(x, w0.z, lg[2]); lg[3] = fmaf(x, w0.w, lg[3]);
        lg[4] = fmaf(x, w1.x, lg[4]); lg[5] = fmaf(x, w1.y, lg[5]); lg[6] = fmaf(x, w1.z, lg[6]); lg[7] = fmaf(x, w1.w, lg[7]); }
#pragma unroll
    for (int e = 0; e < 8; ++e) lg[e] = wave_sum(lg[e]);
    int e0 = 0; float l0 = lg[0];
#pragma unroll
    for (int e = 1; e < 8; ++e) if (lg[e] > l0) { l0 = lg[e]; e0 = e; }
    int e1 = -1; float l1 = -INFINITY;
#pragma unroll
    for (int e = 0; e < 8; ++e) if (e != e0 && lg[e] > l1) { l1 = lg[e]; e1 = e; }
    const float w0 = 1.f / (1.f + expf(l1 - l0)), w1 = 1.f - w0;
    if (lane == 0) {
        const int p0 = atomicAdd(&cnt[e0], 1); lists[e0 * NTOK + p0] = tok; wlists[e0 * NTOK + p0] = w0;
        const int p1 = atomicAdd(&cnt[e1], 1); lists[e1 * NTOK + p1] = tok; wlists[e1 * NTOK + p1] = w1;
    }
}


__global__ void cvt_k(const unsigned short* __restrict__ s, float* __restrict__ d) { const size_t i = (size_t)blockIdx.x * 256 + threadIdx.x; d[i] = __uint_as_float((unsigned)s[i] << 16); }
template <int EPI, bool GATHER>
static void gemm(hipStream_t st, const float* A, int lda, const float* W, int ldw, int M, int N, int K, EpiArgs ea) {
    hipLaunchKernelGGL((gemm_k<EPI, GATHER>), dim3(N / 128, M / 128), dim3(256), 0, st, A, lda, W, ldw, M, N, K, ea);
}
}
#endif
extern "C" void kernel_launch(void* const* d_in, const int* in_sizes, int n_in, void* d_out, int out_size, void* d_ws, size_t ws_size, hipStream_t stream) {
    static int grid = 0;
    if (grid == 0) {
        grid = -1;
        if (n_in != 24 || in_sizes[0] != NTOK * DM || out_size != NTOK * DM || ws_size < WS_END) { fprintf(stderr, "kernel_launch: unexpected problem (n_in %d, ws %zu)\n", n_in, ws_size); return; }
        int dev = 0, cus = 0;
        if (hipGetDevice(&dev) != hipSuccess || hipDeviceGetAttribute(&cus, hipDeviceAttributeMultiprocessorCount, dev) != hipSuccess) return;
        if (hipFuncSetAttribute((const void*)mega_fwd, hipFuncAttributeMaxDynamicSharedMemorySize, LDS_BYTES) != hipSuccess) return;
        int per_cu = 0;
        if (hipOccupancyMaxActiveBlocksPerMultiprocessor(&per_cu, (const void*)mega_fwd, NWAVES * 64, LDS_BYTES) != hipSuccess || per_cu < 1) { fprintf(stderr, "kernel_launch: occupancy query says %d\n", per_cu); (void)hipGetLastError(); return; }
        if (cus != 256) { fprintf(stderr, "kernel_launch: built for 256 CUs, found %d\n", cus); return; }
        grid = cus;
    }
    if (grid < 0) return;
    if (hipMemsetAsync((char*)d_ws + WS_CTL, 0, CTL_ZERO_BYTES, stream) != hipSuccess) return;
    Args a{};
    for (int i = 0; i < 24; ++i) a.in[i] = (const float*)d_in[i];
    a.out = (float*)d_out; a.ws = (unsigned char*)d_ws; a.ph_lo = 0; a.ph_hi = CUT ? CUT : 18;
    hipLaunchKernelGGL(mega_fwd, dim3(grid), dim3(NWAVES * 64), LDS_BYTES, stream, a);
#if CUT
    {
        using namespace nv;
        const float* gains = (const float*)d_in[1];
        const float* ffn_g = (const float*)d_in[13]; const float* ffn_u = (const float*)d_in[14]; const float* ffn_d = (const float*)d_in[15];
        const float* w_qkv = (const float*)d_in[16]; const float* q_gain = (const float*)d_in[17]; const float* k_gain = (const float*)d_in[18]; const float* attn_wo = (const float*)d_in[19];
        const float* w_router = (const float*)d_in[20]; const float* moe_g = (const float*)d_in[21]; const float* moe_u = (const float*)d_in[22]; const float* moe_d = (const float*)d_in[23];
        float* h = (float*)d_out; char* ws = (char*)d_ws;
        float* xn = (float*)(ws + 4 * MiB); float* mix = (float*)(ws + 68 * MiB);
        hipLaunchKernelGGL(cvt_k, dim3(NTOK * DM / 256), dim3(256), 0, stream, (const unsigned short*)(ws + WS_XN), xn);
        if (CUT <= 8) {
            float* G = (float*)(ws + 132 * MiB);
            gemm<0, false>(stream, xn, DM, ffn_g, DFF, NTOK, DFF, DM, EpiArgs{G, DFF, nullptr, 0, nullptr, nullptr, nullptr});
            gemm<2, false>(stream, xn, DM, ffn_u, DFF, NTOK, DFF, DM, EpiArgs{G, DFF, G, DFF, nullptr, nullptr, nullptr});
            gemm<0, false>(stream, G, DFF, ffn_d, DM, NTOK, DM, DFF, EpiArgs{mix, DM, nullptr, 0, nullptr, nullptr, nullptr});
            hipLaunchKernelGGL(resnorm_k, dim3(NTOK / 4), dim3(256), 0, stream, h, mix, gains + 3 * DM, gains + 4 * DM, h, xn);
        }
        if (CUT <= 11) {
            float* qkv = (float*)(ws + 132 * MiB); float* ob = (float*)(ws + 228 * MiB);
            gemm<0, false>(stream, xn, DM, w_qkv, QKVW, NTOK, QKVW, DM, EpiArgs{qkv, QKVW, nullptr, 0, nullptr, nullptr, nullptr});
            hipLaunchKernelGGL(qknorm_rope_k, dim3(NTOK * 20 / 4), dim3(256), 0, stream, qkv, q_gain, k_gain);
            hipLaunchKernelGGL(attn_k, dim3(SEQ / 64, 16, NB), dim3(256), 0, stream, qkv, ob);
            gemm<0, false>(stream, ob, DM, attn_wo, DM, NTOK, DM, DM, EpiArgs{mix, DM, nullptr, 0, nullptr, nullptr, nullptr});
            hipLaunchKernelGGL(resnorm_k, dim3(NTOK / 4), dim3(256), 0, stream, h, mix, gains + 5 * DM, gains + 6 * DM, h, xn);
        }
        {
            float* Ge = (float*)(ws + 132 * MiB); float* ff = (float*)(ws + 356 * MiB);
            int* cnt = (int*)(ws + 420 * MiB); int* lists = (int*)(ws + 421 * MiB); float* wlists = (float*)(ws + 422 * MiB);
            (void)hipMemsetAsync(cnt, 0, 64, stream);
            (void)hipMemsetAsync(ff, 0, (size_t)NTOK * DM * 4, stream);
            hipLaunchKernelGGL(router_k, dim3(NTOK / 4), dim3(256), 0, stream, xn, w_router, cnt, lists, wlists);
            for (int e = 0; e < NEXP; ++e) {
                const int* le = lists + e * NTOK; const float* we = wlists + e * NTOK;
                gemm<0, true>(stream, xn, DM, moe_g + (size_t)e * DM * DFE, DFE, NTOK, DFE, DM, EpiArgs{Ge, DFE, nullptr, 0, le, we, cnt + e});
                gemm<2, true>(stream, xn, DM, moe_u + (size_t)e * DM * DFE, DFE, NTOK, DFE, DM, EpiArgs{Ge, DFE, Ge, DFE, le, we, cnt + e});
                gemm<3, false>(stream, Ge, DFE, moe_d + (size_t)e * DFE * DM, DM, NTOK, DM, DFE, EpiArgs{ff, DM, nullptr, 0, le, we, cnt + e});
            }
            hipLaunchKernelGGL(resnorm_k, dim3(NTOK / 4), dim3(256), 0, stream, h, ff, gains + 7 * DM, gains + 7 * DM, h, (float*)nullptr);
        }
    }
#endif
}
```

```cpp
#include <hip/hip_runtime.h>
#include <hip/hip_bf16.h>
#include <cstdio>
#include <cstdint>
#include <cmath>
#define CUT 0
#define DUPMASK 0
#define P0DUP 0
#define EXP_GATHER 0
#define MOE_WGM 4

namespace pg8 {
#define PG8_LAS __attribute__((address_space(3)))
typedef unsigned short bf16_t;
typedef short bf16x8 __attribute__((ext_vector_type(8)));
typedef float f32x4 __attribute__((ext_vector_type(4)));
typedef unsigned u32x4 __attribute__((ext_vector_type(4)));
typedef unsigned u32x2 __attribute__((ext_vector_type(2)));
typedef int v8i32 __attribute__((ext_vector_type(8)));
constexpr int BM = 256, BK = 64, HALF = 128, HTB = HALF * BK * 2  , STAGE_BYTES = 8 * HTB, NXCD = 8, WGM = 8;

__host__ __device__ __forceinline__ int lds_byte(int r, int c) { const int st = (r >> 4) * 2 + (c >> 5), rr = r & 15, cc = c & 31, ob = rr * 64 + cc * 2; return st * 1024 + (ob ^ (((ob >> 9) & 1) << 5)); }
__host__ __device__ __forceinline__ void stage_rc(int b, int& R, int& C) { const int st = b / 1024, sb = b % 1024, swz = sb ^ (((sb >> 9) & 1) << 5); R = (st >> 1) * 16 + swz / 64; C = (st & 1) * 32 + (swz % 64) / 2; }
__host__ __device__ __forceinline__ int perm32(int rho) { const int n = rho >> 4, i = rho & 15; return 8 * (i >> 2) + 4 * n + (i & 3); }

struct Unit { int pm, pn, kofs, nt, aux; };

struct StaticOrder {
    int nM, nN, nwg, G, c, wgm;
    __host__ __device__ void init(int nM_, int nN_, int G_, int c_, int wgm_ = WGM) { nM = nM_; nN = nN_; nwg = nM * nN; G = G_; c = c_; wgm = wgm_; }
    __host__ __device__ bool next(int i, Unit& u) const {
        const long L = (long)i * G + c; if (L >= nwg) return false;
        int wgid = (int)L; { const int q = nwg / NXCD, r = nwg % NXCD, xcd = wgid % NXCD, off = wgid / NXCD; wgid = (xcd < r ? xcd * (q + 1) : r * (q + 1) + (xcd - r) * q) + off; }
        const int nig = wgm * nN, gid = wgid / nig, fm = gid * wgm, gsz = (nM - fm) < wgm ? (nM - fm) : wgm;
        u.pm = fm + ((wgid % nig) % gsz); u.pn = (wgid % nig) / gsz; return true;
    }
};

__device__ __forceinline__ unsigned cvt_pk_bf16(float lo, float hi) { unsigned r; asm volatile("v_cvt_pk_bf16_f32 %0, %1, %2" : "=v"(r) : "v"(lo), "v"(hi)); return r; }
__device__ __forceinline__ float bf_lo(unsigned w) { return __uint_as_float(w << 16); }
__device__ __forceinline__ float bf_hi(unsigned w) { return __uint_as_float(w & 0xffff0000u); }
__device__ __forceinline__ float sigm(float x) { return __builtin_amdgcn_rcpf(1.f + __builtin_amdgcn_exp2f(-1.4426950408889634f * x)); }
__device__ __forceinline__ float gelu_t(float x) { return x * sigm(1.5957691216057308f * (x + 0.044715f * x * x * x)); }
#ifndef WT_STORES
#define WT_STORES 0
#endif
__device__ __forceinline__ void st16(void* p, const u32x4& v) {
#if WT_STORES
    asm volatile("global_store_dwordx4 %0, %1, off sc1\n\ts_nop 1" :: "v"(p), "v"(v) : "memory");
#else
    *(u32x4*)p = v;
#endif
}
__device__ __forceinline__ u32x4 pack8(const f32x4& a, const f32x4& b) { u32x4 w; w.x = cvt_pk_bf16(a[0], a[1]); w.y = cvt_pk_bf16(a[2], a[3]); w.z = cvt_pk_bf16(b[0], b[1]); w.w = cvt_pk_bf16(b[2], b[3]); return w; }

struct ProbPlain {
    const char* abase; const char* Bt; int K; unsigned ldaB, ldbB; size_t bstride; int pm_per_b; StaticOrder S;
    __device__ __forceinline__ bool next(int i, Unit& u) const { u.kofs = 0; u.nt = K / BK; u.aux = 0; return S.next(i, u); }
    __device__ __forceinline__ const char* bbase(const Unit& u) const { return Bt + (size_t)(u.pm / pm_per_b) * bstride + (size_t)u.pn * 256 * ldbB; }
    __device__ __forceinline__ void aoffs(const Unit& u, const int (&R)[2], unsigned (&off)[2][2]) const {
#pragma unroll
        for (int h = 0; h < 2; ++h)
#pragma unroll
            for (int i = 0; i < 2; ++i) off[h][i] = (unsigned)(u.pm * 256 + h * 128 + R[i]) * ldaB;
    }
};
struct ProbMoE {
    const char* abase; const char* Bt; int K; unsigned ldaB, ldbB; size_t bstride; StaticOrder S;
    const int* lists; volatile PG8_LAS int* misc; bool gather;
    __device__ __forceinline__ bool next(int i, Unit& u) const {
        if (gather) { u.kofs = 0; u.nt = K / BK; u.aux = 0; return S.next(i, u); }
        const int c = S.c, x = c & 7, y = c >> 3, first_rem = misc[10];
        const int pm = 64 * i + 8 * x + (y & 7);
        if (pm < first_rem) { u.pm = pm; u.pn = y >> 3; u.kofs = 0; u.nt = K / BK; u.aux = 0; return true; }
        if (64 * i != first_rem || c >= misc[11]) return false;
        const int parts = misc[9], j = c / parts, part = c - j * parts, ntp = (K / BK) / parts;
        u.pm = first_rem + (j >> 2); u.pn = j & 3; u.nt = ntp; u.kofs = part * ntp * BK * 2; u.aux = c + 1; return true;
    }
    __device__ __forceinline__ int expert(int pm) const { int e = 0;
#pragma unroll
        for (int j = 1; j < 8; ++j) e += (pm >= misc[j]) ? 1 : 0;
        return e; }
    __device__ __forceinline__ const char* bbase(const Unit& u) const { return Bt + (size_t)__builtin_amdgcn_readfirstlane(expert(u.pm)) * bstride + (size_t)u.pn * 256 * ldbB; }
    __device__ __forceinline__ void aoffs(const Unit& u, const int (&R)[2], unsigned (&off)[2][2]) const {
        if (gather) {
            const int e = expert(u.pm), t0 = misc[e], cnt = misc[16 + e];
#pragma unroll
            for (int h = 0; h < 2; ++h)
#pragma unroll
                for (int i = 0; i < 2; ++i) { const int pos = (u.pm - t0) * 256 + h * 128 + R[i]; const int tok = pos < cnt ? lists[e * 16384 + pos] : 0; off[h][i] = (unsigned)tok * ldaB; }
        } else {
#pragma unroll
            for (int h = 0; h < 2; ++h)
#pragma unroll
                for (int i = 0; i < 2; ++i) off[h][i] = (unsigned)(u.pm * 256 + h * 128 + R[i]) * ldaB;
        }
    }
};

struct EpiF32 {
    static constexpr bool PERM = false;
    float* C; int ldc;
    __device__ __forceinline__ void operator()(const f32x4 (&acc)[2][2][4][2], const Unit& u, int wr, int wc, int fr, int fq) const {
        const int row0 = u.pm * BM + wr * 64 + fr, col0 = u.pn * BM + wc * 32 + 4 * fq;
#pragma unroll
        for (int ai = 0; ai < 2; ++ai)
#pragma unroll
            for (int m = 0; m < 4; ++m) { float* rowp = C + (size_t)(row0 + ai * HALF + m * 16) * ldc + col0;
#pragma unroll
                for (int bj = 0; bj < 2; ++bj)
#pragma unroll
                    for (int n = 0; n < 2; ++n) { const f32x4 t_ = acc[ai][bj][m][n]; st16(rowp + bj * HALF + n * 16, __builtin_bit_cast(u32x4, t_)); } }
    }
};
struct EpiBf16 {
    static constexpr bool PERM = true;
    bf16_t* O; int ldc; float scale;
    __device__ __forceinline__ void operator()(const f32x4 (&acc)[2][2][4][2], const Unit& u, int wr, int wc, int fr, int fq) const {
        const int row0 = u.pm * BM + wr * 64 + fr, col0 = u.pn * BM + wc * 32 + 8 * fq;
#pragma unroll
        for (int ai = 0; ai < 2; ++ai)
#pragma unroll
            for (int m = 0; m < 4; ++m) { bf16_t* rowp = O + (size_t)(row0 + ai * HALF + m * 16) * ldc + col0;
#pragma unroll
                for (int bj = 0; bj < 2; ++bj) st16(rowp + bj * HALF, pack8(acc[ai][bj][m][0] * scale, acc[ai][bj][m][1] * scale)); }
    }
};
struct EpiMoeDown {
    static constexpr bool PERM = true;
    bf16_t* O; bf16_t* PART; float scale;
    __device__ __forceinline__ void operator()(const f32x4 (&acc)[2][2][4][2], const Unit& u, int wr, int wc, int fr, int fq) const {
        const int r0 = wr * 64 + fr, c0 = wc * 32 + 8 * fq;
        bf16_t* base = u.aux == 0 ? O + ((size_t)u.pm * BM * 1024 + (size_t)u.pn * BM) : PART + (size_t)(u.aux - 1) * 65536;
        const int ldo = u.aux == 0 ? 1024 : 256;
#pragma unroll
        for (int ai = 0; ai < 2; ++ai)
#pragma unroll
            for (int m = 0; m < 4; ++m) { bf16_t* rowp = base + (size_t)(r0 + ai * HALF + m * 16) * ldo + c0;
#pragma unroll
                for (int bj = 0; bj < 2; ++bj) st16(rowp + bj * HALF, pack8(acc[ai][bj][m][0] * scale, acc[ai][bj][m][1] * scale)); }
    }
};
__device__ __forceinline__ unsigned pack4_fp8(float a, float b, float c, float d) {
    a = __builtin_amdgcn_fmed3f(a, -448.f, 448.f); b = __builtin_amdgcn_fmed3f(b, -448.f, 448.f); c = __builtin_amdgcn_fmed3f(c, -448.f, 448.f); d = __builtin_amdgcn_fmed3f(d, -448.f, 448.f);
    int w = __builtin_amdgcn_cvt_pk_fp8_f32(a, b, 0, false); w = __builtin_amdgcn_cvt_pk_fp8_f32(c, d, w, true); return (unsigned)w; }
struct EpiSwigluF8 {
    static constexpr bool PERM = true;
    unsigned char* O; int ldc; float sin, sout;
    __device__ __forceinline__ void operator()(const f32x4 (&acc)[2][2][4][2], const Unit& u, int wr, int wc, int fr, int fq) const {
        const int row0 = u.pm * BM + wr * 64 + fr, col0 = u.pn * HALF + wc * 32 + 8 * fq;
        const float c1 = -1.4426950408889634f * sin, kk = 1.f / (sin * sin * sout);
#pragma unroll
        for (int ai = 0; ai < 2; ++ai)
#pragma unroll
            for (int m = 0; m < 4; ++m) { f32x4 a, b;
#pragma unroll
                for (int e = 0; e < 4; ++e) {
                    const float g0 = acc[ai][0][m][0][e], g1 = acc[ai][0][m][1][e];
                    const float e0 = __builtin_amdgcn_exp2f(g0 * c1), e1 = __builtin_amdgcn_exp2f(g1 * c1);
                    a[e] = (g0 * acc[ai][1][m][0][e]) * __builtin_amdgcn_rcpf(__builtin_fmaf(e0, kk, kk)); b[e] = (g1 * acc[ai][1][m][1][e]) * __builtin_amdgcn_rcpf(__builtin_fmaf(e1, kk, kk)); }
                u32x2 w; w.x = pack4_fp8(a[0], a[1], a[2], a[3]); w.y = pack4_fp8(b[0], b[1], b[2], b[3]);
                *(u32x2*)(O + (size_t)(row0 + ai * HALF + m * 16) * ldc + col0) = w; }
    }
};
struct EpiU {
    static constexpr bool PERM = true;
    bf16_t* A2;
    __device__ __forceinline__ void operator()(const f32x4 (&acc)[2][2][4][2], const Unit& u, int wr, int wc, int fr, int fq) const {
        const int row0 = u.pm * BM + wr * 64 + fr, col0 = u.pn * BM + wc * 32 + 8 * fq;
#pragma unroll
        for (int ai = 0; ai < 2; ++ai)
#pragma unroll
            for (int m = 0; m < 4; ++m) { const int row = row0 + ai * HALF + m * 16, c = row >> 4, t = row & 15;
#pragma unroll
                for (int bj = 0; bj < 2; ++bj) { const int col = col0 + bj * HALF, g = col >> 4, i0 = col & 15;
                    st16(A2 + ((size_t)(g * 1024 + c) * 512 + t * 16 + i0), pack8(acc[ai][bj][m][0], acc[ai][bj][m][1])); } }
    }
};
struct EpiY {
    static constexpr bool PERM = true;
    bf16_t* G1;
    __device__ __forceinline__ void operator()(const f32x4 (&acc)[2][2][4][2], const Unit& u, int wr, int wc, int fr, int fq) const {
        const int row0 = u.pm * BM + wr * 64 + fr, col0 = wc * 32 + 8 * fq;
#pragma unroll
        for (int ai = 0; ai < 2; ++ai)
#pragma unroll
            for (int m = 0; m < 4; ++m) { const int row = row0 + ai * HALF + m * 16, g = row >> 10, c = row & 1023;
#pragma unroll
                for (int bj = 0; bj < 2; ++bj) { const int col = col0 + bj * HALF, t = col >> 4, j0 = col & 15;
                    f32x4 a = acc[ai][bj][m][0], b = acc[ai][bj][m][1];
#pragma unroll
                    for (int e = 0; e < 4; ++e) { a[e] = gelu_t(a[e]); b[e] = gelu_t(b[e]); }
                    st16(G1 + ((size_t)(c * 16 + t) * 1024 + g * 16 + j0), pack8(a, b)); } }
    }
};
struct EpiGlu {
    static constexpr bool PERM = true;
    const bf16_t* G1; bf16_t* G2;
    __device__ __forceinline__ void operator()(const f32x4 (&acc)[2][2][4][2], const Unit& u, int wr, int wc, int fr, int fq) const {
        const int row0 = u.pm * BM + wr * 64 + fr, col0 = u.pn * BM + wc * 32 + 8 * fq;
#pragma unroll
        for (int ai = 0; ai < 2; ++ai)
#pragma unroll
            for (int m = 0; m < 4; ++m) { const size_t ro = (size_t)(row0 + ai * HALF + m * 16) * 1024 + col0;
#pragma unroll
                for (int bj = 0; bj < 2; ++bj) { const u32x4 gv = *(const u32x4*)(G1 + ro + bj * HALF);
                    f32x4 a = acc[ai][bj][m][0], b = acc[ai][bj][m][1];
                    a[0] = bf_lo(gv.x) * sigm(a[0]); a[1] = bf_hi(gv.x) * sigm(a[1]); a[2] = bf_lo(gv.y) * sigm(a[2]); a[3] = bf_hi(gv.y) * sigm(a[3]);
                    b[0] = bf_lo(gv.z) * sigm(b[0]); b[1] = bf_hi(gv.z) * sigm(b[1]); b[2] = bf_lo(gv.w) * sigm(b[2]); b[3] = bf_hi(gv.w) * sigm(b[3]);
                    st16(G2 + ro + bj * HALF, pack8(a, b)); } }
    }
};
struct EpiSwiglu {
    static constexpr bool PERM = true;
    bf16_t* O; int ldc;
    __device__ __forceinline__ void operator()(const f32x4 (&acc)[2][2][4][2], const Unit& u, int wr, int wc, int fr, int fq) const {
        const int row0 = u.pm * BM + wr * 64 + fr, col0 = u.pn * HALF + wc * 32 + 8 * fq;
#pragma unroll
        for (int ai = 0; ai < 2; ++ai)
#pragma unroll
            for (int m = 0; m < 4; ++m) { f32x4 a, b;
#pragma unroll
                for (int e = 0; e < 4; ++e) { const float g0 = acc[ai][0][m][0][e], g1 = acc[ai][0][m][1][e]; a[e] = g0 * sigm(g0) * acc[ai][1][m][0][e]; b[e] = g1 * sigm(g1) * acc[ai][1][m][1][e]; }
                st16(O + (size_t)(row0 + ai * HALF + m * 16) * ldc + col0, pack8(a, b)); }
    }
};
struct EpiQKV {
    static constexpr bool PERM = true;
    bf16_t* base; unsigned koff, voff; const float* gtab; const float4* rope; float qscale;
    __device__ __forceinline__ void operator()(const f32x4 (&acc)[2][2][4][2], const Unit& u, int wr, int wc, int fr, int fq) const {
        const int row0 = u.pm * BM + wr * 64 + fr, pn = u.pn;
        const float* gain = gtab + (pn < 4 ? 0 : 64) + 8 * fq;
        const float sc = pn < 4 ? qscale : 1.f;
        const unsigned tbase = pn < 4 ? (unsigned)((4 * pn + wc) * 64) : (pn == 4 ? koff : voff) + (unsigned)(wc * 64);
        const int ldo = pn < 4 ? 1024 : 256;
#pragma unroll
        for (int ai = 0; ai < 2; ++ai)
#pragma unroll
            for (int m = 0; m < 4; ++m) { const int row = row0 + ai * HALF + m * 16;
                bf16_t* dst = base + ((size_t)tbase + (size_t)row * ldo + 8 * fq);
                if (pn < 5) {
                    float ss = 0.f;
#pragma unroll
                    for (int bj = 0; bj < 2; ++bj)
#pragma unroll
                        for (int n = 0; n < 2; ++n) { const f32x4 v = acc[ai][bj][m][n]; ss += (v[0] * v[0] + v[1] * v[1]) + (v[2] * v[2] + v[3] * v[3]); }
                    ss += __shfl_xor(ss, 16); ss += __shfl_xor(ss, 32);
                    const float r = rsqrtf(ss * (1.f / 64.f) + 1e-6f);
                    const int pos = row & 8191;
                    const float4* t0 = rope + (pos >> 6) * 8 + 2 * fq; const float4* t1 = rope + 1024 + (pos & 63) * 8 + 2 * fq;
#pragma unroll
                    for (int bj = 0; bj < 2; ++bj) { f32x4 o[2];
#pragma unroll
                        for (int n = 0; n < 2; ++n) { const float4 cs = bj == 0 ? t0[n] : t1[n]; const f32x4 g = *(const f32x4*)(gain + 32 * bj + 4 * n); const f32x4 v = acc[ai][bj][m][n];
                            const float x0 = v[0] * r * g[0], x1 = v[1] * r * g[1], x2 = v[2] * r * g[2], x3 = v[3] * r * g[3];
                            o[n][0] = (x0 * cs.x - x1 * cs.y) * sc; o[n][1] = (x0 * cs.y + x1 * cs.x) * sc; o[n][2] = (x2 * cs.z - x3 * cs.w) * sc; o[n][3] = (x2 * cs.w + x3 * cs.z) * sc; }
                        st16(dst + 32 * bj, pack8(o[0], o[1])); }
                } else {
#pragma unroll
                    for (int bj = 0; bj < 2; ++bj) st16(dst + 32 * bj, pack8(acc[ai][bj][m][0], acc[ai][bj][m][1]));
                }
                asm volatile("" ::: "memory"); }
    }
};

typedef int v4i32 __attribute__((ext_vector_type(4)));
template <bool F8> struct Frag;
template <> struct Frag<false> { u32x4 k[2]; };
template <> struct Frag<true> { v8i32 v; };
template <class Prob, class Epi, bool ALIGN_EPI = false, bool SP2 = false, bool FP8 = false>
__device__ __forceinline__ void gemm_phase(PG8_LAS unsigned char* lds, const Prob& P, const Epi& E) {
    const int tid = threadIdx.x, wid = __builtin_amdgcn_readfirstlane(tid >> 6), lane = tid & 63, wr = wid >> 2, wc = wid & 3, fr = lane & 15, fq = lane >> 4;
    int Rr[2]; unsigned cof[2], voffB[2];
#pragma unroll
    for (int i = 0; i < 2; ++i) { int R, C; stage_rc(tid * 16 + i * 8192, R, C); const int Rb = Epi::PERM ? ((R & ~31) + perm32(R & 31)) : R;
        Rr[i] = R; cof[i] = (unsigned)C * 2u; voffB[i] = (unsigned)Rb * P.ldbB + (unsigned)C * 2u; }
    const size_t kstep = (size_t)(BK * 2);
    const size_t hstepB = (size_t)HALF * P.ldbB;
    const unsigned ldsw = (unsigned)wid * 1024u;
    const int aoff = FP8 ? lds_byte(wr * 64 + fr, fq * 16) : lds_byte(wr * 64 + fr, fq * 8), boff = FP8 ? lds_byte(wc * 32 + fr, fq * 16) : lds_byte(wc * 32 + fr, fq * 8);

#define PG8_SA(b, h) (((b) * 2 + (h)) * HTB)
#define PG8_SB(b, h) ((4 + (b) * 2 + (h)) * HTB)
#define PG8_STAGE(bufoff, gbase, voff) do { _Pragma("unroll") for (int _i = 0; _i < 2; ++_i) \
        __builtin_amdgcn_global_load_lds((const unsigned*)((const char*)(gbase) + (voff)[_i]), (PG8_LAS unsigned*)(lds + (bufoff) + ldsw + _i * 8192), 16, 0, 0); } while (0)
#define PG8_LD1(dst, addr) do { if constexpr (FP8) { const v4i32 lo_ = *(const PG8_LAS v4i32*)(addr), hi_ = *(const PG8_LAS v4i32*)((addr) + 16); (dst).v = __builtin_shufflevector(lo_, hi_, 0, 1, 2, 3, 4, 5, 6, 7); } \
        else { _Pragma("unroll") for (int k = 0; k < 2; ++k) (dst).k[k] = *(const PG8_LAS u32x4*)((addr) + k * 1024); } } while (0)
#define PG8_LDA(dst, b, h) do { _Pragma("unroll") for (int m = 0; m < 4; ++m) PG8_LD1(dst[m], lds + PG8_SA(b, h) + aoff + m * 2048); } while (0)
#define PG8_LDB(dst, b, h) do { _Pragma("unroll") for (int n = 0; n < 2; ++n) PG8_LD1(dst[n], lds + PG8_SB(b, h) + boff + n * 2048); } while (0)
#define PG8_MMA(ai, bj, At, Bt) do { __builtin_amdgcn_s_setprio(1); _Pragma("unroll") for (int m = 0; m < 4; ++m) _Pragma("unroll") for (int n = 0; n < 2; ++n) { \
        if constexpr (FP8) asm volatile("v_mfma_scale_f32_16x16x128_f8f6f4 %0, %1, %2, %0, %3, %3 op_sel_hi:[0,0,0]" : "+v"(acc[ai][bj][m][n]) : "v"(Bt[n].v), "v"(At[m].v), "v"(f8scale_)); \
        else { _Pragma("unroll") for (int k = 0; k < 2; ++k) acc[ai][bj][m][n] = __builtin_amdgcn_mfma_f32_16x16x32_bf16(__builtin_bit_cast(bf16x8, Bt[n].k[k]), __builtin_bit_cast(bf16x8, At[m].k[k]), acc[ai][bj][m][n], 0, 0, 0); } } \
        __builtin_amdgcn_s_setprio(0); } while (0)
#define PG8_WAIT_V(n) asm volatile("s_waitcnt vmcnt(" #n ")" ::: "memory")
#define PG8_WAIT_L(n) asm volatile("s_waitcnt lgkmcnt(" #n ")" ::: "memory")
#define PG8_BAR __builtin_amdgcn_s_barrier()
#define PG8_SCHED __builtin_amdgcn_sched_barrier(0)
    const int f8scale_ = 0x7f7f7f7f;
    Unit cur, nxt; int ui = 0;
    if (!P.next(0, cur)) return;
    f32x4 acc[2][2][4][2];
#pragma unroll
    for (int a = 0; a < 2; ++a)
#pragma unroll
        for (int b = 0; b < 2; ++b)
#pragma unroll
            for (int m = 0; m < 4; ++m)
#pragma unroll
                for (int n = 0; n < 2; ++n) acc[a][b][m][n] = (f32x4){0.f, 0.f, 0.f, 0.f};
    Frag<FP8> At[4], B0[2], B1[2];
    unsigned voC[2][2], voN[2][2];
    P.aoffs(cur, Rr, voC);
#pragma unroll
    for (int h = 0; h < 2; ++h)
#pragma unroll
        for (int i = 0; i < 2; ++i) voC[h][i] += cof[i] + (unsigned)cur.kofs;
    const char* const aB = P.abase; const char* cB = P.bbase(cur) + cur.kofs;
    if constexpr (SP2) {
        PG8_STAGE(PG8_SB(0, 0), cB, voffB); PG8_STAGE(PG8_SB(0, 1), cB + hstepB, voffB); PG8_STAGE(PG8_SA(0, 0), aB, voC[0]); PG8_STAGE(PG8_SA(0, 1), aB, voC[1]);
        if (wr == 1) PG8_BAR;
        PG8_WAIT_V(2); PG8_BAR;
        PG8_STAGE(PG8_SB(1, 0), cB + kstep, voffB); PG8_STAGE(PG8_SA(1, 0), aB + kstep, voC[0]); PG8_STAGE(PG8_SB(1, 1), cB + hstepB + kstep, voffB);
        PG8_WAIT_V(6); PG8_BAR;
    } else {
        PG8_STAGE(PG8_SB(0, 0), cB, voffB); PG8_STAGE(PG8_SA(0, 0), aB, voC[0]); PG8_STAGE(PG8_SB(0, 1), cB + hstepB, voffB); PG8_STAGE(PG8_SA(0, 1), aB, voC[1]);
        if (wr == 1) PG8_BAR;
        PG8_WAIT_V(4); PG8_BAR;
        PG8_STAGE(PG8_SB(1, 0), cB + kstep, voffB); PG8_STAGE(PG8_SA(1, 0), aB + kstep, voC[0]); PG8_STAGE(PG8_SB(1, 1), cB + hstepB + kstep, voffB);
        PG8_WAIT_V(6); PG8_BAR;
    }
    for (;;) {
        const bool has_next = P.next(ui + 1, nxt);
        if (has_next) { P.aoffs(nxt, Rr, voN);
#pragma unroll
            for (int h = 0; h < 2; ++h)
#pragma unroll
                for (int i = 0; i < 2; ++i) voN[h][i] += cof[i] + (unsigned)nxt.kofs; }
        else {
#pragma unroll
            for (int h = 0; h < 2; ++h)
#pragma unroll
                for (int i = 0; i < 2; ++i) voN[h][i] = voC[h][i]; }
        const char* nB = has_next ? P.bbase(nxt) + nxt.kofs : cB;
        const int nt = cur.nt;
        for (int t = 0; t < nt; t += 2) {
            const bool last = (t == nt - 2);
            const char* a1 = aB + (size_t)(t + 1) * kstep;
            const char* a2 = last ? aB : aB + (size_t)(t + 2) * kstep; const char* b2 = last ? nB : cB + (size_t)(t + 2) * kstep;
            const char* a3 = a2 + kstep; const char* b3 = b2 + kstep;
            unsigned vo2[2][2];
#pragma unroll
            for (int h = 0; h < 2; ++h)
#pragma unroll
                for (int i = 0; i < 2; ++i) vo2[h][i] = last ? voN[h][i] : voC[h][i];
            if constexpr (SP2) {
            PG8_LDB(B0, 0, 0); PG8_LDB(B1, 0, 1); PG8_SCHED; PG8_LDA(At, 0, 0); PG8_STAGE(PG8_SA(1, 1), a1, voC[1]);
            PG8_WAIT_V(8); PG8_WAIT_L(0); PG8_BAR; PG8_MMA(0, 0, At, B0); PG8_MMA(0, 1, At, B1); PG8_BAR; PG8_SCHED;
            PG8_LDA(At, 0, 1); PG8_STAGE(PG8_SB(0, 0), b2, voffB); PG8_STAGE(PG8_SB(0, 1), b2 + hstepB, voffB); PG8_STAGE(PG8_SA(0, 0), a2, vo2[0]);
            PG8_WAIT_V(8); PG8_WAIT_L(0); PG8_BAR; PG8_MMA(1, 0, At, B0); PG8_MMA(1, 1, At, B1); PG8_BAR; PG8_SCHED;
            PG8_LDB(B0, 1, 0); PG8_LDB(B1, 1, 1); PG8_SCHED; PG8_LDA(At, 1, 0); PG8_STAGE(PG8_SA(0, 1), a2, vo2[1]);
            PG8_WAIT_V(8); PG8_WAIT_L(0); PG8_BAR; PG8_MMA(0, 0, At, B0); PG8_MMA(0, 1, At, B1); PG8_BAR; PG8_SCHED;
            PG8_LDA(At, 1, 1); PG8_STAGE(PG8_SB(1, 0), b3, voffB); PG8_STAGE(PG8_SB(1, 1), b3 + hstepB, voffB); PG8_STAGE(PG8_SA(1, 0), a3, vo2[0]);
            PG8_WAIT_V(8); PG8_WAIT_L(0); PG8_BAR; PG8_MMA(1, 0, At, B0); PG8_MMA(1, 1, At, B1); PG8_BAR; PG8_SCHED;
            } else {
            PG8_LDB(B0, 0, 0); PG8_SCHED; PG8_LDA(At, 0, 0); PG8_STAGE(PG8_SA(1, 1), a1, voC[1]);
            PG8_WAIT_L(8); PG8_BAR; PG8_WAIT_L(0); PG8_MMA(0, 0, At, B0); PG8_BAR; PG8_SCHED;
            PG8_LDB(B1, 0, 1); PG8_STAGE(PG8_SB(0, 0), b2, voffB);
            PG8_BAR; PG8_WAIT_L(0); PG8_MMA(0, 1, At, B1); PG8_BAR;
            PG8_LDA(At, 0, 1); PG8_STAGE(PG8_SA(0, 0), a2, vo2[0]);
            PG8_BAR; PG8_WAIT_L(0); PG8_MMA(1, 0, At, B0); PG8_BAR; PG8_SCHED;
            PG8_STAGE(PG8_SB(0, 1), b2 + hstepB, voffB);
            PG8_WAIT_V(6); PG8_BAR; PG8_MMA(1, 1, At, B1); PG8_BAR;
            PG8_LDB(B0, 1, 0); PG8_SCHED; PG8_LDA(At, 1, 0); PG8_STAGE(PG8_SA(0, 1), a2, vo2[1]);
            PG8_WAIT_L(8); PG8_BAR; PG8_WAIT_L(0); PG8_MMA(0, 0, At, B0); PG8_BAR; PG8_SCHED;
            PG8_LDB(B1, 1, 1); PG8_STAGE(PG8_SB(1, 0), b3, voffB);
            PG8_BAR; PG8_WAIT_L(0); PG8_MMA(0, 1, At, B1); PG8_BAR;
            PG8_LDA(At, 1, 1); PG8_STAGE(PG8_SA(1, 0), a3, vo2[0]);
            PG8_BAR; PG8_WAIT_L(0); PG8_MMA(1, 0, At, B0); PG8_BAR; PG8_SCHED;
            PG8_STAGE(PG8_SB(1, 1), b3 + hstepB, voffB);
            PG8_WAIT_V(6); PG8_BAR; PG8_MMA(1, 1, At, B1); PG8_BAR;
            }
        }
        if constexpr (ALIGN_EPI) { if (wr == 0) PG8_BAR; }
        if constexpr (FP8) asm volatile("s_nop 15\n\ts_nop 15" ::: "memory");
        E(acc, cur, wr, wc, fr, fq);
#if defined(EPI_TWICE) && EPI_TWICE
        if constexpr (FP8) { asm volatile("" ::: "memory"); E(acc, cur, wr, wc, fr, fq); }
#endif
        if (!has_next) break;
#pragma unroll
        for (int a = 0; a < 2; ++a)
#pragma unroll
            for (int b = 0; b < 2; ++b)
#pragma unroll
                for (int m = 0; m < 4; ++m)
#pragma unroll
                    for (int n = 0; n < 2; ++n) acc[a][b][m][n] = (f32x4){0.f, 0.f, 0.f, 0.f};
        cur = nxt; cB = nB; ++ui;
#pragma unroll
        for (int h = 0; h < 2; ++h)
#pragma unroll
            for (int i = 0; i < 2; ++i) voC[h][i] = voN[h][i];
        if constexpr (ALIGN_EPI) { if (wr == 1) PG8_BAR; }
    }
    PG8_WAIT_V(0);
    if constexpr (!ALIGN_EPI) { if (wr == 0) PG8_BAR; }
    PG8_BAR;
#undef PG8_SA
#undef PG8_SB
#undef PG8_STAGE
#undef PG8_LD1
#undef PG8_LDA
#undef PG8_LDB
#undef PG8_MMA
#undef PG8_WAIT_V
#undef PG8_WAIT_L
#undef PG8_BAR
#undef PG8_SCHED
}
}

#include <hip/hip_bf16.h>
#include <cmath>
namespace attn_body {
using bf16=__hip_bfloat16;
using bf16x8=__attribute__((ext_vector_type(8)))short;
using s16x4=__attribute__((ext_vector_type(4)))short;
using f32x16=__attribute__((ext_vector_type(16)))float;
using u32x4=__attribute__((ext_vector_type(4)))unsigned;
constexpr int BATCH=2,NHEAD=16,SEQ=8192,D=64,DM=NHEAD*D,KVP=256;
constexpr int NW=8,QBLK=32,QB=QBLK*NW,KVBLK=64,NQB=SEQ/QB;
constexpr int ATTN_PITCH=DM, ATTN_UNIT_ROWS=QB;
__device__ __forceinline__ int crow(int r,int hi){return (r&3)+8*(r>>2)+4*hi;}
#define SBAR() __builtin_amdgcn_sched_barrier(0)
__device__ __forceinline__ void cmask(f32x16&p0,f32x16&p1,int jb,int qrel,int hi){
  const float NEG=-INFINITY; int kb=64*jb+4*hi;
  #pragma unroll
  for(int r=0;r<16;++r){int kv=kb+(r&3)+8*(r>>2); if(kv>qrel)p0[r]=NEG; if(kv+32>qrel)p1[r]=NEG;}
}

constexpr int NSLOT=3, SLOTB=8192;
constexpr int LDS_K=0, LDS_V=NSLOT*SLOTB, LDS_WS=2*NSLOT*SLOTB, LDS_OST=LDS_WS+NW*64*4, LDS_BYTES=LDS_OST+NW*4096;
constexpr float C2=0.125f*1.4426950408889634f;
__device__ __forceinline__ void glds16(const void*gsrc,unsigned lds_dst){unsigned keep;
  asm volatile("s_mov_b32 %0, m0\n\ts_mov_b32 m0, %2\n\ts_nop 0\n\tglobal_load_lds_dwordx4 %1, off\n\ts_mov_b32 m0, %0":"=&s"(keep):"v"(gsrc),"s"(lds_dst):"memory");}
__device__ __forceinline__ float max3f(float a,float b,float c){float r;asm("v_max3_f32 %0, %1, %2, %3":"=v"(r):"v"(a),"v"(b),"v"(c));return r;}
__device__ __forceinline__ float max2f(float a,float b){float r;asm("v_max_f32_e32 %0, %1, %2":"=v"(r):"v"(a),"v"(b));return r;}
__device__ __forceinline__ float fadd_s(float a,float b){float r;asm("v_add_f32_e32 %0, %1, %2":"=v"(r):"v"(a),"v"(b));return r;}
__device__ __forceinline__ float fsub_s(float a,float b){float r;asm("v_sub_f32_e32 %0, %1, %2":"=v"(r):"v"(a),"v"(b));return r;}
typedef float f32x2_t __attribute__((ext_vector_type(2))); typedef __bf16 bf16x2_t __attribute__((ext_vector_type(2)));
__device__ __forceinline__ unsigned cvtpk_s(float lo,float hi){f32x2_t v={lo,hi};bf16x2_t b=__builtin_convertvector(v,bf16x2_t);return __builtin_bit_cast(unsigned,b);}
#define WAIT_BAR(N) asm volatile("s_waitcnt vmcnt(" #N ") lgkmcnt(0)\n\ts_barrier":::"memory")

__device__ __forceinline__ void qkt(f32x16&p0,f32x16&p1,const char*Kslot,const bf16x8*qr,const f32x16&negm,int r32,int hi){
  const char*kb=Kslot+hi*1024+r32*16;
  #pragma unroll
  for(int d0=0;d0<4;++d0){
    const bf16x8 b0=*reinterpret_cast<const bf16x8*>(kb+d0*2048);
    const bf16x8 b1=*reinterpret_cast<const bf16x8*>(kb+d0*2048+512);
    if(d0==0){p0=__builtin_amdgcn_mfma_f32_32x32x16_bf16(b0,qr[0],negm,0,0,0);p1=__builtin_amdgcn_mfma_f32_32x32x16_bf16(b1,qr[0],negm,0,0,0);}
    else{p0=__builtin_amdgcn_mfma_f32_32x32x16_bf16(b0,qr[d0],p0,0,0,0);p1=__builtin_amdgcn_mfma_f32_32x32x16_bf16(b1,qr[d0],p1,0,0,0);}}
}
typedef __attribute__((address_space(3))) const char* lds_cptr;
typedef short v4i16_t __attribute__((ext_vector_type(4)));
__device__ __forceinline__ void kload8(bf16x8*kf,lds_cptr kp){
  kf[0]=*(const __attribute__((address_space(3))) bf16x8*)(kp);      kf[1]=*(const __attribute__((address_space(3))) bf16x8*)(kp+512);
  kf[2]=*(const __attribute__((address_space(3))) bf16x8*)(kp+2048); kf[3]=*(const __attribute__((address_space(3))) bf16x8*)(kp+2560);
  kf[4]=*(const __attribute__((address_space(3))) bf16x8*)(kp+4096); kf[5]=*(const __attribute__((address_space(3))) bf16x8*)(kp+4608);
  kf[6]=*(const __attribute__((address_space(3))) bf16x8*)(kp+6144); kf[7]=*(const __attribute__((address_space(3))) bf16x8*)(kp+6656);
}
__device__ __forceinline__ void kload2(bf16x8*kf,lds_cptr kp,int j){ kf[2*j]=*(const __attribute__((address_space(3))) bf16x8*)(kp+j*2048); kf[2*j+1]=*(const __attribute__((address_space(3))) bf16x8*)(kp+j*2048+512); }
__device__ __forceinline__ s16x4 vtr(lds_cptr p){ return __builtin_bit_cast(s16x4,__builtin_amdgcn_ds_read_tr16_b64_v4i16((__attribute__((address_space(3))) v4i16_t*)p)); }
__device__ __forceinline__ float rowmax(const f32x16&p0,const f32x16&p1){
  float a=max3f(p0[0],p0[1],p1[0]),b=max3f(p0[2],p0[3],p1[1]);a=max3f(a,p1[2],p1[3]);
  #pragma unroll
  for(int r=4;r<16;r+=4){a=max3f(a,p0[r],p0[r+1]);b=max3f(b,p0[r+2],p0[r+3]);a=max3f(a,p1[r],p1[r+1]);b=max3f(b,p1[r+2],p1[r+3]);}
  const float m=max2f(a,b);
  auto rr=__builtin_amdgcn_permlane32_swap(__float_as_uint(m),__float_as_uint(m),false,false);
  return max2f(__uint_as_float(rr[0]),__uint_as_float(rr[1]));
}
__device__ __forceinline__ void pv(f32x16*o,int vb,bf16x8 pa0,bf16x8 pa1,bf16x8 pa2,bf16x8 pa3){
  #pragma unroll
  for(int d0=0;d0<2;++d0){s16x4 lo[4],hi[4];
    #pragma unroll
    for(int ks=0;ks<4;++ks){
      asm volatile("ds_read_b64_tr_b16 %0,%1 offset:%c2":"=&v"(lo[ks]):"v"(vb),"i"(d0*4096+ks*1024):"memory");
      asm volatile("ds_read_b64_tr_b16 %0,%1 offset:%c2":"=&v"(hi[ks]):"v"(vb),"i"(d0*4096+ks*1024+512):"memory");}
    asm volatile("s_waitcnt lgkmcnt(0)":::"memory");SBAR();
    #define PK(k) (bf16x8){lo[k][0],lo[k][1],lo[k][2],lo[k][3],hi[k][0],hi[k][1],hi[k][2],hi[k][3]}
    o[d0]=__builtin_amdgcn_mfma_f32_32x32x16_bf16(pa0,PK(0),o[d0],0,0,0);
    o[d0]=__builtin_amdgcn_mfma_f32_32x32x16_bf16(pa1,PK(1),o[d0],0,0,0);
    o[d0]=__builtin_amdgcn_mfma_f32_32x32x16_bf16(pa2,PK(2),o[d0],0,0,0);
    o[d0]=__builtin_amdgcn_mfma_f32_32x32x16_bf16(pa3,PK(3),o[d0],0,0,0);
    #undef PK
  }
}

#ifndef ATTN_STORE16
#define ATTN_STORE16(p,v) pg8::st16((void*)(p),(v))
#endif
template<int THRL,bool FIX> __device__ __forceinline__ void attn_unit(float refB,int b,int h,int kvh,int qb,const bf16*Q,const bf16*__restrict__ K,const bf16*__restrict__ V,bf16*O,char*shm){
  const int tid=threadIdx.x,lane=tid&63,r32=lane&31,hi=lane>>5; const int wid=__builtin_amdgcn_readfirstlane(tid>>6);
  const long rowbase=(long)b*SEQ; const int q0=qb*QB;
  const bf16*Qw=Q+(rowbase+q0+wid*QBLK)*DM+h*D;
  const bf16*Kh=K+rowbase*KVP+kvh*D,*Vh=V+rowbase*KVP+kvh*D;
  const unsigned lds0=(unsigned)(uintptr_t)shm;
  float*wsf=(float*)(shm+LDS_WS)+wid*64;
  const bf16*ksrc=Kh+(long)lane*KVP+wid*8;
  const bf16*vsrc=Vh+(long)(16*(wid&3)+(lane>>2))*KVP+(wid>>2)*32+(lane&3)*8;
  const unsigned kdst=lds0+LDS_K+wid*1024, vdst=lds0+LDS_V+wid*1024;
  #define DMA_K(t,slot) glds16(ksrc+(long)(t)*KVBLK*KVP,(unsigned)__builtin_amdgcn_readfirstlane(kdst+(slot)))
  #define DMA_V(t,slot) glds16(vsrc+(long)(t)*KVBLK*KVP,(unsigned)__builtin_amdgcn_readfirstlane(vdst+(slot)))
  const int vb0=(int)(lds0+LDS_V)+((lane>>4)&1)*32+(lane&3)*8+(4*hi+((lane&15)>>2))*64;
  const char*Kbase=shm+LDS_K; bf16x8 kf[8];
  const lds_cptr shm3=(lds_cptr)shm; const lds_cptr kp0=shm3+LDS_K+hi*1024+r32*16; const lds_cptr vp0=shm3+LDS_V+((lane>>4)&1)*32+(lane&3)*8+(4*hi+((lane&15)>>2))*64;
  const int NT=SEQ/KVBLK;
  DMA_K(0,0);DMA_V(0,0);DMA_K(1,SLOTB);
  bf16x8 qr[4];
  #pragma unroll
  for(int d0=0;d0<4;++d0)qr[d0]=*reinterpret_cast<const bf16x8*>(&Qw[(long)r32*DM+d0*16+hi*8]);
  float mhat=0.f,l_reg=0.f;f32x16 o[2];o[0]=f32x16{};o[1]=f32x16{};f32x16 negm=f32x16{}; if constexpr(FIX){ _Pragma("unroll") for(int r=0;r<16;++r)negm[r]=-refB; } asm volatile("":"+v"(negm));
  const int qrel=wid*QBLK+r32;
  #define CMASK(P0,P1,t) do{}while(0)
  bool resc=false;
  #define START(P0,P1) do{ if constexpr(!FIX){ const float rm=rowmax(P0,P1); resc=false; \
    { const float dl=rm; mhat=fadd_s(mhat,dl); \
      _Pragma("unroll") for(int r=0;r<16;++r){P0[r]=fsub_s(P0[r],dl);P1[r]=fsub_s(P1[r],dl);} \
      _Pragma("unroll") for(int r=0;r<16;++r)negm[r]=-mhat; asm volatile("":"+v"(negm)); } } \
    _Pragma("unroll") for(int r=0;r<16;++r)P0[r]=__builtin_amdgcn_exp2f(P0[r]); }while(0)
  #define RESC() do{ if constexpr(!FIX) if(resc){ asm volatile("s_waitcnt lgkmcnt(0)":::"memory"); \
      _Pragma("unroll") for(int d_=0;d_<2;++d_) _Pragma("unroll") for(int r=0;r<16;++r)o[d_][r]*=wsf[crow(r,hi)]; } }while(0)
  f32x16 pA0,pA1,pB0,pB1;
  int sl_prev=0,sl_cur=0,sl_next=SLOTB;
  #define ROT() do{sl_prev=sl_cur;sl_cur=sl_next;sl_next=(sl_next==(NSLOT-1)*SLOTB)?0:sl_next+SLOTB;}while(0)
  DMA_K(2,2*SLOTB);
  WAIT_BAR(3);
  qkt(pA0,pA1,Kbase,qr,negm,r32,hi);asm volatile("s_nop 15\n\ts_nop 7":"+v"(pA0),"+v"(pA1));CMASK(pA0,pA1,0);
  START(pA0,pA1);
  _Pragma("unroll") for(int r=0;r<16;++r)pA1[r]=__builtin_amdgcn_exp2f(pA1[r]);
  WAIT_BAR(0);
  DMA_K(3,0);DMA_V(1,SLOTB);
  ROT();
  kload8(kf,kp0+sl_cur);
  WAIT_BAR(2);
  s16x4 vlo[8],vhi[8]; u32x4 pw0,pw1,pw2,pw3;
  #define PKW(P,B) cvtpk_s(P[B],P[B+1])
  #define PAF(k) __builtin_bit_cast(bf16x8,pw##k)
  #define VFR(i) (bf16x8){vlo[i][0],vlo[i][1],vlo[i][2],vlo[i][3],vhi[i][0],vhi[i][1],vhi[i][2],vhi[i][3]}
  #define PIN(x) asm volatile("":"+v"(x))
  #define MX3(a,b,c) __builtin_fmaxf(__builtin_fmaxf((a),(b)),(c))
  #define GAPA(MF,A0,A1,A2,A3,W0,W1,PW) do{ MF; sacc+=A0; sacc+=A1; sacc+=A2; sacc+=A3; PIN(sacc); W0; W1; PIN(PW); SBAR(); }while(0)
  #define EX(v) __builtin_amdgcn_exp2f(v)
  #define GAPB(MF,X,B) do{ MF; X[B]=EX(X[B]); X[B+1]=EX(X[B+1]); X[B+2]=EX(X[B+2]); X[B+3]=EX(X[B+3]); PIN(X); SBAR(); }while(0)
  #define VRD(i) do{ vlo[i]=vtr(vp_+(((i)>>2)*4096+((i)&3)*1024)); vhi[i]=vtr(vp_+(((i)>>2)*4096+((i)&3)*1024+512)); }while(0)
  #define KRD(G,j) do{ if(G){ kload2(kf,kp0+sl_next,j); SBAR(); } }while(0)
  #define STEP(C0,C1,P0,P1,t,GK,GV,GL) do{ SBAR(); \
    const lds_cptr vp_=vp0+sl_prev; \
    VRD(0); SBAR(); float sacc=(P0[0]+P0[1]); \
    GAPA(C0=__builtin_amdgcn_mfma_f32_32x32x16_bf16(kf[0],qr[0],negm,0,0,0), P0[2],P0[3],P0[4],P0[5],     pw0[0]=PKW(P0,0), pw0[1]=PKW(P0,2), pw0); \
    VRD(4); SBAR(); GAPA(C1=__builtin_amdgcn_mfma_f32_32x32x16_bf16(kf[1],qr[0],negm,0,0,0), P0[6],P0[7],P0[8],P0[9],     pw0[2]=PKW(P0,4), pw0[3]=PKW(P0,6), pw0); \
    VRD(1); SBAR(); GAPA(C0=__builtin_amdgcn_mfma_f32_32x32x16_bf16(kf[2],qr[1],C0,0,0,0),   P0[10],P0[11],P0[12],P0[13], pw1[0]=PKW(P0,8), pw1[1]=PKW(P0,10), pw1); \
    VRD(5); SBAR(); GAPA(C1=__builtin_amdgcn_mfma_f32_32x32x16_bf16(kf[3],qr[1],C1,0,0,0),   P0[14],P0[15],P1[0],P1[1],   pw1[2]=PKW(P0,12),pw1[3]=PKW(P0,14), pw1); \
    VRD(2); SBAR(); GAPA(C0=__builtin_amdgcn_mfma_f32_32x32x16_bf16(kf[4],qr[2],C0,0,0,0),   P1[2],P1[3],P1[4],P1[5],     pw2[0]=PKW(P1,0), pw2[1]=PKW(P1,2), pw2); \
    VRD(6); SBAR(); GAPA(C1=__builtin_amdgcn_mfma_f32_32x32x16_bf16(kf[5],qr[2],C1,0,0,0),   P1[6],P1[7],P1[8],P1[9],     pw2[2]=PKW(P1,4), pw2[3]=PKW(P1,6), pw2); \
    VRD(3); SBAR(); GAPA(C0=__builtin_amdgcn_mfma_f32_32x32x16_bf16(kf[6],qr[3],C0,0,0,0),   P1[10],P1[11],P1[12],P1[13], pw3[0]=PKW(P1,8), pw3[1]=PKW(P1,10), pw3); \
    VRD(7); SBAR(); GAPA(C1=__builtin_amdgcn_mfma_f32_32x32x16_bf16(kf[7],qr[3],C1,0,0,0),   P1[14],P1[15],0.f,0.f,       pw3[2]=PKW(P1,12),pw3[3]=PKW(P1,14), pw3); \
    l_reg+=sacc; \
    if(GK){DMA_K((t)+3,sl_cur);} if(GV){DMA_V((t)+1,sl_next);} \
    CMASK(C0,C1,t); \
    if constexpr(!FIX){ float a=MX3(C0[0],C0[1],C1[0]),b=MX3(C0[2],C0[3],C1[1]); a=MX3(a,C1[2],C1[3]); \
      _Pragma("unroll") for(int r=4;r<16;r+=4){a=MX3(a,C0[r],C0[r+1]);b=MX3(b,C0[r+2],C0[r+3]);a=MX3(a,C1[r],C1[r+1]);b=MX3(b,C1[r+2],C1[r+3]);} \
      float rm=__builtin_fmaxf(a,b); { auto rr=__builtin_amdgcn_permlane32_swap(__float_as_uint(rm),__float_as_uint(rm),false,false); rm=__builtin_fmaxf(__uint_as_float(rr[0]),__uint_as_float(rr[1])); } \
      resc=false; \
      if(__builtin_expect(__any(rm>(float)THRL),0)){ const float dl=__builtin_fmaxf(rm,0.f); mhat+=dl; \
        _Pragma("unroll") for(int r=0;r<16;++r){C0[r]-=dl;C1[r]-=dl;} \
        _Pragma("unroll") for(int r=0;r<16;++r)negm[r]=-mhat; asm volatile("":"+v"(negm)); \
        const float f=__builtin_amdgcn_exp2f(-dl); l_reg*=f; if(hi==0)wsf[r32]=f; resc=true; } } \
    SBAR(); \
    GAPB(o[0]=__builtin_amdgcn_mfma_f32_32x32x16_bf16(PAF(0),VFR(0),o[0],0,0,0), C0,0); \
    GAPB(o[1]=__builtin_amdgcn_mfma_f32_32x32x16_bf16(PAF(0),VFR(4),o[1],0,0,0), C0,4); \
    KRD(GL,0); GAPB(o[0]=__builtin_amdgcn_mfma_f32_32x32x16_bf16(PAF(1),VFR(1),o[0],0,0,0), C0,8); \
    KRD(GL,1); GAPB(o[1]=__builtin_amdgcn_mfma_f32_32x32x16_bf16(PAF(1),VFR(5),o[1],0,0,0), C0,12); \
    KRD(GL,2); GAPB(o[0]=__builtin_amdgcn_mfma_f32_32x32x16_bf16(PAF(2),VFR(2),o[0],0,0,0), C1,0); \
    KRD(GL,3); GAPB(o[1]=__builtin_amdgcn_mfma_f32_32x32x16_bf16(PAF(2),VFR(6),o[1],0,0,0), C1,4); \
    GAPB(o[0]=__builtin_amdgcn_mfma_f32_32x32x16_bf16(PAF(3),VFR(3),o[0],0,0,0), C1,8); \
    GAPB(o[1]=__builtin_amdgcn_mfma_f32_32x32x16_bf16(PAF(3),VFR(7),o[1],0,0,0), C1,12); \
    }while(0)
  int t=1;
#if defined(ATTN_PRIO) && ATTN_PRIO
  if(wid>=4)__builtin_amdgcn_s_setprio(1);
#endif
  #undef CMASK
  #define CMASK(P0,P1,t) do{}while(0)
  for(;t+5<NT;t+=2){
    STEP(pB0,pB1,pA0,pA1,t,true,true,true);     WAIT_BAR(2); RESC(); ROT();
    STEP(pA0,pA1,pB0,pB1,t+1,true,true,true);   WAIT_BAR(2); RESC(); ROT();
  }
  #undef CMASK
  #define CMASK(P0,P1,t) do{}while(0)
  #define ENDW(tt) do{ if((tt)+3<NT){WAIT_BAR(2);} else if((tt)+2<NT){WAIT_BAR(1);} else {WAIT_BAR(0);} }while(0)
  for(;t+1<NT;t+=2){
    STEP(pB0,pB1,pA0,pA1,t,(t+3<NT),(t+1<NT),(t+1<NT));       ENDW(t);   RESC(); ROT();
    STEP(pA0,pA1,pB0,pB1,t+1,(t+4<NT),(t+2<NT),(t+2<NT));     ENDW(t+1); RESC(); ROT();
  }
  STEP(pB0,pB1,pA0,pA1,NT-1,false,false,false); RESC();
  { float sacc=pB0[0]+pB0[1]; _Pragma("unroll") for(int r=2;r<16;++r)sacc+=pB0[r]; _Pragma("unroll") for(int r=0;r<16;++r)sacc+=pB1[r]; l_reg+=sacc;
    pw0=(u32x4){PKW(pB0,0),PKW(pB0,2),PKW(pB0,4),PKW(pB0,6)};pw1=(u32x4){PKW(pB0,8),PKW(pB0,10),PKW(pB0,12),PKW(pB0,14)};pw2=(u32x4){PKW(pB1,0),PKW(pB1,2),PKW(pB1,4),PKW(pB1,6)};pw3=(u32x4){PKW(pB1,8),PKW(pB1,10),PKW(pB1,12),PKW(pB1,14)};
    SBAR(); pv(o,vb0+sl_cur,PAF(0),PAF(1),PAF(2),PAF(3)); }
  #undef PKW
  #undef PAF
  #undef VFR
  #undef PIN
  #undef MX3
  #undef GAPA
  #undef GAPB
  #undef EX
  #undef VRD
  #undef KRD
  #undef STEP
  #undef ENDW
#if defined(ATTN_PRIO) && ATTN_PRIO
  __builtin_amdgcn_s_setprio(0);
#endif
  {auto rr=__builtin_amdgcn_permlane32_swap(__float_as_uint(l_reg),__float_as_uint(l_reg),false,false);l_reg=__uint_as_float(rr[0])+__uint_as_float(rr[1]);}
  if(hi==0)wsf[32+r32]=l_reg;asm volatile("s_waitcnt lgkmcnt(0)":::"memory");
  float rli[16];
  #pragma unroll
  for(int r=0;r<16;++r)rli[r]=__builtin_amdgcn_rcpf(wsf[32+crow(r,hi)]);
  bf16*Ow=O+(rowbase+q0+wid*QBLK)*DM+h*D;
  { bf16*stg=(bf16*)(shm+LDS_OST)+wid*2048;
    #pragma unroll
    for(int r=0;r<16;++r){const int orow=crow(r,hi);
      #pragma unroll
      for(int d0=0;d0<2;++d0)stg[orow*64+d0*32+r32]=__float2bfloat16(o[d0][r]*rli[r]);}
    asm volatile("s_waitcnt lgkmcnt(0)":::"memory");
    #pragma unroll
    for(int i=0;i<4;++i){const int row=i*8+(lane>>3),ch=lane&7; const u32x4 v=*(const u32x4*)(stg+row*64+ch*8); ATTN_STORE16(Ow+(long)row*DM+ch*8,v);} }
  asm volatile("s_waitcnt lgkmcnt(0)\n\ts_barrier":::"memory");
  #undef DMA_K
  #undef DMA_V
  #undef CMASK
  #undef START
  #undef RESC
  #undef ROT
}
constexpr int ATTN_LDS_BYTES=LDS_BYTES;
struct AttnTensors { const bf16* Q; const bf16* K; const bf16* V; bf16* O; };
struct AttnUnit { int bh; int qb; };
struct StaticOrder {
  int vcu;
  __device__ __forceinline__ explicit StaticOrder(int grid,int block):vcu((block%8)*(grid/8)+block/8){}
  __device__ __forceinline__ bool next(int i,AttnUnit&u)const{ if(i>=4)return false; const int x=vcu>>5, j=vcu&31; const int b=x>>2, kvh=x&3; u.bh=b*16+kvh*4+i; u.qb=j; return true; }
  __device__ __forceinline__ void a_ready(const AttnUnit&)const{}
  __device__ __forceinline__ void done(const AttnUnit&)const{}
};
template<class Sched,bool FIX,int THRL=8> __device__ __forceinline__ void attn_phase(char*lds,const AttnTensors&T,const Sched&S,float refB){
  AttnUnit u;
  for(int i=0;S.next(i,u);++i){ S.a_ready(u); attn_unit<THRL,FIX>(refB,u.bh/NHEAD,u.bh%NHEAD,(u.bh%NHEAD)>>2,u.qb,T.Q,T.K,T.V,T.O,lds); S.done(u); }
}
#undef SBAR
#undef WAIT_BAR
}

#define GAS __attribute__((address_space(1)))
#define LAS __attribute__((address_space(3)))
typedef unsigned short bf16;
typedef unsigned v4u __attribute__((ext_vector_type(4)));
typedef float f32x4 __attribute__((ext_vector_type(4)));
typedef short bf16x8 __attribute__((ext_vector_type(8)));
typedef GAS unsigned gu32;
typedef GAS unsigned long long gu64;
#define RLX_AGENT __ATOMIC_RELAXED, __HIP_MEMORY_SCOPE_AGENT
#define LDS_WAIT() asm volatile("s_waitcnt lgkmcnt(0)" ::: "memory")
#define VM_WAIT() asm volatile("s_waitcnt vmcnt(0)" ::: "memory")
__device__ __forceinline__ unsigned long long rt() { return __builtin_amdgcn_s_memrealtime(); }
__device__ __forceinline__ unsigned f2bf(float f) { unsigned u = __builtin_bit_cast(unsigned, f); return (u + 0x7fffu + ((u >> 16) & 1u)) >> 16; }
__device__ __forceinline__ unsigned pk2(float lo, float hi) { return pg8::cvt_pk_bf16(lo, hi); }

#define XB_TMO      128
#define XB_XCNT(j)  (256  + 64 * (j))
#define XB_XSUB(j)  (1280 + 64 * (j))
#define XB_XGEN(j)  (2304 + 64 * (j))
#define XB_TOP      3328
#define XB_TOPGEN   3392
#define XCD_BAR_WORDS 3456
#define XB_SPIN_CAP (1u << 18)

__device__ __forceinline__ unsigned xb_ld(unsigned* p)              { return __hip_atomic_load(p, __ATOMIC_RELAXED, __HIP_MEMORY_SCOPE_AGENT); }
__device__ __forceinline__ unsigned xb_add(unsigned* p, unsigned v) { return __hip_atomic_fetch_add(p, v, __ATOMIC_RELAXED, __HIP_MEMORY_SCOPE_AGENT); }
__device__ __forceinline__ unsigned xb_xcc_id() { return (unsigned)__builtin_amdgcn_s_getreg((3 << 11) | 20) & 0xFu; }
#define XB_SPIN(cond, bar) do { unsigned _sp = 0; while (cond) { __builtin_amdgcn_s_sleep(1); \
    if ((++_sp & 255u) == 0u) { if (xb_ld(&(bar)[XB_TMO])) break; if (_sp > XB_SPIN_CAP) { atomicAdd(&(bar)[XB_TMO], 1u); break; } } } } while (0)

struct XcdBarrier {
    unsigned* bar; unsigned x;
    volatile LAS unsigned* st;
};

__device__ __forceinline__ XcdBarrier xcd_barrier_post(unsigned* bar, volatile LAS unsigned* st) {
    XcdBarrier b; b.bar = bar; b.x = xb_xcc_id(); b.st = st;
    if (threadIdx.x == 0) (void)xb_add(&bar[XB_XCNT(b.x)], 1u);
    return b;
}
__device__ __forceinline__ void xcd_barrier_complete(unsigned* bar, unsigned x, unsigned& nloc, unsigned& nx) {
    const unsigned G = gridDim.x * gridDim.y * gridDim.z;
    unsigned sum, cnt, mine, sp = 0u;
    for (;;) {
        sum = 0u; cnt = 0u; mine = 0u;
#pragma unroll
        for (unsigned j = 0; j < 16; ++j) { const unsigned c = xb_ld(&bar[XB_XCNT(j)]); sum += c; cnt += (c > 0u) ? 1u : 0u; mine = (j == x) ? c : mine; }
        if (sum == G) break;
        __builtin_amdgcn_s_sleep(1);
        if ((++sp & 255u) == 0u) { if (xb_ld(&bar[XB_TMO])) break; if (sp > XB_SPIN_CAP) { atomicAdd(&bar[XB_TMO], 1u); break; } }
    }
    nloc = mine > 0u ? mine : 1u; nx = cnt > 0u ? cnt : 1u;
}

__device__ __forceinline__ void xcd_barrier(const XcdBarrier& b) {
    asm volatile("s_waitcnt vmcnt(0)" ::: "memory");
    __syncthreads();
    if (threadIdx.x == 0) {
        unsigned* bar = b.bar;
        __builtin_amdgcn_s_waitcnt(0);
        unsigned nloc = b.st[0], nx = b.st[1];
        if (nloc == 0u) { xcd_barrier_complete(bar, b.x, nloc, nx); b.st[0] = nloc; b.st[1] = nx; }
        const unsigned old = xb_add(&bar[XB_XSUB(b.x)], 1u);
        const unsigned gen = old / nloc;
        if (old + 1u == (gen + 1u) * nloc) {
            __builtin_amdgcn_fence(__ATOMIC_RELEASE, "agent");
            asm volatile("s_waitcnt vmcnt(0)" ::: "memory");
            const unsigned og = xb_add(&bar[XB_TOP], 1u);
            const unsigned tg = og / nx;
            if (og + 1u == (tg + 1u) * nx) xb_add(&bar[XB_TOPGEN], 1u);
            else XB_SPIN(xb_ld(&bar[XB_TOPGEN]) == tg, bar);
            __builtin_amdgcn_fence(__ATOMIC_ACQUIRE, "agent");
            xb_add(&bar[XB_XGEN(b.x)], 1u);
            asm volatile("s_waitcnt vmcnt(0)" ::: "memory");
        } else {
            XB_SPIN(xb_ld(&bar[XB_XGEN(b.x)]) == gen, bar);
            __builtin_amdgcn_fence(__ATOMIC_ACQUIRE, "agent");
            asm volatile("s_waitcnt vmcnt(0)" ::: "memory");
        }
    }
    __syncthreads();
}

#ifndef MOE_FP8
#define MOE_FP8 1
#endif
#ifndef MOE_WGM
#define MOE_WGM 8
#endif
#ifndef P15_ALIGN
#define P15_ALIGN true
#endif
#ifndef P15_SP2
#define P15_SP2 true
#endif
#ifndef FFN_FP8
#define FFN_FP8 0
#endif
#ifndef MOE_CVT_IN_SCAN
#define MOE_CVT_IN_SCAN 1
#endif
#ifndef ATTN_PRIO
#define ATTN_PRIO 1
#endif
#ifndef MOE_CVT_SPLIT
#define MOE_CVT_SPLIT 16384
#endif
#ifndef CVT_P0_END
#define CVT_P0_END T_ISMALL
#endif
#ifndef CVT_S1
#define CVT_S1 11264
#endif
#ifndef CVT_S2
#define CVT_S2 16384
#endif
constexpr int NWAVES = 8;
constexpr int NTOK = 16384, DM = 1024, SEQ = 8192, NB = 2;
constexpr int DFF = 2816, NEXP = 8, DFE = 3584, QKVW = 1536;
constexpr float EPS = 1e-6f;
constexpr float QSCALE = 0.125f * 1.4426950408889634f;

constexpr size_t MiB = 1u << 20;
constexpr size_t WS_CTL = 0, CTL_ZERO_BYTES = 1 * MiB;
constexpr size_t WS_ROPE_R = 1 * MiB, WS_ROPE_C = 1 * MiB + 16384, WS_AT = 1 * MiB + 65536, WS_QKG = 1 * MiB + 131072, WS_TOKINFO = 1 * MiB + 262144;
constexpr size_t WS_LIST = 2 * MiB, WS_IDLIST = 3 * MiB;
constexpr size_t WS_BT_IN = 4 * MiB, WS_BT_GLU = 6 * MiB, WS_BT_SOUT = 8 * MiB, WS_BT_AO = 10 * MiB, WS_BT_QKV = 12 * MiB, WS_BT_GU = 16 * MiB, WS_BT_FD = 28 * MiB;
constexpr size_t WS_S5_MAIN = 34 * MiB, WS_S5_STATE = 50 * MiB;
constexpr size_t WS_A2 = 58 * MiB, WS_S = 122 * MiB, WS_G1 = 122 * MiB, WS_G2 = 154 * MiB, WS_MIX = 58 * MiB;
constexpr size_t WS_ACTF = 122 * MiB;
constexpr size_t WS_Q = 122 * MiB, WS_K = 154 * MiB, WS_V = 162 * MiB, WS_O = 170 * MiB;
constexpr size_t WS_XN = 242 * MiB;
constexpr size_t WS_ACTM = 4 * MiB;
constexpr size_t WS_BT_MGU = 280 * MiB, WS_BT_MD = 392 * MiB, WS_SLOT = 124 * MiB, WS_PART = 192 * MiB, WS_HB = 336 * MiB, WS_END = 448 * MiB;
static_assert(WS_ACTM + (size_t)34816 * DFE * 2 <= WS_XN && WS_XN + (size_t)NTOK * DM * 2 <= WS_BT_MGU && WS_BT_MGU + (size_t)8 * 7168 * 1024 * 2 == WS_BT_MD && WS_BT_MD + (size_t)8 * 1024 * 3584 * 2 == WS_END, "ws map");
static_assert(WS_S5_STATE + (size_t)64 * 256 * 256 * 2 <= WS_A2 && WS_ACTF + (size_t)NTOK * DFF * 2 <= WS_XN && WS_O + (size_t)NTOK * DM * 2 <= WS_XN && WS_SLOT + (size_t)34816 * DM * 2 <= WS_PART && WS_PART + (size_t)256 * 131072 <= WS_XN && WS_ACTM + (size_t)34816 * DFE <= WS_SLOT && WS_BT_MGU + (size_t)8 * 7168 * 1024 <= WS_HB && WS_HB + (size_t)NTOK * DM * 2 <= WS_BT_MD && MOE_FP8 == 1, "ws map 2");
constexpr int CW_TMO = 0, CW_CODE = 1, CW_BAR = 4096, CW_CNT = 8192;

constexpr int RING_OFF = 0, RING_BYTES = 131072;
constexpr int LDSCTL_OFF = RING_BYTES, MISC_OFF = LDSCTL_OFF + 320;
constexpr int LDS_BYTES = 147456;

typedef unsigned v2u __attribute__((ext_vector_type(2)));

constexpr int MOE_OFF = MISC_OFF + 256;
struct Frame {
    LAS unsigned char* lds;
    volatile LAS unsigned* MISC;
    gu32* ctl;
    int tid, lane, wave;
    int vcu, G;
};
__device__ __forceinline__ float wave_sum(float v) {
#pragma unroll
    for (int o = 1; o < 64; o <<= 1) v += __shfl_xor(v, o);
    return v;
}
constexpr int T_ISMALL = 4 * 256 + 384 + 3 * 704, T_NITEMS = T_ISMALL + 8 * 3 * 896;
struct TItem { const float* W; bf16* WT; int K, N, kind, half, item, f8; };
__device__ __forceinline__ TItem t_decode(int it, const float* const* in, unsigned char* ws) {
    constexpr int I_SQ = 256, I_FG = 704, I_QKV = 384, I_M = 896;
    TItem t; int r = it; t.kind = 0; t.half = 0; t.K = DM; t.N = DM; t.f8 = 0;
    if (r < I_SQ) { t.W = in[2]; t.WT = (bf16*)(ws + WS_BT_IN); t.item = r; return t; } r -= I_SQ;
    if (r < I_SQ) { t.W = in[11]; t.WT = (bf16*)(ws + WS_BT_GLU); t.item = r; return t; } r -= I_SQ;
    if (r < I_SQ) { t.W = in[12]; t.WT = (bf16*)(ws + WS_BT_SOUT); t.item = r; return t; } r -= I_SQ;
    if (r < I_SQ) { t.W = in[19]; t.WT = (bf16*)(ws + WS_BT_AO); t.item = r; return t; } r -= I_SQ;
    if (r < I_QKV) { t.W = in[16]; t.WT = (bf16*)(ws + WS_BT_QKV); t.N = QKVW; t.kind = 2; t.item = r; return t; } r -= I_QKV;
    if (r < I_FG) { t.W = in[13]; t.WT = (bf16*)(ws + WS_BT_GU); t.N = DFF; t.kind = 1; t.item = r; t.f8 = FFN_FP8; return t; } r -= I_FG;
    if (r < I_FG) { t.W = in[14]; t.WT = (bf16*)(ws + WS_BT_GU); t.N = DFF; t.kind = 1; t.half = 1; t.item = r; t.f8 = FFN_FP8; return t; } r -= I_FG;
    if (r < I_FG) { t.W = in[15]; t.WT = (bf16*)(ws + WS_BT_FD); t.K = DFF; t.item = r; t.f8 = FFN_FP8; return t; } r -= I_FG;
    const int e = r / (3 * I_M); r -= e * 3 * I_M; t.f8 = MOE_FP8;
    if (r < I_M) { t.W = in[21] + (size_t)e * DM * DFE; t.WT = (bf16*)(ws + WS_BT_MGU + (size_t)e * 7168 * 1024 * (MOE_FP8 ? 1 : 2)); t.N = DFE; t.kind = 1; t.item = r; return t; } r -= I_M;
    if (r < I_M) { t.W = in[22] + (size_t)e * DM * DFE; t.WT = (bf16*)(ws + WS_BT_MGU + (size_t)e * 7168 * 1024 * (MOE_FP8 ? 1 : 2)); t.N = DFE; t.kind = 1; t.half = 1; t.item = r; return t; } r -= I_M;
    t.W = in[23] + (size_t)e * DFE * DM; t.WT = (bf16*)(ws + WS_BT_MD + (size_t)e * 1024 * 3584 * (MOE_FP8 ? 1 : 2)); t.K = DFE; t.item = r; return t;
}
__device__ __forceinline__ void t_issue(const TItem& t, int lane, f32x4 (&ld)[16]) {
    const int nblk = t.N / 64, kb = t.item / nblk, nb = t.item - kb * nblk;
    const int rmul = t.f8 ? 4 : 2;
    const float* p = t.W + (size_t)(64 * kb + rmul * (lane >> 4)) * t.N + 64 * nb + 4 * (lane & 15);
#pragma unroll
    for (int i = 0; i < 16; ++i) ld[i] = *(const GAS f32x4*)(p + (size_t)(t.f8 ? 16 * (i >> 2) + (i & 3) : 8 * (i >> 1) + (i & 1)) * t.N);
}
__device__ __forceinline__ void t_finish(const TItem& t, int lane, const f32x4 (&ld)[16], LAS unsigned* T) {
    const int nblk = t.N / 64, kb = t.item / nblk, nb = t.item - kb * nblk, k0 = 64 * kb, n0 = 64 * nb;
    const int r = lane >> 4, cg = lane & 15;
    if (t.f8) {
        unsigned char* WT8 = (unsigned char*)t.WT;
#pragma unroll
        for (int mq = 0; mq < 4; ++mq) { LAS unsigned* d = T + (4 * mq + r) * 65 + 4 * cg;
            d[0] = pg8::pack4_fp8(ld[4 * mq].x * 64.f, ld[4 * mq + 1].x * 64.f, ld[4 * mq + 2].x * 64.f, ld[4 * mq + 3].x * 64.f);
            d[1] = pg8::pack4_fp8(ld[4 * mq].y * 64.f, ld[4 * mq + 1].y * 64.f, ld[4 * mq + 2].y * 64.f, ld[4 * mq + 3].y * 64.f);
            d[2] = pg8::pack4_fp8(ld[4 * mq].z * 64.f, ld[4 * mq + 1].z * 64.f, ld[4 * mq + 2].z * 64.f, ld[4 * mq + 3].z * 64.f);
            d[3] = pg8::pack4_fp8(ld[4 * mq].w * 64.f, ld[4 * mq + 1].w * 64.f, ld[4 * mq + 2].w * 64.f, ld[4 * mq + 3].w * 64.f); }
        LDS_WAIT(); asm volatile("" ::: "memory");
        const int c4 = lane & 3;
#pragma unroll
        for (int j = 0; j < 4; ++j) { const int nl = (lane >> 2) + 16 * j, n = n0 + nl;
            const int dr = t.kind == 0 ? n : 256 * (n / 128) + (n % 128) + 128 * t.half;
            const LAS unsigned* s = T + (4 * c4) * 65 + nl;
            v4u o; o.x = s[0]; o.y = s[65]; o.z = s[130]; o.w = s[195];
            *(GAS v4u*)(WT8 + (size_t)dr * t.K + k0 + 16 * c4) = o; }
        LDS_WAIT(); asm volatile("" ::: "memory");
        return;
    }
#pragma unroll
    for (int m = 0; m < 8; ++m) { LAS unsigned* d = T + (4 * m + r) * 65 + 4 * cg;
        d[0] = pk2(ld[2 * m].x, ld[2 * m + 1].x); d[1] = pk2(ld[2 * m].y, ld[2 * m + 1].y); d[2] = pk2(ld[2 * m].z, ld[2 * m + 1].z); d[3] = pk2(ld[2 * m].w, ld[2 * m + 1].w); }
    LDS_WAIT(); asm volatile("" ::: "memory");
    const int c = lane & 7;
#pragma unroll
    for (int j = 0; j < 8; ++j) { const int nl = (lane >> 3) + 8 * j, n = n0 + nl;
        const int dr = t.kind == 0 ? n : (t.kind == 1 ? 256 * (n / 128) + (n % 128) + 128 * t.half : 256 * (n / 256) + 128 * ((n % 64) / 32) + 32 * ((n % 256) / 64) + (n % 32));
        const LAS unsigned* s = T + (4 * c) * 65 + nl;
        v4u o; o.x = s[0]; o.y = s[65]; o.z = s[130]; o.w = s[195];
        *(GAS v4u*)(t.WT + (size_t)dr * t.K + k0 + 8 * c) = o; }
    LDS_WAIT(); asm volatile("" ::: "memory");
}
__device__ __forceinline__ void convert_range(const float* const* in, unsigned char* ws, LAS unsigned* scr, int lane, int begin, int end, int wi, int nw) {
    f32x4 lA[16], lB[16]; TItem tA, tB; int it = begin + wi;
    if (it < end) { tA = t_decode(it, in, ws); t_issue(tA, lane, lA); }
    while (it < end) {
        const bool nb = it + nw < end;
        if (nb) { tB = t_decode(it + nw, in, ws); t_issue(tB, lane, lB); }
        t_finish(tA, lane, lA, scr);
        if (!nb) break;
        const bool na = it + 2 * nw < end;
        if (na) { tA = t_decode(it + 2 * nw, in, ws); t_issue(tA, lane, lA); }
        t_finish(tB, lane, lB, scr);
        if (!na) break;
        it += 2 * nw;
    }
}
__device__ __forceinline__ void s5_tables_item(Frame& F, const float* const* in, unsigned char* ws, int g, int tq) {
    const float *lam_re = in[3], *lam_im = in[4], *log_step = in[5], *b_re = in[6], *b_im = in[7], *c_re = in[8], *c_im = in[9], *dsk = in[10];
    LAS float* APOW = (LAS float*)F.lds;
    LAS float* BB = APOW + 2 * 17 * 64 * 2;
    LAS float* CC = BB + 2 * 64 * 16 * 2;
    LAS float* KT = CC + 2 * 16 * 64 * 2;
    const int tid = F.tid;
    __syncthreads();
    if (tid < 128) {
        const int dir = tid >> 6, p = tid & 63;
        const double step = exp((double)log_step[dir * 64 + g]);
        const double lr = lam_re[(dir * 64 + g) * 64 + p], li = lam_im[(dir * 64 + g) * 64 + p];
        const double mag = exp(lr * step), ang = li * step;
        const double ar = mag * cos(ang), ai = mag * sin(ang);
        double pr = 1.0, pi = 0.0;
        for (int tau = 0; tau <= 16; ++tau) { APOW[((dir * 17 + tau) * 64 + p) * 2] = (float)pr; APOW[((dir * 17 + tau) * 64 + p) * 2 + 1] = (float)pi;
            const double nr = pr * ar - pi * ai, ni = pr * ai + pi * ar; pr = nr; pi = ni; if (tau == 15 && tq == 0) { ((float*)(ws + WS_AT))[((dir * 64 + g) * 64 + p) * 2] = (float)nr; ((float*)(ws + WS_AT))[((dir * 64 + g) * 64 + p) * 2 + 1] = (float)ni; } }
        const double nr = ar - 1.0, ni = ai, den = lr * lr + li * li;
        const double qr = (nr * lr + ni * li) / den, qi = (ni * lr - nr * li) / den;
        for (int i = 0; i < 16; ++i) { const double br = b_re[((dir * 64 + g) * 64 + p) * 16 + i], bi = b_im[((dir * 64 + g) * 64 + p) * 16 + i];
            BB[((dir * 64 + p) * 16 + i) * 2] = (float)(qr * br - qi * bi); BB[((dir * 64 + p) * 16 + i) * 2 + 1] = (float)(qr * bi + qi * br); }
    }
    for (int idx = tid; idx < 2048; idx += 512) { const int dir = idx >> 10, j = (idx >> 6) & 15, p = idx & 63;
        CC[idx * 2] = c_re[((dir * 64 + g) * 16 + j) * 64 + p]; CC[idx * 2 + 1] = c_im[((dir * 64 + g) * 16 + j) * 64 + p]; }
    __syncthreads();
    {
        const int dir = tid >> 8, j = (tid >> 4) & 15, i = tid & 15;
        float kt[16];
#pragma unroll
        for (int t = 0; t < 16; ++t) kt[t] = 0.f;
        for (int p = 0; p < 64; ++p) {
            const float cr = CC[((dir * 16 + j) * 64 + p) * 2], ci = CC[((dir * 16 + j) * 64 + p) * 2 + 1];
            const float br = BB[((dir * 64 + p) * 16 + i) * 2], bi = BB[((dir * 64 + p) * 16 + i) * 2 + 1];
            const float wr = cr * br - ci * bi, wi = cr * bi + ci * br;
#pragma unroll
            for (int t = 0; t < 16; ++t) { const float ar = APOW[((dir * 17 + t) * 64 + p) * 2], ai = APOW[((dir * 17 + t) * 64 + p) * 2 + 1]; kt[t] += ar * wr - ai * wi; }
        }
#pragma unroll
        for (int t = 0; t < 16; ++t) KT[(dir * 16 + t) * 256 + j * 16 + i] = kt[t];
    }
    __syncthreads();
    bf16* Bm = (bf16*)(ws + WS_S5_MAIN) + (size_t)(g * 256 + 64 * tq) * 512;
    for (int w = tid; w < 4096; w += 512) {
        const int nl = w >> 6, k0 = (w & 63) * 8, t = 4 * tq + (nl >> 4), j = nl & 15;
        float v[8];
        if (k0 < 256) { const int s = k0 >> 4, i0 = k0 & 15;
#pragma unroll
            for (int e = 0; e < 8; ++e) { const int i = i0 + e;
                v[e] = (t > s) ? KT[(0 * 16 + (t - s)) * 256 + j * 16 + i] : (s > t) ? KT[(1 * 16 + (s - t)) * 256 + j * 16 + i]
                                 : KT[j * 16 + i] + KT[16 * 256 + j * 16 + i] + (i == j ? dsk[g * 16 + j] : 0.f); }
        } else { const int dir = (k0 - 256) >> 7, p0 = ((k0 - 256) & 127) >> 1, tau = dir == 0 ? t + 1 : 16 - t;
#pragma unroll
            for (int e = 0; e < 8; ++e) { const int p = p0 + (e >> 1), ri = e & 1;
                const float cr = CC[((dir * 16 + j) * 64 + p) * 2], ci = CC[((dir * 16 + j) * 64 + p) * 2 + 1];
                const float ar = APOW[((dir * 17 + tau) * 64 + p) * 2], ai = APOW[((dir * 17 + tau) * 64 + p) * 2 + 1];
                v[e] = ri == 0 ? (cr * ar - ci * ai) : -(cr * ai + ci * ar); }
        }
        v4u o; o.x = pk2(v[0], v[1]); o.y = pk2(v[2], v[3]); o.z = pk2(v[4], v[5]); o.w = pk2(v[6], v[7]);
        *(GAS v4u*)(Bm + (size_t)nl * 512 + k0) = o;
    }
    bf16* Bs = (bf16*)(ws + WS_S5_STATE) + (size_t)(g * 256 + 64 * tq) * 256;
    { const int dir = tq >> 1;
      for (int w = tid; w < 2048; w += 512) {
        const int nl = w >> 5, p = 32 * (tq & 1) + (nl >> 1), ri = nl & 1, k0 = (w & 31) * 8, s = k0 >> 4, i0 = k0 & 15, tau = dir == 0 ? 15 - s : s;
        const float ar = APOW[((dir * 17 + tau) * 64 + p) * 2], ai = APOW[((dir * 17 + tau) * 64 + p) * 2 + 1];
        float v[8];
#pragma unroll
        for (int e = 0; e < 8; ++e) { const float br = BB[((dir * 64 + p) * 16 + i0 + e) * 2], bi = BB[((dir * 64 + p) * 16 + i0 + e) * 2 + 1];
            v[e] = ri == 0 ? (ar * br - ai * bi) : (ar * bi + ai * br); }
        v4u o; o.x = pk2(v[0], v[1]); o.y = pk2(v[2], v[3]); o.z = pk2(v[4], v[5]); o.w = pk2(v[6], v[7]);
        *(GAS v4u*)(Bs + (size_t)nl * 256 + k0) = o;
      } }
    __syncthreads();
}
__device__ __forceinline__ void rms_row_to_bf16(int lane, const float* xrow, const float* gain, bf16* orow) {
    const GAS f32x4* xr = (const GAS f32x4*)xrow + lane;
    f32x4 v[4]; float s = 0.f;
#pragma unroll
    for (int j = 0; j < 4; ++j) { v[j] = xr[64 * j]; s += (v[j].x * v[j].x + v[j].y * v[j].y) + (v[j].z * v[j].z + v[j].w * v[j].w); }
    const float r = rsqrtf(wave_sum(s) * (1.f / DM) + EPS);
    GAS v2u* o8 = (GAS v2u*)orow + lane;
#pragma unroll
    for (int j = 0; j < 4; ++j) { const f32x4 g = ((const GAS f32x4*)gain)[lane + 64 * j]; v2u o; o.x = pk2(v[j].x * r * g.x, v[j].y * r * g.y); o.y = pk2(v[j].z * r * g.z, v[j].w * r * g.w); o8[64 * j] = o; }
}
__device__ __forceinline__ void p0_prologue(Frame& F, const float* const* in, unsigned char* ws) {
#ifndef P0DUP
#define P0DUP 0
#endif
    for (int rep = 0; rep < 1 + (P0DUP & 1); ++rep)
    for (int it = blockIdx.x; it < 256; it += F.G) s5_tables_item(F, in, ws, it >> 2, it & 3);
    for (int idx = blockIdx.x * 512 + F.tid; idx < 192 * 16; idx += F.G * 512) {
        const int f = idx & 15, pos = idx < 2048 ? (idx >> 4) : ((idx - 2048) >> 4);
        const float freq = powf(10000.f, -(float)(2 * f) / 32.f), ang = (float)pos * freq;
        float* dst = idx < 2048 ? (float*)(ws + WS_ROPE_R) + idx * 2 : (float*)(ws + WS_ROPE_C) + (idx - 2048) * 2;
        dst[0] = cosf(ang); dst[1] = sinf(ang);
    }
#if defined(EXP_GATHER) && EXP_GATHER
    for (int idx = blockIdx.x * 512 + F.tid; idx < NTOK; idx += F.G * 512) ((int*)(ws + WS_IDLIST))[idx] = idx;
#endif
    if (blockIdx.x == 0 && F.tid < 128) ((float*)(ws + WS_QKG))[F.tid] = F.tid < 64 ? in[17][F.tid] : in[18][F.tid - 64];
    LAS unsigned* scr = (LAS unsigned*)(F.lds + RING_OFF + F.wave * 16384);
    const int gw = F.vcu * NWAVES + F.wave, NGW = F.G * NWAVES;
    for (int rep = 0; rep < 1 + ((P0DUP >> 1) & 1); ++rep) convert_range(in, ws, scr, F.lane, 0, CVT_P0_END, gw, NGW);
    for (int rep = 0; rep < 1 + ((P0DUP >> 2) & 1); ++rep)
    for (int m = gw; m < NTOK; m += NGW) rms_row_to_bf16(F.lane, in[0] + (size_t)m * DM, in[1], (bf16*)(ws + WS_XN) + (size_t)m * DM);
}
__device__ __forceinline__ void scan_phase(Frame& F, const float* const* in, unsigned char* ws) {
    const float* S = (const float*)(ws + WS_S); bf16* A2 = (bf16*)(ws + WS_A2); const float* aT = (const float*)(ws + WS_AT);
#if MOE_CVT_IN_SCAN
    if (F.wave != 0) {
        LAS unsigned* scr = (LAS unsigned*)(F.lds + RING_OFF + F.wave * 16384);
        convert_range(in, ws, scr, F.lane, CVT_P0_END, T_ISMALL + CVT_S1, F.vcu * 7 + (F.wave - 1), F.G * 7);
        return;
    }
    typedef float f32x2s __attribute__((ext_vector_type(2)));
#ifndef SCAN_REPS
#define SCAN_REPS 1
#endif
    for (int srep_ = 0; srep_ < SCAN_REPS; ++srep_)
    for (int it = blockIdx.x; it < 256; it += F.G) {
        const int dir = it & 1, g = (it >> 1) & 63, b = it >> 7;
        const float ar = aT[((dir * 64 + g) * 64 + F.lane) * 2], ai = aT[((dir * 64 + g) * 64 + F.lane) * 2 + 1];
        const size_t row0 = (size_t)g * 1024 + b * 512;
        const float* Sp = S + row0 * 256 + dir * 128 + 2 * F.lane;
        bf16* Ap = A2 + row0 * 512 + 256 + dir * 128 + 2 * F.lane;
        float xr = 0.f, xi = 0.f;
        f32x2s X0[16], X1[16], X2[16];
#define SC_LOAD(X, k0) do { _Pragma("unroll") for (int q = 0; q < 16; ++q) { const int c = dir == 0 ? (k0) + q : 511 - (k0) - q; X[q] = *(const GAS f32x2s*)(Sp + (size_t)c * 256); } } while (0)
#define SC_STEP(X, k0) do { _Pragma("unroll") for (int q = 0; q < 16; ++q) { const int c = dir == 0 ? (k0) + q : 511 - (k0) - q; \
            *(GAS unsigned*)(Ap + (size_t)c * 512) = pk2(xr, xi); \
            const float nxr = ar * xr - ai * xi + X[q].x, nxi = ar * xi + ai * xr + X[q].y; xr = nxr; xi = nxi; } } while (0)
        SC_LOAD(X0, 0); SC_LOAD(X1, 16); SC_LOAD(X2, 32);
        for (int k0 = 0; k0 < 512; k0 += 48) {
            SC_STEP(X0, k0); if (k0 + 48 < 512) SC_LOAD(X0, k0 + 48);
            if (k0 + 16 < 512) { SC_STEP(X1, k0 + 16); if (k0 + 64 < 512) SC_LOAD(X1, k0 + 64); }
            if (k0 + 32 < 512) { SC_STEP(X2, k0 + 32); if (k0 + 80 < 512) SC_LOAD(X2, k0 + 80); }
        }
#undef SC_LOAD
#undef SC_STEP
    }
#else
    LAS float* L = (LAS float*)F.lds;
    for (int it = blockIdx.x; it < 256; it += F.G) {
        const int dir = it & 1, g = (it >> 1) & 63, b = it >> 7;
        const float ar = aT[((dir * 64 + g) * 64 + F.lane) * 2], ai = aT[((dir * 64 + g) * 64 + F.lane) * 2 + 1];
        float xr = 0.f, xi = 0.f;
        for (int hh = 0; hh < 2; ++hh) {
            const int cbase = dir == 0 ? 256 * hh : 256 * (1 - hh);
            const size_t row0 = (size_t)g * 1024 + b * 512 + cbase;
            __syncthreads();
            { f32x4 tv[16];
#pragma unroll
            for (int k = 0; k < 16; ++k) { const int idx = F.tid + 512 * k, cl = idx >> 5, q = idx & 31; tv[k] = *(const GAS f32x4*)(S + (row0 + cl) * 256 + dir * 128 + q * 4); }
#pragma unroll
            for (int k = 0; k < 16; ++k) { const int idx = F.tid + 512 * k, cl = idx >> 5, q = idx & 31; *(LAS f32x4*)(L + cl * 128 + q * 4) = tv[k]; } }
            __syncthreads();
            if (F.wave == 0) {
                for (int s0 = 0; s0 < 256; s0 += 8) { float sr[8], si[8];
#pragma unroll
                    for (int q = 0; q < 8; ++q) { const int cl = dir == 0 ? s0 + q : 255 - s0 - q; sr[q] = L[cl * 128 + 2 * F.lane]; si[q] = L[cl * 128 + 2 * F.lane + 1]; }
#pragma unroll
                    for (int q = 0; q < 8; ++q) { const int cl = dir == 0 ? s0 + q : 255 - s0 - q;
                        *(GAS unsigned*)(A2 + (row0 + cl) * 512 + 256 + dir * 128 + 2 * F.lane) = pk2(xr, xi);
                        const float nxr = ar * xr - ai * xi + sr[q], nxi = ar * xi + ai * xr + si[q]; xr = nxr; xi = nxi; } }
            }
        }
        __syncthreads();
    }
#endif
}
template <bool B16> __device__ __forceinline__ f32x4 ld_h(const void* h, int m, int lane, int j) {
    if constexpr (B16) { const v2u w = ((const GAS v2u*)((const bf16*)h + (size_t)m * DM))[lane + 64 * j]; return (f32x4){pg8::bf_lo(w.x), pg8::bf_hi(w.x), pg8::bf_lo(w.y), pg8::bf_hi(w.y)}; }
    else return ((const GAS f32x4*)((const float*)h + (size_t)m * DM))[lane + 64 * j];
}
template <bool B16> __device__ __forceinline__ void st_h(void* h, int m, int lane, int j, const f32x4& v) {
    if constexpr (B16) { v2u o; o.x = pk2(v.x, v.y); o.y = pk2(v.z, v.w); ((GAS v2u*)((bf16*)h + (size_t)m * DM))[lane + 64 * j] = o; }
    else ((GAS f32x4*)((float*)h + (size_t)m * DM))[lane + 64 * j] = v;
}
template <bool HINB> struct RowRaw { v2u mw[4]; v2u hb[4]; f32x4 hf[4]; };
template <bool HINB> __device__ __forceinline__ void row_load(RowRaw<HINB>& r, const void* hin, const bf16* mix, int m, int lane) {
    const GAS v2u* mr = (const GAS v2u*)(mix + (size_t)m * DM) + lane;
#pragma unroll
    for (int j = 0; j < 4; ++j) { r.mw[j] = mr[64 * j];
        if constexpr (HINB) r.hb[j] = ((const GAS v2u*)((const bf16*)hin + (size_t)m * DM))[lane + 64 * j]; else r.hf[j] = ((const GAS f32x4*)((const float*)hin + (size_t)m * DM))[lane + 64 * j]; }
}
template <bool HINB> __device__ __forceinline__ void row_unpack(const RowRaw<HINB>& r, f32x4 (&v)[4], f32x4 (&hv)[4]) {
#pragma unroll
    for (int j = 0; j < 4; ++j) { v[j] = (f32x4){pg8::bf_lo(r.mw[j].x), pg8::bf_hi(r.mw[j].x), pg8::bf_lo(r.mw[j].y), pg8::bf_hi(r.mw[j].y)};
        if constexpr (HINB) hv[j] = (f32x4){pg8::bf_lo(r.hb[j].x), pg8::bf_hi(r.hb[j].x), pg8::bf_lo(r.hb[j].y), pg8::bf_hi(r.hb[j].y)}; else hv[j] = r.hf[j]; }
}
template <bool XF8, bool HINB, bool HOUTB> __device__ __forceinline__ void e_phase(Frame& F, const void* hin, const bf16* mix, const float* gpost, const float* gpre, void* hout, bf16* xn) {
    const int gw = F.vcu * NWAVES + F.wave, NGW = F.G * NWAVES;
    RowRaw<HINB> R[2];
    row_load<HINB>(R[0], hin, mix, gw, F.lane);
#pragma unroll
    for (int k = 0; k < 8; ++k) { const int m = gw + k * NGW;
        if (k + 1 < 8) row_load<HINB>(R[(k + 1) & 1], hin, mix, m + NGW, F.lane);
        f32x4 v[4], hv[4]; float s = 0.f;
        row_unpack<HINB>(R[k & 1], v, hv);
#pragma unroll
        for (int j = 0; j < 4; ++j) s += (v[j].x * v[j].x + v[j].y * v[j].y) + (v[j].z * v[j].z + v[j].w * v[j].w);
        const float r = rsqrtf(wave_sum(s) * (1.f / DM) + EPS); float s2 = 0.f;
#pragma unroll
        for (int j = 0; j < 4; ++j) { const f32x4 g = ((const GAS f32x4*)gpost)[F.lane + 64 * j]; hv[j] = hv[j] + v[j] * r * g; s2 += (hv[j].x * hv[j].x + hv[j].y * hv[j].y) + (hv[j].z * hv[j].z + hv[j].w * hv[j].w); }
#pragma unroll
        for (int j = 0; j < 4; ++j) st_h<HOUTB>(hout, m, F.lane, j, hv[j]);
        if (xn) { const float r2 = rsqrtf(wave_sum(s2) * (1.f / DM) + EPS); GAS v2u* o8 = (GAS v2u*)(xn + (size_t)m * DM) + F.lane;
#pragma unroll
            for (int j = 0; j < 4; ++j) { const f32x4 g = ((const GAS f32x4*)gpre)[F.lane + 64 * j];
                if constexpr (XF8) ((GAS unsigned*)((unsigned char*)xn + (size_t)m * DM))[F.lane + 64 * j] = pg8::pack4_fp8(hv[j].x * r2 * g.x * 4.f, hv[j].y * r2 * g.y * 4.f, hv[j].z * r2 * g.z * 4.f, hv[j].w * r2 * g.w * 4.f);
                else { v2u o; o.x = pk2(hv[j].x * r2 * g.x, hv[j].y * r2 * g.y); o.y = pk2(hv[j].z * r2 * g.z, hv[j].w * r2 * g.w); o8[64 * j] = o; } } }
    }
}
__device__ __forceinline__ void e3_phase(Frame& F, const void* hin, const bf16* mix, const float* gpost, const float* gpre, void* hout, bf16* xn, const float* wrouter, unsigned char* ws) {
    LAS float* WL = (LAS float*)F.lds;
    LAS int* RI = (LAS int*)(F.lds + 32768);
    for (int idx = F.tid; idx < 8192; idx += 512) WL[(idx & 7) * 1024 + (idx >> 3)] = wrouter[idx];
    if (F.tid < 8) RI[320 + F.tid] = 0;
    __syncthreads();
    const int gw = F.vcu * NWAVES + F.wave, NGW = F.G * NWAVES;
    RowRaw<true> R[2];
    row_load<true>(R[0], hin, mix, gw, F.lane);
#pragma unroll
    for (int k = 0; k < 8; ++k) { const int m = gw + k * NGW;
        if (k + 1 < 8) row_load<true>(R[(k + 1) & 1], hin, mix, m + NGW, F.lane);
        f32x4 v[4], hv[4]; float s = 0.f;
        row_unpack<true>(R[k & 1], v, hv);
#pragma unroll
        for (int j = 0; j < 4; ++j) s += (v[j].x * v[j].x + v[j].y * v[j].y) + (v[j].z * v[j].z + v[j].w * v[j].w);
        const float r = rsqrtf(wave_sum(s) * (1.f / DM) + EPS); float s2 = 0.f;
#pragma unroll
        for (int j = 0; j < 4; ++j) { const f32x4 g = ((const GAS f32x4*)gpost)[F.lane + 64 * j]; hv[j] = hv[j] + v[j] * r * g; s2 += (hv[j].x * hv[j].x + hv[j].y * hv[j].y) + (hv[j].z * hv[j].z + hv[j].w * hv[j].w); }
#pragma unroll
        for (int j = 0; j < 4; ++j) st_h<true>(hout, m, F.lane, j, hv[j]);
        const float r2 = rsqrtf(wave_sum(s2) * (1.f / DM) + EPS); GAS v2u* o8 = (GAS v2u*)(xn + (size_t)m * DM) + F.lane;
        float lg[8];
#pragma unroll
        for (int e = 0; e < 8; ++e) lg[e] = 0.f;
#pragma unroll
        for (int j = 0; j < 4; ++j) { const f32x4 g = ((const GAS f32x4*)gpre)[F.lane + 64 * j]; const f32x4 xf = hv[j] * r2 * g;
#if MOE_FP8
            ((GAS unsigned*)((unsigned char*)xn + (size_t)m * DM))[F.lane + 64 * j] = pg8::pack4_fp8(xf.x * 4.f, xf.y * 4.f, xf.z * 4.f, xf.w * 4.f);
#else
            v2u o; o.x = pk2(xf.x, xf.y); o.y = pk2(xf.z, xf.w); o8[64 * j] = o;
#endif
#pragma unroll
            for (int e = 0; e < 8; ++e) { const f32x4 w = *(const LAS f32x4*)(WL + e * 1024 + 4 * (F.lane + 64 * j)); lg[e] += (xf.x * w.x + xf.y * w.y) + (xf.z * w.z + xf.w * w.w); } }
#pragma unroll
        for (int e = 0; e < 8; ++e) lg[e] = wave_sum(lg[e]);
        int e0 = 0; float l0 = lg[0];
#pragma unroll
        for (int e = 1; e < 8; ++e) if (lg[e] > l0) { l0 = lg[e]; e0 = e; }
        int e1 = -1; float l1 = -INFINITY;
#pragma unroll
        for (int e = 0; e < 8; ++e) if (e != e0 && lg[e] > l1) { l1 = lg[e]; e1 = e; }
        const float w0 = 1.f / (1.f + expf(l1 - l0));
        if (F.lane == 0) { const int sl = F.wave * 8 + k; RI[sl] = e0 | (e1 << 8); RI[64 + sl] = (int)__float_as_uint(w0); RI[128 + sl] = m; }
    }
    __syncthreads();
    if (F.tid < 64) { const int ee = RI[F.tid]; RI[192 + F.tid] = __hip_atomic_fetch_add(&RI[320 + (ee & 255)], 1, __ATOMIC_RELAXED, __HIP_MEMORY_SCOPE_WORKGROUP); RI[256 + F.tid] = __hip_atomic_fetch_add(&RI[320 + (ee >> 8)], 1, __ATOMIC_RELAXED, __HIP_MEMORY_SCOPE_WORKGROUP); }
    __syncthreads();
    if (F.tid < 8) RI[328 + F.tid] = (int)__hip_atomic_fetch_add(F.ctl + CW_CNT + 64 * F.tid, (unsigned)RI[320 + F.tid], RLX_AGENT);
    __syncthreads();
    if (F.tid < 64) { const int ee = RI[F.tid], e0 = ee & 255, e1 = ee >> 8, tok = RI[128 + F.tid];
        const int p0 = RI[328 + e0] + RI[192 + F.tid], p1 = RI[328 + e1] + RI[256 + F.tid];
        int* lists = (int*)(ws + WS_LIST); lists[e0 * NTOK + p0] = tok; lists[e1 * NTOK + p1] = tok;
        v4u ti; ti.x = (unsigned)ee; ti.y = (unsigned)p0; ti.z = (unsigned)p1; ti.w = (unsigned)RI[64 + F.tid];
        *(GAS v4u*)(ws + WS_TOKINFO + (size_t)tok * 16) = ti; }
    __syncthreads();
}
__device__ __forceinline__ void moe_table(Frame& F) {
    volatile LAS int* misc = (volatile LAS int*)(F.lds + MOE_OFF);
    __syncthreads();
    if (F.tid == 0) { int t = 0;
        for (int e = 0; e < 8; ++e) { const int c = (int)__hip_atomic_load(F.ctl + CW_CNT + 64 * e, RLX_AGENT); misc[e] = t; misc[16 + e] = c; t += (c + 255) >> 8; }
        misc[8] = t;
        const int first_rem = (t >> 6) << 6, urem = 4 * (t - first_rem);
        const int parts = urem == 0 ? 1 : (urem * 7 <= 256 ? 7 : (urem * 2 <= 256 ? 2 : 1));
        misc[9] = parts; misc[10] = parts == 1 ? t : first_rem; misc[11] = parts == 1 ? 0 : urem * parts; }
    __syncthreads();
}
__device__ __forceinline__ void e4_phase(Frame& F, const void* hin, const float* gpost, float* hout, unsigned char* ws) {
    volatile LAS int* misc = (volatile LAS int*)(F.lds + MOE_OFF);
    const bf16* SO = (const bf16*)(ws + WS_SLOT);
    const int gw = F.vcu * NWAVES + F.wave, NGW = F.G * NWAVES;
    const int first_rem = misc[10], parts = misc[9];
    v4u ti[8];
#pragma unroll
    for (int k = 0; k < 8; ++k) ti[k] = *(const GAS v4u*)(ws + WS_TOKINFO + (size_t)(gw + k * NGW) * 16);
    struct Raw4 { v2u a[4], b[4], h[4]; int slot0, slot1; };
    Raw4 R[2];
#define E4_ISSUE(RR, k) do { const v4u t_ = ti[k]; const int m_ = gw + (k) * NGW; \
        (RR).slot0 = __builtin_amdgcn_readfirstlane(misc[t_.x & 255] * 256 + (int)t_.y); (RR).slot1 = __builtin_amdgcn_readfirstlane(misc[(t_.x >> 8) & 255] * 256 + (int)t_.z); \
        const bool s0_ = ((RR).slot0 >> 8) >= first_rem, s1_ = ((RR).slot1 >> 8) >= first_rem; \
        const GAS v2u* a8_ = (const GAS v2u*)(SO + (size_t)(s0_ ? 0 : (RR).slot0) * DM) + F.lane; const GAS v2u* b8_ = (const GAS v2u*)(SO + (size_t)(s1_ ? 0 : (RR).slot1) * DM) + F.lane; \
        const GAS v2u* h8_ = (const GAS v2u*)((const bf16*)hin + (size_t)m_ * DM) + F.lane; \
        _Pragma("unroll") for (int j = 0; j < 4; ++j) { (RR).a[j] = a8_[64 * j]; (RR).b[j] = b8_[64 * j]; (RR).h[j] = h8_[64 * j]; } } while (0)
    E4_ISSUE(R[0], 0);
#pragma unroll
    for (int k = 0; k < 8; ++k) { const int m = gw + k * NGW;
        if (k + 1 < 8) E4_ISSUE(R[(k + 1) & 1], k + 1);
        const Raw4& C = R[k & 1];
        const float w0 = __uint_as_float(ti[k].w), w1 = 1.f - w0;
        const int slot0 = C.slot0, slot1 = C.slot1;
        const bool sp0 = (slot0 >> 8) >= first_rem, sp1 = (slot1 >> 8) >= first_rem;
        const float wa = sp0 ? 0.f : w0, wb = sp1 ? 0.f : w1;
        f32x4 v[4], hv[4]; float s = 0.f;
#pragma unroll
        for (int j = 0; j < 4; ++j) { const v2u a = C.a[j], b = C.b[j], hh = C.h[j]; hv[j] = (f32x4){pg8::bf_lo(hh.x), pg8::bf_hi(hh.x), pg8::bf_lo(hh.y), pg8::bf_hi(hh.y)};
            v[j].x = wa * pg8::bf_lo(a.x) + wb * pg8::bf_lo(b.x); v[j].y = wa * pg8::bf_hi(a.x) + wb * pg8::bf_hi(b.x); v[j].z = wa * pg8::bf_lo(a.y) + wb * pg8::bf_lo(b.y); v[j].w = wa * pg8::bf_hi(a.y) + wb * pg8::bf_hi(b.y); }
        if (sp0 || sp1) {
            const bf16* PT = (const bf16*)(ws + WS_PART);
#pragma unroll
            for (int kk = 0; kk < 2; ++kk) { const bool sp = kk == 0 ? sp0 : sp1; const int slot = kk == 0 ? slot0 : slot1; const float w = kk == 0 ? w0 : w1;
                if (sp) { const int pm = slot >> 8, rr = slot & 255;
#pragma unroll
                    for (int j = 0; j < 4; ++j) { f32x4 acc = (f32x4){0.f, 0.f, 0.f, 0.f};
                        for (int p = 0; p < parts; ++p) { const v2u a = *((const GAS v2u*)(PT + ((size_t)(((pm - first_rem) * 4 + j) * parts + p) * 65536 + (size_t)rr * 256)) + F.lane);
                            acc.x += pg8::bf_lo(a.x); acc.y += pg8::bf_hi(a.x); acc.z += pg8::bf_lo(a.y); acc.w += pg8::bf_hi(a.y); }
                        v[j] = v[j] + acc * w; } } }
        }
#pragma unroll
        for (int j = 0; j < 4; ++j) s += (v[j].x * v[j].x + v[j].y * v[j].y) + (v[j].z * v[j].z + v[j].w * v[j].w);
        const float r = rsqrtf(wave_sum(s) * (1.f / DM) + EPS);
        GAS f32x4* ho = (GAS f32x4*)(hout + (size_t)m * DM) + F.lane;
#pragma unroll
        for (int j = 0; j < 4; ++j) { const f32x4 g = ((const GAS f32x4*)gpost)[F.lane + 64 * j]; ho[64 * j] = hv[j] + v[j] * r * g; }
    }
#undef E4_ISSUE
}

#ifndef FLAT_BAR
#define FLAT_BAR 0
#endif
constexpr int FB_REPL = 8, CW_FB = 12288, CW_FBTMO = 12288 + 64 * 8;
struct FlatBar { gu32* ctl; unsigned epoch; };
__device__ __forceinline__ void flat_barrier(FlatBar& fb) {
    asm volatile("s_waitcnt vmcnt(0)" ::: "memory");
    __syncthreads();
    fb.epoch += 1u;
    if (threadIdx.x < 64) {
        const unsigned lane = threadIdx.x;
        __builtin_amdgcn_fence(__ATOMIC_RELEASE, "agent");
        asm volatile("s_waitcnt vmcnt(0)" ::: "memory");
        if (lane < FB_REPL) (void)__hip_atomic_fetch_add(fb.ctl + CW_FB + 64 * lane, 1u, RLX_AGENT);
        const unsigned target = fb.epoch * gridDim.x;
        gu32* mine = fb.ctl + CW_FB + 64 * (blockIdx.x % FB_REPL);
        unsigned sp = 0;
        while ((unsigned)__builtin_amdgcn_readfirstlane(__hip_atomic_load(mine, RLX_AGENT)) < target) {
            __builtin_amdgcn_s_sleep(1);
            if ((++sp & 1023u) == 0u) { if (__hip_atomic_load(fb.ctl + CW_FBTMO, RLX_AGENT) != 0u) break; if (sp > (1u << 20)) { if (lane == 0) __hip_atomic_store(fb.ctl + CW_FBTMO, 1u, RLX_AGENT); break; } }
        }
        __builtin_amdgcn_fence(__ATOMIC_ACQUIRE, "agent");
        asm volatile("s_waitcnt vmcnt(0)" ::: "memory");
    }
    __syncthreads();
}

#ifndef XB2
#define XB2 0
#endif
constexpr int CW_XB2 = 13312;
__device__ __forceinline__ void xcd_barrier2(const XcdBarrier& b, gu32* ctl) {
    asm volatile("s_waitcnt vmcnt(0)" ::: "memory");
    __syncthreads();
    if (threadIdx.x < 64) {
        unsigned* bar = b.bar; const unsigned lane = threadIdx.x;
        unsigned nloc = 1u, nx = 1u, old = 0u;
        if (lane == 0) {
            __builtin_amdgcn_s_waitcnt(0);
            nloc = b.st[0]; nx = b.st[1];
            if (nloc == 0u) { xcd_barrier_complete(bar, b.x, nloc, nx); b.st[0] = nloc; b.st[1] = nx; }
            old = xb_add(&bar[XB_XSUB(b.x)], 1u);
        }
        nloc = (unsigned)__builtin_amdgcn_readfirstlane((int)nloc); nx = (unsigned)__builtin_amdgcn_readfirstlane((int)nx); old = (unsigned)__builtin_amdgcn_readfirstlane((int)old);
        const unsigned gen = old / nloc;
        if (old + 1u == (gen + 1u) * nloc) {
            __builtin_amdgcn_fence(__ATOMIC_RELEASE, "agent");
            asm volatile("s_waitcnt vmcnt(0)" ::: "memory");
            if (lane < 8u) (void)__hip_atomic_fetch_add(ctl + CW_XB2 + 64 * lane, 1u, RLX_AGENT);
        }
        const unsigned target = (gen + 1u) * nx;
        gu32* mine = ctl + CW_XB2 + 64 * (blockIdx.x & 7u);
        unsigned sp = 0u;
        while ((unsigned)__builtin_amdgcn_readfirstlane((int)__hip_atomic_load(mine, RLX_AGENT)) < target) {
            __builtin_amdgcn_s_sleep(1);
            if ((++sp & 255u) == 0u) { if (xb_ld(&bar[XB_TMO])) break; if (sp > XB_SPIN_CAP) { if (lane == 0) atomicAdd(&bar[XB_TMO], 1u); break; } }
        }
        __builtin_amdgcn_fence(__ATOMIC_ACQUIRE, "agent");
        asm volatile("s_waitcnt vmcnt(0)" ::: "memory");
    }
    __syncthreads();
}

struct Args { const float* in[24]; float* out; unsigned char* ws; int ph_lo, ph_hi; };
__global__ void __launch_bounds__(NWAVES * 64, 2) mega_fwd(Args args) {
    extern __shared__ __attribute__((aligned(16))) unsigned char lds[];
    Frame F;
    F.lds = (LAS unsigned char*)lds;
    F.MISC = (volatile LAS unsigned*)(F.lds + MISC_OFF);
    F.tid = threadIdx.x; F.lane = F.tid & 63; F.wave = __builtin_amdgcn_readfirstlane(F.tid >> 6);
    F.G = gridDim.x; { const int bx = blockIdx.x; F.vcu = (F.G % 8 == 0) ? (bx % 8) * (F.G / 8) + bx / 8 : bx; }
    unsigned char* ws = args.ws;
    F.ctl = (gu32*)(ws + WS_CTL);
    for (int u = F.tid; u < (LDS_BYTES - LDSCTL_OFF) / 4; u += NWAVES * 64) ((LAS unsigned*)(F.lds + LDSCTL_OFF))[u] = 0u;
    __syncthreads();
#if FLAT_BAR
    FlatBar bar{F.ctl, 0u};
#define xcd_barrier(b) flat_barrier(b)
#else
    XcdBarrier bar = xcd_barrier_post((unsigned*)(F.ctl + CW_BAR), F.MISC + 8);
#if XB2
#define xcd_barrier(b) xcd_barrier2(b, F.ctl)
#endif
#endif
    const int lo = args.ph_lo, hi = args.ph_hi;
#ifndef PHMASK
#define PHMASK 0x3ffff
#endif
#define IN(k) (((PHMASK >> (k)) & 1) && lo <= (k) && (k) < hi)
#define SEAM(k) do { if (IN(k) && IN((k) + 1)) xcd_barrier(bar); } while (0)
#ifndef DUPMASK
#define DUPMASK 0
#endif
#define REP(k) _Pragma("unroll") for (int rep_ = 0; rep_ < (((DUPMASK) >> (k)) & 1) + 1; ++rep_)
#define REPBAR() do { if (rep_) xcd_barrier(bar); } while (0)
    const float* const* in = args.in;
    const float* gains = in[1];
    float* hbuf = args.out; void* HB = (void*)(ws + WS_HB);
    bf16* XN = (bf16*)(ws + WS_XN); bf16* MIX = (bf16*)(ws + WS_MIX);
    const int BIG = 1 << 30;
    using pg8::ProbPlain; using pg8::ProbMoE;

    if (IN(0)) REP(0) { REPBAR(); p0_prologue(F, in, ws); } SEAM(0);
#if defined(XTRA_BAR) && XTRA_BAR
    for (int xb_ = 0; xb_ < XTRA_BAR; ++xb_) xcd_barrier(bar);
#endif
    if (IN(1)) REP(1) { REPBAR();
        ProbPlain P{(const char*)XN, (const char*)(ws + WS_BT_IN), 1024, 2048u, 2048u, 0, BIG, {}}; P.S.init(64, 4, F.G, (int)blockIdx.x);
        pg8::EpiU E{(pg8::bf16_t*)(ws + WS_A2)};
        pg8::gemm_phase<ProbPlain, pg8::EpiU, true, true>(F.lds + RING_OFF, P, E);
    } SEAM(1);
    if (IN(2)) REP(2) { REPBAR();
        ProbPlain P{(const char*)(ws + WS_A2), (const char*)(ws + WS_S5_STATE), 256, 1024u, 512u, (size_t)256 * 256 * 2, 4, {}}; P.S.init(256, 1, F.G, (int)blockIdx.x);
        pg8::EpiF32 E{(float*)(ws + WS_S), 256};
        pg8::gemm_phase<ProbPlain, pg8::EpiF32, true, true>(F.lds + RING_OFF, P, E);
    } SEAM(2);
    if (IN(3)) REP(3) { REPBAR(); scan_phase(F, in, ws); } SEAM(3);
    if (IN(4)) REP(4) { REPBAR();
        ProbPlain P{(const char*)(ws + WS_A2), (const char*)(ws + WS_S5_MAIN), 512, 1024u, 1024u, (size_t)256 * 512 * 2, 4, {}}; P.S.init(256, 1, F.G, (int)blockIdx.x);
        pg8::EpiY E{(pg8::bf16_t*)(ws + WS_G1)};
        pg8::gemm_phase<ProbPlain, pg8::EpiY, true, true>(F.lds + RING_OFF, P, E);
    } SEAM(4);
    if (IN(5)) REP(5) { REPBAR();
        ProbPlain P{(const char*)(ws + WS_G1), (const char*)(ws + WS_BT_GLU), 1024, 2048u, 2048u, 0, BIG, {}}; P.S.init(64, 4, F.G, (int)blockIdx.x);
        pg8::EpiGlu E{(const pg8::bf16_t*)(ws + WS_G1), (pg8::bf16_t*)(ws + WS_G2)};
        pg8::gemm_phase<ProbPlain, pg8::EpiGlu, true, true>(F.lds + RING_OFF, P, E);
    } SEAM(5);
    if (IN(6)) REP(6) { REPBAR();
        ProbPlain P{(const char*)(ws + WS_G2), (const char*)(ws + WS_BT_SOUT), 1024, 2048u, 2048u, 0, BIG, {}}; P.S.init(64, 4, F.G, (int)blockIdx.x);
        pg8::EpiBf16 E{MIX, 1024, 1.f};
        pg8::gemm_phase<ProbPlain, pg8::EpiBf16, true, true>(F.lds + RING_OFF, P, E);
    } SEAM(6);
    if (IN(7)) REP(7) { REPBAR(); e_phase<FFN_FP8 != 0, false, true>(F, in[0], MIX, gains + 1 * DM, gains + 2 * DM, HB, XN); } SEAM(7);
    if (IN(8)) REP(8) { REPBAR();
#if FFN_FP8
        ProbPlain P{(const char*)XN, (const char*)(ws + WS_BT_GU), 512, 1024u, 1024u, 0, BIG, {}}; P.S.init(64, 22, F.G, (int)blockIdx.x);
        pg8::EpiSwigluF8 E{(unsigned char*)(ws + WS_ACTF), DFF, 1.f / 256.f, 8.f};
        pg8::gemm_phase<ProbPlain, pg8::EpiSwigluF8, true, true, true>(F.lds + RING_OFF, P, E);
#else
        ProbPlain P{(const char*)XN, (const char*)(ws + WS_BT_GU), 1024, 2048u, 2048u, 0, BIG, {}}; P.S.init(64, 22, F.G, (int)blockIdx.x);
        pg8::EpiSwiglu E{(pg8::bf16_t*)(ws + WS_ACTF), DFF};
        pg8::gemm_phase<ProbPlain, pg8::EpiSwiglu, true, true>(F.lds + RING_OFF, P, E);
#endif
        if (F.G == 256 && blockIdx.x >= 128) convert_range(in, ws, (LAS unsigned*)(F.lds + RING_OFF + F.wave * 16384), F.lane, T_ISMALL + CVT_S1, T_ISMALL + CVT_S2, ((int)blockIdx.x - 128) * NWAVES + F.wave, 128 * NWAVES);
    } SEAM(8);
    if (IN(9)) REP(9) { REPBAR();
#if FFN_FP8
        ProbPlain P{(const char*)(ws + WS_ACTF), (const char*)(ws + WS_BT_FD), DFF / 2, (unsigned)DFF, (unsigned)DFF, 0, BIG, {}}; P.S.init(64, 4, F.G, (int)blockIdx.x);
        pg8::EpiBf16 E{MIX, 1024, 1.f / 512.f};
        pg8::gemm_phase<ProbPlain, pg8::EpiBf16, true, true, true>(F.lds + RING_OFF, P, E);
#else
        ProbPlain P{(const char*)(ws + WS_ACTF), (const char*)(ws + WS_BT_FD), DFF, (unsigned)DFF * 2u, (unsigned)DFF * 2u, 0, BIG, {}}; P.S.init(64, 4, F.G, (int)blockIdx.x);
        pg8::EpiBf16 E{MIX, 1024, 1.f};
        pg8::gemm_phase<ProbPlain, pg8::EpiBf16, true, true>(F.lds + RING_OFF, P, E);
#endif
    } SEAM(9);
    if (IN(10)) REP(10) { REPBAR(); e_phase<false, true, true>(F, HB, MIX, gains + 3 * DM, gains + 4 * DM, HB, XN); } SEAM(10);
    if (IN(11)) REP(11) { REPBAR();
        ProbPlain P{(const char*)XN, (const char*)(ws + WS_BT_QKV), 1024, 2048u, 2048u, 0, BIG, {}}; P.S.init(64, 6, F.G, (int)blockIdx.x);
        pg8::EpiQKV E{(pg8::bf16_t*)(ws + WS_Q), (unsigned)((WS_K - WS_Q) / 2), (unsigned)((WS_V - WS_Q) / 2), (const float*)(ws + WS_QKG), (const float4*)(ws + WS_ROPE_R), QSCALE};
        pg8::gemm_phase<ProbPlain, pg8::EpiQKV, true, true>(F.lds + RING_OFF, P, E);
        if (F.G == 256 && blockIdx.x >= 128) convert_range(in, ws, (LAS unsigned*)(F.lds + RING_OFF + F.wave * 16384), F.lane, T_ISMALL + CVT_S2, T_NITEMS, ((int)blockIdx.x - 128) * NWAVES + F.wave, 128 * NWAVES);
    } SEAM(11);
    if (IN(12)) REP(12) { REPBAR();
        static_assert(attn_body::ATTN_LDS_BYTES <= RING_BYTES, "attention body LDS");
        const attn_body::AttnTensors AT{(const attn_body::bf16*)(ws + WS_Q), (const attn_body::bf16*)(ws + WS_K), (const attn_body::bf16*)(ws + WS_V), (attn_body::bf16*)(ws + WS_O)};
        const attn_body::StaticOrder S((int)F.G, (int)blockIdx.x);
        float gq = fabsf(((const float*)(ws + WS_QKG))[F.lane]), gk = fabsf(((const float*)(ws + WS_QKG))[64 + F.lane]);
#pragma unroll
        for (int o = 1; o < 64; o <<= 1) { gq = fmaxf(gq, __shfl_xor(gq, o)); gk = fmaxf(gk, __shfl_xor(gk, o)); }
        const float refB = 11.55f * 1.02f * gq * gk;
        if (__builtin_amdgcn_readfirstlane(__float_as_uint(refB)) <= __float_as_uint(60.f)) attn_body::attn_phase<attn_body::StaticOrder, true>((char*)lds + RING_OFF, AT, S, refB);
        else attn_body::attn_phase<attn_body::StaticOrder, false>((char*)lds + RING_OFF, AT, S, 0.f);
    } SEAM(12);
    if (IN(13)) REP(13) { REPBAR();
        ProbPlain P{(const char*)(ws + WS_O), (const char*)(ws + WS_BT_AO), 1024, 2048u, 2048u, 0, BIG, {}}; P.S.init(64, 4, F.G, (int)blockIdx.x);
        pg8::EpiBf16 E{MIX, 1024, 1.f};
        pg8::gemm_phase<ProbPlain, pg8::EpiBf16, true, true>(F.lds + RING_OFF, P, E);
    } SEAM(13);
    if (IN(14)) REP(14) { REPBAR(); e3_phase(F, HB, MIX, gains + 5 * DM, gains + 6 * DM, HB, XN, in[20], ws); } SEAM(14);
    if (IN(15)) REP(15) { REPBAR();
        moe_table(F);
        volatile LAS int* misc = (volatile LAS int*)(F.lds + MOE_OFF);
#if MOE_FP8
        ProbMoE P{(const char*)XN, (const char*)(ws + WS_BT_MGU), 512, 1024u, 1024u, (size_t)7168 * 1024, {}, (const int*)(ws + WS_LIST), misc, true}; P.S.init(misc[8], 28, F.G, (int)blockIdx.x, MOE_WGM);
        pg8::EpiSwigluF8 E{(unsigned char*)(ws + WS_ACTM), DFE, 1.f / 256.f, 8.f};
        pg8::gemm_phase<ProbMoE, pg8::EpiSwigluF8, P15_ALIGN, P15_SP2, true>(F.lds + RING_OFF, P, E);
#else
        ProbMoE P{(const char*)XN, (const char*)(ws + WS_BT_MGU), 1024, 2048u, 2048u, (size_t)7168 * 1024 * 2, {}, (const int*)(ws + WS_LIST), misc, true}; P.S.init(misc[8], 28, F.G, (int)blockIdx.x);
        pg8::EpiSwiglu E{(pg8::bf16_t*)(ws + WS_ACTM), DFE};
        pg8::gemm_phase<ProbMoE, pg8::EpiSwiglu, true, true>(F.lds + RING_OFF, P, E);
#endif
    } SEAM(15);
    if (IN(16)) REP(16) { REPBAR();
        moe_table(F);
        volatile LAS int* misc = (volatile LAS int*)(F.lds + MOE_OFF);
#if MOE_FP8
        ProbMoE P{(const char*)(ws + WS_ACTM), (const char*)(ws + WS_BT_MD), DFE / 2, (unsigned)DFE, (unsigned)DFE, (size_t)1024 * 3584, {}, (const int*)(ws + WS_LIST), misc, false}; P.S.init(misc[8], 4, F.G, (int)blockIdx.x);
        pg8::EpiMoeDown E{(pg8::bf16_t*)(ws + WS_SLOT), (pg8::bf16_t*)(ws + WS_PART), 1.f / 512.f};
        pg8::gemm_phase<ProbMoE, pg8::EpiMoeDown, true, true, true>(F.lds + RING_OFF, P, E);
#else
        ProbMoE P{(const char*)(ws + WS_ACTM), (const char*)(ws + WS_BT_MD), DFE, (unsigned)DFE * 2u, (unsigned)DFE * 2u, (size_t)1024 * 3584 * 2, {}, (const int*)(ws + WS_LIST), misc, false}; P.S.init(misc[8], 4, F.G, (int)blockIdx.x);
        pg8::EpiMoeDown E{(pg8::bf16_t*)(ws + WS_SLOT), (pg8::bf16_t*)(ws + WS_PART), 1.f};
        pg8::gemm_phase<ProbMoE, pg8::EpiMoeDown, true, true>(F.lds + RING_OFF, P, E);
#endif
    } SEAM(16);
    if (IN(17)) REP(17) { REPBAR(); moe_table(F); e4_phase(F, HB, gains + 7 * DM, hbuf, ws); }
#undef IN
#undef SEAM
#if FLAT_BAR || XB2
#undef xcd_barrier
#endif
}


#ifndef CUT
#define CUT 0
#endif
#if CUT
namespace nv {
__device__ __forceinline__ float sigmoidf_(float x) { return 1.f / (1.f + __expf(-x)); }
__device__ __forceinline__ float gelu_tanh(float x) { return x * sigmoidf_(1.5957691216057308f * (x + 0.044715f * x * x * x)); }

__global__ void rms_k(const float* __restrict__ x, const float* __restrict__ gain, float* __restrict__ out) {
    const int row = blockIdx.x * 4 + (threadIdx.x >> 6), lane = threadIdx.x & 63;
    const float4* xr = (const float4*)(x + (size_t)row * DM);
    float4 v[4]; float s = 0.f;
#pragma unroll
    for (int j = 0; j < 4; ++j) { v[j] = xr[lane + 64 * j]; s += v[j].x * v[j].x + v[j].y * v[j].y + v[j].z * v[j].z + v[j].w * v[j].w; }
    const float r = rsqrtf(wave_sum(s) * (1.f / DM) + EPS);
    float4* o = (float4*)(out + (size_t)row * DM);
#pragma unroll
    for (int j = 0; j < 4; ++j) { const float4 g = ((const float4*)gain)[lane + 64 * j]; o[lane + 64 * j] = make_float4(v[j].x * r * g.x, v[j].y * r * g.y, v[j].z * r * g.z, v[j].w * r * g.w); }
}
__global__ void resnorm_k(const float* h, const float* __restrict__ mix, const float* __restrict__ gpost, const float* __restrict__ gpre, float* hout, float* __restrict__ xn) {
    const int row = blockIdx.x * 4 + (threadIdx.x >> 6), lane = threadIdx.x & 63;
    const float4* mr = (const float4*)(mix + (size_t)row * DM); const float4* hr = (const float4*)(h + (size_t)row * DM);
    float4 v[4], hv[4]; float s = 0.f;
#pragma unroll
    for (int j = 0; j < 4; ++j) { v[j] = mr[lane + 64 * j]; hv[j] = hr[lane + 64 * j]; s += v[j].x * v[j].x + v[j].y * v[j].y + v[j].z * v[j].z + v[j].w * v[j].w; }
    const float r = rsqrtf(wave_sum(s) * (1.f / DM) + EPS);
    float s2 = 0.f;
#pragma unroll
    for (int j = 0; j < 4; ++j) { const float4 g = ((const float4*)gpost)[lane + 64 * j];
        hv[j].x += v[j].x * r * g.x; hv[j].y += v[j].y * r * g.y; hv[j].z += v[j].z * r * g.z; hv[j].w += v[j].w * r * g.w;
        s2 += hv[j].x * hv[j].x + hv[j].y * hv[j].y + hv[j].z * hv[j].z + hv[j].w * hv[j].w; }
    float4* ho = (float4*)(hout + (size_t)row * DM);
#pragma unroll
    for (int j = 0; j < 4; ++j) ho[lane + 64 * j] = hv[j];
    if (xn) {
        const float r2 = rsqrtf(wave_sum(s2) * (1.f / DM) + EPS);
        float4* o = (float4*)(xn + (size_t)row * DM);
#pragma unroll
        for (int j = 0; j < 4; ++j) { const float4 g = ((const float4*)gpre)[lane + 64 * j]; o[lane + 64 * j] = make_float4(hv[j].x * r2 * g.x, hv[j].y * r2 * g.y, hv[j].z * r2 * g.z, hv[j].w * r2 * g.w); }
    }
}

struct EpiArgs { float* C; int ldc; int pad0; const float* aux; int ldaux; int pad1; const int* list; const float* wl; const int* cnt;
  EpiArgs(float* C_, int ldc_, const float* aux_, int ldaux_, const int* l, const float* w, const int* c) : C(C_), ldc(ldc_), pad0(0), aux(aux_), ldaux(ldaux_), pad1(0), list(l), wl(w), cnt(c) {} };
template <int EPI, bool GATHER>
__global__ __launch_bounds__(256) void gemm_k(const float* __restrict__ A, int lda, const float* __restrict__ W, int ldw, int M, int N, int K, EpiArgs ea) {
    __shared__ float As[8][132]; __shared__ float Bs[8][132];
    const int m_lim = ea.cnt ? *ea.cnt : M;
    const int bm = blockIdx.y * 128, bn = blockIdx.x * 128;
    if (bm >= m_lim) return;
    const int tid = threadIdx.x, tx = tid & 15, ty = tid >> 4;
    const int arow = bm + (tid >> 1);
    const int srow = (arow < m_lim) ? (GATHER ? ea.list[arow] : arow) : (GATHER ? ea.list[0] : 0);
    const float* ap = A + (size_t)srow * lda + (tid & 1) * 4;
    const float* bp = W + (size_t)(tid >> 5) * ldw + bn + (tid & 31) * 4;
    float acc[8][8];
#pragma unroll
    for (int i = 0; i < 8; ++i)
#pragma unroll
        for (int j = 0; j < 8; ++j) acc[i][j] = 0.f;
    for (int k0 = 0; k0 < K; k0 += 8) {
        const float4 av = *(const float4*)(ap + k0);
        const float4 bv = *(const float4*)(bp + (size_t)k0 * ldw);
        __syncthreads();
        As[(tid & 1) * 4 + 0][tid >> 1] = av.x; As[(tid & 1) * 4 + 1][tid >> 1] = av.y; As[(tid & 1) * 4 + 2][tid >> 1] = av.z; As[(tid & 1) * 4 + 3][tid >> 1] = av.w;
        *(float4*)&Bs[tid >> 5][(tid & 31) * 4] = bv;
        __syncthreads();
#pragma unroll
        for (int k = 0; k < 8; ++k) {
            float a[8], b[8];
            *(float4*)&a[0] = *(const float4*)&As[k][ty * 8]; *(float4*)&a[4] = *(const float4*)&As[k][ty * 8 + 4];
            *(float4*)&b[0] = *(const float4*)&Bs[k][tx * 8]; *(float4*)&b[4] = *(const float4*)&Bs[k][tx * 8 + 4];
#pragma unroll
            for (int i = 0; i < 8; ++i)
#pragma unroll
                for (int j = 0; j < 8; ++j) acc[i][j] = fmaf(a[i], b[j], acc[i][j]);
        }
    }
#pragma unroll
    for (int i = 0; i < 8; ++i) {
        const int row = bm + ty * 8 + i;
        if (row >= m_lim) continue;
        int tok = 0; float wgt = 0.f;
        if (EPI == 3) { tok = ea.list[row]; wgt = ea.wl[row]; }
#pragma unroll
        for (int j = 0; j < 8; ++j) {
            const int col = bn + tx * 8 + j; const float v = acc[i][j];
            if (EPI == 0) ea.C[(size_t)row * ea.ldc + col] = v;
            else if (EPI == 1) ea.C[(size_t)row * ea.ldc + col] = ea.aux[(size_t)row * ea.ldaux + col] * sigmoidf_(v);
            else if (EPI == 2) { const float g = ea.aux[(size_t)row * ea.ldaux + col]; ea.C[(size_t)row * ea.ldc + col] = g * sigmoidf_(g) * v; }
            else if (EPI == 3) ea.C[(size_t)tok * ea.ldc + col] += wgt * v;
        }
    }
}

__global__ __launch_bounds__(64) void s5_scan_k(const float* __restrict__ u, const float* __restrict__ lam_re, const float* __restrict__ lam_im, const float* __restrict__ log_step,
                                                const float* __restrict__ b_re, const float* __restrict__ b_im, const float* __restrict__ c_re, const float* __restrict__ c_im, float* __restrict__ yout) {
    __shared__ float us[64][16];
    const int dir = blockIdx.x & 1, g = (blockIdx.x >> 1) & 63, b = blockIdx.x >> 7, p = threadIdx.x;
    const double step = exp((double)log_step[dir * 64 + g]);
    const double lr = lam_re[(dir * 64 + g) * 64 + p], li = lam_im[(dir * 64 + g) * 64 + p];
    const double mag = exp(lr * step), ang = li * step;
    const double ard = mag * cos(ang), aid = mag * sin(ang);
    const double nr = ard - 1.0, ni = aid, den = lr * lr + li * li;
    const double qr = (nr * lr + ni * li) / den, qi = (ni * lr - nr * li) / den;
    const float ar = (float)ard, ai = (float)aid;
    float bbr[16], bbi[16], cr[16], ci[16];
#pragma unroll
    for (int i = 0; i < 16; ++i) {
        const double br = b_re[((dir * 64 + g) * 64 + p) * 16 + i], bi = b_im[((dir * 64 + g) * 64 + p) * 16 + i];
        bbr[i] = (float)(qr * br - qi * bi); bbi[i] = (float)(qr * bi + qi * br);
        cr[i] = c_re[((dir * 64 + g) * 16 + i) * 64 + p]; ci[i] = c_im[((dir * 64 + g) * 16 + i) * 64 + p];
    }
    float xr = 0.f, xi = 0.f;
    float* yo = yout + (size_t)dir * NTOK * DM;
    for (int c = 0; c < SEQ / 64; ++c) {
        { const int s = p; const int st = c * 64 + s; const int t = dir == 0 ? st : SEQ - 1 - st;
          const float4* src = (const float4*)(u + (size_t)(b * SEQ + t) * DM + g * 16);
          __syncthreads();
#pragma unroll
          for (int q = 0; q < 4; ++q) *(float4*)&us[s][q * 4] = src[q];
          __syncthreads(); }
        for (int s = 0; s < 64; ++s) {
            const int st = c * 64 + s; const int t = dir == 0 ? st : SEQ - 1 - st;
            float bur = 0.f, bui = 0.f;
#pragma unroll
            for (int i = 0; i < 16; ++i) { const float uu = us[s][i]; bur = fmaf(bbr[i], uu, bur); bui = fmaf(bbi[i], uu, bui); }
            const float nxr = ar * xr - ai * xi + bur, nxi = ar * xi + ai * xr + bui;
            xr = nxr; xi = nxi;
            float mine = 0.f;
#pragma unroll
            for (int j = 0; j < 16; ++j) { const float v = wave_sum(cr[j] * xr - ci[j] * xi); if (p == j) mine = v; }
            if (p < 16) yo[(size_t)(b * SEQ + t) * DM + g * 16 + p] = mine;
        }
    }
}
__global__ void gelu_comb_k(const float* __restrict__ u, const float* __restrict__ dskip, const float* __restrict__ y2, float* __restrict__ g1) {
    const size_t i = (size_t)blockIdx.x * 256 + threadIdx.x;
    const int c = (int)(i & (DM - 1));
    const float y = dskip[c] * u[i] + y2[i] + y2[i + (size_t)NTOK * DM];
    g1[i] = gelu_tanh(y);
}

__global__ void qknorm_rope_k(float* __restrict__ qkv, const float* __restrict__ qg, const float* __restrict__ kg) {
    const int w = blockIdx.x * 4 + (threadIdx.x >> 6), d = threadIdx.x & 63;
    const int tok = w / 20, hs = w % 20;
    float* p = qkv + (size_t)tok * QKVW + hs * 64;
    const float v = p[d];
    const float r = rsqrtf(wave_sum(v * v) * (1.f / 64.f) + EPS);
    const float y = v * r * (hs < 16 ? qg[d] : kg[d]);
    const float partner = __shfl_xor(y, 1);
    const int pos = tok % SEQ, i = d >> 1;
    const int f = i & 15;
    const float freq = powf(10000.f, -(float)(2 * f) / 32.f);
    const float ang = (float)(i < 16 ? pos / 64 : pos % 64) * freq;
    const float c = cosf(ang), s = sinf(ang);
    const float o = (d & 1) ? (partner * s + y * c) : (y * c - partner * s);
    p[d] = o;
}

__global__ __launch_bounds__(256) void attn_k(const float* __restrict__ qkv, float* __restrict__ o) {
    __shared__ float Qs[64][65], Ks[64][65], Vs[64][65];
    float (*Ps)[65] = Ks;
    const int qb = blockIdx.x, h = blockIdx.y, b = blockIdx.z, kvh = h >> 2;
    const int tid = threadIdx.x, tx = tid & 15, ty = tid >> 4;
    const size_t rowbase = (size_t)b * SEQ;
    for (int e = tid; e < 64 * 64; e += 256) { const int r = e >> 6, d = e & 63; Qs[r][d] = qkv[(rowbase + qb * 64 + r) * QKVW + h * 64 + d] * 0.125f; }
    float m[4], l[4], oacc[4][4];
#pragma unroll
    for (int i = 0; i < 4; ++i) { m[i] = -INFINITY; l[i] = 0.f;
#pragma unroll
        for (int j = 0; j < 4; ++j) oacc[i][j] = 0.f; }
    for (int kt = 0; kt < SEQ / 64; ++kt) {
        __syncthreads();
        for (int e = tid; e < 64 * 64; e += 256) { const int r = e >> 6, d = e & 63; const size_t rr = (rowbase + kt * 64 + r) * QKVW;
            Ks[r][d] = qkv[rr + 1024 + kvh * 64 + d]; Vs[r][d] = qkv[rr + 1280 + kvh * 64 + d]; }
        __syncthreads();
        float s[4][4];
#pragma unroll
        for (int i = 0; i < 4; ++i)
#pragma unroll
            for (int j = 0; j < 4; ++j) s[i][j] = 0.f;
        for (int d = 0; d < 64; ++d) {
            float a[4], k[4];
#pragma unroll
            for (int i = 0; i < 4; ++i) { a[i] = Qs[ty * 4 + i][d]; k[i] = Ks[tx * 4 + i][d]; }
#pragma unroll
            for (int i = 0; i < 4; ++i)
#pragma unroll
                for (int j = 0; j < 4; ++j) s[i][j] = fmaf(a[i], k[j], s[i][j]);
        }
        __syncthreads();
#pragma unroll
        for (int i = 0; i < 4; ++i) {
            float mx = fmaxf(fmaxf(s[i][0], s[i][1]), fmaxf(s[i][2], s[i][3]));
#pragma unroll
            for (int of = 1; of < 16; of <<= 1) mx = fmaxf(mx, __shfl_xor(mx, of));
            const float mn = fmaxf(m[i], mx);
            const float sc = __expf(m[i] - mn);
            float ps = 0.f;
#pragma unroll
            for (int j = 0; j < 4; ++j) { const float pp = __expf(s[i][j] - mn); Ps[ty * 4 + i][tx * 4 + j] = pp; ps += pp; }
#pragma unroll
            for (int of = 1; of < 16; of <<= 1) ps += __shfl_xor(ps, of);
            l[i] = l[i] * sc + ps; m[i] = mn;
#pragma unroll
            for (int j = 0; j < 4; ++j) oacc[i][j] *= sc;
        }
        __syncthreads();
        for (int k = 0; k < 64; ++k) {
            float pp[4], vv[4];
#pragma unroll
            for (int i = 0; i < 4; ++i) { pp[i] = Ps[ty * 4 + i][k]; vv[i] = Vs[k][tx * 4 + i]; }
#pragma unroll
            for (int i = 0; i < 4; ++i)
#pragma unroll
                for (int j = 0; j < 4; ++j) oacc[i][j] = fmaf(pp[i], vv[j], oacc[i][j]);
        }
    }
#pragma unroll
    for (int i = 0; i < 4; ++i) { const float inv = 1.f / l[i];
#pragma unroll
        for (int j = 0; j < 4; ++j) o[(rowbase + qb * 64 + ty * 4 + i) * DM + h * 64 + tx * 4 + j] = oacc[i][j] * inv; }
}

__global__ void router_k(const float* __restrict__ xn, const float* __restrict__ wr, int* __restrict__ cnt, int* __restrict__ lists, float* __restrict__ wlists) {
    const int tok = blockIdx.x * 4 + (threadIdx.x >> 6), lane = threadIdx.x & 63;
    float lg[8];
#pragma unroll
    for (int e = 0; e < 8; ++e) lg[e] = 0.f;
    for (int j = 0; j < 16; ++j) { const int d = lane + 64 * j; const float x = xn[(size_t)tok * DM + d];
        const float4 w0 = *(const float4*)(wr + d * 8), w1 = *(const float4*)(wr + d * 8 + 4);
        lg[0] = fmaf(x, w0.x, lg[0]); lg[1] = fmaf(x, w0.y, lg[1]); lg[2] = fmaf(x, w0.z, lg[2]); lg[3] = fmaf(x, w0.w, lg[3]);
        lg[4] = fmaf(x, w1.x, lg[4]); lg[5] = fmaf(x, w1.y, lg[5]); lg[6] = fmaf(x, w1.z, lg[6]); lg[7] = fmaf(x, w1.w, lg[7]); }
#pragma unroll
    for (int e = 0; e < 8; ++e) lg[e] = wave_sum(lg[e]);
    int e0 = 0; float l0 = lg[0];
#pragma unroll
    for (int e = 1; e < 8; ++e) if (lg[e] > l0) { l0 = lg[e]; e0 = e; }
    int e1 = -1; float l1 = -INFINITY;
#pragma unroll
    for (int e = 0; e < 8; ++e) if (e != e0 && lg[e] > l1) { l1 = lg[e]; e1 = e; }
    const float w0 = 1.f / (1.f + expf(l1 - l0)), w1 = 1.f - w0;
    if (lane == 0) {
        const int p0 = atomicAdd(&cnt[e0], 1); lists[e0 * NTOK + p0] = tok; wlists[e0 * NTOK + p0] = w0;
        const int p1 = atomicAdd(&cnt[e1], 1); lists[e1 * NTOK + p1] = tok; wlists[e1 * NTOK + p1] = w1;
    }
}


__global__ void cvt_k(const unsigned short* __restrict__ s, float* __restrict__ d) { const size_t i = (size_t)blockIdx.x * 256 + threadIdx.x; d[i] = __uint_as_float((unsigned)s[i] << 16); }
template <int EPI, bool GATHER>
static void gemm(hipStream_t st, const float* A, int lda, const float* W, int ldw, int M, int N, int K, EpiArgs ea) {
    hipLaunchKernelGGL((gemm_k<EPI, GATHER>), dim3(N / 128, M / 128), dim3(256), 0, st, A, lda, W, ldw, M, N, K, ea);
}
}
#endif
extern "C" void kernel_launch(void* const* d_in, const int* in_sizes, int n_in, void* d_out, int out_size, void* d_ws, size_t ws_size, hipStream_t stream) {
    static int grid = 0;
    if (grid == 0) {
        grid = -1;
        if (n_in != 24 || in_sizes[0] != NTOK * DM || out_size != NTOK * DM || ws_size < WS_END) { fprintf(stderr, "kernel_launch: unexpected problem (n_in %d, ws %zu)\n", n_in, ws_size); return; }
        int dev = 0, cus = 0;
        if (hipGetDevice(&dev) != hipSuccess || hipDeviceGetAttribute(&cus, hipDeviceAttributeMultiprocessorCount, dev) != hipSuccess) return;
        if (hipFuncSetAttribute((const void*)mega_fwd, hipFuncAttributeMaxDynamicSharedMemorySize, LDS_BYTES) != hipSuccess) return;
        int per_cu = 0;
        if (hipOccupancyMaxActiveBlocksPerMultiprocessor(&per_cu, (const void*)mega_fwd, NWAVES * 64, LDS_BYTES) != hipSuccess || per_cu < 1) { fprintf(stderr, "kernel_launch: occupancy query says %d\n", per_cu); (void)hipGetLastError(); return; }
        if (cus != 256) { fprintf(stderr, "kernel_launch: built for 256 CUs, found %d\n", cus); return; }
        grid = cus;
    }
    if (grid < 0) return;
    if (hipMemsetAsync((char*)d_ws + WS_CTL, 0, CTL_ZERO_BYTES, stream) != hipSuccess) return;
    Args a{};
    for (int i = 0; i < 24; ++i) a.in[i] = (const float*)d_in[i];
    a.out = (float*)d_out; a.ws = (unsigned char*)d_ws; a.ph_lo = 0; a.ph_hi = CUT ? CUT : 18;
    hipLaunchKernelGGL(mega_fwd, dim3(grid), dim3(NWAVES * 64), LDS_BYTES, stream, a);
#if CUT
    {
        using namespace nv;
        const float* gains = (const float*)d_in[1];
        const float* ffn_g = (const float*)d_in[13]; const float* ffn_u = (const float*)d_in[14]; const float* ffn_d = (const float*)d_in[15];
        const float* w_qkv = (const float*)d_in[16]; const float* q_gain = (const float*)d_in[17]; const float* k_gain = (const float*)d_in[18]; const float* attn_wo = (const float*)d_in[19];
        const float* w_router = (const float*)d_in[20]; const float* moe_g = (const float*)d_in[21]; const float* moe_u = (const float*)d_in[22]; const float* moe_d = (const float*)d_in[23];
        float* h = (float*)d_out; char* ws = (char*)d_ws;
        float* xn = (float*)(ws + 4 * MiB); float* mix = (float*)(ws + 68 * MiB);
        hipLaunchKernelGGL(cvt_k, dim3(NTOK * DM / 256), dim3(256), 0, stream, (const unsigned short*)(ws + WS_XN), xn);
        if (CUT <= 8) {
            float* G = (float*)(ws + 132 * MiB);
            gemm<0, false>(stream, xn, DM, ffn_g, DFF, NTOK, DFF, DM, EpiArgs{G, DFF, nullptr, 0, nullptr, nullptr, nullptr});
            gemm<2, false>(stream, xn, DM, ffn_u, DFF, NTOK, DFF, DM, EpiArgs{G, DFF, G, DFF, nullptr, nullptr, nullptr});
            gemm<0, false>(stream, G, DFF, ffn_d, DM, NTOK, DM, DFF, EpiArgs{mix, DM, nullptr, 0, nullptr, nullptr, nullptr});
            hipLaunchKernelGGL(resnorm_k, dim3(NTOK / 4), dim3(256), 0, stream, h, mix, gains + 3 * DM, gains + 4 * DM, h, xn);
        }
        if (CUT <= 11) {
            float* qkv = (float*)(ws + 132 * MiB); float* ob = (float*)(ws + 228 * MiB);
            gemm<0, false>(stream, xn, DM, w_qkv, QKVW, NTOK, QKVW, DM, EpiArgs{qkv, QKVW, nullptr, 0, nullptr, nullptr, nullptr});
            hipLaunchKernelGGL(qknorm_rope_k, dim3(NTOK * 20 / 4), dim3(256), 0, stream, qkv, q_gain, k_gain);
            hipLaunchKernelGGL(attn_k, dim3(SEQ / 64, 16, NB), dim3(256), 0, stream, qkv, ob);
            gemm<0, false>(stream, ob, DM, attn_wo, DM, NTOK, DM, DM, EpiArgs{mix, DM, nullptr, 0, nullptr, nullptr, nullptr});
            hipLaunchKernelGGL(resnorm_k, dim3(NTOK / 4), dim3(256), 0, stream, h, mix, gains + 5 * DM, gains + 6 * DM, h, xn);
        }
        {
            float* Ge = (float*)(ws + 132 * MiB); float* ff = (float*)(ws + 356 * MiB);
            int* cnt = (int*)(ws + 420 * MiB); int* lists = (int*)(ws + 421 * MiB); float* wlists = (float*)(ws + 422 * MiB);
            (void)hipMemsetAsync(cnt, 0, 64, stream);
            (void)hipMemsetAsync(ff, 0, (size_t)NTOK * DM * 4, stream);
            hipLaunchKernelGGL(router_k, dim3(NTOK / 4), dim3(256), 0, stream, xn, w_router, cnt, lists, wlists);
            for (int e = 0; e < NEXP; ++e) {
                const int* le = lists + e * NTOK; const float* we = wlists + e * NTOK;
                gemm<0, true>(stream, xn, DM, moe_g + (size_t)e * DM * DFE, DFE, NTOK, DFE, DM, EpiArgs{Ge, DFE, nullptr, 0, le, we, cnt + e});
                gemm<2, true>(stream, xn, DM, moe_u + (size_t)e * DM * DFE, DFE, NTOK, DFE, DM, EpiArgs{Ge, DFE, Ge, DFE, le, we, cnt + e});
                gemm<3, false>(stream, Ge, DFE, moe_d + (size_t)e * DFE * DM, DM, NTOK, DM, DFE, EpiArgs{ff, DM, nullptr, 0, le, we, cnt + e});
            }
            hipLaunchKernelGGL(resnorm_k, dim3(NTOK / 4), dim3(256), 0, stream, h, ff, gains + 7 * DM, gains + 7 * DM, h, (float*)nullptr);
        }
    }
#endif
}
```

```cpp
#include <hip/hip_runtime.h>
#include <hip/hip_bf16.h>
#include <cstdio>
#include <cstdint>
#include <cmath>
#define CUT 0
#define DUPMASK 0
#define P0DUP 0
#define EXP_GATHER 0
#define MOE_WGM 4
#define NORM_FACTOR 1
namespace pg8 {
#define PG8_LAS __attribute__((address_space(3)))
typedef unsigned short bf16_t;
typedef short bf16x8 __attribute__((ext_vector_type(8)));
typedef float f32x4 __attribute__((ext_vector_type(4)));
typedef unsigned u32x4 __attribute__((ext_vector_type(4)));
typedef unsigned u32x2 __attribute__((ext_vector_type(2)));
typedef int v8i32 __attribute__((ext_vector_type(8)));
constexpr int BM = 256, BK = 64, HALF = 128, HTB = HALF * BK * 2  , STAGE_BYTES = 8 * HTB, NXCD = 8, WGM = 8;

__host__ __device__ __forceinline__ int lds_byte(int r, int c) { const int st = (r >> 4) * 2 + (c >> 5), rr = r & 15, cc = c & 31, ob = rr * 64 + cc * 2; return st * 1024 + (ob ^ (((ob >> 9) & 1) << 5)); }
__host__ __device__ __forceinline__ void stage_rc(int b, int& R, int& C) { const int st = b / 1024, sb = b % 1024, swz = sb ^ (((sb >> 9) & 1) << 5); R = (st >> 1) * 16 + swz / 64; C = (st & 1) * 32 + (swz % 64) / 2; }
__host__ __device__ __forceinline__ int perm32(int rho) { const int n = rho >> 4, i = rho & 15; return 8 * (i >> 2) + 4 * n + (i & 3); }

struct Unit { int pm, pn, kofs, nt, aux; };

struct StaticOrder {
    int nM, nN, nwg, G, c, wgm;
    __host__ __device__ void init(int nM_, int nN_, int G_, int c_, int wgm_ = WGM) { nM = nM_; nN = nN_; nwg = nM * nN; G = G_; c = c_; wgm = wgm_; }
    __host__ __device__ bool next(int i, Unit& u) const {
        const long L = (long)i * G + c; if (L >= nwg) return false;
        int wgid = (int)L; { const int q = nwg / NXCD, r = nwg % NXCD, xcd = wgid % NXCD, off = wgid / NXCD; wgid = (xcd < r ? xcd * (q + 1) : r * (q + 1) + (xcd - r) * q) + off; }
        const int nig = wgm * nN, gid = wgid / nig, fm = gid * wgm, gsz = (nM - fm) < wgm ? (nM - fm) : wgm;
        u.pm = fm + ((wgid % nig) % gsz); u.pn = (wgid % nig) / gsz; return true;
    }
};

__device__ __forceinline__ unsigned cvt_pk_bf16(float lo, float hi) { unsigned r; asm volatile("v_cvt_pk_bf16_f32 %0, %1, %2" : "=v"(r) : "v"(lo), "v"(hi)); return r; }
__device__ __forceinline__ float bf_lo(unsigned w) { return __uint_as_float(w << 16); }
__device__ __forceinline__ float bf_hi(unsigned w) { return __uint_as_float(w & 0xffff0000u); }
__device__ __forceinline__ float sigm(float x) { return __builtin_amdgcn_rcpf(1.f + __builtin_amdgcn_exp2f(-1.4426950408889634f * x)); }
__device__ __forceinline__ float gelu_t(float x) { return x * sigm(1.5957691216057308f * (x + 0.044715f * x * x * x)); }
#ifndef WT_STORES
#define WT_STORES 0
#endif
__device__ __forceinline__ void st16(void* p, const u32x4& v) {
#if WT_STORES
    asm volatile("global_store_dwordx4 %0, %1, off sc1\n\ts_nop 1" :: "v"(p), "v"(v) : "memory");
#else
    *(u32x4*)p = v;
#endif
}
__device__ __forceinline__ u32x4 pack8(const f32x4& a, const f32x4& b) { u32x4 w; w.x = cvt_pk_bf16(a[0], a[1]); w.y = cvt_pk_bf16(a[2], a[3]); w.z = cvt_pk_bf16(b[0], b[1]); w.w = cvt_pk_bf16(b[2], b[3]); return w; }

struct ProbPlain {
    const char* abase; const char* Bt; int K; unsigned ldaB, ldbB; size_t bstride; int pm_per_b; StaticOrder S;
    __device__ __forceinline__ bool next(int i, Unit& u) const { u.kofs = 0; u.nt = K / BK; u.aux = 0; return S.next(i, u); }
    __device__ __forceinline__ const char* bbase(const Unit& u) const { return Bt + (size_t)(u.pm / pm_per_b) * bstride + (size_t)u.pn * 256 * ldbB; }
    __device__ __forceinline__ void aoffs(const Unit& u, const int (&R)[2], unsigned (&off)[2][2]) const {
#pragma unroll
        for (int h = 0; h < 2; ++h)
#pragma unroll
            for (int i = 0; i < 2; ++i) off[h][i] = (unsigned)(u.pm * 256 + h * 128 + R[i]) * ldaB;
    }
};
struct ProbMoE {
    const char* abase; const char* Bt; int K; unsigned ldaB, ldbB; size_t bstride; StaticOrder S;
    const int* lists; volatile PG8_LAS int* misc; bool gather;
    __device__ __forceinline__ bool next(int i, Unit& u) const {
        if (gather) { u.kofs = 0; u.nt = K / BK; u.aux = 0; return S.next(i, u); }
        const int c = S.c, x = c & 7, y = c >> 3, first_rem = misc[10];
        const int pm = 64 * i + 8 * x + (y & 7);
        if (pm < first_rem) { u.pm = pm; u.pn = y >> 3; u.kofs = 0; u.nt = K / BK; u.aux = 0; return true; }
        if (64 * i != first_rem || c >= misc[11]) return false;
        const int parts = misc[9], j = c / parts, part = c - j * parts, ntp = (K / BK) / parts;
        u.pm = first_rem + (j >> 2); u.pn = j & 3; u.nt = ntp; u.kofs = part * ntp * BK * 2; u.aux = c + 1; return true;
    }
    __device__ __forceinline__ int expert(int pm) const { int e = 0;
#pragma unroll
        for (int j = 1; j < 8; ++j) e += (pm >= misc[j]) ? 1 : 0;
        return e; }
    __device__ __forceinline__ const char* bbase(const Unit& u) const { return Bt + (size_t)__builtin_amdgcn_readfirstlane(expert(u.pm)) * bstride + (size_t)u.pn * 256 * ldbB; }
    __device__ __forceinline__ void aoffs(const Unit& u, const int (&R)[2], unsigned (&off)[2][2]) const {
        if (gather) {
            const int e = expert(u.pm), t0 = misc[e], cnt = misc[16 + e];
#pragma unroll
            for (int h = 0; h < 2; ++h)
#pragma unroll
                for (int i = 0; i < 2; ++i) { const int pos = (u.pm - t0) * 256 + h * 128 + R[i]; const int tok = pos < cnt ? lists[e * 16384 + pos] : 0; off[h][i] = (unsigned)tok * ldaB; }
        } else {
#pragma unroll
            for (int h = 0; h < 2; ++h)
#pragma unroll
                for (int i = 0; i < 2; ++i) off[h][i] = (unsigned)(u.pm * 256 + h * 128 + R[i]) * ldaB;
        }
    }
};

struct EpiF32 {
    static constexpr bool PERM = false;
    float* C; int ldc;
    __device__ __forceinline__ void operator()(const f32x4 (&acc)[2][2][4][2], const Unit& u, int wr, int wc, int fr, int fq) const {
        const int row0 = u.pm * BM + wr * 64 + fr, col0 = u.pn * BM + wc * 32 + 4 * fq;
#pragma unroll
        for (int ai = 0; ai < 2; ++ai)
#pragma unroll
            for (int m = 0; m < 4; ++m) { float* rowp = C + (size_t)(row0 + ai * HALF + m * 16) * ldc + col0;
#pragma unroll
                for (int bj = 0; bj < 2; ++bj)
#pragma unroll
                    for (int n = 0; n < 2; ++n) { const f32x4 t_ = acc[ai][bj][m][n]; st16(rowp + bj * HALF + n * 16, __builtin_bit_cast(u32x4, t_)); } }
    }
};
struct EpiBf16 {
    static constexpr bool PERM = true;
    bf16_t* O; int ldc; float scale;
    __device__ __forceinline__ void operator()(const f32x4 (&acc)[2][2][4][2], const Unit& u, int wr, int wc, int fr, int fq) const {
        const int row0 = u.pm * BM + wr * 64 + fr, col0 = u.pn * BM + wc * 32 + 8 * fq;
#pragma unroll
        for (int ai = 0; ai < 2; ++ai)
#pragma unroll
            for (int m = 0; m < 4; ++m) { bf16_t* rowp = O + (size_t)(row0 + ai * HALF + m * 16) * ldc + col0;
#pragma unroll
                for (int bj = 0; bj < 2; ++bj) st16(rowp + bj * HALF, pack8(acc[ai][bj][m][0] * scale, acc[ai][bj][m][1] * scale)); }
    }
};
struct EpiMoeDown {
    static constexpr bool PERM = true;
    bf16_t* O; bf16_t* PART; float scale;
    __device__ __forceinline__ void operator()(const f32x4 (&acc)[2][2][4][2], const Unit& u, int wr, int wc, int fr, int fq) const {
        const int r0 = wr * 64 + fr, c0 = wc * 32 + 8 * fq;
        bf16_t* base = u.aux == 0 ? O + ((size_t)u.pm * BM * 1024 + (size_t)u.pn * BM) : PART + (size_t)(u.aux - 1) * 65536;
        const int ldo = u.aux == 0 ? 1024 : 256;
#pragma unroll
        for (int ai = 0; ai < 2; ++ai)
#pragma unroll
            for (int m = 0; m < 4; ++m) { bf16_t* rowp = base + (size_t)(r0 + ai * HALF + m * 16) * ldo + c0;
#pragma unroll
                for (int bj = 0; bj < 2; ++bj) st16(rowp + bj * HALF, pack8(acc[ai][bj][m][0] * scale, acc[ai][bj][m][1] * scale)); }
    }
};
__device__ __forceinline__ unsigned pack4_fp8(float a, float b, float c, float d) {
    a = __builtin_amdgcn_fmed3f(a, -448.f, 448.f); b = __builtin_amdgcn_fmed3f(b, -448.f, 448.f); c = __builtin_amdgcn_fmed3f(c, -448.f, 448.f); d = __builtin_amdgcn_fmed3f(d, -448.f, 448.f);
    int w = __builtin_amdgcn_cvt_pk_fp8_f32(a, b, 0, false); w = __builtin_amdgcn_cvt_pk_fp8_f32(c, d, w, true); return (unsigned)w; }
struct EpiSwigluF8 {
    static constexpr bool PERM = true;
    unsigned char* O; int ldc; float sin, sout;
    __device__ __forceinline__ void operator()(const f32x4 (&acc)[2][2][4][2], const Unit& u, int wr, int wc, int fr, int fq) const {
        const int row0 = u.pm * BM + wr * 64 + fr, col0 = u.pn * HALF + wc * 32 + 8 * fq;
        const float c1 = -1.4426950408889634f * sin, kk = 1.f / (sin * sin * sout);
#pragma unroll
        for (int ai = 0; ai < 2; ++ai)
#pragma unroll
            for (int m = 0; m < 4; ++m) { f32x4 a, b;
#pragma unroll
                for (int e = 0; e < 4; ++e) {
                    const float g0 = acc[ai][0][m][0][e], g1 = acc[ai][0][m][1][e];
                    const float e0 = __builtin_amdgcn_exp2f(g0 * c1), e1 = __builtin_amdgcn_exp2f(g1 * c1);
                    a[e] = (g0 * acc[ai][1][m][0][e]) * __builtin_amdgcn_rcpf(__builtin_fmaf(e0, kk, kk)); b[e] = (g1 * acc[ai][1][m][1][e]) * __builtin_amdgcn_rcpf(__builtin_fmaf(e1, kk, kk)); }
                u32x2 w; w.x = pack4_fp8(a[0], a[1], a[2], a[3]); w.y = pack4_fp8(b[0], b[1], b[2], b[3]);
                *(u32x2*)(O + (size_t)(row0 + ai * HALF + m * 16) * ldc + col0) = w; }
    }
};
struct EpiU {
    static constexpr bool PERM = true;
    bf16_t* A2; const float* rs;
    __device__ __forceinline__ void operator()(const f32x4 (&acc)[2][2][4][2], const Unit& u, int wr, int wc, int fr, int fq) const {
        const int row0 = u.pm * BM + wr * 64 + fr, col0 = u.pn * BM + wc * 32 + 8 * fq;
#pragma unroll
        for (int ai = 0; ai < 2; ++ai)
#pragma unroll
            for (int m = 0; m < 4; ++m) { const int row = row0 + ai * HALF + m * 16, c = row >> 4, t = row & 15; const float s = rs ? rs[row] : 1.f;
#pragma unroll
                for (int bj = 0; bj < 2; ++bj) { const int col = col0 + bj * HALF, g = col >> 4, i0 = col & 15;
                    st16(A2 + ((size_t)(g * 1024 + c) * 512 + t * 16 + i0), pack8(acc[ai][bj][m][0] * s, acc[ai][bj][m][1] * s)); } }
    }
};
struct EpiY {
    static constexpr bool PERM = true;
    bf16_t* G1;
    __device__ __forceinline__ void operator()(const f32x4 (&acc)[2][2][4][2], const Unit& u, int wr, int wc, int fr, int fq) const {
        const int row0 = u.pm * BM + wr * 64 + fr, col0 = wc * 32 + 8 * fq;
#pragma unroll
        for (int ai = 0; ai < 2; ++ai)
#pragma unroll
            for (int m = 0; m < 4; ++m) { const int row = row0 + ai * HALF + m * 16, g = row >> 10, c = row & 1023;
#pragma unroll
                for (int bj = 0; bj < 2; ++bj) { const int col = col0 + bj * HALF, t = col >> 4, j0 = col & 15;
                    f32x4 a = acc[ai][bj][m][0], b = acc[ai][bj][m][1];
#pragma unroll
                    for (int e = 0; e < 4; ++e) { a[e] = gelu_t(a[e]); b[e] = gelu_t(b[e]); }
                    st16(G1 + ((size_t)(c * 16 + t) * 1024 + g * 16 + j0), pack8(a, b)); } }
    }
};
struct EpiGlu {
    static constexpr bool PERM = true;
    const bf16_t* G1; bf16_t* G2;
    __device__ __forceinline__ void operator()(const f32x4 (&acc)[2][2][4][2], const Unit& u, int wr, int wc, int fr, int fq) const {
        const int row0 = u.pm * BM + wr * 64 + fr, col0 = u.pn * BM + wc * 32 + 8 * fq;
#pragma unroll
        for (int ai = 0; ai < 2; ++ai)
#pragma unroll
            for (int m = 0; m < 4; ++m) { const size_t ro = (size_t)(row0 + ai * HALF + m * 16) * 1024 + col0;
#pragma unroll
                for (int bj = 0; bj < 2; ++bj) { const u32x4 gv = *(const u32x4*)(G1 + ro + bj * HALF);
                    f32x4 a = acc[ai][bj][m][0], b = acc[ai][bj][m][1];
                    a[0] = bf_lo(gv.x) * sigm(a[0]); a[1] = bf_hi(gv.x) * sigm(a[1]); a[2] = bf_lo(gv.y) * sigm(a[2]); a[3] = bf_hi(gv.y) * sigm(a[3]);
                    b[0] = bf_lo(gv.z) * sigm(b[0]); b[1] = bf_hi(gv.z) * sigm(b[1]); b[2] = bf_lo(gv.w) * sigm(b[2]); b[3] = bf_hi(gv.w) * sigm(b[3]);
                    st16(G2 + ro + bj * HALF, pack8(a, b)); } }
    }
};
struct EpiSwiglu {
    static constexpr bool PERM = true;
    bf16_t* O; int ldc; const float* rs;
    __device__ __forceinline__ void operator()(const f32x4 (&acc)[2][2][4][2], const Unit& u, int wr, int wc, int fr, int fq) const {
        const int row0 = u.pm * BM + wr * 64 + fr, col0 = u.pn * HALF + wc * 32 + 8 * fq;
#pragma unroll
        for (int ai = 0; ai < 2; ++ai)
#pragma unroll
            for (int m = 0; m < 4; ++m) { f32x4 a, b; const float s = rs ? rs[row0 + ai * HALF + m * 16] : 1.f;
#pragma unroll
                for (int e = 0; e < 4; ++e) { const float g0 = acc[ai][0][m][0][e] * s, g1 = acc[ai][0][m][1][e] * s; a[e] = g0 * sigm(g0) * (acc[ai][1][m][0][e] * s); b[e] = g1 * sigm(g1) * (acc[ai][1][m][1][e] * s); }
                st16(O + (size_t)(row0 + ai * HALF + m * 16) * ldc + col0, pack8(a, b)); }
    }
};
struct EpiQKV {
    static constexpr bool PERM = true;
    bf16_t* base; unsigned koff, voff; const float* gtab; const float4* rope; float qscale; const float* rs;
    __device__ __forceinline__ void operator()(const f32x4 (&acc)[2][2][4][2], const Unit& u, int wr, int wc, int fr, int fq) const {
        const int row0 = u.pm * BM + wr * 64 + fr, pn = u.pn;
        const float* gain = gtab + (pn < 4 ? 0 : 64) + 8 * fq;
        const float sc = pn < 4 ? qscale : 1.f;
        const unsigned tbase = pn < 4 ? (unsigned)((4 * pn + wc) * 64) : (pn == 4 ? koff : voff) + (unsigned)(wc * 64);
        const int ldo = pn < 4 ? 1024 : 256;
#pragma unroll
        for (int ai = 0; ai < 2; ++ai)
#pragma unroll
            for (int m = 0; m < 4; ++m) { const int row = row0 + ai * HALF + m * 16;
                bf16_t* dst = base + ((size_t)tbase + (size_t)row * ldo + 8 * fq);
                const float s2 = rs ? rs[row] : 1.f;
                if (pn < 5) {
                    float ss = 0.f;
#pragma unroll
                    for (int bj = 0; bj < 2; ++bj)
#pragma unroll
                        for (int n = 0; n < 2; ++n) { const f32x4 v = acc[ai][bj][m][n] * s2; ss += (v[0] * v[0] + v[1] * v[1]) + (v[2] * v[2] + v[3] * v[3]); }
                    ss += __shfl_xor(ss, 16); ss += __shfl_xor(ss, 32);
                    const float r = rsqrtf(ss * (1.f / 64.f) + 1e-6f) * s2;
                    const int pos = row & 8191;
                    const float4* t0 = rope + (pos >> 6) * 8 + 2 * fq; const float4* t1 = rope + 1024 + (pos & 63) * 8 + 2 * fq;
#pragma unroll
                    for (int bj = 0; bj < 2; ++bj) { f32x4 o[2];
#pragma unroll
                        for (int n = 0; n < 2; ++n) { const float4 cs = bj == 0 ? t0[n] : t1[n]; const f32x4 g = *(const f32x4*)(gain + 32 * bj + 4 * n); const f32x4 v = acc[ai][bj][m][n];
                            const float x0 = v[0] * r * g[0], x1 = v[1] * r * g[1], x2 = v[2] * r * g[2], x3 = v[3] * r * g[3];
                            o[n][0] = (x0 * cs.x - x1 * cs.y) * sc; o[n][1] = (x0 * cs.y + x1 * cs.x) * sc; o[n][2] = (x2 * cs.z - x3 * cs.w) * sc; o[n][3] = (x2 * cs.w + x3 * cs.z) * sc; }
                        st16(dst + 32 * bj, pack8(o[0], o[1])); }
                } else {
#pragma unroll
                    for (int bj = 0; bj < 2; ++bj) st16(dst + 32 * bj, pack8(acc[ai][bj][m][0] * s2, acc[ai][bj][m][1] * s2));
                }
                asm volatile("" ::: "memory"); }
    }
};

typedef int v4i32 __attribute__((ext_vector_type(4)));
template <bool F8> struct Frag;
template <> struct Frag<false> { u32x4 k[2]; };
template <> struct Frag<true> { v8i32 v; };
template <class Prob, class Epi, bool ALIGN_EPI = false, bool SP2 = false, bool FP8 = false>
__device__ __forceinline__ void gemm_phase(PG8_LAS unsigned char* lds, const Prob& P, const Epi& E) {
    const int tid = threadIdx.x, wid = __builtin_amdgcn_readfirstlane(tid >> 6), lane = tid & 63, wr = wid >> 2, wc = wid & 3, fr = lane & 15, fq = lane >> 4;
    int Rr[2]; unsigned cof[2], voffB[2];
#pragma unroll
    for (int i = 0; i < 2; ++i) { int R, C; stage_rc(tid * 16 + i * 8192, R, C); const int Rb = Epi::PERM ? ((R & ~31) + perm32(R & 31)) : R;
        Rr[i] = R; cof[i] = (unsigned)C * 2u; voffB[i] = (unsigned)Rb * P.ldbB + (unsigned)C * 2u; }
    const size_t kstep = (size_t)(BK * 2);
    const size_t hstepB = (size_t)HALF * P.ldbB;
    const unsigned ldsw = (unsigned)wid * 1024u;
    const int aoff = FP8 ? lds_byte(wr * 64 + fr, fq * 16) : lds_byte(wr * 64 + fr, fq * 8), boff = FP8 ? lds_byte(wc * 32 + fr, fq * 16) : lds_byte(wc * 32 + fr, fq * 8);

#define PG8_SA(b, h) (((b) * 2 + (h)) * HTB)
#define PG8_SB(b, h) ((4 + (b) * 2 + (h)) * HTB)
#define PG8_STAGE(bufoff, gbase, voff) do { _Pragma("unroll") for (int _i = 0; _i < 2; ++_i) \
        __builtin_amdgcn_global_load_lds((const unsigned*)((const char*)(gbase) + (voff)[_i]), (PG8_LAS unsigned*)(lds + (bufoff) + ldsw + _i * 8192), 16, 0, 0); } while (0)
#define PG8_LD1(dst, addr) do { if constexpr (FP8) { const v4i32 lo_ = *(const PG8_LAS v4i32*)(addr), hi_ = *(const PG8_LAS v4i32*)((addr) + 16); (dst).v = __builtin_shufflevector(lo_, hi_, 0, 1, 2, 3, 4, 5, 6, 7); } \
        else { _Pragma("unroll") for (int k = 0; k < 2; ++k) (dst).k[k] = *(const PG8_LAS u32x4*)((addr) + k * 1024); } } while (0)
#define PG8_LDA(dst, b, h) do { _Pragma("unroll") for (int m = 0; m < 4; ++m) PG8_LD1(dst[m], lds + PG8_SA(b, h) + aoff + m * 2048); } while (0)
#define PG8_LDB(dst, b, h) do { _Pragma("unroll") for (int n = 0; n < 2; ++n) PG8_LD1(dst[n], lds + PG8_SB(b, h) + boff + n * 2048); } while (0)
#define PG8_MMA(ai, bj, At, Bt) do { __builtin_amdgcn_s_setprio(1); _Pragma("unroll") for (int m = 0; m < 4; ++m) _Pragma("unroll") for (int n = 0; n < 2; ++n) { \
        if constexpr (FP8) asm volatile("v_mfma_scale_f32_16x16x128_f8f6f4 %0, %1, %2, %0, %3, %3 op_sel_hi:[0,0,0]" : "+v"(acc[ai][bj][m][n]) : "v"(Bt[n].v), "v"(At[m].v), "v"(f8scale_)); \
        else { _Pragma("unroll") for (int k = 0; k < 2; ++k) acc[ai][bj][m][n] = __builtin_amdgcn_mfma_f32_16x16x32_bf16(__builtin_bit_cast(bf16x8, Bt[n].k[k]), __builtin_bit_cast(bf16x8, At[m].k[k]), acc[ai][bj][m][n], 0, 0, 0); } } \
        __builtin_amdgcn_s_setprio(0); } while (0)
#define PG8_WAIT_V(n) asm volatile("s_waitcnt vmcnt(" #n ")" ::: "memory")
#define PG8_WAIT_L(n) asm volatile("s_waitcnt lgkmcnt(" #n ")" ::: "memory")
#define PG8_BAR __builtin_amdgcn_s_barrier()
#define PG8_SCHED __builtin_amdgcn_sched_barrier(0)
    const int f8scale_ = 0x7f7f7f7f;
    Unit cur, nxt; int ui = 0;
    if (!P.next(0, cur)) return;
    f32x4 acc[2][2][4][2];
#pragma unroll
    for (int a = 0; a < 2; ++a)
#pragma unroll
        for (int b = 0; b < 2; ++b)
#pragma unroll
            for (int m = 0; m < 4; ++m)
#pragma unroll
                for (int n = 0; n < 2; ++n) acc[a][b][m][n] = (f32x4){0.f, 0.f, 0.f, 0.f};
    Frag<FP8> At[4], B0[2], B1[2];
    unsigned voC[2][2], voN[2][2];
    P.aoffs(cur, Rr, voC);
#pragma unroll
    for (int h = 0; h < 2; ++h)
#pragma unroll
        for (int i = 0; i < 2; ++i) voC[h][i] += cof[i] + (unsigned)cur.kofs;
    const char* const aB = P.abase; const char* cB = P.bbase(cur) + cur.kofs;
    if constexpr (SP2) {
        PG8_STAGE(PG8_SB(0, 0), cB, voffB); PG8_STAGE(PG8_SB(0, 1), cB + hstepB, voffB); PG8_STAGE(PG8_SA(0, 0), aB, voC[0]); PG8_STAGE(PG8_SA(0, 1), aB, voC[1]);
        if (wr == 1) PG8_BAR;
        PG8_WAIT_V(2); PG8_BAR;
        PG8_STAGE(PG8_SB(1, 0), cB + kstep, voffB); PG8_STAGE(PG8_SA(1, 0), aB + kstep, voC[0]); PG8_STAGE(PG8_SB(1, 1), cB + hstepB + kstep, voffB);
        PG8_WAIT_V(6); PG8_BAR;
    } else {
        PG8_STAGE(PG8_SB(0, 0), cB, voffB); PG8_STAGE(PG8_SA(0, 0), aB, voC[0]); PG8_STAGE(PG8_SB(0, 1), cB + hstepB, voffB); PG8_STAGE(PG8_SA(0, 1), aB, voC[1]);
        if (wr == 1) PG8_BAR;
        PG8_WAIT_V(4); PG8_BAR;
        PG8_STAGE(PG8_SB(1, 0), cB + kstep, voffB); PG8_STAGE(PG8_SA(1, 0), aB + kstep, voC[0]); PG8_STAGE(PG8_SB(1, 1), cB + hstepB + kstep, voffB);
        PG8_WAIT_V(6); PG8_BAR;
    }
    for (;;) {
        const bool has_next = P.next(ui + 1, nxt);
        if (has_next) { P.aoffs(nxt, Rr, voN);
#pragma unroll
            for (int h = 0; h < 2; ++h)
#pragma unroll
                for (int i = 0; i < 2; ++i) voN[h][i] += cof[i] + (unsigned)nxt.kofs; }
        else {
#pragma unroll
            for (int h = 0; h < 2; ++h)
#pragma unroll
                for (int i = 0; i < 2; ++i) voN[h][i] = voC[h][i]; }
        const char* nB = has_next ? P.bbase(nxt) + nxt.kofs : cB;
        const int nt = cur.nt;
        for (int t = 0; t < nt; t += 2) {
            const bool last = (t == nt - 2);
            const char* a1 = aB + (size_t)(t + 1) * kstep;
            const char* a2 = last ? aB : aB + (size_t)(t + 2) * kstep; const char* b2 = last ? nB : cB + (size_t)(t + 2) * kstep;
            const char* a3 = a2 + kstep; const char* b3 = b2 + kstep;
            unsigned vo2[2][2];
#pragma unroll
            for (int h = 0; h < 2; ++h)
#pragma unroll
                for (int i = 0; i < 2; ++i) vo2[h][i] = last ? voN[h][i] : voC[h][i];
            if constexpr (SP2) {
            PG8_LDB(B0, 0, 0); PG8_LDB(B1, 0, 1); PG8_SCHED; PG8_LDA(At, 0, 0); PG8_STAGE(PG8_SA(1, 1), a1, voC[1]);
            PG8_WAIT_V(8); PG8_WAIT_L(0); PG8_BAR; PG8_MMA(0, 0, At, B0); PG8_MMA(0, 1, At, B1); PG8_BAR; PG8_SCHED;
            PG8_LDA(At, 0, 1); PG8_STAGE(PG8_SB(0, 0), b2, voffB); PG8_STAGE(PG8_SB(0, 1), b2 + hstepB, voffB); PG8_STAGE(PG8_SA(0, 0), a2, vo2[0]);
            PG8_WAIT_V(8); PG8_WAIT_L(0); PG8_BAR; PG8_MMA(1, 0, At, B0); PG8_MMA(1, 1, At, B1); PG8_BAR; PG8_SCHED;
            PG8_LDB(B0, 1, 0); PG8_LDB(B1, 1, 1); PG8_SCHED; PG8_LDA(At, 1, 0); PG8_STAGE(PG8_SA(0, 1), a2, vo2[1]);
            PG8_WAIT_V(8); PG8_WAIT_L(0); PG8_BAR; PG8_MMA(0, 0, At, B0); PG8_MMA(0, 1, At, B1); PG8_BAR; PG8_SCHED;
            PG8_LDA(At, 1, 1); PG8_STAGE(PG8_SB(1, 0), b3, voffB); PG8_STAGE(PG8_SB(1, 1), b3 + hstepB, voffB); PG8_STAGE(PG8_SA(1, 0), a3, vo2[0]);
            PG8_WAIT_V(8); PG8_WAIT_L(0); PG8_BAR; PG8_MMA(1, 0, At, B0); PG8_MMA(1, 1, At, B1); PG8_BAR; PG8_SCHED;
            } else {
            PG8_LDB(B0, 0, 0); PG8_SCHED; PG8_LDA(At, 0, 0); PG8_STAGE(PG8_SA(1, 1), a1, voC[1]);
            PG8_WAIT_L(8); PG8_BAR; PG8_WAIT_L(0); PG8_MMA(0, 0, At, B0); PG8_BAR; PG8_SCHED;
            PG8_LDB(B1, 0, 1); PG8_STAGE(PG8_SB(0, 0), b2, voffB);
            PG8_BAR; PG8_WAIT_L(0); PG8_MMA(0, 1, At, B1); PG8_BAR;
            PG8_LDA(At, 0, 1); PG8_STAGE(PG8_SA(0, 0), a2, vo2[0]);
            PG8_BAR; PG8_WAIT_L(0); PG8_MMA(1, 0, At, B0); PG8_BAR; PG8_SCHED;
            PG8_STAGE(PG8_SB(0, 1), b2 + hstepB, voffB);
            PG8_WAIT_V(6); PG8_BAR; PG8_MMA(1, 1, At, B1); PG8_BAR;
            PG8_LDB(B0, 1, 0); PG8_SCHED; PG8_LDA(At, 1, 0); PG8_STAGE(PG8_SA(0, 1), a2, vo2[1]);
            PG8_WAIT_L(8); PG8_BAR; PG8_WAIT_L(0); PG8_MMA(0, 0, At, B0); PG8_BAR; PG8_SCHED;
            PG8_LDB(B1, 1, 1); PG8_STAGE(PG8_SB(1, 0), b3, voffB);
            PG8_BAR; PG8_WAIT_L(0); PG8_MMA(0, 1, At, B1); PG8_BAR;
            PG8_LDA(At, 1, 1); PG8_STAGE(PG8_SA(1, 0), a3, vo2[0]);
            PG8_BAR; PG8_WAIT_L(0); PG8_MMA(1, 0, At, B0); PG8_BAR; PG8_SCHED;
            PG8_STAGE(PG8_SB(1, 1), b3 + hstepB, voffB);
            PG8_WAIT_V(6); PG8_BAR; PG8_MMA(1, 1, At, B1); PG8_BAR;
            }
        }
        if constexpr (ALIGN_EPI) { if (wr == 0) PG8_BAR; }
        if constexpr (FP8) asm volatile("s_nop 15\n\ts_nop 15" ::: "memory");
        E(acc, cur, wr, wc, fr, fq);
#if defined(EPI_TWICE) && EPI_TWICE
        if constexpr (FP8) { asm volatile("" ::: "memory"); E(acc, cur, wr, wc, fr, fq); }
#endif
        if (!has_next) break;
#pragma unroll
        for (int a = 0; a < 2; ++a)
#pragma unroll
            for (int b = 0; b < 2; ++b)
#pragma unroll
                for (int m = 0; m < 4; ++m)
#pragma unroll
                    for (int n = 0; n < 2; ++n) acc[a][b][m][n] = (f32x4){0.f, 0.f, 0.f, 0.f};
        cur = nxt; cB = nB; ++ui;
#pragma unroll
        for (int h = 0; h < 2; ++h)
#pragma unroll
            for (int i = 0; i < 2; ++i) voC[h][i] = voN[h][i];
        if constexpr (ALIGN_EPI) { if (wr == 1) PG8_BAR; }
    }
    PG8_WAIT_V(0);
    if constexpr (!ALIGN_EPI) { if (wr == 0) PG8_BAR; }
    PG8_BAR;
#undef PG8_SA
#undef PG8_SB
#undef PG8_STAGE
#undef PG8_LD1
#undef PG8_LDA
#undef PG8_LDB
#undef PG8_MMA
#undef PG8_WAIT_V
#undef PG8_WAIT_L
#undef PG8_BAR
#undef PG8_SCHED
}
}

#include <hip/hip_bf16.h>
#include <cmath>
namespace attn_body {
using bf16=__hip_bfloat16;
using bf16x8=__attribute__((ext_vector_type(8)))short;
using s16x4=__attribute__((ext_vector_type(4)))short;
using f32x16=__attribute__((ext_vector_type(16)))float;
using u32x4=__attribute__((ext_vector_type(4)))unsigned;
constexpr int BATCH=2,NHEAD=16,SEQ=8192,D=64,DM=NHEAD*D,KVP=256;
constexpr int NW=8,QBLK=32,QB=QBLK*NW,KVBLK=64,NQB=SEQ/QB;
constexpr int ATTN_PITCH=DM, ATTN_UNIT_ROWS=QB;
__device__ __forceinline__ int crow(int r,int hi){return (r&3)+8*(r>>2)+4*hi;}
#define SBAR() __builtin_amdgcn_sched_barrier(0)
__device__ __forceinline__ void cmask(f32x16&p0,f32x16&p1,int jb,int qrel,int hi){
  const float NEG=-INFINITY; int kb=64*jb+4*hi;
  #pragma unroll
  for(int r=0;r<16;++r){int kv=kb+(r&3)+8*(r>>2); if(kv>qrel)p0[r]=NEG; if(kv+32>qrel)p1[r]=NEG;}
}

constexpr int NSLOT=3, SLOTB=8192;
constexpr int LDS_K=0, LDS_V=NSLOT*SLOTB, LDS_WS=2*NSLOT*SLOTB, LDS_OST=LDS_WS+NW*64*4, LDS_BYTES=LDS_OST+NW*4096;
constexpr float C2=0.125f*1.4426950408889634f;
__device__ __forceinline__ void glds16(const void*gsrc,unsigned lds_dst){unsigned keep;
  asm volatile("s_mov_b32 %0, m0\n\ts_mov_b32 m0, %2\n\ts_nop 0\n\tglobal_load_lds_dwordx4 %1, off\n\ts_mov_b32 m0, %0":"=&s"(keep):"v"(gsrc),"s"(lds_dst):"memory");}
__device__ __forceinline__ float max3f(float a,float b,float c){float r;asm("v_max3_f32 %0, %1, %2, %3":"=v"(r):"v"(a),"v"(b),"v"(c));return r;}
__device__ __forceinline__ float max2f(float a,float b){float r;asm("v_max_f32_e32 %0, %1, %2":"=v"(r):"v"(a),"v"(b));return r;}
__device__ __forceinline__ float fadd_s(float a,float b){float r;asm("v_add_f32_e32 %0, %1, %2":"=v"(r):"v"(a),"v"(b));return r;}
__device__ __forceinline__ float fsub_s(float a,float b){float r;asm("v_sub_f32_e32 %0, %1, %2":"=v"(r):"v"(a),"v"(b));return r;}
typedef float f32x2_t __attribute__((ext_vector_type(2))); typedef __bf16 bf16x2_t __attribute__((ext_vector_type(2)));
__device__ __forceinline__ unsigned cvtpk_s(float lo,float hi){f32x2_t v={lo,hi};bf16x2_t b=__builtin_convertvector(v,bf16x2_t);return __builtin_bit_cast(unsigned,b);}
#define WAIT_BAR(N) asm volatile("s_waitcnt vmcnt(" #N ") lgkmcnt(0)\n\ts_barrier":::"memory")

__device__ __forceinline__ void qkt(f32x16&p0,f32x16&p1,const char*Kslot,const bf16x8*qr,const f32x16&negm,int r32,int hi){
  const char*kb=Kslot+hi*1024+r32*16;
  #pragma unroll
  for(int d0=0;d0<4;++d0){
    const bf16x8 b0=*reinterpret_cast<const bf16x8*>(kb+d0*2048);
    const bf16x8 b1=*reinterpret_cast<const bf16x8*>(kb+d0*2048+512);
    if(d0==0){p0=__builtin_amdgcn_mfma_f32_32x32x16_bf16(b0,qr[0],negm,0,0,0);p1=__builtin_amdgcn_mfma_f32_32x32x16_bf16(b1,qr[0],negm,0,0,0);}
    else{p0=__builtin_amdgcn_mfma_f32_32x32x16_bf16(b0,qr[d0],p0,0,0,0);p1=__builtin_amdgcn_mfma_f32_32x32x16_bf16(b1,qr[d0],p1,0,0,0);}}
}
typedef __attribute__((address_space(3))) const char* lds_cptr;
typedef short v4i16_t __attribute__((ext_vector_type(4)));
__device__ __forceinline__ void kload8(bf16x8*kf,lds_cptr kp){
  kf[0]=*(const __attribute__((address_space(3))) bf16x8*)(kp);      kf[1]=*(const __attribute__((address_space(3))) bf16x8*)(kp+512);
  kf[2]=*(const __attribute__((address_space(3))) bf16x8*)(kp+2048); kf[3]=*(const __attribute__((address_space(3))) bf16x8*)(kp+2560);
  kf[4]=*(const __attribute__((address_space(3))) bf16x8*)(kp+4096); kf[5]=*(const __attribute__((address_space(3))) bf16x8*)(kp+4608);
  kf[6]=*(const __attribute__((address_space(3))) bf16x8*)(kp+6144); kf[7]=*(const __attribute__((address_space(3))) bf16x8*)(kp+6656);
}
__device__ __forceinline__ void kload2(bf16x8*kf,lds_cptr kp,int j){ kf[2*j]=*(const __attribute__((address_space(3))) bf16x8*)(kp+j*2048); kf[2*j+1]=*(const __attribute__((address_space(3))) bf16x8*)(kp+j*2048+512); }
__device__ __forceinline__ s16x4 vtr(lds_cptr p){ return __builtin_bit_cast(s16x4,__builtin_amdgcn_ds_read_tr16_b64_v4i16((__attribute__((address_space(3))) v4i16_t*)p)); }
__device__ __forceinline__ float rowmax(const f32x16&p0,const f32x16&p1){
  float a=max3f(p0[0],p0[1],p1[0]),b=max3f(p0[2],p0[3],p1[1]);a=max3f(a,p1[2],p1[3]);
  #pragma unroll
  for(int r=4;r<16;r+=4){a=max3f(a,p0[r],p0[r+1]);b=max3f(b,p0[r+2],p0[r+3]);a=max3f(a,p1[r],p1[r+1]);b=max3f(b,p1[r+2],p1[r+3]);}
  const float m=max2f(a,b);
  auto rr=__builtin_amdgcn_permlane32_swap(__float_as_uint(m),__float_as_uint(m),false,false);
  return max2f(__uint_as_float(rr[0]),__uint_as_float(rr[1]));
}
__device__ __forceinline__ void pv(f32x16*o,int vb,bf16x8 pa0,bf16x8 pa1,bf16x8 pa2,bf16x8 pa3){
  #pragma unroll
  for(int d0=0;d0<2;++d0){s16x4 lo[4],hi[4];
    #pragma unroll
    for(int ks=0;ks<4;++ks){
      asm volatile("ds_read_b64_tr_b16 %0,%1 offset:%c2":"=&v"(lo[ks]):"v"(vb),"i"(d0*4096+ks*1024):"memory");
      asm volatile("ds_read_b64_tr_b16 %0,%1 offset:%c2":"=&v"(hi[ks]):"v"(vb),"i"(d0*4096+ks*1024+512):"memory");}
    asm volatile("s_waitcnt lgkmcnt(0)":::"memory");SBAR();
    #define PK(k) (bf16x8){lo[k][0],lo[k][1],lo[k][2],lo[k][3],hi[k][0],hi[k][1],hi[k][2],hi[k][3]}
    o[d0]=__builtin_amdgcn_mfma_f32_32x32x16_bf16(pa0,PK(0),o[d0],0,0,0);
    o[d0]=__builtin_amdgcn_mfma_f32_32x32x16_bf16(pa1,PK(1),o[d0],0,0,0);
    o[d0]=__builtin_amdgcn_mfma_f32_32x32x16_bf16(pa2,PK(2),o[d0],0,0,0);
    o[d0]=__builtin_amdgcn_mfma_f32_32x32x16_bf16(pa3,PK(3),o[d0],0,0,0);
    #undef PK
  }
}

#ifndef ATTN_STORE16
#define ATTN_STORE16(p,v) pg8::st16((void*)(p),(v))
#endif
template<int THRL,bool FIX> __device__ __forceinline__ void attn_unit(float refB,int b,int h,int kvh,int qb,const bf16*Q,const bf16*__restrict__ K,const bf16*__restrict__ V,bf16*O,char*shm){
  const int tid=threadIdx.x,lane=tid&63,r32=lane&31,hi=lane>>5; const int wid=__builtin_amdgcn_readfirstlane(tid>>6);
  const long rowbase=(long)b*SEQ; const int q0=qb*QB;
  const bf16*Qw=Q+(rowbase+q0+wid*QBLK)*DM+h*D;
  const bf16*Kh=K+rowbase*KVP+kvh*D,*Vh=V+rowbase*KVP+kvh*D;
  const unsigned lds0=(unsigned)(uintptr_t)shm;
  float*wsf=(float*)(shm+LDS_WS)+wid*64;
  const bf16*ksrc=Kh+(long)lane*KVP+wid*8;
  const bf16*vsrc=Vh+(long)(16*(wid&3)+(lane>>2))*KVP+(wid>>2)*32+(lane&3)*8;
  const unsigned kdst=lds0+LDS_K+wid*1024, vdst=lds0+LDS_V+wid*1024;
  #define DMA_K(t,slot) glds16(ksrc+(long)(t)*KVBLK*KVP,(unsigned)__builtin_amdgcn_readfirstlane(kdst+(slot)))
  #define DMA_V(t,slot) glds16(vsrc+(long)(t)*KVBLK*KVP,(unsigned)__builtin_amdgcn_readfirstlane(vdst+(slot)))
  const int vb0=(int)(lds0+LDS_V)+((lane>>4)&1)*32+(lane&3)*8+(4*hi+((lane&15)>>2))*64;
  const char*Kbase=shm+LDS_K; bf16x8 kf[8];
  const lds_cptr shm3=(lds_cptr)shm; const lds_cptr kp0=shm3+LDS_K+hi*1024+r32*16; const lds_cptr vp0=shm3+LDS_V+((lane>>4)&1)*32+(lane&3)*8+(4*hi+((lane&15)>>2))*64;
  const int NT=SEQ/KVBLK;
  DMA_K(0,0);DMA_V(0,0);DMA_K(1,SLOTB);
  bf16x8 qr[4];
  #pragma unroll
  for(int d0=0;d0<4;++d0)qr[d0]=*reinterpret_cast<const bf16x8*>(&Qw[(long)r32*DM+d0*16+hi*8]);
  float mhat=0.f,l_reg=0.f;f32x16 o[2];o[0]=f32x16{};o[1]=f32x16{};f32x16 negm=f32x16{}; if constexpr(FIX){ _Pragma("unroll") for(int r=0;r<16;++r)negm[r]=-refB; } asm volatile("":"+v"(negm));
  const int qrel=wid*QBLK+r32;
  #define CMASK(P0,P1,t) do{}while(0)
  bool resc=false;
  #define START(P0,P1) do{ if constexpr(!FIX){ const float rm=rowmax(P0,P1); resc=false; \
    { const float dl=rm; mhat=fadd_s(mhat,dl); \
      _Pragma("unroll") for(int r=0;r<16;++r){P0[r]=fsub_s(P0[r],dl);P1[r]=fsub_s(P1[r],dl);} \
      _Pragma("unroll") for(int r=0;r<16;++r)negm[r]=-mhat; asm volatile("":"+v"(negm)); } } \
    _Pragma("unroll") for(int r=0;r<16;++r)P0[r]=__builtin_amdgcn_exp2f(P0[r]); }while(0)
  #define RESC() do{ if constexpr(!FIX) if(resc){ asm volatile("s_waitcnt lgkmcnt(0)":::"memory"); \
      _Pragma("unroll") for(int d_=0;d_<2;++d_) _Pragma("unroll") for(int r=0;r<16;++r)o[d_][r]*=wsf[crow(r,hi)]; } }while(0)
  f32x16 pA0,pA1,pB0,pB1;
  int sl_prev=0,sl_cur=0,sl_next=SLOTB;
  #define ROT() do{sl_prev=sl_cur;sl_cur=sl_next;sl_next=(sl_next==(NSLOT-1)*SLOTB)?0:sl_next+SLOTB;}while(0)
  DMA_K(2,2*SLOTB);
  WAIT_BAR(3);
  qkt(pA0,pA1,Kbase,qr,negm,r32,hi);asm volatile("s_nop 15\n\ts_nop 7":"+v"(pA0),"+v"(pA1));CMASK(pA0,pA1,0);
  START(pA0,pA1);
  _Pragma("unroll") for(int r=0;r<16;++r)pA1[r]=__builtin_amdgcn_exp2f(pA1[r]);
  WAIT_BAR(0);
  DMA_K(3,0);DMA_V(1,SLOTB);
  ROT();
  kload8(kf,kp0+sl_cur);
  WAIT_BAR(2);
  s16x4 vlo[8],vhi[8]; u32x4 pw0,pw1,pw2,pw3;
  #define PKW(P,B) cvtpk_s(P[B],P[B+1])
  #define PAF(k) __builtin_bit_cast(bf16x8,pw##k)
  #define VFR(i) (bf16x8){vlo[i][0],vlo[i][1],vlo[i][2],vlo[i][3],vhi[i][0],vhi[i][1],vhi[i][2],vhi[i][3]}
  #define PIN(x) asm volatile("":"+v"(x))
  #define MX3(a,b,c) __builtin_fmaxf(__builtin_fmaxf((a),(b)),(c))
  #define GAPA(MF,A0,A1,A2,A3,W0,W1,PW) do{ MF; sacc+=A0; sacc+=A1; sacc+=A2; sacc+=A3; PIN(sacc); W0; W1; PIN(PW); SBAR(); }while(0)
  #define EX(v) __builtin_amdgcn_exp2f(v)
  #define GAPB(MF,X,B) do{ MF; X[B]=EX(X[B]); X[B+1]=EX(X[B+1]); X[B+2]=EX(X[B+2]); X[B+3]=EX(X[B+3]); PIN(X); SBAR(); }while(0)
  #define VRD(i) do{ vlo[i]=vtr(vp_+(((i)>>2)*4096+((i)&3)*1024)); vhi[i]=vtr(vp_+(((i)>>2)*4096+((i)&3)*1024+512)); }while(0)
  #define KRD(G,j) do{ if(G){ kload2(kf,kp0+sl_next,j); SBAR(); } }while(0)
  #define STEP(C0,C1,P0,P1,t,GK,GV,GL) do{ SBAR(); \
    const lds_cptr vp_=vp0+sl_prev; \
    VRD(0); SBAR(); float sacc=(P0[0]+P0[1]); \
    GAPA(C0=__builtin_amdgcn_mfma_f32_32x32x16_bf16(kf[0],qr[0],negm,0,0,0), P0[2],P0[3],P0[4],P0[5],     pw0[0]=PKW(P0,0), pw0[1]=PKW(P0,2), pw0); \
    VRD(4); SBAR(); GAPA(C1=__builtin_amdgcn_mfma_f32_32x32x16_bf16(kf[1],qr[0],negm,0,0,0), P0[6],P0[7],P0[8],P0[9],     pw0[2]=PKW(P0,4), pw0[3]=PKW(P0,6), pw0); \
    VRD(1); SBAR(); GAPA(C0=__builtin_amdgcn_mfma_f32_32x32x16_bf16(kf[2],qr[1],C0,0,0,0),   P0[10],P0[11],P0[12],P0[13], pw1[0]=PKW(P0,8), pw1[1]=PKW(P0,10), pw1); \
    VRD(5); SBAR(); GAPA(C1=__builtin_amdgcn_mfma_f32_32x32x16_bf16(kf[3],qr[1],C1,0,0,0),   P0[14],P0[15],P1[0],P1[1],   pw1[2]=PKW(P0,12),pw1[3]=PKW(P0,14), pw1); \
    VRD(2); SBAR(); GAPA(C0=__builtin_amdgcn_mfma_f32_32x32x16_bf16(kf[4],qr[2],C0,0,0,0),   P1[2],P1[3],P1[4],P1[5],     pw2[0]=PKW(P1,0), pw2[1]=PKW(P1,2), pw2); \
    VRD(6); SBAR(); GAPA(C1=__builtin_amdgcn_mfma_f32_32x32x16_bf16(kf[5],qr[2],C1,0,0,0),   P1[6],P1[7],P1[8],P1[9],     pw2[2]=PKW(P1,4), pw2[3]=PKW(P1,6), pw2); \
    VRD(3); SBAR(); GAPA(C0=__builtin_amdgcn_mfma_f32_32x32x16_bf16(kf[6],qr[3],C0,0,0,0),   P1[10],P1[11],P1[12],P1[13], pw3[0]=PKW(P1,8), pw3[1]=PKW(P1,10), pw3); \
    VRD(7); SBAR(); GAPA(C1=__builtin_amdgcn_mfma_f32_32x32x16_bf16(kf[7],qr[3],C1,0,0,0),   P1[14],P1[15],0.f,0.f,       pw3[2]=PKW(P1,12),pw3[3]=PKW(P1,14), pw3); \
    l_reg+=sacc; \
    if(GK){DMA_K((t)+3,sl_cur);} if(GV){DMA_V((t)+1,sl_next);} \
    CMASK(C0,C1,t); \
    if constexpr(!FIX){ float a=MX3(C0[0],C0[1],C1[0]),b=MX3(C0[2],C0[3],C1[1]); a=MX3(a,C1[2],C1[3]); \
      _Pragma("unroll") for(int r=4;r<16;r+=4){a=MX3(a,C0[r],C0[r+1]);b=MX3(b,C0[r+2],C0[r+3]);a=MX3(a,C1[r],C1[r+1]);b=MX3(b,C1[r+2],C1[r+3]);} \
      float rm=__builtin_fmaxf(a,b); { auto rr=__builtin_amdgcn_permlane32_swap(__float_as_uint(rm),__float_as_uint(rm),false,false); rm=__builtin_fmaxf(__uint_as_float(rr[0]),__uint_as_float(rr[1])); } \
      resc=false; \
      if(__builtin_expect(__any(rm>(float)THRL),0)){ const float dl=__builtin_fmaxf(rm,0.f); mhat+=dl; \
        _Pragma("unroll") for(int r=0;r<16;++r){C0[r]-=dl;C1[r]-=dl;} \
        _Pragma("unroll") for(int r=0;r<16;++r)negm[r]=-mhat; asm volatile("":"+v"(negm)); \
        const float f=__builtin_amdgcn_exp2f(-dl); l_reg*=f; if(hi==0)wsf[r32]=f; resc=true; } } \
    SBAR(); \
    GAPB(o[0]=__builtin_amdgcn_mfma_f32_32x32x16_bf16(PAF(0),VFR(0),o[0],0,0,0), C0,0); \
    GAPB(o[1]=__builtin_amdgcn_mfma_f32_32x32x16_bf16(PAF(0),VFR(4),o[1],0,0,0), C0,4); \
    KRD(GL,0); GAPB(o[0]=__builtin_amdgcn_mfma_f32_32x32x16_bf16(PAF(1),VFR(1),o[0],0,0,0), C0,8); \
    KRD(GL,1); GAPB(o[1]=__builtin_amdgcn_mfma_f32_32x32x16_bf16(PAF(1),VFR(5),o[1],0,0,0), C0,12); \
    KRD(GL,2); GAPB(o[0]=__builtin_amdgcn_mfma_f32_32x32x16_bf16(PAF(2),VFR(2),o[0],0,0,0), C1,0); \
    KRD(GL,3); GAPB(o[1]=__builtin_amdgcn_mfma_f32_32x32x16_bf16(PAF(2),VFR(6),o[1],0,0,0), C1,4); \
    GAPB(o[0]=__builtin_amdgcn_mfma_f32_32x32x16_bf16(PAF(3),VFR(3),o[0],0,0,0), C1,8); \
    GAPB(o[1]=__builtin_amdgcn_mfma_f32_32x32x16_bf16(PAF(3),VFR(7),o[1],0,0,0), C1,12); \
    }while(0)
  int t=1;
#if defined(ATTN_PRIO) && ATTN_PRIO
  if(wid>=4)__builtin_amdgcn_s_setprio(1);
#endif
  #undef CMASK
  #define CMASK(P0,P1,t) do{}while(0)
  for(;t+5<NT;t+=2){
    STEP(pB0,pB1,pA0,pA1,t,true,true,true);     WAIT_BAR(2); RESC(); ROT();
    STEP(pA0,pA1,pB0,pB1,t+1,true,true,true);   WAIT_BAR(2); RESC(); ROT();
  }
  #undef CMASK
  #define CMASK(P0,P1,t) do{}while(0)
  #define ENDW(tt) do{ if((tt)+3<NT){WAIT_BAR(2);} else if((tt)+2<NT){WAIT_BAR(1);} else {WAIT_BAR(0);} }while(0)
  for(;t+1<NT;t+=2){
    STEP(pB0,pB1,pA0,pA1,t,(t+3<NT),(t+1<NT),(t+1<NT));       ENDW(t);   RESC(); ROT();
    STEP(pA0,pA1,pB0,pB1,t+1,(t+4<NT),(t+2<NT),(t+2<NT));     ENDW(t+1); RESC(); ROT();
  }
  STEP(pB0,pB1,pA0,pA1,NT-1,false,false,false); RESC();
  { float sacc=pB0[0]+pB0[1]; _Pragma("unroll") for(int r=2;r<16;++r)sacc+=pB0[r]; _Pragma("unroll") for(int r=0;r<16;++r)sacc+=pB1[r]; l_reg+=sacc;
    pw0=(u32x4){PKW(pB0,0),PKW(pB0,2),PKW(pB0,4),PKW(pB0,6)};pw1=(u32x4){PKW(pB0,8),PKW(pB0,10),PKW(pB0,12),PKW(pB0,14)};pw2=(u32x4){PKW(pB1,0),PKW(pB1,2),PKW(pB1,4),PKW(pB1,6)};pw3=(u32x4){PKW(pB1,8),PKW(pB1,10),PKW(pB1,12),PKW(pB1,14)};
    SBAR(); pv(o,vb0+sl_cur,PAF(0),PAF(1),PAF(2),PAF(3)); }
  #undef PKW
  #undef PAF
  #undef VFR
  #undef PIN
  #undef MX3
  #undef GAPA
  #undef GAPB
  #undef EX
  #undef VRD
  #undef KRD
  #undef STEP
  #undef ENDW
#if defined(ATTN_PRIO) && ATTN_PRIO
  __builtin_amdgcn_s_setprio(0);
#endif
  {auto rr=__builtin_amdgcn_permlane32_swap(__float_as_uint(l_reg),__float_as_uint(l_reg),false,false);l_reg=__uint_as_float(rr[0])+__uint_as_float(rr[1]);}
  if(hi==0)wsf[32+r32]=l_reg;asm volatile("s_waitcnt lgkmcnt(0)":::"memory");
  float rli[16];
  #pragma unroll
  for(int r=0;r<16;++r)rli[r]=__builtin_amdgcn_rcpf(wsf[32+crow(r,hi)]);
  bf16*Ow=O+(rowbase+q0+wid*QBLK)*DM+h*D;
  { bf16*stg=(bf16*)(shm+LDS_OST)+wid*2048;
    #pragma unroll
    for(int r=0;r<16;++r){const int orow=crow(r,hi);
      #pragma unroll
      for(int d0=0;d0<2;++d0)stg[orow*64+d0*32+r32]=__float2bfloat16(o[d0][r]*rli[r]);}
    asm volatile("s_waitcnt lgkmcnt(0)":::"memory");
    #pragma unroll
    for(int i=0;i<4;++i){const int row=i*8+(lane>>3),ch=lane&7; const u32x4 v=*(const u32x4*)(stg+row*64+ch*8); ATTN_STORE16(Ow+(long)row*DM+ch*8,v);} }
  asm volatile("s_waitcnt lgkmcnt(0)\n\ts_barrier":::"memory");
  #undef DMA_K
  #undef DMA_V
  #undef CMASK
  #undef START
  #undef RESC
  #undef ROT
}
constexpr int ATTN_LDS_BYTES=LDS_BYTES;
struct AttnTensors { const bf16* Q; const bf16* K; const bf16* V; bf16* O; };
struct AttnUnit { int bh; int qb; };
struct StaticOrder {
  int vcu;
  __device__ __forceinline__ explicit StaticOrder(int grid,int block):vcu((block%8)*(grid/8)+block/8){}
  __device__ __forceinline__ bool next(int i,AttnUnit&u)const{ if(i>=4)return false; const int x=vcu>>5, j=vcu&31; const int b=x>>2, kvh=x&3; u.bh=b*16+kvh*4+i; u.qb=j; return true; }
  __device__ __forceinline__ void a_ready(const AttnUnit&)const{}
  __device__ __forceinline__ void done(const AttnUnit&)const{}
};
template<class Sched,bool FIX,int THRL=8> __device__ __forceinline__ void attn_phase(char*lds,const AttnTensors&T,const Sched&S,float refB){
  AttnUnit u;
  for(int i=0;S.next(i,u);++i){ S.a_ready(u); attn_unit<THRL,FIX>(refB,u.bh/NHEAD,u.bh%NHEAD,(u.bh%NHEAD)>>2,u.qb,T.Q,T.K,T.V,T.O,lds); S.done(u); }
}
#undef SBAR
#undef WAIT_BAR
}

#define GAS __attribute__((address_space(1)))
#define LAS __attribute__((address_space(3)))
typedef unsigned short bf16;
typedef unsigned v4u __attribute__((ext_vector_type(4)));
typedef float f32x4 __attribute__((ext_vector_type(4)));
typedef short bf16x8 __attribute__((ext_vector_type(8)));
typedef GAS unsigned gu32;
typedef GAS unsigned long long gu64;
#define RLX_AGENT __ATOMIC_RELAXED, __HIP_MEMORY_SCOPE_AGENT
#define LDS_WAIT() asm volatile("s_waitcnt lgkmcnt(0)" ::: "memory")
#define VM_WAIT() asm volatile("s_waitcnt vmcnt(0)" ::: "memory")
__device__ __forceinline__ unsigned long long rt() { return __builtin_amdgcn_s_memrealtime(); }
__device__ __forceinline__ unsigned f2bf(float f) { unsigned u = __builtin_bit_cast(unsigned, f); return (u + 0x7fffu + ((u >> 16) & 1u)) >> 16; }
__device__ __forceinline__ unsigned pk2(float lo, float hi) { return pg8::cvt_pk_bf16(lo, hi); }

#define XB_TMO      128
#define XB_XCNT(j)  (256  + 64 * (j))
#define XB_XSUB(j)  (1280 + 64 * (j))
#define XB_XGEN(j)  (2304 + 64 * (j))
#define XB_TOP      3328
#define XB_TOPGEN   3392
#define XCD_BAR_WORDS 3456
#define XB_SPIN_CAP (1u << 18)

__device__ __forceinline__ unsigned xb_ld(unsigned* p)              { return __hip_atomic_load(p, __ATOMIC_RELAXED, __HIP_MEMORY_SCOPE_AGENT); }
__device__ __forceinline__ unsigned xb_add(unsigned* p, unsigned v) { return __hip_atomic_fetch_add(p, v, __ATOMIC_RELAXED, __HIP_MEMORY_SCOPE_AGENT); }
__device__ __forceinline__ unsigned xb_xcc_id() { return (unsigned)__builtin_amdgcn_s_getreg((3 << 11) | 20) & 0xFu; }
#ifndef XB_SLEEP
#define XB_SLEEP 1
#endif
#define XB_SPIN(cond, bar) do { unsigned _sp = 0; while (cond) { __builtin_amdgcn_s_sleep(XB_SLEEP); \
    if ((++_sp & 255u) == 0u) { if (xb_ld(&(bar)[XB_TMO])) break; if (_sp > XB_SPIN_CAP) { atomicAdd(&(bar)[XB_TMO], 1u); break; } } } } while (0)

struct XcdBarrier {
    unsigned* bar; unsigned x;
    volatile LAS unsigned* st;
};

__device__ __forceinline__ XcdBarrier xcd_barrier_post(unsigned* bar, volatile LAS unsigned* st) {
    XcdBarrier b; b.bar = bar; b.x = xb_xcc_id(); b.st = st;
    if (threadIdx.x == 0) (void)xb_add(&bar[XB_XCNT(b.x)], 1u);
    return b;
}
__device__ __forceinline__ void xcd_barrier_complete(unsigned* bar, unsigned x, unsigned& nloc, unsigned& nx) {
    const unsigned G = gridDim.x * gridDim.y * gridDim.z;
    unsigned sum, cnt, mine, sp = 0u;
    for (;;) {
        sum = 0u; cnt = 0u; mine = 0u;
#pragma unroll
        for (unsigned j = 0; j < 16; ++j) { const unsigned c = xb_ld(&bar[XB_XCNT(j)]); sum += c; cnt += (c > 0u) ? 1u : 0u; mine = (j == x) ? c : mine; }
        if (sum == G) break;
        __builtin_amdgcn_s_sleep(1);
        if ((++sp & 255u) == 0u) { if (xb_ld(&bar[XB_TMO])) break; if (sp > XB_SPIN_CAP) { atomicAdd(&bar[XB_TMO], 1u); break; } }
    }
    nloc = mine > 0u ? mine : 1u; nx = cnt > 0u ? cnt : 1u;
}

__device__ __forceinline__ void xcd_barrier(const XcdBarrier& b) {
    asm volatile("s_waitcnt vmcnt(0)" ::: "memory");
    __syncthreads();
    if (threadIdx.x == 0) {
        unsigned* bar = b.bar;
        __builtin_amdgcn_s_waitcnt(0);
        unsigned nloc = b.st[0], nx = b.st[1];
        if (nloc == 0u) { xcd_barrier_complete(bar, b.x, nloc, nx); b.st[0] = nloc; b.st[1] = nx; }
        const unsigned old = xb_add(&bar[XB_XSUB(b.x)], 1u);
        const unsigned gen = old / nloc;
        if (old + 1u == (gen + 1u) * nloc) {
            __builtin_amdgcn_fence(__ATOMIC_RELEASE, "agent");
            asm volatile("s_waitcnt vmcnt(0)" ::: "memory");
            const unsigned og = xb_add(&bar[XB_TOP], 1u);
            const unsigned tg = og / nx;
            if (og + 1u == (tg + 1u) * nx) xb_add(&bar[XB_TOPGEN], 1u);
            else XB_SPIN(xb_ld(&bar[XB_TOPGEN]) == tg, bar);
            __builtin_amdgcn_fence(__ATOMIC_ACQUIRE, "agent");
            xb_add(&bar[XB_XGEN(b.x)], 1u);
            asm volatile("s_waitcnt vmcnt(0)" ::: "memory");
        } else {
            XB_SPIN(xb_ld(&bar[XB_XGEN(b.x)]) == gen, bar);
            __builtin_amdgcn_fence(__ATOMIC_ACQUIRE, "agent");
            asm volatile("s_waitcnt vmcnt(0)" ::: "memory");
        }
    }
    __syncthreads();
}

#ifndef MOE_FP8
#define MOE_FP8 1
#endif
#ifndef MOE_WGM
#define MOE_WGM 8
#endif
#ifndef P15_ALIGN
#define P15_ALIGN true
#endif
#ifndef P15_SP2
#define P15_SP2 true
#endif
#ifndef FFN_FP8
#define FFN_FP8 0
#endif
#ifndef MOE_CVT_IN_SCAN
#define MOE_CVT_IN_SCAN 1
#endif
#ifndef ATTN_PRIO
#define ATTN_PRIO 1
#endif
#ifndef MOE_CVT_SPLIT
#define MOE_CVT_SPLIT 16384
#endif
#ifndef CVT_P0_END
#define CVT_P0_END T_ISMALL
#endif
#ifndef CVT_S1
#define CVT_S1 11264
#endif
#ifndef CVT_S2
#define CVT_S2 16384
#endif
#ifndef FFN_WGM
#define FFN_WGM 8
#endif
#ifndef NORM_FACTOR
#define NORM_FACTOR 0
#endif
constexpr int NWAVES = 8;
constexpr int NTOK = 16384, DM = 1024, SEQ = 8192, NB = 2;
constexpr int DFF = 2816, NEXP = 8, DFE = 3584, QKVW = 1536;
constexpr float EPS = 1e-6f;
constexpr float QSCALE = 0.125f * 1.4426950408889634f;

constexpr size_t MiB = 1u << 20;
constexpr size_t WS_CTL = 0, CTL_ZERO_BYTES = 1 * MiB;
constexpr size_t WS_ROPE_R = 1 * MiB, WS_ROPE_C = 1 * MiB + 16384, WS_AT = 1 * MiB + 65536, WS_QKG = 1 * MiB + 131072, WS_TOKINFO = 1 * MiB + 262144;
constexpr size_t WS_RSTD = 1 * MiB + 524288;
constexpr size_t WS_LIST = 2 * MiB, WS_IDLIST = 3 * MiB;
constexpr size_t WS_BT_IN = 4 * MiB, WS_BT_GLU = 6 * MiB, WS_BT_SOUT = 8 * MiB, WS_BT_AO = 10 * MiB, WS_BT_QKV = 12 * MiB, WS_BT_GU = 16 * MiB, WS_BT_FD = 28 * MiB;
constexpr size_t WS_S5_MAIN = 34 * MiB, WS_S5_STATE = 50 * MiB;
constexpr size_t WS_A2 = 58 * MiB, WS_S = 122 * MiB, WS_G1 = 122 * MiB, WS_G2 = 154 * MiB, WS_MIX = 58 * MiB;
constexpr size_t WS_ACTF = 122 * MiB;
constexpr size_t WS_Q = 122 * MiB, WS_K = 154 * MiB, WS_V = 162 * MiB, WS_O = 170 * MiB;
constexpr size_t WS_XN = 242 * MiB;
constexpr size_t WS_ACTM = 4 * MiB;
constexpr size_t WS_BT_MGU = 280 * MiB, WS_BT_MD = 392 * MiB, WS_SLOT = 124 * MiB, WS_PART = 192 * MiB, WS_HB = 336 * MiB, WS_END = 448 * MiB;
static_assert(WS_ACTM + (size_t)34816 * DFE * 2 <= WS_XN && WS_XN + (size_t)NTOK * DM * 2 <= WS_BT_MGU && WS_BT_MGU + (size_t)8 * 7168 * 1024 * 2 == WS_BT_MD && WS_BT_MD + (size_t)8 * 1024 * 3584 * 2 == WS_END, "ws map");
static_assert(WS_S5_STATE + (size_t)64 * 256 * 256 * 2 <= WS_A2 && WS_ACTF + (size_t)NTOK * DFF * 2 <= WS_XN && WS_O + (size_t)NTOK * DM * 2 <= WS_XN && WS_SLOT + (size_t)34816 * DM * 2 <= WS_PART && WS_PART + (size_t)256 * 131072 <= WS_XN && WS_ACTM + (size_t)34816 * DFE <= WS_SLOT && WS_BT_MGU + (size_t)8 * 7168 * 1024 <= WS_HB && WS_HB + (size_t)NTOK * DM * 2 <= WS_BT_MD && MOE_FP8 == 1, "ws map 2");
constexpr int CW_TMO = 0, CW_CODE = 1, CW_BAR = 4096, CW_CNT = 8192;

constexpr int RING_OFF = 0, RING_BYTES = 131072;
constexpr int LDSCTL_OFF = RING_BYTES, MISC_OFF = LDSCTL_OFF + 320;
constexpr int LDS_BYTES = 147456;

typedef unsigned v2u __attribute__((ext_vector_type(2)));
typedef float v2f __attribute__((ext_vector_type(2)));

constexpr int MOE_OFF = MISC_OFF + 256;
struct Frame {
    LAS unsigned char* lds;
    volatile LAS unsigned* MISC;
    gu32* ctl;
    int tid, lane, wave;
    int vcu, G;
};
__device__ __forceinline__ float wave_sum(float v) {
#pragma unroll
    for (int o = 1; o < 64; o <<= 1) v += __shfl_xor(v, o);
    return v;
}
constexpr int T_ISMALL = 4 * 256 + 384 + 3 * 704, T_NITEMS = T_ISMALL + 8 * 3 * 896;
struct TItem { const float* W; bf16* WT; int K, N, kind, half, item, f8; const float* gain; };
__device__ __forceinline__ TItem t_decode(int it, const float* const* in, unsigned char* ws) {
    constexpr int I_SQ = 256, I_FG = 704, I_QKV = 384, I_M = 896;
    TItem t; int r = it; t.kind = 0; t.half = 0; t.K = DM; t.N = DM; t.f8 = 0; t.gain = nullptr;
    if (r < I_SQ) { t.W = in[2]; t.WT = (bf16*)(ws + WS_BT_IN); t.item = r; if (NORM_FACTOR) t.gain = in[1]; return t; } r -= I_SQ;
    if (r < I_SQ) { t.W = in[11]; t.WT = (bf16*)(ws + WS_BT_GLU); t.item = r; return t; } r -= I_SQ;
    if (r < I_SQ) { t.W = in[12]; t.WT = (bf16*)(ws + WS_BT_SOUT); t.item = r; return t; } r -= I_SQ;
    if (r < I_SQ) { t.W = in[19]; t.WT = (bf16*)(ws + WS_BT_AO); t.item = r; return t; } r -= I_SQ;
    if (r < I_QKV) { t.W = in[16]; t.WT = (bf16*)(ws + WS_BT_QKV); t.N = QKVW; t.kind = 2; t.item = r; if (NORM_FACTOR) t.gain = in[1] + 4 * DM; return t; } r -= I_QKV;
    if (r < I_FG) { t.W = in[13]; t.WT = (bf16*)(ws + WS_BT_GU); t.N = DFF; t.kind = 1; t.item = r; t.f8 = FFN_FP8; if (NORM_FACTOR) t.gain = in[1] + 2 * DM; return t; } r -= I_FG;
    if (r < I_FG) { t.W = in[14]; t.WT = (bf16*)(ws + WS_BT_GU); t.N = DFF; t.kind = 1; t.half = 1; t.item = r; t.f8 = FFN_FP8; if (NORM_FACTOR) t.gain = in[1] + 2 * DM; return t; } r -= I_FG;
    if (r < I_FG) { t.W = in[15]; t.WT = (bf16*)(ws + WS_BT_FD); t.K = DFF; t.item = r; t.f8 = FFN_FP8; return t; } r -= I_FG;
    const int e = r / (3 * I_M); r -= e * 3 * I_M; t.f8 = MOE_FP8;
    if (r < I_M) { t.W = in[21] + (size_t)e * DM * DFE; t.WT = (bf16*)(ws + WS_BT_MGU + (size_t)e * 7168 * 1024 * (MOE_FP8 ? 1 : 2)); t.N = DFE; t.kind = 1; t.item = r; return t; } r -= I_M;
    if (r < I_M) { t.W = in[22] + (size_t)e * DM * DFE; t.WT = (bf16*)(ws + WS_BT_MGU + (size_t)e * 7168 * 1024 * (MOE_FP8 ? 1 : 2)); t.N = DFE; t.kind = 1; t.half = 1; t.item = r; return t; } r -= I_M;
    t.W = in[23] + (size_t)e * DFE * DM; t.WT = (bf16*)(ws + WS_BT_MD + (size_t)e * 1024 * 3584 * (MOE_FP8 ? 1 : 2)); t.K = DFE; t.item = r; return t;
}
__device__ __forceinline__ void t_issue(const TItem& t, int lane, f32x4 (&ld)[16]) {
    const int nblk = t.N / 64, kb = t.item / nblk, nb = t.item - kb * nblk;
    const int rmul = t.f8 ? 4 : 2;
    const float* p = t.W + (size_t)(64 * kb + rmul * (lane >> 4)) * t.N + 64 * nb + 4 * (lane & 15);
#pragma unroll
    for (int i = 0; i < 16; ++i) ld[i] = *(const GAS f32x4*)(p + (size_t)(t.f8 ? 16 * (i >> 2) + (i & 3) : 8 * (i >> 1) + (i & 1)) * t.N);
}
__device__ __forceinline__ void t_finish(const TItem& t, int lane, const f32x4 (&ld)[16], LAS unsigned* T) {
    const int nblk = t.N / 64, kb = t.item / nblk, nb = t.item - kb * nblk, k0 = 64 * kb, n0 = 64 * nb;
    const int r = lane >> 4, cg = lane & 15;
    if (t.f8) {
        unsigned char* WT8 = (unsigned char*)t.WT;
#pragma unroll
        for (int mq = 0; mq < 4; ++mq) { LAS unsigned* d = T + (4 * mq + r) * 65 + 4 * cg;
            d[0] = pg8::pack4_fp8(ld[4 * mq].x * 64.f, ld[4 * mq + 1].x * 64.f, ld[4 * mq + 2].x * 64.f, ld[4 * mq + 3].x * 64.f);
            d[1] = pg8::pack4_fp8(ld[4 * mq].y * 64.f, ld[4 * mq + 1].y * 64.f, ld[4 * mq + 2].y * 64.f, ld[4 * mq + 3].y * 64.f);
            d[2] = pg8::pack4_fp8(ld[4 * mq].z * 64.f, ld[4 * mq + 1].z * 64.f, ld[4 * mq + 2].z * 64.f, ld[4 * mq + 3].z * 64.f);
            d[3] = pg8::pack4_fp8(ld[4 * mq].w * 64.f, ld[4 * mq + 1].w * 64.f, ld[4 * mq + 2].w * 64.f, ld[4 * mq + 3].w * 64.f); }
        LDS_WAIT(); asm volatile("" ::: "memory");
        const int c4 = lane & 3;
#pragma unroll
        for (int j = 0; j < 4; ++j) { const int nl = (lane >> 2) + 16 * j, n = n0 + nl;
            const int dr = t.kind == 0 ? n : 256 * (n / 128) + (n % 128) + 128 * t.half;
            const LAS unsigned* s = T + (4 * c4) * 65 + nl;
            v4u o; o.x = s[0]; o.y = s[65]; o.z = s[130]; o.w = s[195];
            *(GAS v4u*)(WT8 + (size_t)dr * t.K + k0 + 16 * c4) = o; }
        LDS_WAIT(); asm volatile("" ::: "memory");
        return;
    }
#pragma unroll
    for (int m = 0; m < 8; ++m) { LAS unsigned* d = T + (4 * m + r) * 65 + 4 * cg;
        float g0 = 1.f, g1 = 1.f; if (NORM_FACTOR && t.gain) { const v2f gg = *(const GAS v2f*)(t.gain + k0 + 8 * m + 2 * r); g0 = gg.x; g1 = gg.y; }
        d[0] = pk2(ld[2 * m].x * g0, ld[2 * m + 1].x * g1); d[1] = pk2(ld[2 * m].y * g0, ld[2 * m + 1].y * g1); d[2] = pk2(ld[2 * m].z * g0, ld[2 * m + 1].z * g1); d[3] = pk2(ld[2 * m].w * g0, ld[2 * m + 1].w * g1); }
    LDS_WAIT(); asm volatile("" ::: "memory");
    const int c = lane & 7;
#pragma unroll
    for (int j = 0; j < 8; ++j) { const int nl = (lane >> 3) + 8 * j, n = n0 + nl;
        const int dr = t.kind == 0 ? n : (t.kind == 1 ? 256 * (n / 128) + (n % 128) + 128 * t.half : 256 * (n / 256) + 128 * ((n % 64) / 32) + 32 * ((n % 256) / 64) + (n % 32));
        const LAS unsigned* s = T + (4 * c) * 65 + nl;
        v4u o; o.x = s[0]; o.y = s[65]; o.z = s[130]; o.w = s[195];
        *(GAS v4u*)(t.WT + (size_t)dr * t.K + k0 + 8 * c) = o; }
    LDS_WAIT(); asm volatile("" ::: "memory");
}
__device__ __forceinline__ void convert_range(const float* const* in, unsigned char* ws, LAS unsigned* scr, int lane, int begin, int end, int wi, int nw) {
    f32x4 lA[16], lB[16]; TItem tA, tB; int it = begin + wi;
    if (it < end) { tA = t_decode(it, in, ws); t_issue(tA, lane, lA); }
    while (it < end) {
        const bool nb = it + nw < end;
        if (nb) { tB = t_decode(it + nw, in, ws); t_issue(tB, lane, lB); }
        t_finish(tA, lane, lA, scr);
        if (!nb) break;
        const bool na = it + 2 * nw < end;
        if (na) { tA = t_decode(it + 2 * nw, in, ws); t_issue(tA, lane, lA); }
        t_finish(tB, lane, lB, scr);
        if (!na) break;
        it += 2 * nw;
    }
}
__device__ __forceinline__ void s5_tables_item(Frame& F, const float* const* in, unsigned char* ws, int g, int tq) {
    const float *lam_re = in[3], *lam_im = in[4], *log_step = in[5], *b_re = in[6], *b_im = in[7], *c_re = in[8], *c_im = in[9], *dsk = in[10];
    LAS float* APOW = (LAS float*)F.lds;
    LAS float* BB = APOW + 2 * 17 * 64 * 2;
    LAS float* CC = BB + 2 * 64 * 16 * 2;
    LAS float* KT = CC + 2 * 16 * 64 * 2;
    const int tid = F.tid;
    __syncthreads();
    if (tid < 128) {
        const int dir = tid >> 6, p = tid & 63;
        const double step = exp((double)log_step[dir * 64 + g]);
        const double lr = lam_re[(dir * 64 + g) * 64 + p], li = lam_im[(dir * 64 + g) * 64 + p];
        const double mag = exp(lr * step), ang = li * step;
        const double ar = mag * cos(ang), ai = mag * sin(ang);
        double pr = 1.0, pi = 0.0;
        for (int tau = 0; tau <= 16; ++tau) { APOW[((dir * 17 + tau) * 64 + p) * 2] = (float)pr; APOW[((dir * 17 + tau) * 64 + p) * 2 + 1] = (float)pi;
            const double nr = pr * ar - pi * ai, ni = pr * ai + pi * ar; pr = nr; pi = ni; if (tau == 15 && tq == 0) { ((float*)(ws + WS_AT))[((dir * 64 + g) * 64 + p) * 2] = (float)nr; ((float*)(ws + WS_AT))[((dir * 64 + g) * 64 + p) * 2 + 1] = (float)ni; } }
        const double nr = ar - 1.0, ni = ai, den = lr * lr + li * li;
        const double qr = (nr * lr + ni * li) / den, qi = (ni * lr - nr * li) / den;
        for (int i = 0; i < 16; ++i) { const double br = b_re[((dir * 64 + g) * 64 + p) * 16 + i], bi = b_im[((dir * 64 + g) * 64 + p) * 16 + i];
            BB[((dir * 64 + p) * 16 + i) * 2] = (float)(qr * br - qi * bi); BB[((dir * 64 + p) * 16 + i) * 2 + 1] = (float)(qr * bi + qi * br); }
    }
    for (int idx = tid; idx < 2048; idx += 512) { const int dir = idx >> 10, j = (idx >> 6) & 15, p = idx & 63;
        CC[idx * 2] = c_re[((dir * 64 + g) * 16 + j) * 64 + p]; CC[idx * 2 + 1] = c_im[((dir * 64 + g) * 16 + j) * 64 + p]; }
    __syncthreads();
    {
        const int dir = tid >> 8, j = (tid >> 4) & 15, i = tid & 15;
        float kt[16];
#pragma unroll
        for (int t = 0; t < 16; ++t) kt[t] = 0.f;
        for (int p = 0; p < 64; ++p) {
            const float cr = CC[((dir * 16 + j) * 64 + p) * 2], ci = CC[((dir * 16 + j) * 64 + p) * 2 + 1];
            const float br = BB[((dir * 64 + p) * 16 + i) * 2], bi = BB[((dir * 64 + p) * 16 + i) * 2 + 1];
            const float wr = cr * br - ci * bi, wi = cr * bi + ci * br;
#pragma unroll
            for (int t = 0; t < 16; ++t) { const float ar = APOW[((dir * 17 + t) * 64 + p) * 2], ai = APOW[((dir * 17 + t) * 64 + p) * 2 + 1]; kt[t] += ar * wr - ai * wi; }
        }
#pragma unroll
        for (int t = 0; t < 16; ++t) KT[(dir * 16 + t) * 256 + j * 16 + i] = kt[t];
    }
    __syncthreads();
    bf16* Bm = (bf16*)(ws + WS_S5_MAIN) + (size_t)(g * 256 + 64 * tq) * 512;
    for (int w = tid; w < 4096; w += 512) {
        const int nl = w >> 6, k0 = (w & 63) * 8, t = 4 * tq + (nl >> 4), j = nl & 15;
        float v[8];
        if (k0 < 256) { const int s = k0 >> 4, i0 = k0 & 15;
#pragma unroll
            for (int e = 0; e < 8; ++e) { const int i = i0 + e;
                v[e] = (t > s) ? KT[(0 * 16 + (t - s)) * 256 + j * 16 + i] : (s > t) ? KT[(1 * 16 + (s - t)) * 256 + j * 16 + i]
                                 : KT[j * 16 + i] + KT[16 * 256 + j * 16 + i] + (i == j ? dsk[g * 16 + j] : 0.f); }
        } else { const int dir = (k0 - 256) >> 7, p0 = ((k0 - 256) & 127) >> 1, tau = dir == 0 ? t + 1 : 16 - t;
#pragma unroll
            for (int e = 0; e < 8; ++e) { const int p = p0 + (e >> 1), ri = e & 1;
                const float cr = CC[((dir * 16 + j) * 64 + p) * 2], ci = CC[((dir * 16 + j) * 64 + p) * 2 + 1];
                const float ar = APOW[((dir * 17 + tau) * 64 + p) * 2], ai = APOW[((dir * 17 + tau) * 64 + p) * 2 + 1];
                v[e] = ri == 0 ? (cr * ar - ci * ai) : -(cr * ai + ci * ar); }
        }
        v4u o; o.x = pk2(v[0], v[1]); o.y = pk2(v[2], v[3]); o.z = pk2(v[4], v[5]); o.w = pk2(v[6], v[7]);
        *(GAS v4u*)(Bm + (size_t)nl * 512 + k0) = o;
    }
    bf16* Bs = (bf16*)(ws + WS_S5_STATE) + (size_t)(g * 256 + 64 * tq) * 256;
    { const int dir = tq >> 1;
      for (int w = tid; w < 2048; w += 512) {
        const int nl = w >> 5, p = 32 * (tq & 1) + (nl >> 1), ri = nl & 1, k0 = (w & 31) * 8, s = k0 >> 4, i0 = k0 & 15, tau = dir == 0 ? 15 - s : s;
        const float ar = APOW[((dir * 17 + tau) * 64 + p) * 2], ai = APOW[((dir * 17 + tau) * 64 + p) * 2 + 1];
        float v[8];
#pragma unroll
        for (int e = 0; e < 8; ++e) { const float br = BB[((dir * 64 + p) * 16 + i0 + e) * 2], bi = BB[((dir * 64 + p) * 16 + i0 + e) * 2 + 1];
            v[e] = ri == 0 ? (ar * br - ai * bi) : (ar * bi + ai * br); }
        v4u o; o.x = pk2(v[0], v[1]); o.y = pk2(v[2], v[3]); o.z = pk2(v[4], v[5]); o.w = pk2(v[6], v[7]);
        *(GAS v4u*)(Bs + (size_t)nl * 256 + k0) = o;
      } }
    __syncthreads();
}
__device__ __forceinline__ void rms_row_to_bf16(int lane, const float* xrow, const float* gain, bf16* orow) {
    const GAS f32x4* xr = (const GAS f32x4*)xrow + lane;
    f32x4 v[4]; float s = 0.f;
#pragma unroll
    for (int j = 0; j < 4; ++j) { v[j] = xr[64 * j]; s += (v[j].x * v[j].x + v[j].y * v[j].y) + (v[j].z * v[j].z + v[j].w * v[j].w); }
    const float r = rsqrtf(wave_sum(s) * (1.f / DM) + EPS);
    GAS v2u* o8 = (GAS v2u*)orow + lane;
#pragma unroll
    for (int j = 0; j < 4; ++j) { const f32x4 g = ((const GAS f32x4*)gain)[lane + 64 * j]; v2u o; o.x = pk2(v[j].x * r * g.x, v[j].y * r * g.y); o.y = pk2(v[j].z * r * g.z, v[j].w * r * g.w); o8[64 * j] = o; }
}
__device__ __forceinline__ void row_to_bf16_rs(int lane, const float* xrow, bf16* orow, float* rs) {
    const GAS f32x4* xr = (const GAS f32x4*)xrow + lane;
    f32x4 v[4]; float s = 0.f;
#pragma unroll
    for (int j = 0; j < 4; ++j) { v[j] = xr[64 * j]; s += (v[j].x * v[j].x + v[j].y * v[j].y) + (v[j].z * v[j].z + v[j].w * v[j].w); }
    GAS v2u* o8 = (GAS v2u*)orow + lane;
#pragma unroll
    for (int j = 0; j < 4; ++j) { v2u o; o.x = pk2(v[j].x, v[j].y); o.y = pk2(v[j].z, v[j].w); o8[64 * j] = o; }
    const float r = rsqrtf(wave_sum(s) * (1.f / DM) + EPS);
    if (lane == 0) *rs = r;
}
__device__ __forceinline__ void p0_prologue(Frame& F, const float* const* in, unsigned char* ws) {
#ifndef P0DUP
#define P0DUP 0
#endif
    for (int rep = 0; rep < 1 + (P0DUP & 1); ++rep)
    for (int it = blockIdx.x; it < 256; it += F.G) s5_tables_item(F, in, ws, it >> 2, it & 3);
    for (int idx = blockIdx.x * 512 + F.tid; idx < 192 * 16; idx += F.G * 512) {
        const int f = idx & 15, pos = idx < 2048 ? (idx >> 4) : ((idx - 2048) >> 4);
        const float freq = powf(10000.f, -(float)(2 * f) / 32.f), ang = (float)pos * freq;
        float* dst = idx < 2048 ? (float*)(ws + WS_ROPE_R) + idx * 2 : (float*)(ws + WS_ROPE_C) + (idx - 2048) * 2;
        dst[0] = cosf(ang); dst[1] = sinf(ang);
    }
#if defined(EXP_GATHER) && EXP_GATHER
    for (int idx = blockIdx.x * 512 + F.tid; idx < NTOK; idx += F.G * 512) ((int*)(ws + WS_IDLIST))[idx] = idx;
#endif
    if (blockIdx.x == 0 && F.tid < 128) ((float*)(ws + WS_QKG))[F.tid] = F.tid < 64 ? in[17][F.tid] : in[18][F.tid - 64];
    LAS unsigned* scr = (LAS unsigned*)(F.lds + RING_OFF + F.wave * 16384);
    const int gw = F.vcu * NWAVES + F.wave, NGW = F.G * NWAVES;
    for (int rep = 0; rep < 1 + ((P0DUP >> 1) & 1); ++rep) convert_range(in, ws, scr, F.lane, 0, CVT_P0_END, gw, NGW);
    for (int rep = 0; rep < 1 + ((P0DUP >> 2) & 1); ++rep)
#if NORM_FACTOR
    for (int m = gw; m < NTOK; m += NGW) row_to_bf16_rs(F.lane, in[0] + (size_t)m * DM, (bf16*)(ws + WS_HB) + (size_t)m * DM, (float*)(ws + WS_RSTD) + m);
#else
    for (int m = gw; m < NTOK; m += NGW) rms_row_to_bf16(F.lane, in[0] + (size_t)m * DM, in[1], (bf16*)(ws + WS_XN) + (size_t)m * DM);
#endif
}
__device__ __forceinline__ void scan_phase(Frame& F, const float* const* in, unsigned char* ws) {
    const float* S = (const float*)(ws + WS_S); bf16* A2 = (bf16*)(ws + WS_A2); const float* aT = (const float*)(ws + WS_AT);
#if MOE_CVT_IN_SCAN
    if (F.wave != 0) {
        LAS unsigned* scr = (LAS unsigned*)(F.lds + RING_OFF + F.wave * 16384);
        convert_range(in, ws, scr, F.lane, CVT_P0_END, T_ISMALL + CVT_S1, F.vcu * 7 + (F.wave - 1), F.G * 7);
        return;
    }
    typedef float f32x2s __attribute__((ext_vector_type(2)));
#ifndef SCAN_REPS
#define SCAN_REPS 1
#endif
    for (int srep_ = 0; srep_ < SCAN_REPS; ++srep_)
    for (int it = blockIdx.x; it < 256; it += F.G) {
        const int dir = it & 1, g = (it >> 1) & 63, b = it >> 7;
        const float ar = aT[((dir * 64 + g) * 64 + F.lane) * 2], ai = aT[((dir * 64 + g) * 64 + F.lane) * 2 + 1];
        const size_t row0 = (size_t)g * 1024 + b * 512;
        const float* Sp = S + row0 * 256 + dir * 128 + 2 * F.lane;
        bf16* Ap = A2 + row0 * 512 + 256 + dir * 128 + 2 * F.lane;
        float xr = 0.f, xi = 0.f;
        f32x2s X0[16], X1[16], X2[16];
#define SC_LOAD(X, k0) do { _Pragma("unroll") for (int q = 0; q < 16; ++q) { const int c = dir == 0 ? (k0) + q : 511 - (k0) - q; X[q] = *(const GAS f32x2s*)(Sp + (size_t)c * 256); } } while (0)
#define SC_STEP(X, k0) do { _Pragma("unroll") for (int q = 0; q < 16; ++q) { const int c = dir == 0 ? (k0) + q : 511 - (k0) - q; \
            *(GAS unsigned*)(Ap + (size_t)c * 512) = pk2(xr, xi); \
            const float nxr = ar * xr - ai * xi + X[q].x, nxi = ar * xi + ai * xr + X[q].y; xr = nxr; xi = nxi; } } while (0)
        SC_LOAD(X0, 0); SC_LOAD(X1, 16); SC_LOAD(X2, 32);
        for (int k0 = 0; k0 < 512; k0 += 48) {
            SC_STEP(X0, k0); if (k0 + 48 < 512) SC_LOAD(X0, k0 + 48);
            if (k0 + 16 < 512) { SC_STEP(X1, k0 + 16); if (k0 + 64 < 512) SC_LOAD(X1, k0 + 64); }
            if (k0 + 32 < 512) { SC_STEP(X2, k0 + 32); if (k0 + 80 < 512) SC_LOAD(X2, k0 + 80); }
        }
#undef SC_LOAD
#undef SC_STEP
    }
#else
    LAS float* L = (LAS float*)F.lds;
    for (int it = blockIdx.x; it < 256; it += F.G) {
        const int dir = it & 1, g = (it >> 1) & 63, b = it >> 7;
        const float ar = aT[((dir * 64 + g) * 64 + F.lane) * 2], ai = aT[((dir * 64 + g) * 64 + F.lane) * 2 + 1];
        float xr = 0.f, xi = 0.f;
        for (int hh = 0; hh < 2; ++hh) {
            const int cbase = dir == 0 ? 256 * hh : 256 * (1 - hh);
            const size_t row0 = (size_t)g * 1024 + b * 512 + cbase;
            __syncthreads();
            { f32x4 tv[16];
#pragma unroll
            for (int k = 0; k < 16; ++k) { const int idx = F.tid + 512 * k, cl = idx >> 5, q = idx & 31; tv[k] = *(const GAS f32x4*)(S + (row0 + cl) * 256 + dir * 128 + q * 4); }
#pragma unroll
            for (int k = 0; k < 16; ++k) { const int idx = F.tid + 512 * k, cl = idx >> 5, q = idx & 31; *(LAS f32x4*)(L + cl * 128 + q * 4) = tv[k]; } }
            __syncthreads();
            if (F.wave == 0) {
                for (int s0 = 0; s0 < 256; s0 += 8) { float sr[8], si[8];
#pragma unroll
                    for (int q = 0; q < 8; ++q) { const int cl = dir == 0 ? s0 + q : 255 - s0 - q; sr[q] = L[cl * 128 + 2 * F.lane]; si[q] = L[cl * 128 + 2 * F.lane + 1]; }
#pragma unroll
                    for (int q = 0; q < 8; ++q) { const int cl = dir == 0 ? s0 + q : 255 - s0 - q;
                        *(GAS unsigned*)(A2 + (row0 + cl) * 512 + 256 + dir * 128 + 2 * F.lane) = pk2(xr, xi);
                        const float nxr = ar * xr - ai * xi + sr[q], nxi = ar * xi + ai * xr + si[q]; xr = nxr; xi = nxi; } }
            }
        }
        __syncthreads();
    }
#endif
}
template <bool B16> __device__ __forceinline__ f32x4 ld_h(const void* h, int m, int lane, int j) {
    if constexpr (B16) { const v2u w = ((const GAS v2u*)((const bf16*)h + (size_t)m * DM))[lane + 64 * j]; return (f32x4){pg8::bf_lo(w.x), pg8::bf_hi(w.x), pg8::bf_lo(w.y), pg8::bf_hi(w.y)}; }
    else return ((const GAS f32x4*)((const float*)h + (size_t)m * DM))[lane + 64 * j];
}
template <bool B16> __device__ __forceinline__ void st_h(void* h, int m, int lane, int j, const f32x4& v) {
    if constexpr (B16) { v2u o; o.x = pk2(v.x, v.y); o.y = pk2(v.z, v.w); ((GAS v2u*)((bf16*)h + (size_t)m * DM))[lane + 64 * j] = o; }
    else ((GAS f32x4*)((float*)h + (size_t)m * DM))[lane + 64 * j] = v;
}
template <bool HINB> struct RowRaw { v2u mw[4]; v2u hb[4]; f32x4 hf[4]; };
template <bool HINB> __device__ __forceinline__ void row_load(RowRaw<HINB>& r, const void* hin, const bf16* mix, int m, int lane) {
    const GAS v2u* mr = (const GAS v2u*)(mix + (size_t)m * DM) + lane;
#pragma unroll
    for (int j = 0; j < 4; ++j) { r.mw[j] = mr[64 * j];
        if constexpr (HINB) r.hb[j] = ((const GAS v2u*)((const bf16*)hin + (size_t)m * DM))[lane + 64 * j]; else r.hf[j] = ((const GAS f32x4*)((const float*)hin + (size_t)m * DM))[lane + 64 * j]; }
}
template <bool HINB> __device__ __forceinline__ void row_unpack(const RowRaw<HINB>& r, f32x4 (&v)[4], f32x4 (&hv)[4]) {
#pragma unroll
    for (int j = 0; j < 4; ++j) { v[j] = (f32x4){pg8::bf_lo(r.mw[j].x), pg8::bf_hi(r.mw[j].x), pg8::bf_lo(r.mw[j].y), pg8::bf_hi(r.mw[j].y)};
        if constexpr (HINB) hv[j] = (f32x4){pg8::bf_lo(r.hb[j].x), pg8::bf_hi(r.hb[j].x), pg8::bf_lo(r.hb[j].y), pg8::bf_hi(r.hb[j].y)}; else hv[j] = r.hf[j]; }
}
template <bool XF8, bool HINB, bool HOUTB> __device__ __forceinline__ void e_phase(Frame& F, const void* hin, const bf16* mix, const float* gpost, const float* gpre, void* hout, bf16* xn, float* rs_out = nullptr) {
    const int gw = F.vcu * NWAVES + F.wave, NGW = F.G * NWAVES;
    RowRaw<HINB> R[2];
    row_load<HINB>(R[0], hin, mix, gw, F.lane);
#pragma unroll
    for (int k = 0; k < 8; ++k) { const int m = gw + k * NGW;
        if (k + 1 < 8) row_load<HINB>(R[(k + 1) & 1], hin, mix, m + NGW, F.lane);
        f32x4 v[4], hv[4]; float s = 0.f;
        row_unpack<HINB>(R[k & 1], v, hv);
#pragma unroll
        for (int j = 0; j < 4; ++j) s += (v[j].x * v[j].x + v[j].y * v[j].y) + (v[j].z * v[j].z + v[j].w * v[j].w);
        const float r = rsqrtf(wave_sum(s) * (1.f / DM) + EPS); float s2 = 0.f;
#pragma unroll
        for (int j = 0; j < 4; ++j) { const f32x4 g = ((const GAS f32x4*)gpost)[F.lane + 64 * j]; hv[j] = hv[j] + v[j] * r * g; s2 += (hv[j].x * hv[j].x + hv[j].y * hv[j].y) + (hv[j].z * hv[j].z + hv[j].w * hv[j].w); }
#pragma unroll
        for (int j = 0; j < 4; ++j) st_h<HOUTB>(hout, m, F.lane, j, hv[j]);
        if (rs_out) { const float r2 = rsqrtf(wave_sum(s2) * (1.f / DM) + EPS); if (F.lane == 0) rs_out[m] = r2; }
        if (xn) { const float r2 = rsqrtf(wave_sum(s2) * (1.f / DM) + EPS); GAS v2u* o8 = (GAS v2u*)(xn + (size_t)m * DM) + F.lane;
#pragma unroll
            for (int j = 0; j < 4; ++j) { const f32x4 g = ((const GAS f32x4*)gpre)[F.lane + 64 * j];
                if constexpr (XF8) ((GAS unsigned*)((unsigned char*)xn + (size_t)m * DM))[F.lane + 64 * j] = pg8::pack4_fp8(hv[j].x * r2 * g.x * 4.f, hv[j].y * r2 * g.y * 4.f, hv[j].z * r2 * g.z * 4.f, hv[j].w * r2 * g.w * 4.f);
                else { v2u o; o.x = pk2(hv[j].x * r2 * g.x, hv[j].y * r2 * g.y); o.y = pk2(hv[j].z * r2 * g.z, hv[j].w * r2 * g.w); o8[64 * j] = o; } } }
    }
}
__device__ __forceinline__ void e3_phase(Frame& F, const void* hin, const bf16* mix, const float* gpost, const float* gpre, void* hout, bf16* xn, const float* wrouter, unsigned char* ws) {
    LAS float* WL = (LAS float*)F.lds;
    LAS int* RI = (LAS int*)(F.lds + 32768);
    for (int idx = F.tid; idx < 8192; idx += 512) WL[(idx & 7) * 1024 + (idx >> 3)] = wrouter[idx];
    if (F.tid < 8) RI[320 + F.tid] = 0;
    __syncthreads();
    const int gw = F.vcu * NWAVES + F.wave, NGW = F.G * NWAVES;
    RowRaw<true> R[2];
    row_load<true>(R[0], hin, mix, gw, F.lane);
#pragma unroll
    for (int k = 0; k < 8; ++k) { const int m = gw + k * NGW;
        if (k + 1 < 8) row_load<true>(R[(k + 1) & 1], hin, mix, m + NGW, F.lane);
        f32x4 v[4], hv[4]; float s = 0.f;
        row_unpack<true>(R[k & 1], v, hv);
#pragma unroll
        for (int j = 0; j < 4; ++j) s += (v[j].x * v[j].x + v[j].y * v[j].y) + (v[j].z * v[j].z + v[j].w * v[j].w);
        const float r = rsqrtf(wave_sum(s) * (1.f / DM) + EPS); float s2 = 0.f;
#pragma unroll
        for (int j = 0; j < 4; ++j) { const f32x4 g = ((const GAS f32x4*)gpost)[F.lane + 64 * j]; hv[j] = hv[j] + v[j] * r * g; s2 += (hv[j].x * hv[j].x + hv[j].y * hv[j].y) + (hv[j].z * hv[j].z + hv[j].w * hv[j].w); }
#pragma unroll
        for (int j = 0; j < 4; ++j) st_h<true>(hout, m, F.lane, j, hv[j]);
        const float r2 = rsqrtf(wave_sum(s2) * (1.f / DM) + EPS); GAS v2u* o8 = (GAS v2u*)(xn + (size_t)m * DM) + F.lane;
        float lg[8];
#pragma unroll
        for (int e = 0; e < 8; ++e) lg[e] = 0.f;
#pragma unroll
        for (int j = 0; j < 4; ++j) { const f32x4 g = ((const GAS f32x4*)gpre)[F.lane + 64 * j]; const f32x4 xf = hv[j] * r2 * g;
#if MOE_FP8
            ((GAS unsigned*)((unsigned char*)xn + (size_t)m * DM))[F.lane + 64 * j] = pg8::pack4_fp8(xf.x * 4.f, xf.y * 4.f, xf.z * 4.f, xf.w * 4.f);
#else
            v2u o; o.x = pk2(xf.x, xf.y); o.y = pk2(xf.z, xf.w); o8[64 * j] = o;
#endif
#pragma unroll
            for (int e = 0; e < 8; ++e) { const f32x4 w = *(const LAS f32x4*)(WL + e * 1024 + 4 * (F.lane + 64 * j)); lg[e] += (xf.x * w.x + xf.y * w.y) + (xf.z * w.z + xf.w * w.w); } }
#pragma unroll
        for (int e = 0; e < 8; ++e) lg[e] = wave_sum(lg[e]);
        int e0 = 0; float l0 = lg[0];
#pragma unroll
        for (int e = 1; e < 8; ++e) if (lg[e] > l0) { l0 = lg[e]; e0 = e; }
        int e1 = -1; float l1 = -INFINITY;
#pragma unroll
        for (int e = 0; e < 8; ++e) if (e != e0 && lg[e] > l1) { l1 = lg[e]; e1 = e; }
        const float w0 = 1.f / (1.f + expf(l1 - l0));
        if (F.lane == 0) { const int sl = F.wave * 8 + k; RI[sl] = e0 | (e1 << 8); RI[64 + sl] = (int)__float_as_uint(w0); RI[128 + sl] = m; }
    }
    __syncthreads();
    if (F.tid < 64) { const int ee = RI[F.tid]; RI[192 + F.tid] = __hip_atomic_fetch_add(&RI[320 + (ee & 255)], 1, __ATOMIC_RELAXED, __HIP_MEMORY_SCOPE_WORKGROUP); RI[256 + F.tid] = __hip_atomic_fetch_add(&RI[320 + (ee >> 8)], 1, __ATOMIC_RELAXED, __HIP_MEMORY_SCOPE_WORKGROUP); }
    __syncthreads();
    if (F.tid < 8) RI[328 + F.tid] = (int)__hip_atomic_fetch_add(F.ctl + CW_CNT + 64 * F.tid, (unsigned)RI[320 + F.tid], RLX_AGENT);
    __syncthreads();
    if (F.tid < 64) { const int ee = RI[F.tid], e0 = ee & 255, e1 = ee >> 8, tok = RI[128 + F.tid];
        const int p0 = RI[328 + e0] + RI[192 + F.tid], p1 = RI[328 + e1] + RI[256 + F.tid];
        int* lists = (int*)(ws + WS_LIST); lists[e0 * NTOK + p0] = tok; lists[e1 * NTOK + p1] = tok;
        v4u ti; ti.x = (unsigned)ee; ti.y = (unsigned)p0; ti.z = (unsigned)p1; ti.w = (unsigned)RI[64 + F.tid];
        *(GAS v4u*)(ws + WS_TOKINFO + (size_t)tok * 16) = ti; }
    __syncthreads();
}
__device__ __forceinline__ void moe_table(Frame& F) {
    volatile LAS int* misc = (volatile LAS int*)(F.lds + MOE_OFF);
    __syncthreads();
    if (F.tid == 0) { int t = 0;
        for (int e = 0; e < 8; ++e) { const int c = (int)__hip_atomic_load(F.ctl + CW_CNT + 64 * e, RLX_AGENT); misc[e] = t; misc[16 + e] = c; t += (c + 255) >> 8; }
        misc[8] = t;
        const int first_rem = (t >> 6) << 6, urem = 4 * (t - first_rem);
        const int parts = urem == 0 ? 1 : (urem * 7 <= 256 ? 7 : (urem * 2 <= 256 ? 2 : 1));
        misc[9] = parts; misc[10] = parts == 1 ? t : first_rem; misc[11] = parts == 1 ? 0 : urem * parts; }
    __syncthreads();
}
__device__ __forceinline__ void e4_phase(Frame& F, const void* hin, const float* gpost, float* hout, unsigned char* ws) {
    volatile LAS int* misc = (volatile LAS int*)(F.lds + MOE_OFF);
    const bf16* SO = (const bf16*)(ws + WS_SLOT);
    const int gw = F.vcu * NWAVES + F.wave, NGW = F.G * NWAVES;
    const int first_rem = misc[10], parts = misc[9];
    v4u ti[8];
#pragma unroll
    for (int k = 0; k < 8; ++k) ti[k] = *(const GAS v4u*)(ws + WS_TOKINFO + (size_t)(gw + k * NGW) * 16);
    struct Raw4 { v2u a[4], b[4], h[4]; int slot0, slot1; };
    Raw4 R[2];
#define E4_ISSUE(RR, k) do { const v4u t_ = ti[k]; const int m_ = gw + (k) * NGW; \
        (RR).slot0 = __builtin_amdgcn_readfirstlane(misc[t_.x & 255] * 256 + (int)t_.y); (RR).slot1 = __builtin_amdgcn_readfirstlane(misc[(t_.x >> 8) & 255] * 256 + (int)t_.z); \
        const bool s0_ = ((RR).slot0 >> 8) >= first_rem, s1_ = ((RR).slot1 >> 8) >= first_rem; \
        const GAS v2u* a8_ = (const GAS v2u*)(SO + (size_t)(s0_ ? 0 : (RR).slot0) * DM) + F.lane; const GAS v2u* b8_ = (const GAS v2u*)(SO + (size_t)(s1_ ? 0 : (RR).slot1) * DM) + F.lane; \
        const GAS v2u* h8_ = (const GAS v2u*)((const bf16*)hin + (size_t)m_ * DM) + F.lane; \
        _Pragma("unroll") for (int j = 0; j < 4; ++j) { (RR).a[j] = a8_[64 * j]; (RR).b[j] = b8_[64 * j]; (RR).h[j] = h8_[64 * j]; } } while (0)
    E4_ISSUE(R[0], 0);
#pragma unroll
    for (int k = 0; k < 8; ++k) { const int m = gw + k * NGW;
        if (k + 1 < 8) E4_ISSUE(R[(k + 1) & 1], k + 1);
        const Raw4& C = R[k & 1];
        const float w0 = __uint_as_float(ti[k].w), w1 = 1.f - w0;
        const int slot0 = C.slot0, slot1 = C.slot1;
        const bool sp0 = (slot0 >> 8) >= first_rem, sp1 = (slot1 >> 8) >= first_rem;
        const float wa = sp0 ? 0.f : w0, wb = sp1 ? 0.f : w1;
        f32x4 v[4], hv[4]; float s = 0.f;
#pragma unroll
        for (int j = 0; j < 4; ++j) { const v2u a = C.a[j], b = C.b[j], hh = C.h[j]; hv[j] = (f32x4){pg8::bf_lo(hh.x), pg8::bf_hi(hh.x), pg8::bf_lo(hh.y), pg8::bf_hi(hh.y)};
            v[j].x = wa * pg8::bf_lo(a.x) + wb * pg8::bf_lo(b.x); v[j].y = wa * pg8::bf_hi(a.x) + wb * pg8::bf_hi(b.x); v[j].z = wa * pg8::bf_lo(a.y) + wb * pg8::bf_lo(b.y); v[j].w = wa * pg8::bf_hi(a.y) + wb * pg8::bf_hi(b.y); }
        if (sp0 || sp1) {
            const bf16* PT = (const bf16*)(ws + WS_PART);
#pragma unroll
            for (int kk = 0; kk < 2; ++kk) { const bool sp = kk == 0 ? sp0 : sp1; const int slot = kk == 0 ? slot0 : slot1; const float w = kk == 0 ? w0 : w1;
                if (sp) { const int pm = slot >> 8, rr = slot & 255;
#pragma unroll
                    for (int j = 0; j < 4; ++j) { f32x4 acc = (f32x4){0.f, 0.f, 0.f, 0.f};
                        for (int p = 0; p < parts; ++p) { const v2u a = *((const GAS v2u*)(PT + ((size_t)(((pm - first_rem) * 4 + j) * parts + p) * 65536 + (size_t)rr * 256)) + F.lane);
                            acc.x += pg8::bf_lo(a.x); acc.y += pg8::bf_hi(a.x); acc.z += pg8::bf_lo(a.y); acc.w += pg8::bf_hi(a.y); }
                        v[j] = v[j] + acc * w; } } }
        }
#pragma unroll
        for (int j = 0; j < 4; ++j) s += (v[j].x * v[j].x + v[j].y * v[j].y) + (v[j].z * v[j].z + v[j].w * v[j].w);
        const float r = rsqrtf(wave_sum(s) * (1.f / DM) + EPS);
        GAS f32x4* ho = (GAS f32x4*)(hout + (size_t)m * DM) + F.lane;
#pragma unroll
        for (int j = 0; j < 4; ++j) { const f32x4 g = ((const GAS f32x4*)gpost)[F.lane + 64 * j]; ho[64 * j] = hv[j] + v[j] * r * g; }
    }
#undef E4_ISSUE
}

#ifndef FLAT_BAR
#define FLAT_BAR 0
#endif
constexpr int FB_REPL = 8, CW_FB = 12288, CW_FBTMO = 12288 + 64 * 8;
struct FlatBar { gu32* ctl; unsigned epoch; };
__device__ __forceinline__ void flat_barrier(FlatBar& fb) {
    asm volatile("s_waitcnt vmcnt(0)" ::: "memory");
    __syncthreads();
    fb.epoch += 1u;
    if (threadIdx.x < 64) {
        const unsigned lane = threadIdx.x;
        __builtin_amdgcn_fence(__ATOMIC_RELEASE, "agent");
        asm volatile("s_waitcnt vmcnt(0)" ::: "memory");
        if (lane < FB_REPL) (void)__hip_atomic_fetch_add(fb.ctl + CW_FB + 64 * lane, 1u, RLX_AGENT);
        const unsigned target = fb.epoch * gridDim.x;
        gu32* mine = fb.ctl + CW_FB + 64 * (blockIdx.x % FB_REPL);
        unsigned sp = 0;
        while ((unsigned)__builtin_amdgcn_readfirstlane(__hip_atomic_load(mine, RLX_AGENT)) < target) {
            __builtin_amdgcn_s_sleep(1);
            if ((++sp & 1023u) == 0u) { if (__hip_atomic_load(fb.ctl + CW_FBTMO, RLX_AGENT) != 0u) break; if (sp > (1u << 20)) { if (lane == 0) __hip_atomic_store(fb.ctl + CW_FBTMO, 1u, RLX_AGENT); break; } }
        }
        __builtin_amdgcn_fence(__ATOMIC_ACQUIRE, "agent");
        asm volatile("s_waitcnt vmcnt(0)" ::: "memory");
    }
    __syncthreads();
}

#ifndef XB2
#define XB2 0
#endif
constexpr int CW_XB2 = 13312;
__device__ __forceinline__ void xcd_barrier2(const XcdBarrier& b, gu32* ctl) {
    asm volatile("s_waitcnt vmcnt(0)" ::: "memory");
    __syncthreads();
    if (threadIdx.x < 64) {
        unsigned* bar = b.bar; const unsigned lane = threadIdx.x;
        unsigned nloc = 1u, nx = 1u, old = 0u;
        if (lane == 0) {
            __builtin_amdgcn_s_waitcnt(0);
            nloc = b.st[0]; nx = b.st[1];
            if (nloc == 0u) { xcd_barrier_complete(bar, b.x, nloc, nx); b.st[0] = nloc; b.st[1] = nx; }
            old = xb_add(&bar[XB_XSUB(b.x)], 1u);
        }
        nloc = (unsigned)__builtin_amdgcn_readfirstlane((int)nloc); nx = (unsigned)__builtin_amdgcn_readfirstlane((int)nx); old = (unsigned)__builtin_amdgcn_readfirstlane((int)old);
        const unsigned gen = old / nloc;
        if (old + 1u == (gen + 1u) * nloc) {
            __builtin_amdgcn_fence(__ATOMIC_RELEASE, "agent");
            asm volatile("s_waitcnt vmcnt(0)" ::: "memory");
            if (lane < 8u) (void)__hip_atomic_fetch_add(ctl + CW_XB2 + 64 * lane, 1u, RLX_AGENT);
        }
        const unsigned target = (gen + 1u) * nx;
        gu32* mine = ctl + CW_XB2 + 64 * (blockIdx.x & 7u);
        unsigned sp = 0u;
        while ((unsigned)__builtin_amdgcn_readfirstlane((int)__hip_atomic_load(mine, RLX_AGENT)) < target) {
            __builtin_amdgcn_s_sleep(1);
            if ((++sp & 255u) == 0u) { if (xb_ld(&bar[XB_TMO])) break; if (sp > XB_SPIN_CAP) { if (lane == 0) atomicAdd(&bar[XB_TMO], 1u); break; } }
        }
        __builtin_amdgcn_fence(__ATOMIC_ACQUIRE, "agent");
        asm volatile("s_waitcnt vmcnt(0)" ::: "memory");
    }
    __syncthreads();
}

struct Args { const float* in[24]; float* out; unsigned char* ws; int ph_lo, ph_hi; };
__global__ void __launch_bounds__(NWAVES * 64, 2) mega_fwd(Args args) {
    extern __shared__ __attribute__((aligned(16))) unsigned char lds[];
    Frame F;
    F.lds = (LAS unsigned char*)lds;
    F.MISC = (volatile LAS unsigned*)(F.lds + MISC_OFF);
    F.tid = threadIdx.x; F.lane = F.tid & 63; F.wave = __builtin_amdgcn_readfirstlane(F.tid >> 6);
    F.G = gridDim.x; { const int bx = blockIdx.x; F.vcu = (F.G % 8 == 0) ? (bx % 8) * (F.G / 8) + bx / 8 : bx; }
    unsigned char* ws = args.ws;
    F.ctl = (gu32*)(ws + WS_CTL);
    for (int u = F.tid; u < (LDS_BYTES - LDSCTL_OFF) / 4; u += NWAVES * 64) ((LAS unsigned*)(F.lds + LDSCTL_OFF))[u] = 0u;
    __syncthreads();
#if FLAT_BAR
    FlatBar bar{F.ctl, 0u};
#define xcd_barrier(b) flat_barrier(b)
#else
    XcdBarrier bar = xcd_barrier_post((unsigned*)(F.ctl + CW_BAR), F.MISC + 8);
#if XB2
#define xcd_barrier(b) xcd_barrier2(b, F.ctl)
#endif
#endif
    const int lo = args.ph_lo, hi = args.ph_hi;
#ifndef PHMASK
#define PHMASK 0x3ffff
#endif
#define IN(k) (((PHMASK >> (k)) & 1) && lo <= (k) && (k) < hi)
#define SEAM(k) do { if (IN(k) && IN((k) + 1)) xcd_barrier(bar); } while (0)
#ifndef DUPMASK
#define DUPMASK 0
#endif
#define REP(k) _Pragma("unroll") for (int rep_ = 0; rep_ < (((DUPMASK) >> (k)) & 1) + 1; ++rep_)
#define REPBAR() do { if (rep_) xcd_barrier(bar); } while (0)
    const float* const* in = args.in;
    const float* gains = in[1];
    float* hbuf = args.out; void* HB = (void*)(ws + WS_HB);
    bf16* XN = (bf16*)(ws + WS_XN); bf16* MIX = (bf16*)(ws + WS_MIX);
    const int BIG = 1 << 30;
    using pg8::ProbPlain; using pg8::ProbMoE;

    if (IN(0)) REP(0) { REPBAR(); p0_prologue(F, in, ws); } SEAM(0);
#if defined(XTRA_BAR) && XTRA_BAR
    for (int xb_ = 0; xb_ < XTRA_BAR; ++xb_) xcd_barrier(bar);
#endif
    if (IN(1)) REP(1) { REPBAR();
        ProbPlain P{NORM_FACTOR ? (const char*)HB : (const char*)XN, (const char*)(ws + WS_BT_IN), 1024, 2048u, 2048u, 0, BIG, {}}; P.S.init(64, 4, F.G, (int)blockIdx.x);
        pg8::EpiU E{(pg8::bf16_t*)(ws + WS_A2), NORM_FACTOR ? (const float*)(ws + WS_RSTD) : (const float*)nullptr};
        pg8::gemm_phase<ProbPlain, pg8::EpiU, true, true>(F.lds + RING_OFF, P, E);
    } SEAM(1);
    if (IN(2)) REP(2) { REPBAR();
        ProbPlain P{(const char*)(ws + WS_A2), (const char*)(ws + WS_S5_STATE), 256, 1024u, 512u, (size_t)256 * 256 * 2, 4, {}}; P.S.init(256, 1, F.G, (int)blockIdx.x);
        pg8::EpiF32 E{(float*)(ws + WS_S), 256};
        pg8::gemm_phase<ProbPlain, pg8::EpiF32, true, true>(F.lds + RING_OFF, P, E);
    } SEAM(2);
    if (IN(3)) REP(3) { REPBAR(); scan_phase(F, in, ws); } SEAM(3);
    if (IN(4)) REP(4) { REPBAR();
        ProbPlain P{(const char*)(ws + WS_A2), (const char*)(ws + WS_S5_MAIN), 512, 1024u, 1024u, (size_t)256 * 512 * 2, 4, {}}; P.S.init(256, 1, F.G, (int)blockIdx.x);
        pg8::EpiY E{(pg8::bf16_t*)(ws + WS_G1)};
        pg8::gemm_phase<ProbPlain, pg8::EpiY, true, true>(F.lds + RING_OFF, P, E);
    } SEAM(4);
    if (IN(5)) REP(5) { REPBAR();
        ProbPlain P{(const char*)(ws + WS_G1), (const char*)(ws + WS_BT_GLU), 1024, 2048u, 2048u, 0, BIG, {}}; P.S.init(64, 4, F.G, (int)blockIdx.x);
        pg8::EpiGlu E{(const pg8::bf16_t*)(ws + WS_G1), (pg8::bf16_t*)(ws + WS_G2)};
        pg8::gemm_phase<ProbPlain, pg8::EpiGlu, true, true>(F.lds + RING_OFF, P, E);
    } SEAM(5);
    if (IN(6)) REP(6) { REPBAR();
        ProbPlain P{(const char*)(ws + WS_G2), (const char*)(ws + WS_BT_SOUT), 1024, 2048u, 2048u, 0, BIG, {}}; P.S.init(64, 4, F.G, (int)blockIdx.x);
        pg8::EpiBf16 E{MIX, 1024, 1.f};
        pg8::gemm_phase<ProbPlain, pg8::EpiBf16, true, true>(F.lds + RING_OFF, P, E);
    } SEAM(6);
#if NORM_FACTOR
    if (IN(7)) REP(7) { REPBAR(); e_phase<false, true, true>(F, HB, MIX, gains + 1 * DM, gains + 2 * DM, HB, nullptr, (float*)(ws + WS_RSTD) + NTOK); } SEAM(7);
#else
    if (IN(7)) REP(7) { REPBAR(); e_phase<FFN_FP8 != 0, false, true>(F, in[0], MIX, gains + 1 * DM, gains + 2 * DM, HB, XN); } SEAM(7);
#endif
    if (IN(8)) REP(8) { REPBAR();
#if FFN_FP8
        ProbPlain P{(const char*)XN, (const char*)(ws + WS_BT_GU), 512, 1024u, 1024u, 0, BIG, {}}; P.S.init(64, 22, F.G, (int)blockIdx.x);
        pg8::EpiSwigluF8 E{(unsigned char*)(ws + WS_ACTF), DFF, 1.f / 256.f, 8.f};
        pg8::gemm_phase<ProbPlain, pg8::EpiSwigluF8, true, true, true>(F.lds + RING_OFF, P, E);
#else
        ProbPlain P{NORM_FACTOR ? (const char*)HB : (const char*)XN, (const char*)(ws + WS_BT_GU), 1024, 2048u, 2048u, 0, BIG, {}}; P.S.init(64, 22, F.G, (int)blockIdx.x, FFN_WGM);
        pg8::EpiSwiglu E{(pg8::bf16_t*)(ws + WS_ACTF), DFF, NORM_FACTOR ? (const float*)(ws + WS_RSTD) + NTOK : (const float*)nullptr};
#if defined(DEPHASE8) && DEPHASE8
        if (((int)blockIdx.x >> 3) & 1) { _Pragma("unroll") for (int d_ = 0; d_ < DEPHASE8; ++d_) __builtin_amdgcn_s_sleep(127); }
#endif
        pg8::gemm_phase<ProbPlain, pg8::EpiSwiglu, true, true>(F.lds + RING_OFF, P, E);
#endif
        if (F.G == 256 && blockIdx.x >= 128) convert_range(in, ws, (LAS unsigned*)(F.lds + RING_OFF + F.wave * 16384), F.lane, T_ISMALL + CVT_S1, T_ISMALL + CVT_S2, ((int)blockIdx.x - 128) * NWAVES + F.wave, 128 * NWAVES);
    } SEAM(8);
    if (IN(9)) REP(9) { REPBAR();
#if FFN_FP8
        ProbPlain P{(const char*)(ws + WS_ACTF), (const char*)(ws + WS_BT_FD), DFF / 2, (unsigned)DFF, (unsigned)DFF, 0, BIG, {}}; P.S.init(64, 4, F.G, (int)blockIdx.x);
        pg8::EpiBf16 E{MIX, 1024, 1.f / 512.f};
        pg8::gemm_phase<ProbPlain, pg8::EpiBf16, true, true, true>(F.lds + RING_OFF, P, E);
#else
        ProbPlain P{(const char*)(ws + WS_ACTF), (const char*)(ws + WS_BT_FD), DFF, (unsigned)DFF * 2u, (unsigned)DFF * 2u, 0, BIG, {}}; P.S.init(64, 4, F.G, (int)blockIdx.x);
        pg8::EpiBf16 E{MIX, 1024, 1.f};
        pg8::gemm_phase<ProbPlain, pg8::EpiBf16, true, true>(F.lds + RING_OFF, P, E);
#endif
    } SEAM(9);
    if (IN(10)) REP(10) { REPBAR(); e_phase<false, true, true>(F, HB, MIX, gains + 3 * DM, gains + 4 * DM, HB, NORM_FACTOR ? (bf16*)nullptr : XN, NORM_FACTOR ? (float*)(ws + WS_RSTD) + 2 * NTOK : (float*)nullptr); } SEAM(10);
    if (IN(11)) REP(11) { REPBAR();
        ProbPlain P{NORM_FACTOR ? (const char*)HB : (const char*)XN, (const char*)(ws + WS_BT_QKV), 1024, 2048u, 2048u, 0, BIG, {}}; P.S.init(64, 6, F.G, (int)blockIdx.x);
        pg8::EpiQKV E{(pg8::bf16_t*)(ws + WS_Q), (unsigned)((WS_K - WS_Q) / 2), (unsigned)((WS_V - WS_Q) / 2), (const float*)(ws + WS_QKG), (const float4*)(ws + WS_ROPE_R), QSCALE, NORM_FACTOR ? (const float*)(ws + WS_RSTD) + 2 * NTOK : (const float*)nullptr};
        pg8::gemm_phase<ProbPlain, pg8::EpiQKV, true, true>(F.lds + RING_OFF, P, E);
        if (F.G == 256 && blockIdx.x >= 128) convert_range(in, ws, (LAS unsigned*)(F.lds + RING_OFF + F.wave * 16384), F.lane, T_ISMALL + CVT_S2, T_NITEMS, ((int)blockIdx.x - 128) * NWAVES + F.wave, 128 * NWAVES);
    } SEAM(11);
    if (IN(12)) REP(12) { REPBAR();
        static_assert(attn_body::ATTN_LDS_BYTES <= RING_BYTES, "attention body LDS");
        const attn_body::AttnTensors AT{(const attn_body::bf16*)(ws + WS_Q), (const attn_body::bf16*)(ws + WS_K), (const attn_body::bf16*)(ws + WS_V), (attn_body::bf16*)(ws + WS_O)};
        const attn_body::StaticOrder S((int)F.G, (int)blockIdx.x);
        float gq = fabsf(((const float*)(ws + WS_QKG))[F.lane]), gk = fabsf(((const float*)(ws + WS_QKG))[64 + F.lane]);
#pragma unroll
        for (int o = 1; o < 64; o <<= 1) { gq = fmaxf(gq, __shfl_xor(gq, o)); gk = fmaxf(gk, __shfl_xor(gk, o)); }
        const float refB = 11.55f * 1.02f * gq * gk;
        if (__builtin_amdgcn_readfirstlane(__float_as_uint(refB)) <= __float_as_uint(60.f)) attn_body::attn_phase<attn_body::StaticOrder, true>((char*)lds + RING_OFF, AT, S, refB);
        else attn_body::attn_phase<attn_body::StaticOrder, false>((char*)lds + RING_OFF, AT, S, 0.f);
    } SEAM(12);
    if (IN(13)) REP(13) { REPBAR();
        ProbPlain P{(const char*)(ws + WS_O), (const char*)(ws + WS_BT_AO), 1024, 2048u, 2048u, 0, BIG, {}}; P.S.init(64, 4, F.G, (int)blockIdx.x);
        pg8::EpiBf16 E{MIX, 1024, 1.f};
        pg8::gemm_phase<ProbPlain, pg8::EpiBf16, true, true>(F.lds + RING_OFF, P, E);
    } SEAM(13);
    if (IN(14)) REP(14) { REPBAR(); e3_phase(F, HB, MIX, gains + 5 * DM, gains + 6 * DM, HB, XN, in[20], ws); } SEAM(14);
    if (IN(15)) REP(15) { REPBAR();
        moe_table(F);
        volatile LAS int* misc = (volatile LAS int*)(F.lds + MOE_OFF);
#if MOE_FP8
        ProbMoE P{(const char*)XN, (const char*)(ws + WS_BT_MGU), 512, 1024u, 1024u, (size_t)7168 * 1024, {}, (const int*)(ws + WS_LIST), misc, true}; P.S.init(misc[8], 28, F.G, (int)blockIdx.x, MOE_WGM);
        pg8::EpiSwigluF8 E{(unsigned char*)(ws + WS_ACTM), DFE, 1.f / 256.f, 8.f};
#if defined(DEPHASE15) && DEPHASE15
        if (((int)blockIdx.x >> 3) & 1) { _Pragma("unroll") for (int d_ = 0; d_ < DEPHASE15; ++d_) __builtin_amdgcn_s_sleep(127); }
#endif
        pg8::gemm_phase<ProbMoE, pg8::EpiSwigluF8, P15_ALIGN, P15_SP2, true>(F.lds + RING_OFF, P, E);
#else
        ProbMoE P{(const char*)XN, (const char*)(ws + WS_BT_MGU), 1024, 2048u, 2048u, (size_t)7168 * 1024 * 2, {}, (const int*)(ws + WS_LIST), misc, true}; P.S.init(misc[8], 28, F.G, (int)blockIdx.x);
        pg8::EpiSwiglu E{(pg8::bf16_t*)(ws + WS_ACTM), DFE, nullptr};
        pg8::gemm_phase<ProbMoE, pg8::EpiSwiglu, true, true>(F.lds + RING_OFF, P, E);
#endif
    } SEAM(15);
    if (IN(16)) REP(16) { REPBAR();
        moe_table(F);
        volatile LAS int* misc = (volatile LAS int*)(F.lds + MOE_OFF);
#if MOE_FP8
        ProbMoE P{(const char*)(ws + WS_ACTM), (const char*)(ws + WS_BT_MD), DFE / 2, (unsigned)DFE, (unsigned)DFE, (size_t)1024 * 3584, {}, (const int*)(ws + WS_LIST), misc, false}; P.S.init(misc[8], 4, F.G, (int)blockIdx.x);
        pg8::EpiMoeDown E{(pg8::bf16_t*)(ws + WS_SLOT), (pg8::bf16_t*)(ws + WS_PART), 1.f / 512.f};
        pg8::gemm_phase<ProbMoE, pg8::EpiMoeDown, true, true, true>(F.lds + RING_OFF, P, E);
#else
        ProbMoE P{(const char*)(ws + WS_ACTM), (const char*)(ws + WS_BT_MD), DFE, (unsigned)DFE * 2u, (unsigned)DFE * 2u, (size_t)1024 * 3584 * 2, {}, (const int*)(ws + WS_LIST), misc, false}; P.S.init(misc[8], 4, F.G, (int)blockIdx.x);
        pg8::EpiMoeDown E{(pg8::bf16_t*)(ws + WS_SLOT), (pg8::bf16_t*)(ws + WS_PART), 1.f};
        pg8::gemm_phase<ProbMoE, pg8::EpiMoeDown, true, true>(F.lds + RING_OFF, P, E);
#endif
    } SEAM(16);
    if (IN(17)) REP(17) { REPBAR(); moe_table(F); e4_phase(F, HB, gains + 7 * DM, hbuf, ws); }
#undef IN
#undef SEAM
#if FLAT_BAR || XB2
#undef xcd_barrier
#endif
}


#ifndef CUT
#define CUT 0
#endif
#if CUT
namespace nv {
__device__ __forceinline__ float sigmoidf_(float x) { return 1.f / (1.f + __expf(-x)); }
__device__ __forceinline__ float gelu_tanh(float x) { return x * sigmoidf_(1.5957691216057308f * (x + 0.044715f * x * x * x)); }

__global__ void rms_k(const float* __restrict__ x, const float* __restrict__ gain, float* __restrict__ out) {
    const int row = blockIdx.x * 4 + (threadIdx.x >> 6), lane = threadIdx.x & 63;
    const float4* xr = (const float4*)(x + (size_t)row * DM);
    float4 v[4]; float s = 0.f;
#pragma unroll
    for (int j = 0; j < 4; ++j) { v[j] = xr[lane + 64 * j]; s += v[j].x * v[j].x + v[j].y * v[j].y + v[j].z * v[j].z + v[j].w * v[j].w; }
    const float r = rsqrtf(wave_sum(s) * (1.f / DM) + EPS);
    float4* o = (float4*)(out + (size_t)row * DM);
#pragma unroll
    for (int j = 0; j < 4; ++j) { const float4 g = ((const float4*)gain)[lane + 64 * j]; o[lane + 64 * j] = make_float4(v[j].x * r * g.x, v[j].y * r * g.y, v[j].z * r * g.z, v[j].w * r * g.w); }
}
__global__ void resnorm_k(const float* h, const float* __restrict__ mix, const float* __restrict__ gpost, const float* __restrict__ gpre, float* hout, float* __restrict__ xn) {
    const int row = blockIdx.x * 4 + (threadIdx.x >> 6), lane = threadIdx.x & 63;
    const float4* mr = (const float4*)(mix + (size_t)row * DM); const float4* hr = (const float4*)(h + (size_t)row * DM);
    float4 v[4], hv[4]; float s = 0.f;
#pragma unroll
    for (int j = 0; j < 4; ++j) { v[j] = mr[lane + 64 * j]; hv[j] = hr[lane + 64 * j]; s += v[j].x * v[j].x + v[j].y * v[j].y + v[j].z * v[j].z + v[j].w * v[j].w; }
    const float r = rsqrtf(wave_sum(s) * (1.f / DM) + EPS);
    float s2 = 0.f;
#pragma unroll
    for (int j = 0; j < 4; ++j) { const float4 g = ((const float4*)gpost)[lane + 64 * j];
        hv[j].x += v[j].x * r * g.x; hv[j].y += v[j].y * r * g.y; hv[j].z += v[j].z * r * g.z; hv[j].w += v[j].w * r * g.w;
        s2 += hv[j].x * hv[j].x + hv[j].y * hv[j].y + hv[j].z * hv[j].z + hv[j].w * hv[j].w; }
    float4* ho = (float4*)(hout + (size_t)row * DM);
#pragma unroll
    for (int j = 0; j < 4; ++j) ho[lane + 64 * j] = hv[j];
    if (xn) {
        const float r2 = rsqrtf(wave_sum(s2) * (1.f / DM) + EPS);
        float4* o = (float4*)(xn + (size_t)row * DM);
#pragma unroll
        for (int j = 0; j < 4; ++j) { const float4 g = ((const float4*)gpre)[lane + 64 * j]; o[lane + 64 * j] = make_float4(hv[j].x * r2 * g.x, hv[j].y * r2 * g.y, hv[j].z * r2 * g.z, hv[j].w * r2 * g.w); }
    }
}

struct EpiArgs { float* C; int ldc; int pad0; const float* aux; int ldaux; int pad1; const int* list; const float* wl; const int* cnt;
  EpiArgs(float* C_, int ldc_, const float* aux_, int ldaux_, const int* l, const float* w, const int* c) : C(C_), ldc(ldc_), pad0(0), aux(aux_), ldaux(ldaux_), pad1(0), list(l), wl(w), cnt(c) {} };
template <int EPI, bool GATHER>
__global__ __launch_bounds__(256) void gemm_k(const float* __restrict__ A, int lda, const float* __restrict__ W, int ldw, int M, int N, int K, EpiArgs ea) {
    __shared__ float As[8][132]; __shared__ float Bs[8][132];
    const int m_lim = ea.cnt ? *ea.cnt : M;
    const int bm = blockIdx.y * 128, bn = blockIdx.x * 128;
    if (bm >= m_lim) return;
    const int tid = threadIdx.x, tx = tid & 15, ty = tid >> 4;
    const int arow = bm + (tid >> 1);
    const int srow = (arow < m_lim) ? (GATHER ? ea.list[arow] : arow) : (GATHER ? ea.list[0] : 0);
    const float* ap = A + (size_t)srow * lda + (tid & 1) * 4;
    const float* bp = W + (size_t)(tid >> 5) * ldw + bn + (tid & 31) * 4;
    float acc[8][8];
#pragma unroll
    for (int i = 0; i < 8; ++i)
#pragma unroll
        for (int j = 0; j < 8; ++j) acc[i][j] = 0.f;
    for (int k0 = 0; k0 < K; k0 += 8) {
        const float4 av = *(const float4*)(ap + k0);
        const float4 bv = *(const float4*)(bp + (size_t)k0 * ldw);
        __syncthreads();
        As[(tid & 1) * 4 + 0][tid >> 1] = av.x; As[(tid & 1) * 4 + 1][tid >> 1] = av.y; As[(tid & 1) * 4 + 2][tid >> 1] = av.z; As[(tid & 1) * 4 + 3][tid >> 1] = av.w;
        *(float4*)&Bs[tid >> 5][(tid & 31) * 4] = bv;
        __syncthreads();
#pragma unroll
        for (int k = 0; k < 8; ++k) {
            float a[8], b[8];
            *(float4*)&a[0] = *(const float4*)&As[k][ty * 8]; *(float4*)&a[4] = *(const float4*)&As[k][ty * 8 + 4];
            *(float4*)&b[0] = *(const float4*)&Bs[k][tx * 8]; *(float4*)&b[4] = *(const float4*)&Bs[k][tx * 8 + 4];
#pragma unroll
            for (int i = 0; i < 8; ++i)
#pragma unroll
                for (int j = 0; j < 8; ++j) acc[i][j] = fmaf(a[i], b[j], acc[i][j]);
        }
    }
#pragma unroll
    for (int i = 0; i < 8; ++i) {
        const int row = bm + ty * 8 + i;
        if (row >= m_lim) continue;
        int tok = 0; float wgt = 0.f;
        if (EPI == 3) { tok = ea.list[row]; wgt = ea.wl[row]; }
#pragma unroll
        for (int j = 0; j < 8; ++j) {
            const int col = bn + tx * 8 + j; const float v = acc[i][j];
            if (EPI == 0) ea.C[(size_t)row * ea.ldc + col] = v;
            else if (EPI == 1) ea.C[(size_t)row * ea.ldc + col] = ea.aux[(size_t)row * ea.ldaux + col] * sigmoidf_(v);
            else if (EPI == 2) { const float g = ea.aux[(size_t)row * ea.ldaux + col]; ea.C[(size_t)row * ea.ldc + col] = g * sigmoidf_(g) * v; }
            else if (EPI == 3) ea.C[(size_t)tok * ea.ldc + col] += wgt * v;
        }
    }
}

__global__ __launch_bounds__(64) void s5_scan_k(const float* __restrict__ u, const float* __restrict__ lam_re, const float* __restrict__ lam_im, const float* __restrict__ log_step,
                                                const float* __restrict__ b_re, const float* __restrict__ b_im, const float* __restrict__ c_re, const float* __restrict__ c_im, float* __restrict__ yout) {
    __shared__ float us[64][16];
    const int dir = blockIdx.x & 1, g = (blockIdx.x >> 1) & 63, b = blockIdx.x >> 7, p = threadIdx.x;
    const double step = exp((double)log_step[dir * 64 + g]);
    const double lr = lam_re[(dir * 64 + g) * 64 + p], li = lam_im[(dir * 64 + g) * 64 + p];
    const double mag = exp(lr * step), ang = li * step;
    const double ard = mag * cos(ang), aid = mag * sin(ang);
    const double nr = ard - 1.0, ni = aid, den = lr * lr + li * li;
    const double qr = (nr * lr + ni * li) / den, qi = (ni * lr - nr * li) / den;
    const float ar = (float)ard, ai = (float)aid;
    float bbr[16], bbi[16], cr[16], ci[16];
#pragma unroll
    for (int i = 0; i < 16; ++i) {
        const double br = b_re[((dir * 64 + g) * 64 + p) * 16 + i], bi = b_im[((dir * 64 + g) * 64 + p) * 16 + i];
        bbr[i] = (float)(qr * br - qi * bi); bbi[i] = (float)(qr * bi + qi * br);
        cr[i] = c_re[((dir * 64 + g) * 16 + i) * 64 + p]; ci[i] = c_im[((dir * 64 + g) * 16 + i) * 64 + p];
    }
    float xr = 0.f, xi = 0.f;
    float* yo = yout + (size_t)dir * NTOK * DM;
    for (int c = 0; c < SEQ / 64; ++c) {
        { const int s = p; const int st = c * 64 + s; const int t = dir == 0 ? st : SEQ - 1 - st;
          const float4* src = (const float4*)(u + (size_t)(b * SEQ + t) * DM + g * 16);
          __syncthreads();
#pragma unroll
          for (int q = 0; q < 4; ++q) *(float4*)&us[s][q * 4] = src[q];
          __syncthreads(); }
        for (int s = 0; s < 64; ++s) {
            const int st = c * 64 + s; const int t = dir == 0 ? st : SEQ - 1 - st;
            float bur = 0.f, bui = 0.f;
#pragma unroll
            for (int i = 0; i < 16; ++i) { const float uu = us[s][i]; bur = fmaf(bbr[i], uu, bur); bui = fmaf(bbi[i], uu, bui); }
            const float nxr = ar * xr - ai * xi + bur, nxi = ar * xi + ai * xr + bui;
            xr = nxr; xi = nxi;
            float mine = 0.f;
#pragma unroll
            for (int j = 0; j < 16; ++j) { const float v = wave_sum(cr[j] * xr - ci[j] * xi); if (p == j) mine = v; }
            if (p < 16) yo[(size_t)(b * SEQ + t) * DM + g * 16 + p] = mine;
        }
    }
}
__global__ void gelu_comb_k(const float* __restrict__ u, const float* __restrict__ dskip, const float* __restrict__ y2, float* __restrict__ g1) {
    const size_t i = (size_t)blockIdx.x * 256 + threadIdx.x;
    const int c = (int)(i & (DM - 1));
    const float y = dskip[c] * u[i] + y2[i] + y2[i + (size_t)NTOK * DM];
    g1[i] = gelu_tanh(y);
}

__global__ void qknorm_rope_k(float* __restrict__ qkv, const float* __restrict__ qg, const float* __restrict__ kg) {
    const int w = blockIdx.x * 4 + (threadIdx.x >> 6), d = threadIdx.x & 63;
    const int tok = w / 20, hs = w % 20;
    float* p = qkv + (size_t)tok * QKVW + hs * 64;
    const float v = p[d];
    const float r = rsqrtf(wave_sum(v * v) * (1.f / 64.f) + EPS);
    const float y = v * r * (hs < 16 ? qg[d] : kg[d]);
    const float partner = __shfl_xor(y, 1);
    const int pos = tok % SEQ, i = d >> 1;
    const int f = i & 15;
    const float freq = powf(10000.f, -(float)(2 * f) / 32.f);
    const float ang = (float)(i < 16 ? pos / 64 : pos % 64) * freq;
    const float c = cosf(ang), s = sinf(ang);
    const float o = (d & 1) ? (partner * s + y * c) : (y * c - partner * s);
    p[d] = o;
}

__global__ __launch_bounds__(256) void attn_k(const float* __restrict__ qkv, float* __restrict__ o) {
    __shared__ float Qs[64][65], Ks[64][65], Vs[64][65];
    float (*Ps)[65] = Ks;
    const int qb = blockIdx.x, h = blockIdx.y, b = blockIdx.z, kvh = h >> 2;
    const int tid = threadIdx.x, tx = tid & 15, ty = tid >> 4;
    const size_t rowbase = (size_t)b * SEQ;
    for (int e = tid; e < 64 * 64; e += 256) { const int r = e >> 6, d = e & 63; Qs[r][d] = qkv[(rowbase + qb * 64 + r) * QKVW + h * 64 + d] * 0.125f; }
    float m[4], l[4], oacc[4][4];
#pragma unroll
    for (int i = 0; i < 4; ++i) { m[i] = -INFINITY; l[i] = 0.f;
#pragma unroll
        for (int j = 0; j < 4; ++j) oacc[i][j] = 0.f; }
    for (int kt = 0; kt < SEQ / 64; ++kt) {
        __syncthreads();
        for (int e = tid; e < 64 * 64; e += 256) { const int r = e >> 6, d = e & 63; const size_t rr = (rowbase + kt * 64 + r) * QKVW;
            Ks[r][d] = qkv[rr + 1024 + kvh * 64 + d]; Vs[r][d] = qkv[rr + 1280 + kvh * 64 + d]; }
        __syncthreads();
        float s[4][4];
#pragma unroll
        for (int i = 0; i < 4; ++i)
#pragma unroll
            for (int j = 0; j < 4; ++j) s[i][j] = 0.f;
        for (int d = 0; d < 64; ++d) {
            float a[4], k[4];
#pragma unroll
            for (int i = 0; i < 4; ++i) { a[i] = Qs[ty * 4 + i][d]; k[i] = Ks[tx * 4 + i][d]; }
#pragma unroll
            for (int i = 0; i < 4; ++i)
#pragma unroll
                for (int j = 0; j < 4; ++j) s[i][j] = fmaf(a[i], k[j], s[i][j]);
        }
        __syncthreads();
#pragma unroll
        for (int i = 0; i < 4; ++i) {
            float mx = fmaxf(fmaxf(s[i][0], s[i][1]), fmaxf(s[i][2], s[i][3]));
#pragma unroll
            for (int of = 1; of < 16; of <<= 1) mx = fmaxf(mx, __shfl_xor(mx, of));
            const float mn = fmaxf(m[i], mx);
            const float sc = __expf(m[i] - mn);
            float ps = 0.f;
#pragma unroll
            for (int j = 0; j < 4; ++j) { const float pp = __expf(s[i][j] - mn); Ps[ty * 4 + i][tx * 4 + j] = pp; ps += pp; }
#pragma unroll
            for (int of = 1; of < 16; of <<= 1) ps += __shfl_xor(ps, of);
            l[i] = l[i] * sc + ps; m[i] = mn;
#pragma unroll
            for (int j = 0; j < 4; ++j) oacc[i][j] *= sc;
        }
        __syncthreads();
        for (int k = 0; k < 64; ++k) {
            float pp[4], vv[4];
#pragma unroll
            for (int i = 0; i < 4; ++i) { pp[i] = Ps[ty * 4 + i][k]; vv[i] = Vs[k][tx * 4 + i]; }
#pragma unroll
            for (int i = 0; i < 4; ++i)
#pragma unroll
                for (int j = 0; j < 4; ++j) oacc[i][j] = fmaf(pp[i], vv[j], oacc[i][j]);
        }
    }
#pragma unroll
    for (int i = 0; i < 4; ++i) { const float inv = 1.f / l[i];
#pragma unroll
        for (int j = 0; j < 4; ++j) o[(rowbase + qb * 64 + ty * 4 + i) * DM + h * 64 + tx * 4 + j] = oacc[i][j] * inv; }
}

__global__ void router_k(const float* __restrict__ xn, const float* __restrict__ wr, int* __restrict__ cnt, int* __restrict__ lists, float* __restrict__ wlists) {
    const int tok = blockIdx.x * 4 + (threadIdx.x >> 6), lane = threadIdx.x & 63;
    float lg[8];
#pragma unroll
    for (int e = 0; e < 8; ++e) lg[e] = 0.f;
    for (int j = 0; j < 16; ++j) { const int d = lane + 64 * j; const float x = xn[(size_t)tok * DM + d];
        const float4 w0 = *(const float4*)(wr + d * 8), w1 = *(const float4*)(wr + d * 8 + 4);
        lg[0] = fmaf(x, w0.x, lg[0]); lg[1] = fmaf(x, w0.y, lg[1]); lg[2] = fmaf(x, w0.z, lg[2]); lg[3] = fmaf(x, w0.w, lg[3]);
        lg[4] = fmaf(x, w1.x, lg[4]); lg[5] = fmaf(x, w1.y, lg[5]); lg[6] = fmaf(x, w1.z, lg[6]); lg[7] = fmaf(x, w1.w, lg[7]); }
#pragma unroll
    for (int e = 0; e < 8; ++e) lg[e] = wave_sum(lg[e]);
    int e0 = 0; float l0 = lg[0];
#pragma unroll
    for (int e = 1; e < 8; ++e) if (lg[e] > l0) { l0 = lg[e]; e0 = e; }
    int e1 = -1; float l1 = -INFINITY;
#pragma unroll
    for (int e = 0; e < 8; ++e) if (e != e0 && lg[e] > l1) { l1 = lg[e]; e1 = e; }
    const float w0 = 1.f / (1.f + expf(l1 - l0)), w1 = 1.f - w0;
    if (lane == 0) {
        const int p0 = atomicAdd(&cnt[e0], 1); lists[e0 * NTOK + p0] = tok; wlists[e0 * NTOK + p0] = w0;
        const int p1 = atomicAdd(&cnt[e1], 1); lists[e1 * NTOK + p1] = tok; wlists[e1 * NTOK + p1] = w1;
    }
}


__global__ void cvt_k(const unsigned short* __restrict__ s, float* __restrict__ d) { const size_t i = (size_t)blockIdx.x * 256 + threadIdx.x; d[i] = __uint_as_float((unsigned)s[i] << 16); }
template <int EPI, bool GATHER>
static void gemm(hipStream_t st, const float* A, int lda, const float* W, int ldw, int M, int N, int K, EpiArgs ea) {
    hipLaunchKernelGGL((gemm_k<EPI, GATHER>), dim3(N / 128, M / 128), dim3(256), 0, st, A, lda, W, ldw, M, N, K, ea);
}
}
#endif
extern "C" void kernel_launch(void* const* d_in, const int* in_sizes, int n_in, void* d_out, int out_size, void* d_ws, size_t ws_size, hipStream_t stream) {
    static int grid = 0;
    if (grid == 0) {
        grid = -1;
        if (n_in != 24 || in_sizes[0] != NTOK * DM || out_size != NTOK * DM || ws_size < WS_END) { fprintf(stderr, "kernel_launch: unexpected problem (n_in %d, ws %zu)\n", n_in, ws_size); return; }
        int dev = 0, cus = 0;
        if (hipGetDevice(&dev) != hipSuccess || hipDeviceGetAttribute(&cus, hipDeviceAttributeMultiprocessorCount, dev) != hipSuccess) return;
        if (hipFuncSetAttribute((const void*)mega_fwd, hipFuncAttributeMaxDynamicSharedMemorySize, LDS_BYTES) != hipSuccess) return;
        int per_cu = 0;
        if (hipOccupancyMaxActiveBlocksPerMultiprocessor(&per_cu, (const void*)mega_fwd, NWAVES * 64, LDS_BYTES) != hipSuccess || per_cu < 1) { fprintf(stderr, "kernel_launch: occupancy query says %d\n", per_cu); (void)hipGetLastError(); return; }
        if (cus != 256) { fprintf(stderr, "kernel_launch: built for 256 CUs, found %d\n", cus); return; }
        grid = cus;
    }
    if (grid < 0) return;
    if (hipMemsetAsync((char*)d_ws + WS_CTL, 0, CTL_ZERO_BYTES, stream) != hipSuccess) return;
    Args a{};
    for (int i = 0; i < 24; ++i) a.in[i] = (const float*)d_in[i];
    a.out = (float*)d_out; a.ws = (unsigned char*)d_ws; a.ph_lo = 0; a.ph_hi = CUT ? CUT : 18;
    hipLaunchKernelGGL(mega_fwd, dim3(grid), dim3(NWAVES * 64), LDS_BYTES, stream, a);
#if CUT
    {
        using namespace nv;
        const float* gains = (const float*)d_in[1];
        const float* ffn_g = (const float*)d_in[13]; const float* ffn_u = (const float*)d_in[14]; const float* ffn_d = (const float*)d_in[15];
        const float* w_qkv = (const float*)d_in[16]; const float* q_gain = (const float*)d_in[17]; const float* k_gain = (const float*)d_in[18]; const float* attn_wo = (const float*)d_in[19];
        const float* w_router = (const float*)d_in[20]; const float* moe_g = (const float*)d_in[21]; const float* moe_u = (const float*)d_in[22]; const float* moe_d = (const float*)d_in[23];
        float* h = (float*)d_out; char* ws = (char*)d_ws;
        float* xn = (float*)(ws + 4 * MiB); float* mix = (float*)(ws + 68 * MiB);
        hipLaunchKernelGGL(cvt_k, dim3(NTOK * DM / 256), dim3(256), 0, stream, (const unsigned short*)(ws + WS_XN), xn);
        if (CUT <= 8) {
            float* G = (float*)(ws + 132 * MiB);
            gemm<0, false>(stream, xn, DM, ffn_g, DFF, NTOK, DFF, DM, EpiArgs{G, DFF, nullptr, 0, nullptr, nullptr, nullptr});
            gemm<2, false>(stream, xn, DM, ffn_u, DFF, NTOK, DFF, DM, EpiArgs{G, DFF, G, DFF, nullptr, nullptr, nullptr});
            gemm<0, false>(stream, G, DFF, ffn_d, DM, NTOK, DM, DFF, EpiArgs{mix, DM, nullptr, 0, nullptr, nullptr, nullptr});
            hipLaunchKernelGGL(resnorm_k, dim3(NTOK / 4), dim3(256), 0, stream, h, mix, gains + 3 * DM, gains + 4 * DM, h, xn);
        }
        if (CUT <= 11) {
            float* qkv = (float*)(ws + 132 * MiB); float* ob = (float*)(ws + 228 * MiB);
            gemm<0, false>(stream, xn, DM, w_qkv, QKVW, NTOK, QKVW, DM, EpiArgs{qkv, QKVW, nullptr, 0, nullptr, nullptr, nullptr});
            hipLaunchKernelGGL(qknorm_rope_k, dim3(NTOK * 20 / 4), dim3(256), 0, stream, qkv, q_gain, k_gain);
            hipLaunchKernelGGL(attn_k, dim3(SEQ / 64, 16, NB), dim3(256), 0, stream, qkv, ob);
            gemm<0, false>(stream, ob, DM, attn_wo, DM, NTOK, DM, DM, EpiArgs{mix, DM, nullptr, 0, nullptr, nullptr, nullptr});
            hipLaunchKernelGGL(resnorm_k, dim3(NTOK / 4), dim3(256), 0, stream, h, mix, gains + 5 * DM, gains + 6 * DM, h, xn);
        }
        {
            float* Ge = (float*)(ws + 132 * MiB); float* ff = (float*)(ws + 356 * MiB);
            int* cnt = (int*)(ws + 420 * MiB); int* lists = (int*)(ws + 421 * MiB); float* wlists = (float*)(ws + 422 * MiB);
            (void)hipMemsetAsync(cnt, 0, 64, stream);
            (void)hipMemsetAsync(ff, 0, (size_t)NTOK * DM * 4, stream);
            hipLaunchKernelGGL(router_k, dim3(NTOK / 4), dim3(256), 0, stream, xn, w_router, cnt, lists, wlists);
            for (int e = 0; e < NEXP; ++e) {
                const int* le = lists + e * NTOK; const float* we = wlists + e * NTOK;
                gemm<0, true>(stream, xn, DM, moe_g + (size_t)e * DM * DFE, DFE, NTOK, DFE, DM, EpiArgs{Ge, DFE, nullptr, 0, le, we, cnt + e});
                gemm<2, true>(stream, xn, DM, moe_u + (size_t)e * DM * DFE, DFE, NTOK, DFE, DM, EpiArgs{Ge, DFE, Ge, DFE, le, we, cnt + e});
                gemm<3, false>(stream, Ge, DFE, moe_d + (size_t)e * DFE * DM, DM, NTOK, DM, DFE, EpiArgs{ff, DM, nullptr, 0, le, we, cnt + e});
            }
            hipLaunchKernelGGL(resnorm_k, dim3(NTOK / 4), dim3(256), 0, stream, h, ff, gains + 7 * DM, gains + 7 * DM, h, (float*)nullptr);
        }
    }
#endif
}
```

```cpp
#include <hip/hip_runtime.h>
#include <hip/hip_bf16.h>
#include <cstdio>
#include <cstdint>
#include <cmath>
#define CUT 0
#define DUPMASK 0
#define P0DUP 0
#define EXP_GATHER 0
#define MOE_WGM 4
#define NORM_FACTOR 1
#define S_BF16 1
namespace pg8 {
#define PG8_LAS __attribute__((address_space(3)))
typedef unsigned short bf16_t;
typedef short bf16x8 __attribute__((ext_vector_type(8)));
typedef float f32x4 __attribute__((ext_vector_type(4)));
typedef unsigned u32x4 __attribute__((ext_vector_type(4)));
typedef unsigned u32x2 __attribute__((ext_vector_type(2)));
typedef int v8i32 __attribute__((ext_vector_type(8)));
constexpr int BM = 256, BK = 64, HALF = 128, HTB = HALF * BK * 2  , STAGE_BYTES = 8 * HTB, NXCD = 8, WGM = 8;

__host__ __device__ __forceinline__ int lds_byte(int r, int c) { const int st = (r >> 4) * 2 + (c >> 5), rr = r & 15, cc = c & 31, ob = rr * 64 + cc * 2; return st * 1024 + (ob ^ (((ob >> 9) & 1) << 5)); }
__host__ __device__ __forceinline__ void stage_rc(int b, int& R, int& C) { const int st = b / 1024, sb = b % 1024, swz = sb ^ (((sb >> 9) & 1) << 5); R = (st >> 1) * 16 + swz / 64; C = (st & 1) * 32 + (swz % 64) / 2; }
__host__ __device__ __forceinline__ int perm32(int rho) { const int n = rho >> 4, i = rho & 15; return 8 * (i >> 2) + 4 * n + (i & 3); }

struct Unit { int pm, pn, kofs, nt, aux; };

struct StaticOrder {
    int nM, nN, nwg, G, c, wgm;
    __host__ __device__ void init(int nM_, int nN_, int G_, int c_, int wgm_ = WGM) { nM = nM_; nN = nN_; nwg = nM * nN; G = G_; c = c_; wgm = wgm_; }
    __host__ __device__ bool next(int i, Unit& u) const {
        const long L = (long)i * G + c; if (L >= nwg) return false;
        int wgid = (int)L; { const int q = nwg / NXCD, r = nwg % NXCD, xcd = wgid % NXCD, off = wgid / NXCD; wgid = (xcd < r ? xcd * (q + 1) : r * (q + 1) + (xcd - r) * q) + off; }
        const int nig = wgm * nN, gid = wgid / nig, fm = gid * wgm, gsz = (nM - fm) < wgm ? (nM - fm) : wgm;
        u.pm = fm + ((wgid % nig) % gsz); u.pn = (wgid % nig) / gsz; return true;
    }
};

__device__ __forceinline__ unsigned cvt_pk_bf16(float lo, float hi) { unsigned r; asm volatile("v_cvt_pk_bf16_f32 %0, %1, %2" : "=v"(r) : "v"(lo), "v"(hi)); return r; }
__device__ __forceinline__ float bf_lo(unsigned w) { return __uint_as_float(w << 16); }
__device__ __forceinline__ float bf_hi(unsigned w) { return __uint_as_float(w & 0xffff0000u); }
__device__ __forceinline__ float sigm(float x) { return __builtin_amdgcn_rcpf(1.f + __builtin_amdgcn_exp2f(-1.4426950408889634f * x)); }
__device__ __forceinline__ float gelu_t(float x) { return x * sigm(1.5957691216057308f * (x + 0.044715f * x * x * x)); }
#ifndef WT_STORES
#define WT_STORES 0
#endif
__device__ __forceinline__ void st16(void* p, const u32x4& v) {
#if WT_STORES
    asm volatile("global_store_dwordx4 %0, %1, off sc1\n\ts_nop 1" :: "v"(p), "v"(v) : "memory");
#else
    *(u32x4*)p = v;
#endif
}
__device__ __forceinline__ u32x4 pack8(const f32x4& a, const f32x4& b) { u32x4 w; w.x = cvt_pk_bf16(a[0], a[1]); w.y = cvt_pk_bf16(a[2], a[3]); w.z = cvt_pk_bf16(b[0], b[1]); w.w = cvt_pk_bf16(b[2], b[3]); return w; }

struct ProbPlain {
    const char* abase; const char* Bt; int K; unsigned ldaB, ldbB; size_t bstride; int pm_per_b; StaticOrder S;
    __device__ __forceinline__ bool next(int i, Unit& u) const { u.kofs = 0; u.nt = K / BK; u.aux = 0; return S.next(i, u); }
    __device__ __forceinline__ const char* bbase(const Unit& u) const { return Bt + (size_t)(u.pm / pm_per_b) * bstride + (size_t)u.pn * 256 * ldbB; }
    __device__ __forceinline__ void aoffs(const Unit& u, const int (&R)[2], unsigned (&off)[2][2]) const {
#pragma unroll
        for (int h = 0; h < 2; ++h)
#pragma unroll
            for (int i = 0; i < 2; ++i) off[h][i] = (unsigned)(u.pm * 256 + h * 128 + R[i]) * ldaB;
    }
};
struct ProbMoE {
    const char* abase; const char* Bt; int K; unsigned ldaB, ldbB; size_t bstride; StaticOrder S;
    const int* lists; volatile PG8_LAS int* misc; bool gather;
    __device__ __forceinline__ bool next(int i, Unit& u) const {
        if (gather) { u.kofs = 0; u.nt = K / BK; u.aux = 0; return S.next(i, u); }
        const int c = S.c, x = c & 7, y = c >> 3, first_rem = misc[10];
        const int pm = 64 * i + 8 * x + (y & 7);
        if (pm < first_rem) { u.pm = pm; u.pn = y >> 3; u.kofs = 0; u.nt = K / BK; u.aux = 0; return true; }
        if (64 * i != first_rem || c >= misc[11]) return false;
        const int parts = misc[9], j = c / parts, part = c - j * parts, ntp = (K / BK) / parts;
        u.pm = first_rem + (j >> 2); u.pn = j & 3; u.nt = ntp; u.kofs = part * ntp * BK * 2; u.aux = c + 1; return true;
    }
    __device__ __forceinline__ int expert(int pm) const { int e = 0;
#pragma unroll
        for (int j = 1; j < 8; ++j) e += (pm >= misc[j]) ? 1 : 0;
        return e; }
    __device__ __forceinline__ const char* bbase(const Unit& u) const { return Bt + (size_t)__builtin_amdgcn_readfirstlane(expert(u.pm)) * bstride + (size_t)u.pn * 256 * ldbB; }
    __device__ __forceinline__ void aoffs(const Unit& u, const int (&R)[2], unsigned (&off)[2][2]) const {
        if (gather) {
            const int e = expert(u.pm), t0 = misc[e], cnt = misc[16 + e];
#pragma unroll
            for (int h = 0; h < 2; ++h)
#pragma unroll
                for (int i = 0; i < 2; ++i) { const int pos = (u.pm - t0) * 256 + h * 128 + R[i]; const int tok = pos < cnt ? lists[e * 16384 + pos] : 0; off[h][i] = (unsigned)tok * ldaB; }
        } else {
#pragma unroll
            for (int h = 0; h < 2; ++h)
#pragma unroll
                for (int i = 0; i < 2; ++i) off[h][i] = (unsigned)(u.pm * 256 + h * 128 + R[i]) * ldaB;
        }
    }
};

struct EpiF32 {
    static constexpr bool PERM = false;
    float* C; int ldc;
    __device__ __forceinline__ void operator()(const f32x4 (&acc)[2][2][4][2], const Unit& u, int wr, int wc, int fr, int fq) const {
        const int row0 = u.pm * BM + wr * 64 + fr, col0 = u.pn * BM + wc * 32 + 4 * fq;
#pragma unroll
        for (int ai = 0; ai < 2; ++ai)
#pragma unroll
            for (int m = 0; m < 4; ++m) { float* rowp = C + (size_t)(row0 + ai * HALF + m * 16) * ldc + col0;
#pragma unroll
                for (int bj = 0; bj < 2; ++bj)
#pragma unroll
                    for (int n = 0; n < 2; ++n) { const f32x4 t_ = acc[ai][bj][m][n]; st16(rowp + bj * HALF + n * 16, __builtin_bit_cast(u32x4, t_)); } }
    }
};
struct EpiBf16 {
    static constexpr bool PERM = true;
    bf16_t* O; int ldc; float scale;
    __device__ __forceinline__ void operator()(const f32x4 (&acc)[2][2][4][2], const Unit& u, int wr, int wc, int fr, int fq) const {
        const int row0 = u.pm * BM + wr * 64 + fr, col0 = u.pn * BM + wc * 32 + 8 * fq;
#pragma unroll
        for (int ai = 0; ai < 2; ++ai)
#pragma unroll
            for (int m = 0; m < 4; ++m) { bf16_t* rowp = O + (size_t)(row0 + ai * HALF + m * 16) * ldc + col0;
#pragma unroll
                for (int bj = 0; bj < 2; ++bj) st16(rowp + bj * HALF, pack8(acc[ai][bj][m][0] * scale, acc[ai][bj][m][1] * scale)); }
    }
};
struct EpiMoeDown {
    static constexpr bool PERM = true;
    bf16_t* O; bf16_t* PART; float scale;
    __device__ __forceinline__ void operator()(const f32x4 (&acc)[2][2][4][2], const Unit& u, int wr, int wc, int fr, int fq) const {
        const int r0 = wr * 64 + fr, c0 = wc * 32 + 8 * fq;
        bf16_t* base = u.aux == 0 ? O + ((size_t)u.pm * BM * 1024 + (size_t)u.pn * BM) : PART + (size_t)(u.aux - 1) * 65536;
        const int ldo = u.aux == 0 ? 1024 : 256;
#pragma unroll
        for (int ai = 0; ai < 2; ++ai)
#pragma unroll
            for (int m = 0; m < 4; ++m) { bf16_t* rowp = base + (size_t)(r0 + ai * HALF + m * 16) * ldo + c0;
#pragma unroll
                for (int bj = 0; bj < 2; ++bj) st16(rowp + bj * HALF, pack8(acc[ai][bj][m][0] * scale, acc[ai][bj][m][1] * scale)); }
    }
};
__device__ __forceinline__ unsigned pack4_fp8(float a, float b, float c, float d) {
    a = __builtin_amdgcn_fmed3f(a, -448.f, 448.f); b = __builtin_amdgcn_fmed3f(b, -448.f, 448.f); c = __builtin_amdgcn_fmed3f(c, -448.f, 448.f); d = __builtin_amdgcn_fmed3f(d, -448.f, 448.f);
    int w = __builtin_amdgcn_cvt_pk_fp8_f32(a, b, 0, false); w = __builtin_amdgcn_cvt_pk_fp8_f32(c, d, w, true); return (unsigned)w; }
struct EpiSwigluF8 {
    static constexpr bool PERM = true;
    unsigned char* O; int ldc; float sin, sout;
    __device__ __forceinline__ void operator()(const f32x4 (&acc)[2][2][4][2], const Unit& u, int wr, int wc, int fr, int fq) const {
        const int row0 = u.pm * BM + wr * 64 + fr, col0 = u.pn * HALF + wc * 32 + 8 * fq;
        const float c1 = -1.4426950408889634f * sin, kk = 1.f / (sin * sin * sout);
#pragma unroll
        for (int ai = 0; ai < 2; ++ai)
#pragma unroll
            for (int m = 0; m < 4; ++m) { f32x4 a, b;
#pragma unroll
                for (int e = 0; e < 4; ++e) {
                    const float g0 = acc[ai][0][m][0][e], g1 = acc[ai][0][m][1][e];
                    const float e0 = __builtin_amdgcn_exp2f(g0 * c1), e1 = __builtin_amdgcn_exp2f(g1 * c1);
                    a[e] = (g0 * acc[ai][1][m][0][e]) * __builtin_amdgcn_rcpf(__builtin_fmaf(e0, kk, kk)); b[e] = (g1 * acc[ai][1][m][1][e]) * __builtin_amdgcn_rcpf(__builtin_fmaf(e1, kk, kk)); }
                u32x2 w; w.x = pack4_fp8(a[0], a[1], a[2], a[3]); w.y = pack4_fp8(b[0], b[1], b[2], b[3]);
                *(u32x2*)(O + (size_t)(row0 + ai * HALF + m * 16) * ldc + col0) = w; }
    }
};
struct EpiU {
    static constexpr bool PERM = true;
    bf16_t* A2; const float* rs;
    __device__ __forceinline__ void operator()(const f32x4 (&acc)[2][2][4][2], const Unit& u, int wr, int wc, int fr, int fq) const {
        const int row0 = u.pm * BM + wr * 64 + fr, col0 = u.pn * BM + wc * 32 + 8 * fq;
#pragma unroll
        for (int ai = 0; ai < 2; ++ai)
#pragma unroll
            for (int m = 0; m < 4; ++m) { const int row = row0 + ai * HALF + m * 16, c = row >> 4, t = row & 15; const float s = rs ? rs[row] : 1.f;
#pragma unroll
                for (int bj = 0; bj < 2; ++bj) { const int col = col0 + bj * HALF, g = col >> 4, i0 = col & 15;
                    st16(A2 + ((size_t)(g * 1024 + c) * 512 + t * 16 + i0), pack8(acc[ai][bj][m][0] * s, acc[ai][bj][m][1] * s)); } }
    }
};
struct EpiY {
    static constexpr bool PERM = true;
    bf16_t* G1;
    __device__ __forceinline__ void operator()(const f32x4 (&acc)[2][2][4][2], const Unit& u, int wr, int wc, int fr, int fq) const {
        const int row0 = u.pm * BM + wr * 64 + fr, col0 = wc * 32 + 8 * fq;
#pragma unroll
        for (int ai = 0; ai < 2; ++ai)
#pragma unroll
            for (int m = 0; m < 4; ++m) { const int row = row0 + ai * HALF + m * 16, g = row >> 10, c = row & 1023;
#pragma unroll
                for (int bj = 0; bj < 2; ++bj) { const int col = col0 + bj * HALF, t = col >> 4, j0 = col & 15;
                    f32x4 a = acc[ai][bj][m][0], b = acc[ai][bj][m][1];
#pragma unroll
                    for (int e = 0; e < 4; ++e) { a[e] = gelu_t(a[e]); b[e] = gelu_t(b[e]); }
                    st16(G1 + ((size_t)(c * 16 + t) * 1024 + g * 16 + j0), pack8(a, b)); } }
    }
};
struct EpiGlu {
    static constexpr bool PERM = true;
    const bf16_t* G1; bf16_t* G2;
    __device__ __forceinline__ void operator()(const f32x4 (&acc)[2][2][4][2], const Unit& u, int wr, int wc, int fr, int fq) const {
        const int row0 = u.pm * BM + wr * 64 + fr, col0 = u.pn * BM + wc * 32 + 8 * fq;
#pragma unroll
        for (int ai = 0; ai < 2; ++ai)
#pragma unroll
            for (int m = 0; m < 4; ++m) { const size_t ro = (size_t)(row0 + ai * HALF + m * 16) * 1024 + col0;
#pragma unroll
                for (int bj = 0; bj < 2; ++bj) { const u32x4 gv = *(const u32x4*)(G1 + ro + bj * HALF);
                    f32x4 a = acc[ai][bj][m][0], b = acc[ai][bj][m][1];
                    a[0] = bf_lo(gv.x) * sigm(a[0]); a[1] = bf_hi(gv.x) * sigm(a[1]); a[2] = bf_lo(gv.y) * sigm(a[2]); a[3] = bf_hi(gv.y) * sigm(a[3]);
                    b[0] = bf_lo(gv.z) * sigm(b[0]); b[1] = bf_hi(gv.z) * sigm(b[1]); b[2] = bf_lo(gv.w) * sigm(b[2]); b[3] = bf_hi(gv.w) * sigm(b[3]);
                    st16(G2 + ro + bj * HALF, pack8(a, b)); } }
    }
};
struct EpiSwiglu {
    static constexpr bool PERM = true;
    bf16_t* O; int ldc; const float* rs;
    __device__ __forceinline__ void operator()(const f32x4 (&acc)[2][2][4][2], const Unit& u, int wr, int wc, int fr, int fq) const {
        const int row0 = u.pm * BM + wr * 64 + fr, col0 = u.pn * HALF + wc * 32 + 8 * fq;
#pragma unroll
        for (int ai = 0; ai < 2; ++ai)
#pragma unroll
            for (int m = 0; m < 4; ++m) { f32x4 a, b; const float s = rs ? rs[row0 + ai * HALF + m * 16] : 1.f;
#pragma unroll
                for (int e = 0; e < 4; ++e) { const float g0 = acc[ai][0][m][0][e] * s, g1 = acc[ai][0][m][1][e] * s; a[e] = g0 * sigm(g0) * (acc[ai][1][m][0][e] * s); b[e] = g1 * sigm(g1) * (acc[ai][1][m][1][e] * s); }
                st16(O + (size_t)(row0 + ai * HALF + m * 16) * ldc + col0, pack8(a, b)); }
    }
};
struct EpiQKV {
    static constexpr bool PERM = true;
    bf16_t* base; unsigned koff, voff; const float* gtab; const float4* rope; float qscale; const float* rs;
    __device__ __forceinline__ void operator()(const f32x4 (&acc)[2][2][4][2], const Unit& u, int wr, int wc, int fr, int fq) const {
        const int row0 = u.pm * BM + wr * 64 + fr, pn = u.pn;
        const float* gain = gtab + (pn < 4 ? 0 : 64) + 8 * fq;
        const float sc = pn < 4 ? qscale : 1.f;
        const unsigned tbase = pn < 4 ? (unsigned)((4 * pn + wc) * 64) : (pn == 4 ? koff : voff) + (unsigned)(wc * 64);
        const int ldo = pn < 4 ? 1024 : 256;
#pragma unroll
        for (int ai = 0; ai < 2; ++ai)
#pragma unroll
            for (int m = 0; m < 4; ++m) { const int row = row0 + ai * HALF + m * 16;
                bf16_t* dst = base + ((size_t)tbase + (size_t)row * ldo + 8 * fq);
                const float s2 = rs ? rs[row] : 1.f;
                if (pn < 5) {
                    float ss = 0.f;
#pragma unroll
                    for (int bj = 0; bj < 2; ++bj)
#pragma unroll
                        for (int n = 0; n < 2; ++n) { const f32x4 v = acc[ai][bj][m][n] * s2; ss += (v[0] * v[0] + v[1] * v[1]) + (v[2] * v[2] + v[3] * v[3]); }
                    ss += __shfl_xor(ss, 16); ss += __shfl_xor(ss, 32);
                    const float r = rsqrtf(ss * (1.f / 64.f) + 1e-6f) * s2;
                    const int pos = row & 8191;
                    const float4* t0 = rope + (pos >> 6) * 8 + 2 * fq; const float4* t1 = rope + 1024 + (pos & 63) * 8 + 2 * fq;
#pragma unroll
                    for (int bj = 0; bj < 2; ++bj) { f32x4 o[2];
#pragma unroll
                        for (int n = 0; n < 2; ++n) { const float4 cs = bj == 0 ? t0[n] : t1[n]; const f32x4 g = *(const f32x4*)(gain + 32 * bj + 4 * n); const f32x4 v = acc[ai][bj][m][n];
                            const float x0 = v[0] * r * g[0], x1 = v[1] * r * g[1], x2 = v[2] * r * g[2], x3 = v[3] * r * g[3];
                            o[n][0] = (x0 * cs.x - x1 * cs.y) * sc; o[n][1] = (x0 * cs.y + x1 * cs.x) * sc; o[n][2] = (x2 * cs.z - x3 * cs.w) * sc; o[n][3] = (x2 * cs.w + x3 * cs.z) * sc; }
                        st16(dst + 32 * bj, pack8(o[0], o[1])); }
                } else {
#pragma unroll
                    for (int bj = 0; bj < 2; ++bj) st16(dst + 32 * bj, pack8(acc[ai][bj][m][0] * s2, acc[ai][bj][m][1] * s2));
                }
                asm volatile("" ::: "memory"); }
    }
};

typedef int v4i32 __attribute__((ext_vector_type(4)));
template <bool F8> struct Frag;
template <> struct Frag<false> { u32x4 k[2]; };
template <> struct Frag<true> { v8i32 v; };
template <class Prob, class Epi, bool ALIGN_EPI = false, bool SP2 = false, bool FP8 = false>
__device__ __forceinline__ void gemm_phase(PG8_LAS unsigned char* lds, const Prob& P, const Epi& E) {
    const int tid = threadIdx.x, wid = __builtin_amdgcn_readfirstlane(tid >> 6), lane = tid & 63, wr = wid >> 2, wc = wid & 3, fr = lane & 15, fq = lane >> 4;
    int Rr[2]; unsigned cof[2], voffB[2];
#pragma unroll
    for (int i = 0; i < 2; ++i) { int R, C; stage_rc(tid * 16 + i * 8192, R, C); const int Rb = Epi::PERM ? ((R & ~31) + perm32(R & 31)) : R;
        Rr[i] = R; cof[i] = (unsigned)C * 2u; voffB[i] = (unsigned)Rb * P.ldbB + (unsigned)C * 2u; }
    const size_t kstep = (size_t)(BK * 2);
    const size_t hstepB = (size_t)HALF * P.ldbB;
    const unsigned ldsw = (unsigned)wid * 1024u;
    const int aoff = FP8 ? lds_byte(wr * 64 + fr, fq * 16) : lds_byte(wr * 64 + fr, fq * 8), boff = FP8 ? lds_byte(wc * 32 + fr, fq * 16) : lds_byte(wc * 32 + fr, fq * 8);

#define PG8_SA(b, h) (((b) * 2 + (h)) * HTB)
#define PG8_SB(b, h) ((4 + (b) * 2 + (h)) * HTB)
#define PG8_STAGE(bufoff, gbase, voff) do { _Pragma("unroll") for (int _i = 0; _i < 2; ++_i) \
        __builtin_amdgcn_global_load_lds((const unsigned*)((const char*)(gbase) + (voff)[_i]), (PG8_LAS unsigned*)(lds + (bufoff) + ldsw + _i * 8192), 16, 0, 0); } while (0)
#define PG8_LD1(dst, addr) do { if constexpr (FP8) { const v4i32 lo_ = *(const PG8_LAS v4i32*)(addr), hi_ = *(const PG8_LAS v4i32*)((addr) + 16); (dst).v = __builtin_shufflevector(lo_, hi_, 0, 1, 2, 3, 4, 5, 6, 7); } \
        else { _Pragma("unroll") for (int k = 0; k < 2; ++k) (dst).k[k] = *(const PG8_LAS u32x4*)((addr) + k * 1024); } } while (0)
#define PG8_LDA(dst, b, h) do { _Pragma("unroll") for (int m = 0; m < 4; ++m) PG8_LD1(dst[m], lds + PG8_SA(b, h) + aoff + m * 2048); } while (0)
#define PG8_LDB(dst, b, h) do { _Pragma("unroll") for (int n = 0; n < 2; ++n) PG8_LD1(dst[n], lds + PG8_SB(b, h) + boff + n * 2048); } while (0)
#define PG8_MMA(ai, bj, At, Bt) do { __builtin_amdgcn_s_setprio(1); _Pragma("unroll") for (int m = 0; m < 4; ++m) _Pragma("unroll") for (int n = 0; n < 2; ++n) { \
        if constexpr (FP8) asm volatile("v_mfma_scale_f32_16x16x128_f8f6f4 %0, %1, %2, %0, %3, %3 op_sel_hi:[0,0,0]" : "+v"(acc[ai][bj][m][n]) : "v"(Bt[n].v), "v"(At[m].v), "v"(f8scale_)); \
        else { _Pragma("unroll") for (int k = 0; k < 2; ++k) acc[ai][bj][m][n] = __builtin_amdgcn_mfma_f32_16x16x32_bf16(__builtin_bit_cast(bf16x8, Bt[n].k[k]), __builtin_bit_cast(bf16x8, At[m].k[k]), acc[ai][bj][m][n], 0, 0, 0); } } \
        __builtin_amdgcn_s_setprio(0); } while (0)
#define PG8_WAIT_V(n) asm volatile("s_waitcnt vmcnt(" #n ")" ::: "memory")
#define PG8_WAIT_L(n) asm volatile("s_waitcnt lgkmcnt(" #n ")" ::: "memory")
#define PG8_BAR __builtin_amdgcn_s_barrier()
#define PG8_SCHED __builtin_amdgcn_sched_barrier(0)
    const int f8scale_ = 0x7f7f7f7f;
    Unit cur, nxt; int ui = 0;
    if (!P.next(0, cur)) return;
    f32x4 acc[2][2][4][2];
#pragma unroll
    for (int a = 0; a < 2; ++a)
#pragma unroll
        for (int b = 0; b < 2; ++b)
#pragma unroll
            for (int m = 0; m < 4; ++m)
#pragma unroll
                for (int n = 0; n < 2; ++n) acc[a][b][m][n] = (f32x4){0.f, 0.f, 0.f, 0.f};
    Frag<FP8> At[4], B0[2], B1[2];
    unsigned voC[2][2], voN[2][2];
    P.aoffs(cur, Rr, voC);
#pragma unroll
    for (int h = 0; h < 2; ++h)
#pragma unroll
        for (int i = 0; i < 2; ++i) voC[h][i] += cof[i] + (unsigned)cur.kofs;
    const char* const aB = P.abase; const char* cB = P.bbase(cur) + cur.kofs;
    if constexpr (SP2) {
        PG8_STAGE(PG8_SB(0, 0), cB, voffB); PG8_STAGE(PG8_SB(0, 1), cB + hstepB, voffB); PG8_STAGE(PG8_SA(0, 0), aB, voC[0]); PG8_STAGE(PG8_SA(0, 1), aB, voC[1]);
        if (wr == 1) PG8_BAR;
        PG8_WAIT_V(2); PG8_BAR;
        PG8_STAGE(PG8_SB(1, 0), cB + kstep, voffB); PG8_STAGE(PG8_SA(1, 0), aB + kstep, voC[0]); PG8_STAGE(PG8_SB(1, 1), cB + hstepB + kstep, voffB);
        PG8_WAIT_V(6); PG8_BAR;
    } else {
        PG8_STAGE(PG8_SB(0, 0), cB, voffB); PG8_STAGE(PG8_SA(0, 0), aB, voC[0]); PG8_STAGE(PG8_SB(0, 1), cB + hstepB, voffB); PG8_STAGE(PG8_SA(0, 1), aB, voC[1]);
        if (wr == 1) PG8_BAR;
        PG8_WAIT_V(4); PG8_BAR;
        PG8_STAGE(PG8_SB(1, 0), cB + kstep, voffB); PG8_STAGE(PG8_SA(1, 0), aB + kstep, voC[0]); PG8_STAGE(PG8_SB(1, 1), cB + hstepB + kstep, voffB);
        PG8_WAIT_V(6); PG8_BAR;
    }
    for (;;) {
        const bool has_next = P.next(ui + 1, nxt);
        if (has_next) { P.aoffs(nxt, Rr, voN);
#pragma unroll
            for (int h = 0; h < 2; ++h)
#pragma unroll
                for (int i = 0; i < 2; ++i) voN[h][i] += cof[i] + (unsigned)nxt.kofs; }
        else {
#pragma unroll
            for (int h = 0; h < 2; ++h)
#pragma unroll
                for (int i = 0; i < 2; ++i) voN[h][i] = voC[h][i]; }
        const char* nB = has_next ? P.bbase(nxt) + nxt.kofs : cB;
        const int nt = cur.nt;
        for (int t = 0; t < nt; t += 2) {
            const bool last = (t == nt - 2);
            const char* a1 = aB + (size_t)(t + 1) * kstep;
            const char* a2 = last ? aB : aB + (size_t)(t + 2) * kstep; const char* b2 = last ? nB : cB + (size_t)(t + 2) * kstep;
            const char* a3 = a2 + kstep; const char* b3 = b2 + kstep;
            unsigned vo2[2][2];
#pragma unroll
            for (int h = 0; h < 2; ++h)
#pragma unroll
                for (int i = 0; i < 2; ++i) vo2[h][i] = last ? voN[h][i] : voC[h][i];
            if constexpr (SP2) {
            PG8_LDB(B0, 0, 0); PG8_LDB(B1, 0, 1); PG8_SCHED; PG8_LDA(At, 0, 0); PG8_STAGE(PG8_SA(1, 1), a1, voC[1]);
            PG8_WAIT_V(8); PG8_WAIT_L(0); PG8_BAR; PG8_MMA(0, 0, At, B0); PG8_MMA(0, 1, At, B1); PG8_BAR; PG8_SCHED;
            PG8_LDA(At, 0, 1); PG8_STAGE(PG8_SB(0, 0), b2, voffB); PG8_STAGE(PG8_SB(0, 1), b2 + hstepB, voffB); PG8_STAGE(PG8_SA(0, 0), a2, vo2[0]);
            PG8_WAIT_V(8); PG8_WAIT_L(0); PG8_BAR; PG8_MMA(1, 0, At, B0); PG8_MMA(1, 1, At, B1); PG8_BAR; PG8_SCHED;
            PG8_LDB(B0, 1, 0); PG8_LDB(B1, 1, 1); PG8_SCHED; PG8_LDA(At, 1, 0); PG8_STAGE(PG8_SA(0, 1), a2, vo2[1]);
            PG8_WAIT_V(8); PG8_WAIT_L(0); PG8_BAR; PG8_MMA(0, 0, At, B0); PG8_MMA(0, 1, At, B1); PG8_BAR; PG8_SCHED;
            PG8_LDA(At, 1, 1); PG8_STAGE(PG8_SB(1, 0), b3, voffB); PG8_STAGE(PG8_SB(1, 1), b3 + hstepB, voffB); PG8_STAGE(PG8_SA(1, 0), a3, vo2[0]);
            PG8_WAIT_V(8); PG8_WAIT_L(0); PG8_BAR; PG8_MMA(1, 0, At, B0); PG8_MMA(1, 1, At, B1); PG8_BAR; PG8_SCHED;
            } else {
            PG8_LDB(B0, 0, 0); PG8_SCHED; PG8_LDA(At, 0, 0); PG8_STAGE(PG8_SA(1, 1), a1, voC[1]);
            PG8_WAIT_L(8); PG8_BAR; PG8_WAIT_L(0); PG8_MMA(0, 0, At, B0); PG8_BAR; PG8_SCHED;
            PG8_LDB(B1, 0, 1); PG8_STAGE(PG8_SB(0, 0), b2, voffB);
            PG8_BAR; PG8_WAIT_L(0); PG8_MMA(0, 1, At, B1); PG8_BAR;
            PG8_LDA(At, 0, 1); PG8_STAGE(PG8_SA(0, 0), a2, vo2[0]);
            PG8_BAR; PG8_WAIT_L(0); PG8_MMA(1, 0, At, B0); PG8_BAR; PG8_SCHED;
            PG8_STAGE(PG8_SB(0, 1), b2 + hstepB, voffB);
            PG8_WAIT_V(6); PG8_BAR; PG8_MMA(1, 1, At, B1); PG8_BAR;
            PG8_LDB(B0, 1, 0); PG8_SCHED; PG8_LDA(At, 1, 0); PG8_STAGE(PG8_SA(0, 1), a2, vo2[1]);
            PG8_WAIT_L(8); PG8_BAR; PG8_WAIT_L(0); PG8_MMA(0, 0, At, B0); PG8_BAR; PG8_SCHED;
            PG8_LDB(B1, 1, 1); PG8_STAGE(PG8_SB(1, 0), b3, voffB);
            PG8_BAR; PG8_WAIT_L(0); PG8_MMA(0, 1, At, B1); PG8_BAR;
            PG8_LDA(At, 1, 1); PG8_STAGE(PG8_SA(1, 0), a3, vo2[0]);
            PG8_BAR; PG8_WAIT_L(0); PG8_MMA(1, 0, At, B0); PG8_BAR; PG8_SCHED;
            PG8_STAGE(PG8_SB(1, 1), b3 + hstepB, voffB);
            PG8_WAIT_V(6); PG8_BAR; PG8_MMA(1, 1, At, B1); PG8_BAR;
            }
        }
        if constexpr (ALIGN_EPI) { if (wr == 0) PG8_BAR; }
        if constexpr (FP8) asm volatile("s_nop 15\n\ts_nop 15" ::: "memory");
        E(acc, cur, wr, wc, fr, fq);
#if defined(EPI_TWICE) && EPI_TWICE
        if constexpr (FP8) { asm volatile("" ::: "memory"); E(acc, cur, wr, wc, fr, fq); }
#endif
        if (!has_next) break;
#pragma unroll
        for (int a = 0; a < 2; ++a)
#pragma unroll
            for (int b = 0; b < 2; ++b)
#pragma unroll
                for (int m = 0; m < 4; ++m)
#pragma unroll
                    for (int n = 0; n < 2; ++n) acc[a][b][m][n] = (f32x4){0.f, 0.f, 0.f, 0.f};
        cur = nxt; cB = nB; ++ui;
#pragma unroll
        for (int h = 0; h < 2; ++h)
#pragma unroll
            for (int i = 0; i < 2; ++i) voC[h][i] = voN[h][i];
        if constexpr (ALIGN_EPI) { if (wr == 1) PG8_BAR; }
    }
    PG8_WAIT_V(0);
    if constexpr (!ALIGN_EPI) { if (wr == 0) PG8_BAR; }
    PG8_BAR;
#undef PG8_SA
#undef PG8_SB
#undef PG8_STAGE
#undef PG8_LD1
#undef PG8_LDA
#undef PG8_LDB
#undef PG8_MMA
#undef PG8_WAIT_V
#undef PG8_WAIT_L
#undef PG8_BAR
#undef PG8_SCHED
}
}

#include <hip/hip_bf16.h>
#include <cmath>
namespace attn_body {
using bf16=__hip_bfloat16;
using bf16x8=__attribute__((ext_vector_type(8)))short;
using s16x4=__attribute__((ext_vector_type(4)))short;
using f32x16=__attribute__((ext_vector_type(16)))float;
using u32x4=__attribute__((ext_vector_type(4)))unsigned;
constexpr int BATCH=2,NHEAD=16,SEQ=8192,D=64,DM=NHEAD*D,KVP=256;
constexpr int NW=8,QBLK=32,QB=QBLK*NW,KVBLK=64,NQB=SEQ/QB;
constexpr int ATTN_PITCH=DM, ATTN_UNIT_ROWS=QB;
__device__ __forceinline__ int crow(int r,int hi){return (r&3)+8*(r>>2)+4*hi;}
#define SBAR() __builtin_amdgcn_sched_barrier(0)
__device__ __forceinline__ void cmask(f32x16&p0,f32x16&p1,int jb,int qrel,int hi){
  const float NEG=-INFINITY; int kb=64*jb+4*hi;
  #pragma unroll
  for(int r=0;r<16;++r){int kv=kb+(r&3)+8*(r>>2); if(kv>qrel)p0[r]=NEG; if(kv+32>qrel)p1[r]=NEG;}
}

constexpr int NSLOT=3, SLOTB=8192;
constexpr int LDS_K=0, LDS_V=NSLOT*SLOTB, LDS_WS=2*NSLOT*SLOTB, LDS_OST=LDS_WS+NW*64*4, LDS_BYTES=LDS_OST+NW*4096;
constexpr float C2=0.125f*1.4426950408889634f;
__device__ __forceinline__ void glds16(const void*gsrc,unsigned lds_dst){unsigned keep;
  asm volatile("s_mov_b32 %0, m0\n\ts_mov_b32 m0, %2\n\ts_nop 0\n\tglobal_load_lds_dwordx4 %1, off\n\ts_mov_b32 m0, %0":"=&s"(keep):"v"(gsrc),"s"(lds_dst):"memory");}
__device__ __forceinline__ float max3f(float a,float b,float c){float r;asm("v_max3_f32 %0, %1, %2, %3":"=v"(r):"v"(a),"v"(b),"v"(c));return r;}
__device__ __forceinline__ float max2f(float a,float b){float r;asm("v_max_f32_e32 %0, %1, %2":"=v"(r):"v"(a),"v"(b));return r;}
__device__ __forceinline__ float fadd_s(float a,float b){float r;asm("v_add_f32_e32 %0, %1, %2":"=v"(r):"v"(a),"v"(b));return r;}
__device__ __forceinline__ float fsub_s(float a,float b){float r;asm("v_sub_f32_e32 %0, %1, %2":"=v"(r):"v"(a),"v"(b));return r;}
typedef float f32x2_t __attribute__((ext_vector_type(2))); typedef __bf16 bf16x2_t __attribute__((ext_vector_type(2)));
__device__ __forceinline__ unsigned cvtpk_s(float lo,float hi){f32x2_t v={lo,hi};bf16x2_t b=__builtin_convertvector(v,bf16x2_t);return __builtin_bit_cast(unsigned,b);}
#define WAIT_BAR(N) asm volatile("s_waitcnt vmcnt(" #N ") lgkmcnt(0)\n\ts_barrier":::"memory")

__device__ __forceinline__ void qkt(f32x16&p0,f32x16&p1,const char*Kslot,const bf16x8*qr,const f32x16&negm,int r32,int hi){
  const char*kb=Kslot+hi*1024+r32*16;
  #pragma unroll
  for(int d0=0;d0<4;++d0){
    const bf16x8 b0=*reinterpret_cast<const bf16x8*>(kb+d0*2048);
    const bf16x8 b1=*reinterpret_cast<const bf16x8*>(kb+d0*2048+512);
    if(d0==0){p0=__builtin_amdgcn_mfma_f32_32x32x16_bf16(b0,qr[0],negm,0,0,0);p1=__builtin_amdgcn_mfma_f32_32x32x16_bf16(b1,qr[0],negm,0,0,0);}
    else{p0=__builtin_amdgcn_mfma_f32_32x32x16_bf16(b0,qr[d0],p0,0,0,0);p1=__builtin_amdgcn_mfma_f32_32x32x16_bf16(b1,qr[d0],p1,0,0,0);}}
}
typedef __attribute__((address_space(3))) const char* lds_cptr;
typedef short v4i16_t __attribute__((ext_vector_type(4)));
__device__ __forceinline__ void kload8(bf16x8*kf,lds_cptr kp){
  kf[0]=*(const __attribute__((address_space(3))) bf16x8*)(kp);      kf[1]=*(const __attribute__((address_space(3))) bf16x8*)(kp+512);
  kf[2]=*(const __attribute__((address_space(3))) bf16x8*)(kp+2048); kf[3]=*(const __attribute__((address_space(3))) bf16x8*)(kp+2560);
  kf[4]=*(const __attribute__((address_space(3))) bf16x8*)(kp+4096); kf[5]=*(const __attribute__((address_space(3))) bf16x8*)(kp+4608);
  kf[6]=*(const __attribute__((address_space(3))) bf16x8*)(kp+6144); kf[7]=*(const __attribute__((address_space(3))) bf16x8*)(kp+6656);
}
__device__ __forceinline__ void kload2(bf16x8*kf,lds_cptr kp,int j){ kf[2*j]=*(const __attribute__((address_space(3))) bf16x8*)(kp+j*2048); kf[2*j+1]=*(const __attribute__((address_space(3))) bf16x8*)(kp+j*2048+512); }
__device__ __forceinline__ s16x4 vtr(lds_cptr p){ return __builtin_bit_cast(s16x4,__builtin_amdgcn_ds_read_tr16_b64_v4i16((__attribute__((address_space(3))) v4i16_t*)p)); }
__device__ __forceinline__ float rowmax(const f32x16&p0,const f32x16&p1){
  float a=max3f(p0[0],p0[1],p1[0]),b=max3f(p0[2],p0[3],p1[1]);a=max3f(a,p1[2],p1[3]);
  #pragma unroll
  for(int r=4;r<16;r+=4){a=max3f(a,p0[r],p0[r+1]);b=max3f(b,p0[r+2],p0[r+3]);a=max3f(a,p1[r],p1[r+1]);b=max3f(b,p1[r+2],p1[r+3]);}
  const float m=max2f(a,b);
  auto rr=__builtin_amdgcn_permlane32_swap(__float_as_uint(m),__float_as_uint(m),false,false);
  return max2f(__uint_as_float(rr[0]),__uint_as_float(rr[1]));
}
__device__ __forceinline__ void pv(f32x16*o,int vb,bf16x8 pa0,bf16x8 pa1,bf16x8 pa2,bf16x8 pa3){
  #pragma unroll
  for(int d0=0;d0<2;++d0){s16x4 lo[4],hi[4];
    #pragma unroll
    for(int ks=0;ks<4;++ks){
      asm volatile("ds_read_b64_tr_b16 %0,%1 offset:%c2":"=&v"(lo[ks]):"v"(vb),"i"(d0*4096+ks*1024):"memory");
      asm volatile("ds_read_b64_tr_b16 %0,%1 offset:%c2":"=&v"(hi[ks]):"v"(vb),"i"(d0*4096+ks*1024+512):"memory");}
    asm volatile("s_waitcnt lgkmcnt(0)":::"memory");SBAR();
    #define PK(k) (bf16x8){lo[k][0],lo[k][1],lo[k][2],lo[k][3],hi[k][0],hi[k][1],hi[k][2],hi[k][3]}
    o[d0]=__builtin_amdgcn_mfma_f32_32x32x16_bf16(pa0,PK(0),o[d0],0,0,0);
    o[d0]=__builtin_amdgcn_mfma_f32_32x32x16_bf16(pa1,PK(1),o[d0],0,0,0);
    o[d0]=__builtin_amdgcn_mfma_f32_32x32x16_bf16(pa2,PK(2),o[d0],0,0,0);
    o[d0]=__builtin_amdgcn_mfma_f32_32x32x16_bf16(pa3,PK(3),o[d0],0,0,0);
    #undef PK
  }
}

#ifndef ATTN_STORE16
#define ATTN_STORE16(p,v) pg8::st16((void*)(p),(v))
#endif
template<int THRL,bool FIX> __device__ __forceinline__ void attn_unit(float refB,int b,int h,int kvh,int qb,const bf16*Q,const bf16*__restrict__ K,const bf16*__restrict__ V,bf16*O,char*shm){
  const int tid=threadIdx.x,lane=tid&63,r32=lane&31,hi=lane>>5; const int wid=__builtin_amdgcn_readfirstlane(tid>>6);
  const long rowbase=(long)b*SEQ; const int q0=qb*QB;
  const bf16*Qw=Q+(rowbase+q0+wid*QBLK)*DM+h*D;
  const bf16*Kh=K+rowbase*KVP+kvh*D,*Vh=V+rowbase*KVP+kvh*D;
  const unsigned lds0=(unsigned)(uintptr_t)shm;
  float*wsf=(float*)(shm+LDS_WS)+wid*64;
  const bf16*ksrc=Kh+(long)lane*KVP+wid*8;
  const bf16*vsrc=Vh+(long)(16*(wid&3)+(lane>>2))*KVP+(wid>>2)*32+(lane&3)*8;
  const unsigned kdst=lds0+LDS_K+wid*1024, vdst=lds0+LDS_V+wid*1024;
  #define DMA_K(t,slot) glds16(ksrc+(long)(t)*KVBLK*KVP,(unsigned)__builtin_amdgcn_readfirstlane(kdst+(slot)))
  #define DMA_V(t,slot) glds16(vsrc+(long)(t)*KVBLK*KVP,(unsigned)__builtin_amdgcn_readfirstlane(vdst+(slot)))
  const int vb0=(int)(lds0+LDS_V)+((lane>>4)&1)*32+(lane&3)*8+(4*hi+((lane&15)>>2))*64;
  const char*Kbase=shm+LDS_K; bf16x8 kf[8];
  const lds_cptr shm3=(lds_cptr)shm; const lds_cptr kp0=shm3+LDS_K+hi*1024+r32*16; const lds_cptr vp0=shm3+LDS_V+((lane>>4)&1)*32+(lane&3)*8+(4*hi+((lane&15)>>2))*64;
  const int NT=SEQ/KVBLK;
  DMA_K(0,0);DMA_V(0,0);DMA_K(1,SLOTB);
  bf16x8 qr[4];
  #pragma unroll
  for(int d0=0;d0<4;++d0)qr[d0]=*reinterpret_cast<const bf16x8*>(&Qw[(long)r32*DM+d0*16+hi*8]);
  float mhat=0.f,l_reg=0.f;f32x16 o[2];o[0]=f32x16{};o[1]=f32x16{};f32x16 negm=f32x16{}; if constexpr(FIX){ _Pragma("unroll") for(int r=0;r<16;++r)negm[r]=-refB; } asm volatile("":"+v"(negm));
  const int qrel=wid*QBLK+r32;
  #define CMASK(P0,P1,t) do{}while(0)
  bool resc=false;
  #define START(P0,P1) do{ if constexpr(!FIX){ const float rm=rowmax(P0,P1); resc=false; \
    { const float dl=rm; mhat=fadd_s(mhat,dl); \
      _Pragma("unroll") for(int r=0;r<16;++r){P0[r]=fsub_s(P0[r],dl);P1[r]=fsub_s(P1[r],dl);} \
      _Pragma("unroll") for(int r=0;r<16;++r)negm[r]=-mhat; asm volatile("":"+v"(negm)); } } \
    _Pragma("unroll") for(int r=0;r<16;++r)P0[r]=__builtin_amdgcn_exp2f(P0[r]); }while(0)
  #define RESC() do{ if constexpr(!FIX) if(resc){ asm volatile("s_waitcnt lgkmcnt(0)":::"memory"); \
      _Pragma("unroll") for(int d_=0;d_<2;++d_) _Pragma("unroll") for(int r=0;r<16;++r)o[d_][r]*=wsf[crow(r,hi)]; } }while(0)
  f32x16 pA0,pA1,pB0,pB1;
  int sl_prev=0,sl_cur=0,sl_next=SLOTB;
  #define ROT() do{sl_prev=sl_cur;sl_cur=sl_next;sl_next=(sl_next==(NSLOT-1)*SLOTB)?0:sl_next+SLOTB;}while(0)
  DMA_K(2,2*SLOTB);
  WAIT_BAR(3);
  qkt(pA0,pA1,Kbase,qr,negm,r32,hi);asm volatile("s_nop 15\n\ts_nop 7":"+v"(pA0),"+v"(pA1));CMASK(pA0,pA1,0);
  START(pA0,pA1);
  _Pragma("unroll") for(int r=0;r<16;++r)pA1[r]=__builtin_amdgcn_exp2f(pA1[r]);
  WAIT_BAR(0);
  DMA_K(3,0);DMA_V(1,SLOTB);
  ROT();
  kload8(kf,kp0+sl_cur);
  WAIT_BAR(2);
  s16x4 vlo[8],vhi[8]; u32x4 pw0,pw1,pw2,pw3;
  #define PKW(P,B) cvtpk_s(P[B],P[B+1])
  #define PAF(k) __builtin_bit_cast(bf16x8,pw##k)
  #define VFR(i) (bf16x8){vlo[i][0],vlo[i][1],vlo[i][2],vlo[i][3],vhi[i][0],vhi[i][1],vhi[i][2],vhi[i][3]}
  #define PIN(x) asm volatile("":"+v"(x))
  #define MX3(a,b,c) __builtin_fmaxf(__builtin_fmaxf((a),(b)),(c))
  #define GAPA(MF,A0,A1,A2,A3,W0,W1,PW) do{ MF; sacc+=A0; sacc+=A1; sacc+=A2; sacc+=A3; PIN(sacc); W0; W1; PIN(PW); SBAR(); }while(0)
  #define EX(v) __builtin_amdgcn_exp2f(v)
  #define GAPB(MF,X,B) do{ MF; X[B]=EX(X[B]); X[B+1]=EX(X[B+1]); X[B+2]=EX(X[B+2]); X[B+3]=EX(X[B+3]); PIN(X); SBAR(); }while(0)
  #define VRD(i) do{ vlo[i]=vtr(vp_+(((i)>>2)*4096+((i)&3)*1024)); vhi[i]=vtr(vp_+(((i)>>2)*4096+((i)&3)*1024+512)); }while(0)
  #define KRD(G,j) do{ if(G){ kload2(kf,kp0+sl_next,j); SBAR(); } }while(0)
  #define STEP(C0,C1,P0,P1,t,GK,GV,GL) do{ SBAR(); \
    const lds_cptr vp_=vp0+sl_prev; \
    VRD(0); SBAR(); float sacc=(P0[0]+P0[1]); \
    GAPA(C0=__builtin_amdgcn_mfma_f32_32x32x16_bf16(kf[0],qr[0],negm,0,0,0), P0[2],P0[3],P0[4],P0[5],     pw0[0]=PKW(P0,0), pw0[1]=PKW(P0,2), pw0); \
    VRD(4); SBAR(); GAPA(C1=__builtin_amdgcn_mfma_f32_32x32x16_bf16(kf[1],qr[0],negm,0,0,0), P0[6],P0[7],P0[8],P0[9],     pw0[2]=PKW(P0,4), pw0[3]=PKW(P0,6), pw0); \
    VRD(1); SBAR(); GAPA(C0=__builtin_amdgcn_mfma_f32_32x32x16_bf16(kf[2],qr[1],C0,0,0,0),   P0[10],P0[11],P0[12],P0[13], pw1[0]=PKW(P0,8), pw1[1]=PKW(P0,10), pw1); \
    VRD(5); SBAR(); GAPA(C1=__builtin_amdgcn_mfma_f32_32x32x16_bf16(kf[3],qr[1],C1,0,0,0),   P0[14],P0[15],P1[0],P1[1],   pw1[2]=PKW(P0,12),pw1[3]=PKW(P0,14), pw1); \
    VRD(2); SBAR(); GAPA(C0=__builtin_amdgcn_mfma_f32_32x32x16_bf16(kf[4],qr[2],C0,0,0,0),   P1[2],P1[3],P1[4],P1[5],     pw2[0]=PKW(P1,0), pw2[1]=PKW(P1,2), pw2); \
    VRD(6); SBAR(); GAPA(C1=__builtin_amdgcn_mfma_f32_32x32x16_bf16(kf[5],qr[2],C1,0,0,0),   P1[6],P1[7],P1[8],P1[9],     pw2[2]=PKW(P1,4), pw2[3]=PKW(P1,6), pw2); \
    VRD(3); SBAR(); GAPA(C0=__builtin_amdgcn_mfma_f32_32x32x16_bf16(kf[6],qr[3],C0,0,0,0),   P1[10],P1[11],P1[12],P1[13], pw3[0]=PKW(P1,8), pw3[1]=PKW(P1,10), pw3); \
    VRD(7); SBAR(); GAPA(C1=__builtin_amdgcn_mfma_f32_32x32x16_bf16(kf[7],qr[3],C1,0,0,0),   P1[14],P1[15],0.f,0.f,       pw3[2]=PKW(P1,12),pw3[3]=PKW(P1,14), pw3); \
    l_reg+=sacc; \
    if(GK){DMA_K((t)+3,sl_cur);} if(GV){DMA_V((t)+1,sl_next);} \
    CMASK(C0,C1,t); \
    if constexpr(!FIX){ float a=MX3(C0[0],C0[1],C1[0]),b=MX3(C0[2],C0[3],C1[1]); a=MX3(a,C1[2],C1[3]); \
      _Pragma("unroll") for(int r=4;r<16;r+=4){a=MX3(a,C0[r],C0[r+1]);b=MX3(b,C0[r+2],C0[r+3]);a=MX3(a,C1[r],C1[r+1]);b=MX3(b,C1[r+2],C1[r+3]);} \
      float rm=__builtin_fmaxf(a,b); { auto rr=__builtin_amdgcn_permlane32_swap(__float_as_uint(rm),__float_as_uint(rm),false,false); rm=__builtin_fmaxf(__uint_as_float(rr[0]),__uint_as_float(rr[1])); } \
      resc=false; \
      if(__builtin_expect(__any(rm>(float)THRL),0)){ const float dl=__builtin_fmaxf(rm,0.f); mhat+=dl; \
        _Pragma("unroll") for(int r=0;r<16;++r){C0[r]-=dl;C1[r]-=dl;} \
        _Pragma("unroll") for(int r=0;r<16;++r)negm[r]=-mhat; asm volatile("":"+v"(negm)); \
        const float f=__builtin_amdgcn_exp2f(-dl); l_reg*=f; if(hi==0)wsf[r32]=f; resc=true; } } \
    SBAR(); \
    GAPB(o[0]=__builtin_amdgcn_mfma_f32_32x32x16_bf16(PAF(0),VFR(0),o[0],0,0,0), C0,0); \
    GAPB(o[1]=__builtin_amdgcn_mfma_f32_32x32x16_bf16(PAF(0),VFR(4),o[1],0,0,0), C0,4); \
    KRD(GL,0); GAPB(o[0]=__builtin_amdgcn_mfma_f32_32x32x16_bf16(PAF(1),VFR(1),o[0],0,0,0), C0,8); \
    KRD(GL,1); GAPB(o[1]=__builtin_amdgcn_mfma_f32_32x32x16_bf16(PAF(1),VFR(5),o[1],0,0,0), C0,12); \
    KRD(GL,2); GAPB(o[0]=__builtin_amdgcn_mfma_f32_32x32x16_bf16(PAF(2),VFR(2),o[0],0,0,0), C1,0); \
    KRD(GL,3); GAPB(o[1]=__builtin_amdgcn_mfma_f32_32x32x16_bf16(PAF(2),VFR(6),o[1],0,0,0), C1,4); \
    GAPB(o[0]=__builtin_amdgcn_mfma_f32_32x32x16_bf16(PAF(3),VFR(3),o[0],0,0,0), C1,8); \
    GAPB(o[1]=__builtin_amdgcn_mfma_f32_32x32x16_bf16(PAF(3),VFR(7),o[1],0,0,0), C1,12); \
    }while(0)
  int t=1;
#if defined(ATTN_PRIO) && ATTN_PRIO
  if(wid>=4)__builtin_amdgcn_s_setprio(1);
#endif
  #undef CMASK
  #define CMASK(P0,P1,t) do{}while(0)
  for(;t+5<NT;t+=2){
    STEP(pB0,pB1,pA0,pA1,t,true,true,true);     WAIT_BAR(2); RESC(); ROT();
    STEP(pA0,pA1,pB0,pB1,t+1,true,true,true);   WAIT_BAR(2); RESC(); ROT();
  }
  #undef CMASK
  #define CMASK(P0,P1,t) do{}while(0)
  #define ENDW(tt) do{ if((tt)+3<NT){WAIT_BAR(2);} else if((tt)+2<NT){WAIT_BAR(1);} else {WAIT_BAR(0);} }while(0)
  for(;t+1<NT;t+=2){
    STEP(pB0,pB1,pA0,pA1,t,(t+3<NT),(t+1<NT),(t+1<NT));       ENDW(t);   RESC(); ROT();
    STEP(pA0,pA1,pB0,pB1,t+1,(t+4<NT),(t+2<NT),(t+2<NT));     ENDW(t+1); RESC(); ROT();
  }
  STEP(pB0,pB1,pA0,pA1,NT-1,false,false,false); RESC();
  { float sacc=pB0[0]+pB0[1]; _Pragma("unroll") for(int r=2;r<16;++r)sacc+=pB0[r]; _Pragma("unroll") for(int r=0;r<16;++r)sacc+=pB1[r]; l_reg+=sacc;
    pw0=(u32x4){PKW(pB0,0),PKW(pB0,2),PKW(pB0,4),PKW(pB0,6)};pw1=(u32x4){PKW(pB0,8),PKW(pB0,10),PKW(pB0,12),PKW(pB0,14)};pw2=(u32x4){PKW(pB1,0),PKW(pB1,2),PKW(pB1,4),PKW(pB1,6)};pw3=(u32x4){PKW(pB1,8),PKW(pB1,10),PKW(pB1,12),PKW(pB1,14)};
    SBAR(); pv(o,vb0+sl_cur,PAF(0),PAF(1),PAF(2),PAF(3)); }
  #undef PKW
  #undef PAF
  #undef VFR
  #undef PIN
  #undef MX3
  #undef GAPA
  #undef GAPB
  #undef EX
  #undef VRD
  #undef KRD
  #undef STEP
  #undef ENDW
#if defined(ATTN_PRIO) && ATTN_PRIO
  __builtin_amdgcn_s_setprio(0);
#endif
  {auto rr=__builtin_amdgcn_permlane32_swap(__float_as_uint(l_reg),__float_as_uint(l_reg),false,false);l_reg=__uint_as_float(rr[0])+__uint_as_float(rr[1]);}
  if(hi==0)wsf[32+r32]=l_reg;asm volatile("s_waitcnt lgkmcnt(0)":::"memory");
  float rli[16];
  #pragma unroll
  for(int r=0;r<16;++r)rli[r]=__builtin_amdgcn_rcpf(wsf[32+crow(r,hi)]);
  bf16*Ow=O+(rowbase+q0+wid*QBLK)*DM+h*D;
  { bf16*stg=(bf16*)(shm+LDS_OST)+wid*2048;
    #pragma unroll
    for(int r=0;r<16;++r){const int orow=crow(r,hi);
      #pragma unroll
      for(int d0=0;d0<2;++d0)stg[orow*64+d0*32+r32]=__float2bfloat16(o[d0][r]*rli[r]);}
    asm volatile("s_waitcnt lgkmcnt(0)":::"memory");
    #pragma unroll
    for(int i=0;i<4;++i){const int row=i*8+(lane>>3),ch=lane&7; const u32x4 v=*(const u32x4*)(stg+row*64+ch*8); ATTN_STORE16(Ow+(long)row*DM+ch*8,v);} }
  asm volatile("s_waitcnt lgkmcnt(0)\n\ts_barrier":::"memory");
  #undef DMA_K
  #undef DMA_V
  #undef CMASK
  #undef START
  #undef RESC
  #undef ROT
}
constexpr int ATTN_LDS_BYTES=LDS_BYTES;
struct AttnTensors { const bf16* Q; const bf16* K; const bf16* V; bf16* O; };
struct AttnUnit { int bh; int qb; };
struct StaticOrder {
  int vcu;
  __device__ __forceinline__ explicit StaticOrder(int grid,int block):vcu((block%8)*(grid/8)+block/8){}
  __device__ __forceinline__ bool next(int i,AttnUnit&u)const{ if(i>=4)return false; const int x=vcu>>5, j=vcu&31; const int b=x>>2, kvh=x&3; u.bh=b*16+kvh*4+i; u.qb=j; return true; }
  __device__ __forceinline__ void a_ready(const AttnUnit&)const{}
  __device__ __forceinline__ void done(const AttnUnit&)const{}
};
template<class Sched,bool FIX,int THRL=8> __device__ __forceinline__ void attn_phase(char*lds,const AttnTensors&T,const Sched&S,float refB){
  AttnUnit u;
  for(int i=0;S.next(i,u);++i){ S.a_ready(u); attn_unit<THRL,FIX>(refB,u.bh/NHEAD,u.bh%NHEAD,(u.bh%NHEAD)>>2,u.qb,T.Q,T.K,T.V,T.O,lds); S.done(u); }
}
#undef SBAR
#undef WAIT_BAR
}

#define GAS __attribute__((address_space(1)))
#define LAS __attribute__((address_space(3)))
typedef unsigned short bf16;
typedef unsigned v4u __attribute__((ext_vector_type(4)));
typedef float f32x4 __attribute__((ext_vector_type(4)));
typedef short bf16x8 __attribute__((ext_vector_type(8)));
typedef GAS unsigned gu32;
typedef GAS unsigned long long gu64;
#define RLX_AGENT __ATOMIC_RELAXED, __HIP_MEMORY_SCOPE_AGENT
#define LDS_WAIT() asm volatile("s_waitcnt lgkmcnt(0)" ::: "memory")
#define VM_WAIT() asm volatile("s_waitcnt vmcnt(0)" ::: "memory")
__device__ __forceinline__ unsigned long long rt() { return __builtin_amdgcn_s_memrealtime(); }
__device__ __forceinline__ unsigned f2bf(float f) { unsigned u = __builtin_bit_cast(unsigned, f); return (u + 0x7fffu + ((u >> 16) & 1u)) >> 16; }
__device__ __forceinline__ unsigned pk2(float lo, float hi) { return pg8::cvt_pk_bf16(lo, hi); }

#define XB_TMO      128
#define XB_XCNT(j)  (256  + 64 * (j))
#define XB_XSUB(j)  (1280 + 64 * (j))
#define XB_XGEN(j)  (2304 + 64 * (j))
#define XB_TOP      3328
#define XB_TOPGEN   3392
#define XCD_BAR_WORDS 3456
#define XB_SPIN_CAP (1u << 18)

__device__ __forceinline__ unsigned xb_ld(unsigned* p)              { return __hip_atomic_load(p, __ATOMIC_RELAXED, __HIP_MEMORY_SCOPE_AGENT); }
__device__ __forceinline__ unsigned xb_add(unsigned* p, unsigned v) { return __hip_atomic_fetch_add(p, v, __ATOMIC_RELAXED, __HIP_MEMORY_SCOPE_AGENT); }
__device__ __forceinline__ unsigned xb_xcc_id() { return (unsigned)__builtin_amdgcn_s_getreg((3 << 11) | 20) & 0xFu; }
#ifndef XB_SLEEP
#define XB_SLEEP 1
#endif
#define XB_SPIN(cond, bar) do { unsigned _sp = 0; while (cond) { __builtin_amdgcn_s_sleep(XB_SLEEP); \
    if ((++_sp & 255u) == 0u) { if (xb_ld(&(bar)[XB_TMO])) break; if (_sp > XB_SPIN_CAP) { atomicAdd(&(bar)[XB_TMO], 1u); break; } } } } while (0)

struct XcdBarrier {
    unsigned* bar; unsigned x;
    volatile LAS unsigned* st;
};

__device__ __forceinline__ XcdBarrier xcd_barrier_post(unsigned* bar, volatile LAS unsigned* st) {
    XcdBarrier b; b.bar = bar; b.x = xb_xcc_id(); b.st = st;
    if (threadIdx.x == 0) (void)xb_add(&bar[XB_XCNT(b.x)], 1u);
    return b;
}
__device__ __forceinline__ void xcd_barrier_complete(unsigned* bar, unsigned x, unsigned& nloc, unsigned& nx) {
    const unsigned G = gridDim.x * gridDim.y * gridDim.z;
    unsigned sum, cnt, mine, sp = 0u;
    for (;;) {
        sum = 0u; cnt = 0u; mine = 0u;
#pragma unroll
        for (unsigned j = 0; j < 16; ++j) { const unsigned c = xb_ld(&bar[XB_XCNT(j)]); sum += c; cnt += (c > 0u) ? 1u : 0u; mine = (j == x) ? c : mine; }
        if (sum == G) break;
        __builtin_amdgcn_s_sleep(1);
        if ((++sp & 255u) == 0u) { if (xb_ld(&bar[XB_TMO])) break; if (sp > XB_SPIN_CAP) { atomicAdd(&bar[XB_TMO], 1u); break; } }
    }
    nloc = mine > 0u ? mine : 1u; nx = cnt > 0u ? cnt : 1u;
}

__device__ __forceinline__ void xcd_barrier(const XcdBarrier& b) {
    asm volatile("s_waitcnt vmcnt(0)" ::: "memory");
    __syncthreads();
    if (threadIdx.x == 0) {
        unsigned* bar = b.bar;
        __builtin_amdgcn_s_waitcnt(0);
        unsigned nloc = b.st[0], nx = b.st[1];
        if (nloc == 0u) { xcd_barrier_complete(bar, b.x, nloc, nx); b.st[0] = nloc; b.st[1] = nx; }
        const unsigned old = xb_add(&bar[XB_XSUB(b.x)], 1u);
        const unsigned gen = old / nloc;
        if (old + 1u == (gen + 1u) * nloc) {
            __builtin_amdgcn_fence(__ATOMIC_RELEASE, "agent");
            asm volatile("s_waitcnt vmcnt(0)" ::: "memory");
            const unsigned og = xb_add(&bar[XB_TOP], 1u);
            const unsigned tg = og / nx;
            if (og + 1u == (tg + 1u) * nx) xb_add(&bar[XB_TOPGEN], 1u);
            else XB_SPIN(xb_ld(&bar[XB_TOPGEN]) == tg, bar);
            __builtin_amdgcn_fence(__ATOMIC_ACQUIRE, "agent");
            xb_add(&bar[XB_XGEN(b.x)], 1u);
            asm volatile("s_waitcnt vmcnt(0)" ::: "memory");
        } else {
            XB_SPIN(xb_ld(&bar[XB_XGEN(b.x)]) == gen, bar);
            __builtin_amdgcn_fence(__ATOMIC_ACQUIRE, "agent");
            asm volatile("s_waitcnt vmcnt(0)" ::: "memory");
        }
    }
    __syncthreads();
}

#ifndef MOE_FP8
#define MOE_FP8 1
#endif
#ifndef MOE_WGM
#define MOE_WGM 8
#endif
#ifndef P15_ALIGN
#define P15_ALIGN true
#endif
#ifndef P15_SP2
#define P15_SP2 true
#endif
#ifndef FFN_FP8
#define FFN_FP8 0
#endif
#ifndef MOE_CVT_IN_SCAN
#define MOE_CVT_IN_SCAN 1
#endif
#ifndef ATTN_PRIO
#define ATTN_PRIO 1
#endif
#ifndef MOE_CVT_SPLIT
#define MOE_CVT_SPLIT 16384
#endif
#ifndef CVT_P0_END
#define CVT_P0_END T_ISMALL
#endif
#ifndef CVT_S1
#define CVT_S1 11264
#endif
#ifndef CVT_S2
#define CVT_S2 16384
#endif
#ifndef FFN_WGM
#define FFN_WGM 8
#endif
#ifndef S_BF16
#define S_BF16 0
#endif
#ifndef NORM_FACTOR
#define NORM_FACTOR 0
#endif
constexpr int NWAVES = 8;
constexpr int NTOK = 16384, DM = 1024, SEQ = 8192, NB = 2;
constexpr int DFF = 2816, NEXP = 8, DFE = 3584, QKVW = 1536;
constexpr float EPS = 1e-6f;
constexpr float QSCALE = 0.125f * 1.4426950408889634f;

constexpr size_t MiB = 1u << 20;
constexpr size_t WS_CTL = 0, CTL_ZERO_BYTES = 1 * MiB;
constexpr size_t WS_ROPE_R = 1 * MiB, WS_ROPE_C = 1 * MiB + 16384, WS_AT = 1 * MiB + 65536, WS_QKG = 1 * MiB + 131072, WS_TOKINFO = 1 * MiB + 262144;
constexpr size_t WS_RSTD = 1 * MiB + 524288;
constexpr size_t WS_LIST = 2 * MiB, WS_IDLIST = 3 * MiB;
constexpr size_t WS_BT_IN = 4 * MiB, WS_BT_GLU = 6 * MiB, WS_BT_SOUT = 8 * MiB, WS_BT_AO = 10 * MiB, WS_BT_QKV = 12 * MiB, WS_BT_GU = 16 * MiB, WS_BT_FD = 28 * MiB;
constexpr size_t WS_S5_MAIN = 34 * MiB, WS_S5_STATE = 50 * MiB;
constexpr size_t WS_A2 = 58 * MiB, WS_S = 122 * MiB, WS_G1 = 122 * MiB, WS_G2 = 154 * MiB, WS_MIX = 58 * MiB;
constexpr size_t WS_ACTF = 122 * MiB;
constexpr size_t WS_Q = 122 * MiB, WS_K = 154 * MiB, WS_V = 162 * MiB, WS_O = 170 * MiB;
constexpr size_t WS_XN = 242 * MiB;
constexpr size_t WS_ACTM = 4 * MiB;
constexpr size_t WS_BT_MGU = 280 * MiB, WS_BT_MD = 392 * MiB, WS_SLOT = 124 * MiB, WS_PART = 192 * MiB, WS_HB = 336 * MiB, WS_END = 448 * MiB;
static_assert(WS_ACTM + (size_t)34816 * DFE * 2 <= WS_XN && WS_XN + (size_t)NTOK * DM * 2 <= WS_BT_MGU && WS_BT_MGU + (size_t)8 * 7168 * 1024 * 2 == WS_BT_MD && WS_BT_MD + (size_t)8 * 1024 * 3584 * 2 == WS_END, "ws map");
static_assert(WS_S5_STATE + (size_t)64 * 256 * 256 * 2 <= WS_A2 && WS_ACTF + (size_t)NTOK * DFF * 2 <= WS_XN && WS_O + (size_t)NTOK * DM * 2 <= WS_XN && WS_SLOT + (size_t)34816 * DM * 2 <= WS_PART && WS_PART + (size_t)256 * 131072 <= WS_XN && WS_ACTM + (size_t)34816 * DFE <= WS_SLOT && WS_BT_MGU + (size_t)8 * 7168 * 1024 <= WS_HB && WS_HB + (size_t)NTOK * DM * 2 <= WS_BT_MD && MOE_FP8 == 1, "ws map 2");
constexpr int CW_TMO = 0, CW_CODE = 1, CW_BAR = 4096, CW_CNT = 8192;

constexpr int RING_OFF = 0, RING_BYTES = 131072;
constexpr int LDSCTL_OFF = RING_BYTES, MISC_OFF = LDSCTL_OFF + 320;
constexpr int LDS_BYTES = 147456;

typedef unsigned v2u __attribute__((ext_vector_type(2)));
typedef float v2f __attribute__((ext_vector_type(2)));

constexpr int MOE_OFF = MISC_OFF + 256;
struct Frame {
    LAS unsigned char* lds;
    volatile LAS unsigned* MISC;
    gu32* ctl;
    int tid, lane, wave;
    int vcu, G;
};
__device__ __forceinline__ float wave_sum(float v) {
#pragma unroll
    for (int o = 1; o < 64; o <<= 1) v += __shfl_xor(v, o);
    return v;
}
constexpr int T_ISMALL = 4 * 256 + 384 + 3 * 704, T_NITEMS = T_ISMALL + 8 * 3 * 896;
struct TItem { const float* W; bf16* WT; int K, N, kind, half, item, f8; const float* gain; };
__device__ __forceinline__ TItem t_decode(int it, const float* const* in, unsigned char* ws) {
    constexpr int I_SQ = 256, I_FG = 704, I_QKV = 384, I_M = 896;
    TItem t; int r = it; t.kind = 0; t.half = 0; t.K = DM; t.N = DM; t.f8 = 0; t.gain = nullptr;
    if (r < I_SQ) { t.W = in[2]; t.WT = (bf16*)(ws + WS_BT_IN); t.item = r; if (NORM_FACTOR) t.gain = in[1]; return t; } r -= I_SQ;
    if (r < I_SQ) { t.W = in[11]; t.WT = (bf16*)(ws + WS_BT_GLU); t.item = r; return t; } r -= I_SQ;
    if (r < I_SQ) { t.W = in[12]; t.WT = (bf16*)(ws + WS_BT_SOUT); t.item = r; return t; } r -= I_SQ;
    if (r < I_SQ) { t.W = in[19]; t.WT = (bf16*)(ws + WS_BT_AO); t.item = r; return t; } r -= I_SQ;
    if (r < I_QKV) { t.W = in[16]; t.WT = (bf16*)(ws + WS_BT_QKV); t.N = QKVW; t.kind = 2; t.item = r; if (NORM_FACTOR) t.gain = in[1] + 4 * DM; return t; } r -= I_QKV;
    if (r < I_FG) { t.W = in[13]; t.WT = (bf16*)(ws + WS_BT_GU); t.N = DFF; t.kind = 1; t.item = r; t.f8 = FFN_FP8; if (NORM_FACTOR) t.gain = in[1] + 2 * DM; return t; } r -= I_FG;
    if (r < I_FG) { t.W = in[14]; t.WT = (bf16*)(ws + WS_BT_GU); t.N = DFF; t.kind = 1; t.half = 1; t.item = r; t.f8 = FFN_FP8; if (NORM_FACTOR) t.gain = in[1] + 2 * DM; return t; } r -= I_FG;
    if (r < I_FG) { t.W = in[15]; t.WT = (bf16*)(ws + WS_BT_FD); t.K = DFF; t.item = r; t.f8 = FFN_FP8; return t; } r -= I_FG;
    const int e = r / (3 * I_M); r -= e * 3 * I_M; t.f8 = MOE_FP8;
    if (r < I_M) { t.W = in[21] + (size_t)e * DM * DFE; t.WT = (bf16*)(ws + WS_BT_MGU + (size_t)e * 7168 * 1024 * (MOE_FP8 ? 1 : 2)); t.N = DFE; t.kind = 1; t.item = r; return t; } r -= I_M;
    if (r < I_M) { t.W = in[22] + (size_t)e * DM * DFE; t.WT = (bf16*)(ws + WS_BT_MGU + (size_t)e * 7168 * 1024 * (MOE_FP8 ? 1 : 2)); t.N = DFE; t.kind = 1; t.half = 1; t.item = r; return t; } r -= I_M;
    t.W = in[23] + (size_t)e * DFE * DM; t.WT = (bf16*)(ws + WS_BT_MD + (size_t)e * 1024 * 3584 * (MOE_FP8 ? 1 : 2)); t.K = DFE; t.item = r; return t;
}
__device__ __forceinline__ void t_issue(const TItem& t, int lane, f32x4 (&ld)[16]) {
    const int nblk = t.N / 64, kb = t.item / nblk, nb = t.item - kb * nblk;
    const int rmul = t.f8 ? 4 : 2;
    const float* p = t.W + (size_t)(64 * kb + rmul * (lane >> 4)) * t.N + 64 * nb + 4 * (lane & 15);
#pragma unroll
    for (int i = 0; i < 16; ++i) ld[i] = *(const GAS f32x4*)(p + (size_t)(t.f8 ? 16 * (i >> 2) + (i & 3) : 8 * (i >> 1) + (i & 1)) * t.N);
}
__device__ __forceinline__ void t_finish(const TItem& t, int lane, const f32x4 (&ld)[16], LAS unsigned* T) {
    const int nblk = t.N / 64, kb = t.item / nblk, nb = t.item - kb * nblk, k0 = 64 * kb, n0 = 64 * nb;
    const int r = lane >> 4, cg = lane & 15;
    if (t.f8) {
        unsigned char* WT8 = (unsigned char*)t.WT;
#pragma unroll
        for (int mq = 0; mq < 4; ++mq) { LAS unsigned* d = T + (4 * mq + r) * 65 + 4 * cg;
            d[0] = pg8::pack4_fp8(ld[4 * mq].x * 64.f, ld[4 * mq + 1].x * 64.f, ld[4 * mq + 2].x * 64.f, ld[4 * mq + 3].x * 64.f);
            d[1] = pg8::pack4_fp8(ld[4 * mq].y * 64.f, ld[4 * mq + 1].y * 64.f, ld[4 * mq + 2].y * 64.f, ld[4 * mq + 3].y * 64.f);
            d[2] = pg8::pack4_fp8(ld[4 * mq].z * 64.f, ld[4 * mq + 1].z * 64.f, ld[4 * mq + 2].z * 64.f, ld[4 * mq + 3].z * 64.f);
            d[3] = pg8::pack4_fp8(ld[4 * mq].w * 64.f, ld[4 * mq + 1].w * 64.f, ld[4 * mq + 2].w * 64.f, ld[4 * mq + 3].w * 64.f); }
        LDS_WAIT(); asm volatile("" ::: "memory");
        const int c4 = lane & 3;
#pragma unroll
        for (int j = 0; j < 4; ++j) { const int nl = (lane >> 2) + 16 * j, n = n0 + nl;
            const int dr = t.kind == 0 ? n : 256 * (n / 128) + (n % 128) + 128 * t.half;
            const LAS unsigned* s = T + (4 * c4) * 65 + nl;
            v4u o; o.x = s[0]; o.y = s[65]; o.z = s[130]; o.w = s[195];
            *(GAS v4u*)(WT8 + (size_t)dr * t.K + k0 + 16 * c4) = o; }
        LDS_WAIT(); asm volatile("" ::: "memory");
        return;
    }
#pragma unroll
    for (int m = 0; m < 8; ++m) { LAS unsigned* d = T + (4 * m + r) * 65 + 4 * cg;
        float g0 = 1.f, g1 = 1.f; if (NORM_FACTOR && t.gain) { const v2f gg = *(const GAS v2f*)(t.gain + k0 + 8 * m + 2 * r); g0 = gg.x; g1 = gg.y; }
        d[0] = pk2(ld[2 * m].x * g0, ld[2 * m + 1].x * g1); d[1] = pk2(ld[2 * m].y * g0, ld[2 * m + 1].y * g1); d[2] = pk2(ld[2 * m].z * g0, ld[2 * m + 1].z * g1); d[3] = pk2(ld[2 * m].w * g0, ld[2 * m + 1].w * g1); }
    LDS_WAIT(); asm volatile("" ::: "memory");
    const int c = lane & 7;
#pragma unroll
    for (int j = 0; j < 8; ++j) { const int nl = (lane >> 3) + 8 * j, n = n0 + nl;
        const int dr = t.kind == 0 ? n : (t.kind == 1 ? 256 * (n / 128) + (n % 128) + 128 * t.half : 256 * (n / 256) + 128 * ((n % 64) / 32) + 32 * ((n % 256) / 64) + (n % 32));
        const LAS unsigned* s = T + (4 * c) * 65 + nl;
        v4u o; o.x = s[0]; o.y = s[65]; o.z = s[130]; o.w = s[195];
        *(GAS v4u*)(t.WT + (size_t)dr * t.K + k0 + 8 * c) = o; }
    LDS_WAIT(); asm volatile("" ::: "memory");
}
__device__ __forceinline__ void convert_range(const float* const* in, unsigned char* ws, LAS unsigned* scr, int lane, int begin, int end, int wi, int nw) {
    f32x4 lA[16], lB[16]; TItem tA, tB; int it = begin + wi;
    if (it < end) { tA = t_decode(it, in, ws); t_issue(tA, lane, lA); }
    while (it < end) {
        const bool nb = it + nw < end;
        if (nb) { tB = t_decode(it + nw, in, ws); t_issue(tB, lane, lB); }
        t_finish(tA, lane, lA, scr);
        if (!nb) break;
        const bool na = it + 2 * nw < end;
        if (na) { tA = t_decode(it + 2 * nw, in, ws); t_issue(tA, lane, lA); }
        t_finish(tB, lane, lB, scr);
        if (!na) break;
        it += 2 * nw;
    }
}
__device__ __forceinline__ void s5_tables_item(Frame& F, const float* const* in, unsigned char* ws, int g, int tq) {
    const float *lam_re = in[3], *lam_im = in[4], *log_step = in[5], *b_re = in[6], *b_im = in[7], *c_re = in[8], *c_im = in[9], *dsk = in[10];
    LAS float* APOW = (LAS float*)F.lds;
    LAS float* BB = APOW + 2 * 17 * 64 * 2;
    LAS float* CC = BB + 2 * 64 * 16 * 2;
    LAS float* KT = CC + 2 * 16 * 64 * 2;
    const int tid = F.tid;
    __syncthreads();
    if (tid < 128) {
        const int dir = tid >> 6, p = tid & 63;
        const double step = exp((double)log_step[dir * 64 + g]);
        const double lr = lam_re[(dir * 64 + g) * 64 + p], li = lam_im[(dir * 64 + g) * 64 + p];
        const double mag = exp(lr * step), ang = li * step;
        const double ar = mag * cos(ang), ai = mag * sin(ang);
        double pr = 1.0, pi = 0.0;
        for (int tau = 0; tau <= 16; ++tau) { APOW[((dir * 17 + tau) * 64 + p) * 2] = (float)pr; APOW[((dir * 17 + tau) * 64 + p) * 2 + 1] = (float)pi;
            const double nr = pr * ar - pi * ai, ni = pr * ai + pi * ar; pr = nr; pi = ni; if (tau == 15 && tq == 0) { ((float*)(ws + WS_AT))[((dir * 64 + g) * 64 + p) * 2] = (float)nr; ((float*)(ws + WS_AT))[((dir * 64 + g) * 64 + p) * 2 + 1] = (float)ni; } }
        const double nr = ar - 1.0, ni = ai, den = lr * lr + li * li;
        const double qr = (nr * lr + ni * li) / den, qi = (ni * lr - nr * li) / den;
        for (int i = 0; i < 16; ++i) { const double br = b_re[((dir * 64 + g) * 64 + p) * 16 + i], bi = b_im[((dir * 64 + g) * 64 + p) * 16 + i];
            BB[((dir * 64 + p) * 16 + i) * 2] = (float)(qr * br - qi * bi); BB[((dir * 64 + p) * 16 + i) * 2 + 1] = (float)(qr * bi + qi * br); }
    }
    for (int idx = tid; idx < 2048; idx += 512) { const int dir = idx >> 10, j = (idx >> 6) & 15, p = idx & 63;
        CC[idx * 2] = c_re[((dir * 64 + g) * 16 + j) * 64 + p]; CC[idx * 2 + 1] = c_im[((dir * 64 + g) * 16 + j) * 64 + p]; }
    __syncthreads();
    {
        const int dir = tid >> 8, j = (tid >> 4) & 15, i = tid & 15;
        float kt[16];
#pragma unroll
        for (int t = 0; t < 16; ++t) kt[t] = 0.f;
        for (int p = 0; p < 64; ++p) {
            const float cr = CC[((dir * 16 + j) * 64 + p) * 2], ci = CC[((dir * 16 + j) * 64 + p) * 2 + 1];
            const float br = BB[((dir * 64 + p) * 16 + i) * 2], bi = BB[((dir * 64 + p) * 16 + i) * 2 + 1];
            const float wr = cr * br - ci * bi, wi = cr * bi + ci * br;
#pragma unroll
            for (int t = 0; t < 16; ++t) { const float ar = APOW[((dir * 17 + t) * 64 + p) * 2], ai = APOW[((dir * 17 + t) * 64 + p) * 2 + 1]; kt[t] += ar * wr - ai * wi; }
        }
#pragma unroll
        for (int t = 0; t < 16; ++t) KT[(dir * 16 + t) * 256 + j * 16 + i] = kt[t];
    }
    __syncthreads();
    bf16* Bm = (bf16*)(ws + WS_S5_MAIN) + (size_t)(g * 256 + 64 * tq) * 512;
    for (int w = tid; w < 4096; w += 512) {
        const int nl = w >> 6, k0 = (w & 63) * 8, t = 4 * tq + (nl >> 4), j = nl & 15;
        float v[8];
        if (k0 < 256) { const int s = k0 >> 4, i0 = k0 & 15;
#pragma unroll
            for (int e = 0; e < 8; ++e) { const int i = i0 + e;
                v[e] = (t > s) ? KT[(0 * 16 + (t - s)) * 256 + j * 16 + i] : (s > t) ? KT[(1 * 16 + (s - t)) * 256 + j * 16 + i]
                                 : KT[j * 16 + i] + KT[16 * 256 + j * 16 + i] + (i == j ? dsk[g * 16 + j] : 0.f); }
        } else { const int dir = (k0 - 256) >> 7, p0 = ((k0 - 256) & 127) >> 1, tau = dir == 0 ? t + 1 : 16 - t;
#pragma unroll
            for (int e = 0; e < 8; ++e) { const int p = p0 + (e >> 1), ri = e & 1;
                const float cr = CC[((dir * 16 + j) * 64 + p) * 2], ci = CC[((dir * 16 + j) * 64 + p) * 2 + 1];
                const float ar = APOW[((dir * 17 + tau) * 64 + p) * 2], ai = APOW[((dir * 17 + tau) * 64 + p) * 2 + 1];
                v[e] = ri == 0 ? (cr * ar - ci * ai) : -(cr * ai + ci * ar); }
        }
        v4u o; o.x = pk2(v[0], v[1]); o.y = pk2(v[2], v[3]); o.z = pk2(v[4], v[5]); o.w = pk2(v[6], v[7]);
        *(GAS v4u*)(Bm + (size_t)nl * 512 + k0) = o;
    }
    bf16* Bs = (bf16*)(ws + WS_S5_STATE) + (size_t)(g * 256 + 64 * tq) * 256;
    { const int dir = tq >> 1;
      for (int w = tid; w < 2048; w += 512) {
        const int nl = w >> 5, p = 32 * (tq & 1) + (nl >> 1), ri = nl & 1, k0 = (w & 31) * 8, s = k0 >> 4, i0 = k0 & 15, tau = dir == 0 ? 15 - s : s;
        const float ar = APOW[((dir * 17 + tau) * 64 + p) * 2], ai = APOW[((dir * 17 + tau) * 64 + p) * 2 + 1];
        float v[8];
#pragma unroll
        for (int e = 0; e < 8; ++e) { const float br = BB[((dir * 64 + p) * 16 + i0 + e) * 2], bi = BB[((dir * 64 + p) * 16 + i0 + e) * 2 + 1];
            v[e] = ri == 0 ? (ar * br - ai * bi) : (ar * bi + ai * br); }
        v4u o; o.x = pk2(v[0], v[1]); o.y = pk2(v[2], v[3]); o.z = pk2(v[4], v[5]); o.w = pk2(v[6], v[7]);
        *(GAS v4u*)(Bs + (size_t)nl * 256 + k0) = o;
      } }
    __syncthreads();
}
__device__ __forceinline__ void rms_row_to_bf16(int lane, const float* xrow, const float* gain, bf16* orow) {
    const GAS f32x4* xr = (const GAS f32x4*)xrow + lane;
    f32x4 v[4]; float s = 0.f;
#pragma unroll
    for (int j = 0; j < 4; ++j) { v[j] = xr[64 * j]; s += (v[j].x * v[j].x + v[j].y * v[j].y) + (v[j].z * v[j].z + v[j].w * v[j].w); }
    const float r = rsqrtf(wave_sum(s) * (1.f / DM) + EPS);
    GAS v2u* o8 = (GAS v2u*)orow + lane;
#pragma unroll
    for (int j = 0; j < 4; ++j) { const f32x4 g = ((const GAS f32x4*)gain)[lane + 64 * j]; v2u o; o.x = pk2(v[j].x * r * g.x, v[j].y * r * g.y); o.y = pk2(v[j].z * r * g.z, v[j].w * r * g.w); o8[64 * j] = o; }
}
__device__ __forceinline__ void row_to_bf16_rs(int lane, const float* xrow, bf16* orow, float* rs) {
    const GAS f32x4* xr = (const GAS f32x4*)xrow + lane;
    f32x4 v[4]; float s = 0.f;
#pragma unroll
    for (int j = 0; j < 4; ++j) { v[j] = xr[64 * j]; s += (v[j].x * v[j].x + v[j].y * v[j].y) + (v[j].z * v[j].z + v[j].w * v[j].w); }
    GAS v2u* o8 = (GAS v2u*)orow + lane;
#pragma unroll
    for (int j = 0; j < 4; ++j) { v2u o; o.x = pk2(v[j].x, v[j].y); o.y = pk2(v[j].z, v[j].w); o8[64 * j] = o; }
    const float r = rsqrtf(wave_sum(s) * (1.f / DM) + EPS);
    if (lane == 0) *rs = r;
}
__device__ __forceinline__ void p0_prologue(Frame& F, const float* const* in, unsigned char* ws) {
#ifndef P0DUP
#define P0DUP 0
#endif
    for (int rep = 0; rep < 1 + (P0DUP & 1); ++rep)
    for (int it = blockIdx.x; it < 256; it += F.G) s5_tables_item(F, in, ws, it >> 2, it & 3);
    for (int idx = blockIdx.x * 512 + F.tid; idx < 192 * 16; idx += F.G * 512) {
        const int f = idx & 15, pos = idx < 2048 ? (idx >> 4) : ((idx - 2048) >> 4);
        const float freq = powf(10000.f, -(float)(2 * f) / 32.f), ang = (float)pos * freq;
        float* dst = idx < 2048 ? (float*)(ws + WS_ROPE_R) + idx * 2 : (float*)(ws + WS_ROPE_C) + (idx - 2048) * 2;
        dst[0] = cosf(ang); dst[1] = sinf(ang);
    }
#if defined(EXP_GATHER) && EXP_GATHER
    for (int idx = blockIdx.x * 512 + F.tid; idx < NTOK; idx += F.G * 512) ((int*)(ws + WS_IDLIST))[idx] = idx;
#endif
    if (blockIdx.x == 0 && F.tid < 128) ((float*)(ws + WS_QKG))[F.tid] = F.tid < 64 ? in[17][F.tid] : in[18][F.tid - 64];
    LAS unsigned* scr = (LAS unsigned*)(F.lds + RING_OFF + F.wave * 16384);
    const int gw = F.vcu * NWAVES + F.wave, NGW = F.G * NWAVES;
    for (int rep = 0; rep < 1 + ((P0DUP >> 1) & 1); ++rep) convert_range(in, ws, scr, F.lane, 0, CVT_P0_END, gw, NGW);
    for (int rep = 0; rep < 1 + ((P0DUP >> 2) & 1); ++rep)
#if NORM_FACTOR
    for (int m = gw; m < NTOK; m += NGW) row_to_bf16_rs(F.lane, in[0] + (size_t)m * DM, (bf16*)(ws + WS_HB) + (size_t)m * DM, (float*)(ws + WS_RSTD) + m);
#else
    for (int m = gw; m < NTOK; m += NGW) rms_row_to_bf16(F.lane, in[0] + (size_t)m * DM, in[1], (bf16*)(ws + WS_XN) + (size_t)m * DM);
#endif
}
__device__ __forceinline__ void scan_phase(Frame& F, const float* const* in, unsigned char* ws) {
    const float* S = (const float*)(ws + WS_S); bf16* A2 = (bf16*)(ws + WS_A2); const float* aT = (const float*)(ws + WS_AT);
#if MOE_CVT_IN_SCAN
    if (F.wave != 0) {
        LAS unsigned* scr = (LAS unsigned*)(F.lds + RING_OFF + F.wave * 16384);
        convert_range(in, ws, scr, F.lane, CVT_P0_END, T_ISMALL + CVT_S1, F.vcu * 7 + (F.wave - 1), F.G * 7);
        return;
    }
    typedef float f32x2s __attribute__((ext_vector_type(2)));
#ifndef SCAN_REPS
#define SCAN_REPS 1
#endif
    for (int srep_ = 0; srep_ < SCAN_REPS; ++srep_)
    for (int it = blockIdx.x; it < 256; it += F.G) {
        const int dir = it & 1, g = (it >> 1) & 63, b = it >> 7;
        const float ar = aT[((dir * 64 + g) * 64 + F.lane) * 2], ai = aT[((dir * 64 + g) * 64 + F.lane) * 2 + 1];
        const size_t row0 = (size_t)g * 1024 + b * 512;
        const float* Sp = S + row0 * 256 + dir * 128 + 2 * F.lane;
        bf16* Ap = A2 + row0 * 512 + 256 + dir * 128 + 2 * F.lane;
        float xr = 0.f, xi = 0.f;
#if S_BF16
        unsigned X0[16], X1[16], X2[16];
#define SC_RE(x) pg8::bf_lo(x)
#define SC_IM(x) pg8::bf_hi(x)
#else
        f32x2s X0[16], X1[16], X2[16];
#define SC_RE(x) (x).x
#define SC_IM(x) (x).y
#endif
#if S_BF16
#define SC_LOAD(X, k0) do { _Pragma("unroll") for (int q = 0; q < 16; ++q) { const int c = dir == 0 ? (k0) + q : 511 - (k0) - q; X[q] = *(const GAS unsigned*)((const bf16*)(ws + WS_S) + (row0 + c) * 256 + dir * 128 + 2 * F.lane); } } while (0)
#else
#define SC_LOAD(X, k0) do { _Pragma("unroll") for (int q = 0; q < 16; ++q) { const int c = dir == 0 ? (k0) + q : 511 - (k0) - q; X[q] = *(const GAS f32x2s*)(Sp + (size_t)c * 256); } } while (0)
#endif
#define SC_STEP(X, k0) do { _Pragma("unroll") for (int q = 0; q < 16; ++q) { const int c = dir == 0 ? (k0) + q : 511 - (k0) - q; \
            *(GAS unsigned*)(Ap + (size_t)c * 512) = pk2(xr, xi); \
            const float nxr = ar * xr - ai * xi + SC_RE(X[q]), nxi = ar * xi + ai * xr + SC_IM(X[q]); xr = nxr; xi = nxi; } } while (0)
        SC_LOAD(X0, 0); SC_LOAD(X1, 16); SC_LOAD(X2, 32);
        for (int k0 = 0; k0 < 512; k0 += 48) {
            SC_STEP(X0, k0); if (k0 + 48 < 512) SC_LOAD(X0, k0 + 48);
            if (k0 + 16 < 512) { SC_STEP(X1, k0 + 16); if (k0 + 64 < 512) SC_LOAD(X1, k0 + 64); }
            if (k0 + 32 < 512) { SC_STEP(X2, k0 + 32); if (k0 + 80 < 512) SC_LOAD(X2, k0 + 80); }
        }
#undef SC_LOAD
#undef SC_STEP
#undef SC_RE
#undef SC_IM
    }
#else
    LAS float* L = (LAS float*)F.lds;
    for (int it = blockIdx.x; it < 256; it += F.G) {
        const int dir = it & 1, g = (it >> 1) & 63, b = it >> 7;
        const float ar = aT[((dir * 64 + g) * 64 + F.lane) * 2], ai = aT[((dir * 64 + g) * 64 + F.lane) * 2 + 1];
        float xr = 0.f, xi = 0.f;
        for (int hh = 0; hh < 2; ++hh) {
            const int cbase = dir == 0 ? 256 * hh : 256 * (1 - hh);
            const size_t row0 = (size_t)g * 1024 + b * 512 + cbase;
            __syncthreads();
            { f32x4 tv[16];
#pragma unroll
            for (int k = 0; k < 16; ++k) { const int idx = F.tid + 512 * k, cl = idx >> 5, q = idx & 31; tv[k] = *(const GAS f32x4*)(S + (row0 + cl) * 256 + dir * 128 + q * 4); }
#pragma unroll
            for (int k = 0; k < 16; ++k) { const int idx = F.tid + 512 * k, cl = idx >> 5, q = idx & 31; *(LAS f32x4*)(L + cl * 128 + q * 4) = tv[k]; } }
            __syncthreads();
            if (F.wave == 0) {
                for (int s0 = 0; s0 < 256; s0 += 8) { float sr[8], si[8];
#pragma unroll
                    for (int q = 0; q < 8; ++q) { const int cl = dir == 0 ? s0 + q : 255 - s0 - q; sr[q] = L[cl * 128 + 2 * F.lane]; si[q] = L[cl * 128 + 2 * F.lane + 1]; }
#pragma unroll
                    for (int q = 0; q < 8; ++q) { const int cl = dir == 0 ? s0 + q : 255 - s0 - q;
                        *(GAS unsigned*)(A2 + (row0 + cl) * 512 + 256 + dir * 128 + 2 * F.lane) = pk2(xr, xi);
                        const float nxr = ar * xr - ai * xi + sr[q], nxi = ar * xi + ai * xr + si[q]; xr = nxr; xi = nxi; } }
            }
        }
        __syncthreads();
    }
#endif
}
template <bool B16> __device__ __forceinline__ f32x4 ld_h(const void* h, int m, int lane, int j) {
    if constexpr (B16) { const v2u w = ((const GAS v2u*)((const bf16*)h + (size_t)m * DM))[lane + 64 * j]; return (f32x4){pg8::bf_lo(w.x), pg8::bf_hi(w.x), pg8::bf_lo(w.y), pg8::bf_hi(w.y)}; }
    else return ((const GAS f32x4*)((const float*)h + (size_t)m * DM))[lane + 64 * j];
}
template <bool B16> __device__ __forceinline__ void st_h(void* h, int m, int lane, int j, const f32x4& v) {
    if constexpr (B16) { v2u o; o.x = pk2(v.x, v.y); o.y = pk2(v.z, v.w); ((GAS v2u*)((bf16*)h + (size_t)m * DM))[lane + 64 * j] = o; }
    else ((GAS f32x4*)((float*)h + (size_t)m * DM))[lane + 64 * j] = v;
}
template <bool HINB> struct RowRaw { v2u mw[4]; v2u hb[4]; f32x4 hf[4]; };
template <bool HINB> __device__ __forceinline__ void row_load(RowRaw<HINB>& r, const void* hin, const bf16* mix, int m, int lane) {
    const GAS v2u* mr = (const GAS v2u*)(mix + (size_t)m * DM) + lane;
#pragma unroll
    for (int j = 0; j < 4; ++j) { r.mw[j] = mr[64 * j];
        if constexpr (HINB) r.hb[j] = ((const GAS v2u*)((const bf16*)hin + (size_t)m * DM))[lane + 64 * j]; else r.hf[j] = ((const GAS f32x4*)((const float*)hin + (size_t)m * DM))[lane + 64 * j]; }
}
template <bool HINB> __device__ __forceinline__ void row_unpack(const RowRaw<HINB>& r, f32x4 (&v)[4], f32x4 (&hv)[4]) {
#pragma unroll
    for (int j = 0; j < 4; ++j) { v[j] = (f32x4){pg8::bf_lo(r.mw[j].x), pg8::bf_hi(r.mw[j].x), pg8::bf_lo(r.mw[j].y), pg8::bf_hi(r.mw[j].y)};
        if constexpr (HINB) hv[j] = (f32x4){pg8::bf_lo(r.hb[j].x), pg8::bf_hi(r.hb[j].x), pg8::bf_lo(r.hb[j].y), pg8::bf_hi(r.hb[j].y)}; else hv[j] = r.hf[j]; }
}
template <bool XF8, bool HINB, bool HOUTB> __device__ __forceinline__ void e_phase(Frame& F, const void* hin, const bf16* mix, const float* gpost, const float* gpre, void* hout, bf16* xn, float* rs_out = nullptr) {
    const int gw = F.vcu * NWAVES + F.wave, NGW = F.G * NWAVES;
    RowRaw<HINB> R[2];
    row_load<HINB>(R[0], hin, mix, gw, F.lane);
#pragma unroll
    for (int k = 0; k < 8; ++k) { const int m = gw + k * NGW;
        if (k + 1 < 8) row_load<HINB>(R[(k + 1) & 1], hin, mix, m + NGW, F.lane);
        f32x4 v[4], hv[4]; float s = 0.f;
        row_unpack<HINB>(R[k & 1], v, hv);
#pragma unroll
        for (int j = 0; j < 4; ++j) s += (v[j].x * v[j].x + v[j].y * v[j].y) + (v[j].z * v[j].z + v[j].w * v[j].w);
        const float r = rsqrtf(wave_sum(s) * (1.f / DM) + EPS); float s2 = 0.f;
#pragma unroll
        for (int j = 0; j < 4; ++j) { const f32x4 g = ((const GAS f32x4*)gpost)[F.lane + 64 * j]; hv[j] = hv[j] + v[j] * r * g; s2 += (hv[j].x * hv[j].x + hv[j].y * hv[j].y) + (hv[j].z * hv[j].z + hv[j].w * hv[j].w); }
#pragma unroll
        for (int j = 0; j < 4; ++j) st_h<HOUTB>(hout, m, F.lane, j, hv[j]);
        if (rs_out) { const float r2 = rsqrtf(wave_sum(s2) * (1.f / DM) + EPS); if (F.lane == 0) rs_out[m] = r2; }
        if (xn) { const float r2 = rsqrtf(wave_sum(s2) * (1.f / DM) + EPS); GAS v2u* o8 = (GAS v2u*)(xn + (size_t)m * DM) + F.lane;
#pragma unroll
            for (int j = 0; j < 4; ++j) { const f32x4 g = ((const GAS f32x4*)gpre)[F.lane + 64 * j];
                if constexpr (XF8) ((GAS unsigned*)((unsigned char*)xn + (size_t)m * DM))[F.lane + 64 * j] = pg8::pack4_fp8(hv[j].x * r2 * g.x * 4.f, hv[j].y * r2 * g.y * 4.f, hv[j].z * r2 * g.z * 4.f, hv[j].w * r2 * g.w * 4.f);
                else { v2u o; o.x = pk2(hv[j].x * r2 * g.x, hv[j].y * r2 * g.y); o.y = pk2(hv[j].z * r2 * g.z, hv[j].w * r2 * g.w); o8[64 * j] = o; } } }
    }
}
__device__ __forceinline__ void e3_phase(Frame& F, const void* hin, const bf16* mix, const float* gpost, const float* gpre, void* hout, bf16* xn, const float* wrouter, unsigned char* ws) {
    LAS float* WL = (LAS float*)F.lds;
    LAS int* RI = (LAS int*)(F.lds + 32768);
    for (int idx = F.tid; idx < 8192; idx += 512) WL[(idx & 7) * 1024 + (idx >> 3)] = wrouter[idx];
    if (F.tid < 8) RI[320 + F.tid] = 0;
    __syncthreads();
    const int gw = F.vcu * NWAVES + F.wave, NGW = F.G * NWAVES;
    RowRaw<true> R[2];
    row_load<true>(R[0], hin, mix, gw, F.lane);
#pragma unroll
    for (int k = 0; k < 8; ++k) { const int m = gw + k * NGW;
        if (k + 1 < 8) row_load<true>(R[(k + 1) & 1], hin, mix, m + NGW, F.lane);
        f32x4 v[4], hv[4]; float s = 0.f;
        row_unpack<true>(R[k & 1], v, hv);
#pragma unroll
        for (int j = 0; j < 4; ++j) s += (v[j].x * v[j].x + v[j].y * v[j].y) + (v[j].z * v[j].z + v[j].w * v[j].w);
        const float r = rsqrtf(wave_sum(s) * (1.f / DM) + EPS); float s2 = 0.f;
#pragma unroll
        for (int j = 0; j < 4; ++j) { const f32x4 g = ((const GAS f32x4*)gpost)[F.lane + 64 * j]; hv[j] = hv[j] + v[j] * r * g; s2 += (hv[j].x * hv[j].x + hv[j].y * hv[j].y) + (hv[j].z * hv[j].z + hv[j].w * hv[j].w); }
#pragma unroll
        for (int j = 0; j < 4; ++j) st_h<true>(hout, m, F.lane, j, hv[j]);
        const float r2 = rsqrtf(wave_sum(s2) * (1.f / DM) + EPS); GAS v2u* o8 = (GAS v2u*)(xn + (size_t)m * DM) + F.lane;
        float lg[8];
#pragma unroll
        for (int e = 0; e < 8; ++e) lg[e] = 0.f;
#pragma unroll
        for (int j = 0; j < 4; ++j) { const f32x4 g = ((const GAS f32x4*)gpre)[F.lane + 64 * j]; const f32x4 xf = hv[j] * r2 * g;
#if MOE_FP8
            ((GAS unsigned*)((unsigned char*)xn + (size_t)m * DM))[F.lane + 64 * j] = pg8::pack4_fp8(xf.x * 4.f, xf.y * 4.f, xf.z * 4.f, xf.w * 4.f);
#else
            v2u o; o.x = pk2(xf.x, xf.y); o.y = pk2(xf.z, xf.w); o8[64 * j] = o;
#endif
#pragma unroll
            for (int e = 0; e < 8; ++e) { const f32x4 w = *(const LAS f32x4*)(WL + e * 1024 + 4 * (F.lane + 64 * j)); lg[e] += (xf.x * w.x + xf.y * w.y) + (xf.z * w.z + xf.w * w.w); } }
#pragma unroll
        for (int e = 0; e < 8; ++e) lg[e] = wave_sum(lg[e]);
        int e0 = 0; float l0 = lg[0];
#pragma unroll
        for (int e = 1; e < 8; ++e) if (lg[e] > l0) { l0 = lg[e]; e0 = e; }
        int e1 = -1; float l1 = -INFINITY;
#pragma unroll
        for (int e = 0; e < 8; ++e) if (e != e0 && lg[e] > l1) { l1 = lg[e]; e1 = e; }
        const float w0 = 1.f / (1.f + expf(l1 - l0));
        if (F.lane == 0) { const int sl = F.wave * 8 + k; RI[sl] = e0 | (e1 << 8); RI[64 + sl] = (int)__float_as_uint(w0); RI[128 + sl] = m; }
    }
    __syncthreads();
    if (F.tid < 64) { const int ee = RI[F.tid]; RI[192 + F.tid] = __hip_atomic_fetch_add(&RI[320 + (ee & 255)], 1, __ATOMIC_RELAXED, __HIP_MEMORY_SCOPE_WORKGROUP); RI[256 + F.tid] = __hip_atomic_fetch_add(&RI[320 + (ee >> 8)], 1, __ATOMIC_RELAXED, __HIP_MEMORY_SCOPE_WORKGROUP); }
    __syncthreads();
    if (F.tid < 8) RI[328 + F.tid] = (int)__hip_atomic_fetch_add(F.ctl + CW_CNT + 64 * F.tid, (unsigned)RI[320 + F.tid], RLX_AGENT);
    __syncthreads();
    if (F.tid < 64) { const int ee = RI[F.tid], e0 = ee & 255, e1 = ee >> 8, tok = RI[128 + F.tid];
        const int p0 = RI[328 + e0] + RI[192 + F.tid], p1 = RI[328 + e1] + RI[256 + F.tid];
        int* lists = (int*)(ws + WS_LIST); lists[e0 * NTOK + p0] = tok; lists[e1 * NTOK + p1] = tok;
        v4u ti; ti.x = (unsigned)ee; ti.y = (unsigned)p0; ti.z = (unsigned)p1; ti.w = (unsigned)RI[64 + F.tid];
        *(GAS v4u*)(ws + WS_TOKINFO + (size_t)tok * 16) = ti; }
    __syncthreads();
}
__device__ __forceinline__ void moe_table(Frame& F) {
    volatile LAS int* misc = (volatile LAS int*)(F.lds + MOE_OFF);
    __syncthreads();
    if (F.tid == 0) { int t = 0;
        for (int e = 0; e < 8; ++e) { const int c = (int)__hip_atomic_load(F.ctl + CW_CNT + 64 * e, RLX_AGENT); misc[e] = t; misc[16 + e] = c; t += (c + 255) >> 8; }
        misc[8] = t;
        const int first_rem = (t >> 6) << 6, urem = 4 * (t - first_rem);
        const int parts = urem == 0 ? 1 : (urem * 7 <= 256 ? 7 : (urem * 2 <= 256 ? 2 : 1));
        misc[9] = parts; misc[10] = parts == 1 ? t : first_rem; misc[11] = parts == 1 ? 0 : urem * parts; }
    __syncthreads();
}
__device__ __forceinline__ void e4_phase(Frame& F, const void* hin, const float* gpost, float* hout, unsigned char* ws) {
    volatile LAS int* misc = (volatile LAS int*)(F.lds + MOE_OFF);
    const bf16* SO = (const bf16*)(ws + WS_SLOT);
    const int gw = F.vcu * NWAVES + F.wave, NGW = F.G * NWAVES;
    const int first_rem = misc[10], parts = misc[9];
    v4u ti[8];
#pragma unroll
    for (int k = 0; k < 8; ++k) ti[k] = *(const GAS v4u*)(ws + WS_TOKINFO + (size_t)(gw + k * NGW) * 16);
    struct Raw4 { v2u a[4], b[4], h[4]; int slot0, slot1; };
    Raw4 R[2];
#define E4_ISSUE(RR, k) do { const v4u t_ = ti[k]; const int m_ = gw + (k) * NGW; \
        (RR).slot0 = __builtin_amdgcn_readfirstlane(misc[t_.x & 255] * 256 + (int)t_.y); (RR).slot1 = __builtin_amdgcn_readfirstlane(misc[(t_.x >> 8) & 255] * 256 + (int)t_.z); \
        const bool s0_ = ((RR).slot0 >> 8) >= first_rem, s1_ = ((RR).slot1 >> 8) >= first_rem; \
        const GAS v2u* a8_ = (const GAS v2u*)(SO + (size_t)(s0_ ? 0 : (RR).slot0) * DM) + F.lane; const GAS v2u* b8_ = (const GAS v2u*)(SO + (size_t)(s1_ ? 0 : (RR).slot1) * DM) + F.lane; \
        const GAS v2u* h8_ = (const GAS v2u*)((const bf16*)hin + (size_t)m_ * DM) + F.lane; \
        _Pragma("unroll") for (int j = 0; j < 4; ++j) { (RR).a[j] = a8_[64 * j]; (RR).b[j] = b8_[64 * j]; (RR).h[j] = h8_[64 * j]; } } while (0)
    E4_ISSUE(R[0], 0);
#pragma unroll
    for (int k = 0; k < 8; ++k) { const int m = gw + k * NGW;
        if (k + 1 < 8) E4_ISSUE(R[(k + 1) & 1], k + 1);
        const Raw4& C = R[k & 1];
        const float w0 = __uint_as_float(ti[k].w), w1 = 1.f - w0;
        const int slot0 = C.slot0, slot1 = C.slot1;
        const bool sp0 = (slot0 >> 8) >= first_rem, sp1 = (slot1 >> 8) >= first_rem;
        const float wa = sp0 ? 0.f : w0, wb = sp1 ? 0.f : w1;
        f32x4 v[4], hv[4]; float s = 0.f;
#pragma unroll
        for (int j = 0; j < 4; ++j) { const v2u a = C.a[j], b = C.b[j], hh = C.h[j]; hv[j] = (f32x4){pg8::bf_lo(hh.x), pg8::bf_hi(hh.x), pg8::bf_lo(hh.y), pg8::bf_hi(hh.y)};
            v[j].x = wa * pg8::bf_lo(a.x) + wb * pg8::bf_lo(b.x); v[j].y = wa * pg8::bf_hi(a.x) + wb * pg8::bf_hi(b.x); v[j].z = wa * pg8::bf_lo(a.y) + wb * pg8::bf_lo(b.y); v[j].w = wa * pg8::bf_hi(a.y) + wb * pg8::bf_hi(b.y); }
        if (sp0 || sp1) {
            const bf16* PT = (const bf16*)(ws + WS_PART);
#pragma unroll
            for (int kk = 0; kk < 2; ++kk) { const bool sp = kk == 0 ? sp0 : sp1; const int slot = kk == 0 ? slot0 : slot1; const float w = kk == 0 ? w0 : w1;
                if (sp) { const int pm = slot >> 8, rr = slot & 255;
#pragma unroll
                    for (int j = 0; j < 4; ++j) { f32x4 acc = (f32x4){0.f, 0.f, 0.f, 0.f};
                        for (int p = 0; p < parts; ++p) { const v2u a = *((const GAS v2u*)(PT + ((size_t)(((pm - first_rem) * 4 + j) * parts + p) * 65536 + (size_t)rr * 256)) + F.lane);
                            acc.x += pg8::bf_lo(a.x); acc.y += pg8::bf_hi(a.x); acc.z += pg8::bf_lo(a.y); acc.w += pg8::bf_hi(a.y); }
                        v[j] = v[j] + acc * w; } } }
        }
#pragma unroll
        for (int j = 0; j < 4; ++j) s += (v[j].x * v[j].x + v[j].y * v[j].y) + (v[j].z * v[j].z + v[j].w * v[j].w);
        const float r = rsqrtf(wave_sum(s) * (1.f / DM) + EPS);
        GAS f32x4* ho = (GAS f32x4*)(hout + (size_t)m * DM) + F.lane;
#pragma unroll
        for (int j = 0; j < 4; ++j) { const f32x4 g = ((const GAS f32x4*)gpost)[F.lane + 64 * j]; ho[64 * j] = hv[j] + v[j] * r * g; }
    }
#undef E4_ISSUE
}

#ifndef FLAT_BAR
#define FLAT_BAR 0
#endif
constexpr int FB_REPL = 8, CW_FB = 12288, CW_FBTMO = 12288 + 64 * 8;
struct FlatBar { gu32* ctl; unsigned epoch; };
__device__ __forceinline__ void flat_barrier(FlatBar& fb) {
    asm volatile("s_waitcnt vmcnt(0)" ::: "memory");
    __syncthreads();
    fb.epoch += 1u;
    if (threadIdx.x < 64) {
        const unsigned lane = threadIdx.x;
        __builtin_amdgcn_fence(__ATOMIC_RELEASE, "agent");
        asm volatile("s_waitcnt vmcnt(0)" ::: "memory");
        if (lane < FB_REPL) (void)__hip_atomic_fetch_add(fb.ctl + CW_FB + 64 * lane, 1u, RLX_AGENT);
        const unsigned target = fb.epoch * gridDim.x;
        gu32* mine = fb.ctl + CW_FB + 64 * (blockIdx.x % FB_REPL);
        unsigned sp = 0;
        while ((unsigned)__builtin_amdgcn_readfirstlane(__hip_atomic_load(mine, RLX_AGENT)) < target) {
            __builtin_amdgcn_s_sleep(1);
            if ((++sp & 1023u) == 0u) { if (__hip_atomic_load(fb.ctl + CW_FBTMO, RLX_AGENT) != 0u) break; if (sp > (1u << 20)) { if (lane == 0) __hip_atomic_store(fb.ctl + CW_FBTMO, 1u, RLX_AGENT); break; } }
        }
        __builtin_amdgcn_fence(__ATOMIC_ACQUIRE, "agent");
        asm volatile("s_waitcnt vmcnt(0)" ::: "memory");
    }
    __syncthreads();
}

#ifndef XB2
#define XB2 0
#endif
constexpr int CW_XB2 = 13312;
__device__ __forceinline__ void xcd_barrier2(const XcdBarrier& b, gu32* ctl) {
    asm volatile("s_waitcnt vmcnt(0)" ::: "memory");
    __syncthreads();
    if (threadIdx.x < 64) {
        unsigned* bar = b.bar; const unsigned lane = threadIdx.x;
        unsigned nloc = 1u, nx = 1u, old = 0u;
        if (lane == 0) {
            __builtin_amdgcn_s_waitcnt(0);
            nloc = b.st[0]; nx = b.st[1];
            if (nloc == 0u) { xcd_barrier_complete(bar, b.x, nloc, nx); b.st[0] = nloc; b.st[1] = nx; }
            old = xb_add(&bar[XB_XSUB(b.x)], 1u);
        }
        nloc = (unsigned)__builtin_amdgcn_readfirstlane((int)nloc); nx = (unsigned)__builtin_amdgcn_readfirstlane((int)nx); old = (unsigned)__builtin_amdgcn_readfirstlane((int)old);
        const unsigned gen = old / nloc;
        if (old + 1u == (gen + 1u) * nloc) {
            __builtin_amdgcn_fence(__ATOMIC_RELEASE, "agent");
            asm volatile("s_waitcnt vmcnt(0)" ::: "memory");
            if (lane < 8u) (void)__hip_atomic_fetch_add(ctl + CW_XB2 + 64 * lane, 1u, RLX_AGENT);
        }
        const unsigned target = (gen + 1u) * nx;
        gu32* mine = ctl + CW_XB2 + 64 * (blockIdx.x & 7u);
        unsigned sp = 0u;
        while ((unsigned)__builtin_amdgcn_readfirstlane((int)__hip_atomic_load(mine, RLX_AGENT)) < target) {
            __builtin_amdgcn_s_sleep(1);
            if ((++sp & 255u) == 0u) { if (xb_ld(&bar[XB_TMO])) break; if (sp > XB_SPIN_CAP) { if (lane == 0) atomicAdd(&bar[XB_TMO], 1u); break; } }
        }
        __builtin_amdgcn_fence(__ATOMIC_ACQUIRE, "agent");
        asm volatile("s_waitcnt vmcnt(0)" ::: "memory");
    }
    __syncthreads();
}

struct Args { const float* in[24]; float* out; unsigned char* ws; int ph_lo, ph_hi; };
__global__ void __launch_bounds__(NWAVES * 64, 2) mega_fwd(Args args) {
    extern __shared__ __attribute__((aligned(16))) unsigned char lds[];
    Frame F;
    F.lds = (LAS unsigned char*)lds;
    F.MISC = (volatile LAS unsigned*)(F.lds + MISC_OFF);
    F.tid = threadIdx.x; F.lane = F.tid & 63; F.wave = __builtin_amdgcn_readfirstlane(F.tid >> 6);
    F.G = gridDim.x; { const int bx = blockIdx.x; F.vcu = (F.G % 8 == 0) ? (bx % 8) * (F.G / 8) + bx / 8 : bx; }
    unsigned char* ws = args.ws;
    F.ctl = (gu32*)(ws + WS_CTL);
    for (int u = F.tid; u < (LDS_BYTES - LDSCTL_OFF) / 4; u += NWAVES * 64) ((LAS unsigned*)(F.lds + LDSCTL_OFF))[u] = 0u;
    __syncthreads();
#if FLAT_BAR
    FlatBar bar{F.ctl, 0u};
#define xcd_barrier(b) flat_barrier(b)
#else
    XcdBarrier bar = xcd_barrier_post((unsigned*)(F.ctl + CW_BAR), F.MISC + 8);
#if XB2
#define xcd_barrier(b) xcd_barrier2(b, F.ctl)
#endif
#endif
    const int lo = args.ph_lo, hi = args.ph_hi;
#ifndef PHMASK
#define PHMASK 0x3ffff
#endif
#define IN(k) (((PHMASK >> (k)) & 1) && lo <= (k) && (k) < hi)
#define SEAM(k) do { if (IN(k) && IN((k) + 1)) xcd_barrier(bar); } while (0)
#ifndef DUPMASK
#define DUPMASK 0
#endif
#define REP(k) _Pragma("unroll") for (int rep_ = 0; rep_ < (((DUPMASK) >> (k)) & 1) + 1; ++rep_)
#define REPBAR() do { if (rep_) xcd_barrier(bar); } while (0)
    const float* const* in = args.in;
    const float* gains = in[1];
    float* hbuf = args.out; void* HB = (void*)(ws + WS_HB);
    bf16* XN = (bf16*)(ws + WS_XN); bf16* MIX = (bf16*)(ws + WS_MIX);
    const int BIG = 1 << 30;
    using pg8::ProbPlain; using pg8::ProbMoE;

    if (IN(0)) REP(0) { REPBAR(); p0_prologue(F, in, ws); } SEAM(0);
#if defined(XTRA_BAR) && XTRA_BAR
    for (int xb_ = 0; xb_ < XTRA_BAR; ++xb_) xcd_barrier(bar);
#endif
    if (IN(1)) REP(1) { REPBAR();
        ProbPlain P{NORM_FACTOR ? (const char*)HB : (const char*)XN, (const char*)(ws + WS_BT_IN), 1024, 2048u, 2048u, 0, BIG, {}}; P.S.init(64, 4, F.G, (int)blockIdx.x);
        pg8::EpiU E{(pg8::bf16_t*)(ws + WS_A2), NORM_FACTOR ? (const float*)(ws + WS_RSTD) : (const float*)nullptr};
        pg8::gemm_phase<ProbPlain, pg8::EpiU, true, true>(F.lds + RING_OFF, P, E);
    } SEAM(1);
    if (IN(2)) REP(2) { REPBAR();
        ProbPlain P{(const char*)(ws + WS_A2), (const char*)(ws + WS_S5_STATE), 256, 1024u, 512u, (size_t)256 * 256 * 2, 4, {}}; P.S.init(256, 1, F.G, (int)blockIdx.x);
#if S_BF16
        pg8::EpiBf16 E{(pg8::bf16_t*)(ws + WS_S), 256, 1.f};
        pg8::gemm_phase<ProbPlain, pg8::EpiBf16, true, true>(F.lds + RING_OFF, P, E);
#else
        pg8::EpiF32 E{(float*)(ws + WS_S), 256};
        pg8::gemm_phase<ProbPlain, pg8::EpiF32, true, true>(F.lds + RING_OFF, P, E);
#endif
    } SEAM(2);
    if (IN(3)) REP(3) { REPBAR(); scan_phase(F, in, ws); } SEAM(3);
    if (IN(4)) REP(4) { REPBAR();
        ProbPlain P{(const char*)(ws + WS_A2), (const char*)(ws + WS_S5_MAIN), 512, 1024u, 1024u, (size_t)256 * 512 * 2, 4, {}}; P.S.init(256, 1, F.G, (int)blockIdx.x);
        pg8::EpiY E{(pg8::bf16_t*)(ws + WS_G1)};
        pg8::gemm_phase<ProbPlain, pg8::EpiY, true, true>(F.lds + RING_OFF, P, E);
    } SEAM(4);
    if (IN(5)) REP(5) { REPBAR();
        ProbPlain P{(const char*)(ws + WS_G1), (const char*)(ws + WS_BT_GLU), 1024, 2048u, 2048u, 0, BIG, {}}; P.S.init(64, 4, F.G, (int)blockIdx.x);
        pg8::EpiGlu E{(const pg8::bf16_t*)(ws + WS_G1), (pg8::bf16_t*)(ws + WS_G2)};
        pg8::gemm_phase<ProbPlain, pg8::EpiGlu, true, true>(F.lds + RING_OFF, P, E);
    } SEAM(5);
    if (IN(6)) REP(6) { REPBAR();
        ProbPlain P{(const char*)(ws + WS_G2), (const char*)(ws + WS_BT_SOUT), 1024, 2048u, 2048u, 0, BIG, {}}; P.S.init(64, 4, F.G, (int)blockIdx.x);
        pg8::EpiBf16 E{MIX, 1024, 1.f};
        pg8::gemm_phase<ProbPlain, pg8::EpiBf16, true, true>(F.lds + RING_OFF, P, E);
    } SEAM(6);
#if NORM_FACTOR
    if (IN(7)) REP(7) { REPBAR(); e_phase<false, true, true>(F, HB, MIX, gains + 1 * DM, gains + 2 * DM, HB, nullptr, (float*)(ws + WS_RSTD) + NTOK); } SEAM(7);
#else
    if (IN(7)) REP(7) { REPBAR(); e_phase<FFN_FP8 != 0, false, true>(F, in[0], MIX, gains + 1 * DM, gains + 2 * DM, HB, XN); } SEAM(7);
#endif
    if (IN(8)) REP(8) { REPBAR();
#if FFN_FP8
        ProbPlain P{(const char*)XN, (const char*)(ws + WS_BT_GU), 512, 1024u, 1024u, 0, BIG, {}}; P.S.init(64, 22, F.G, (int)blockIdx.x);
        pg8::EpiSwigluF8 E{(unsigned char*)(ws + WS_ACTF), DFF, 1.f / 256.f, 8.f};
        pg8::gemm_phase<ProbPlain, pg8::EpiSwigluF8, true, true, true>(F.lds + RING_OFF, P, E);
#else
        ProbPlain P{NORM_FACTOR ? (const char*)HB : (const char*)XN, (const char*)(ws + WS_BT_GU), 1024, 2048u, 2048u, 0, BIG, {}}; P.S.init(64, 22, F.G, (int)blockIdx.x, FFN_WGM);
        pg8::EpiSwiglu E{(pg8::bf16_t*)(ws + WS_ACTF), DFF, NORM_FACTOR ? (const float*)(ws + WS_RSTD) + NTOK : (const float*)nullptr};
#if defined(DEPHASE8) && DEPHASE8
        if (((int)blockIdx.x >> 3) & 1) { _Pragma("unroll") for (int d_ = 0; d_ < DEPHASE8; ++d_) __builtin_amdgcn_s_sleep(127); }
#endif
        pg8::gemm_phase<ProbPlain, pg8::EpiSwiglu, true, true>(F.lds + RING_OFF, P, E);
#endif
        if (F.G == 256 && blockIdx.x >= 128) convert_range(in, ws, (LAS unsigned*)(F.lds + RING_OFF + F.wave * 16384), F.lane, T_ISMALL + CVT_S1, T_ISMALL + CVT_S2, ((int)blockIdx.x - 128) * NWAVES + F.wave, 128 * NWAVES);
    } SEAM(8);
    if (IN(9)) REP(9) { REPBAR();
#if FFN_FP8
        ProbPlain P{(const char*)(ws + WS_ACTF), (const char*)(ws + WS_BT_FD), DFF / 2, (unsigned)DFF, (unsigned)DFF, 0, BIG, {}}; P.S.init(64, 4, F.G, (int)blockIdx.x);
        pg8::EpiBf16 E{MIX, 1024, 1.f / 512.f};
        pg8::gemm_phase<ProbPlain, pg8::EpiBf16, true, true, true>(F.lds + RING_OFF, P, E);
#else
        ProbPlain P{(const char*)(ws + WS_ACTF), (const char*)(ws + WS_BT_FD), DFF, (unsigned)DFF * 2u, (unsigned)DFF * 2u, 0, BIG, {}}; P.S.init(64, 4, F.G, (int)blockIdx.x);
        pg8::EpiBf16 E{MIX, 1024, 1.f};
        pg8::gemm_phase<ProbPlain, pg8::EpiBf16, true, true>(F.lds + RING_OFF, P, E);
#endif
    } SEAM(9);
    if (IN(10)) REP(10) { REPBAR(); e_phase<false, true, true>(F, HB, MIX, gains + 3 * DM, gains + 4 * DM, HB, NORM_FACTOR ? (bf16*)nullptr : XN, NORM_FACTOR ? (float*)(ws + WS_RSTD) + 2 * NTOK : (float*)nullptr); } SEAM(10);
    if (IN(11)) REP(11) { REPBAR();
        ProbPlain P{NORM_FACTOR ? (const char*)HB : (const char*)XN, (const char*)(ws + WS_BT_QKV), 1024, 2048u, 2048u, 0, BIG, {}}; P.S.init(64, 6, F.G, (int)blockIdx.x);
        pg8::EpiQKV E{(pg8::bf16_t*)(ws + WS_Q), (unsigned)((WS_K - WS_Q) / 2), (unsigned)((WS_V - WS_Q) / 2), (const float*)(ws + WS_QKG), (const float4*)(ws + WS_ROPE_R), QSCALE, NORM_FACTOR ? (const float*)(ws + WS_RSTD) + 2 * NTOK : (const float*)nullptr};
        pg8::gemm_phase<ProbPlain, pg8::EpiQKV, true, true>(F.lds + RING_OFF, P, E);
        if (F.G == 256 && blockIdx.x >= 128) convert_range(in, ws, (LAS unsigned*)(F.lds + RING_OFF + F.wave * 16384), F.lane, T_ISMALL + CVT_S2, T_NITEMS, ((int)blockIdx.x - 128) * NWAVES + F.wave, 128 * NWAVES);
    } SEAM(11);
    if (IN(12)) REP(12) { REPBAR();
        static_assert(attn_body::ATTN_LDS_BYTES <= RING_BYTES, "attention body LDS");
        const attn_body::AttnTensors AT{(const attn_body::bf16*)(ws + WS_Q), (const attn_body::bf16*)(ws + WS_K), (const attn_body::bf16*)(ws + WS_V), (attn_body::bf16*)(ws + WS_O)};
        const attn_body::StaticOrder S((int)F.G, (int)blockIdx.x);
        float gq = fabsf(((const float*)(ws + WS_QKG))[F.lane]), gk = fabsf(((const float*)(ws + WS_QKG))[64 + F.lane]);
#pragma unroll
        for (int o = 1; o < 64; o <<= 1) { gq = fmaxf(gq, __shfl_xor(gq, o)); gk = fmaxf(gk, __shfl_xor(gk, o)); }
        const float refB = 11.55f * 1.02f * gq * gk;
        if (__builtin_amdgcn_readfirstlane(__float_as_uint(refB)) <= __float_as_uint(60.f)) attn_body::attn_phase<attn_body::StaticOrder, true>((char*)lds + RING_OFF, AT, S, refB);
        else attn_body::attn_phase<attn_body::StaticOrder, false>((char*)lds + RING_OFF, AT, S, 0.f);
    } SEAM(12);
    if (IN(13)) REP(13) { REPBAR();
        ProbPlain P{(const char*)(ws + WS_O), (const char*)(ws + WS_BT_AO), 1024, 2048u, 2048u, 0, BIG, {}}; P.S.init(64, 4, F.G, (int)blockIdx.x);
        pg8::EpiBf16 E{MIX, 1024, 1.f};
        pg8::gemm_phase<ProbPlain, pg8::EpiBf16, true, true>(F.lds + RING_OFF, P, E);
    } SEAM(13);
    if (IN(14)) REP(14) { REPBAR(); e3_phase(F, HB, MIX, gains + 5 * DM, gains + 6 * DM, HB, XN, in[20], ws); } SEAM(14);
    if (IN(15)) REP(15) { REPBAR();
        moe_table(F);
        volatile LAS int* misc = (volatile LAS int*)(F.lds + MOE_OFF);
#if MOE_FP8
        ProbMoE P{(const char*)XN, (const char*)(ws + WS_BT_MGU), 512, 1024u, 1024u, (size_t)7168 * 1024, {}, (const int*)(ws + WS_LIST), misc, true}; P.S.init(misc[8], 28, F.G, (int)blockIdx.x, MOE_WGM);
        pg8::EpiSwigluF8 E{(unsigned char*)(ws + WS_ACTM), DFE, 1.f / 256.f, 8.f};
#if defined(DEPHASE15) && DEPHASE15
        if (((int)blockIdx.x >> 3) & 1) { _Pragma("unroll") for (int d_ = 0; d_ < DEPHASE15; ++d_) __builtin_amdgcn_s_sleep(127); }
#endif
        pg8::gemm_phase<ProbMoE, pg8::EpiSwigluF8, P15_ALIGN, P15_SP2, true>(F.lds + RING_OFF, P, E);
#else
        ProbMoE P{(const char*)XN, (const char*)(ws + WS_BT_MGU), 1024, 2048u, 2048u, (size_t)7168 * 1024 * 2, {}, (const int*)(ws + WS_LIST), misc, true}; P.S.init(misc[8], 28, F.G, (int)blockIdx.x);
        pg8::EpiSwiglu E{(pg8::bf16_t*)(ws + WS_ACTM), DFE, nullptr};
        pg8::gemm_phase<ProbMoE, pg8::EpiSwiglu, true, true>(F.lds + RING_OFF, P, E);
#endif
    } SEAM(15);
    if (IN(16)) REP(16) { REPBAR();
        moe_table(F);
        volatile LAS int* misc = (volatile LAS int*)(F.lds + MOE_OFF);
#if MOE_FP8
        ProbMoE P{(const char*)(ws + WS_ACTM), (const char*)(ws + WS_BT_MD), DFE / 2, (unsigned)DFE, (unsigned)DFE, (size_t)1024 * 3584, {}, (const int*)(ws + WS_LIST), misc, false}; P.S.init(misc[8], 4, F.G, (int)blockIdx.x);
        pg8::EpiMoeDown E{(pg8::bf16_t*)(ws + WS_SLOT), (pg8::bf16_t*)(ws + WS_PART), 1.f / 512.f};
        pg8::gemm_phase<ProbMoE, pg8::EpiMoeDown, true, true, true>(F.lds + RING_OFF, P, E);
#else
        ProbMoE P{(const char*)(ws + WS_ACTM), (const char*)(ws + WS_BT_MD), DFE, (unsigned)DFE * 2u, (unsigned)DFE * 2u, (size_t)1024 * 3584 * 2, {}, (const int*)(ws + WS_LIST), misc, false}; P.S.init(misc[8], 4, F.G, (int)blockIdx.x);
        pg8::EpiMoeDown E{(pg8::bf16_t*)(ws + WS_SLOT), (pg8::bf16_t*)(ws + WS_PART), 1.f};
        pg8::gemm_phase<ProbMoE, pg8::EpiMoeDown, true, true>(F.lds + RING_OFF, P, E);
#endif
    } SEAM(16);
    if (IN(17)) REP(17) { REPBAR(); moe_table(F); e4_phase(F, HB, gains + 7 * DM, hbuf, ws); }
#undef IN
#undef SEAM
#if FLAT_BAR || XB2
#undef xcd_barrier
#endif
}


#ifndef CUT
#define CUT 0
#endif
#if CUT
namespace nv {
__device__ __forceinline__ float sigmoidf_(float x) { return 1.f / (1.f + __expf(-x)); }
__device__ __forceinline__ float gelu_tanh(float x) { return x * sigmoidf_(1.5957691216057308f * (x + 0.044715f * x * x * x)); }

__global__ void rms_k(const float* __restrict__ x, const float* __restrict__ gain, float* __restrict__ out) {
    const int row = blockIdx.x * 4 + (threadIdx.x >> 6), lane = threadIdx.x & 63;
    const float4* xr = (const float4*)(x + (size_t)row * DM);
    float4 v[4]; float s = 0.f;
#pragma unroll
    for (int j = 0; j < 4; ++j) { v[j] = xr[lane + 64 * j]; s += v[j].x * v[j].x + v[j].y * v[j].y + v[j].z * v[j].z + v[j].w * v[j].w; }
    const float r = rsqrtf(wave_sum(s) * (1.f / DM) + EPS);
    float4* o = (float4*)(out + (size_t)row * DM);
#pragma unroll
    for (int j = 0; j < 4; ++j) { const float4 g = ((const float4*)gain)[lane + 64 * j]; o[lane + 64 * j] = make_float4(v[j].x * r * g.x, v[j].y * r * g.y, v[j].z * r * g.z, v[j].w * r * g.w); }
}
__global__ void resnorm_k(const float* h, const float* __restrict__ mix, const float* __restrict__ gpost, const float* __restrict__ gpre, float* hout, float* __restrict__ xn) {
    const int row = blockIdx.x * 4 + (threadIdx.x >> 6), lane = threadIdx.x & 63;
    const float4* mr = (const float4*)(mix + (size_t)row * DM); const float4* hr = (const float4*)(h + (size_t)row * DM);
    float4 v[4], hv[4]; float s = 0.f;
#pragma unroll
    for (int j = 0; j < 4; ++j) { v[j] = mr[lane + 64 * j]; hv[j] = hr[lane + 64 * j]; s += v[j].x * v[j].x + v[j].y * v[j].y + v[j].z * v[j].z + v[j].w * v[j].w; }
    const float r = rsqrtf(wave_sum(s) * (1.f / DM) + EPS);
    float s2 = 0.f;
#pragma unroll
    for (int j = 0; j < 4; ++j) { const float4 g = ((const float4*)gpost)[lane + 64 * j];
        hv[j].x += v[j].x * r * g.x; hv[j].y += v[j].y * r * g.y; hv[j].z += v[j].z * r * g.z; hv[j].w += v[j].w * r * g.w;
        s2 += hv[j].x * hv[j].x + hv[j].y * hv[j].y + hv[j].z * hv[j].z + hv[j].w * hv[j].w; }
    float4* ho = (float4*)(hout + (size_t)row * DM);
#pragma unroll
    for (int j = 0; j < 4; ++j) ho[lane + 64 * j] = hv[j];
    if (xn) {
        const float r2 = rsqrtf(wave_sum(s2) * (1.f / DM) + EPS);
        float4* o = (float4*)(xn + (size_t)row * DM);
#pragma unroll
        for (int j = 0; j < 4; ++j) { const float4 g = ((const float4*)gpre)[lane + 64 * j]; o[lane + 64 * j] = make_float4(hv[j].x * r2 * g.x, hv[j].y * r2 * g.y, hv[j].z * r2 * g.z, hv[j].w * r2 * g.w); }
    }
}

struct EpiArgs { float* C; int ldc; int pad0; const float* aux; int ldaux; int pad1; const int* list; const float* wl; const int* cnt;
  EpiArgs(float* C_, int ldc_, const float* aux_, int ldaux_, const int* l, const float* w, const int* c) : C(C_), ldc(ldc_), pad0(0), aux(aux_), ldaux(ldaux_), pad1(0), list(l), wl(w), cnt(c) {} };
template <int EPI, bool GATHER>
__global__ __launch_bounds__(256) void gemm_k(const float* __restrict__ A, int lda, const float* __restrict__ W, int ldw, int M, int N, int K, EpiArgs ea) {
    __shared__ float As[8][132]; __shared__ float Bs[8][132];
    const int m_lim = ea.cnt ? *ea.cnt : M;
    const int bm = blockIdx.y * 128, bn = blockIdx.x * 128;
    if (bm >= m_lim) return;
    const int tid = threadIdx.x, tx = tid & 15, ty = tid >> 4;
    const int arow = bm + (tid >> 1);
    const int srow = (arow < m_lim) ? (GATHER ? ea.list[arow] : arow) : (GATHER ? ea.list[0] : 0);
    const float* ap = A + (size_t)srow * lda + (tid & 1) * 4;
    const float* bp = W + (size_t)(tid >> 5) * ldw + bn + (tid & 31) * 4;
    float acc[8][8];
#pragma unroll
    for (int i = 0; i < 8; ++i)
#pragma unroll
        for (int j = 0; j < 8; ++j) acc[i][j] = 0.f;
    for (int k0 = 0; k0 < K; k0 += 8) {
        const float4 av = *(const float4*)(ap + k0);
        const float4 bv = *(const float4*)(bp + (size_t)k0 * ldw);
        __syncthreads();
        As[(tid & 1) * 4 + 0][tid >> 1] = av.x; As[(tid & 1) * 4 + 1][tid >> 1] = av.y; As[(tid & 1) * 4 + 2][tid >> 1] = av.z; As[(tid & 1) * 4 + 3][tid >> 1] = av.w;
        *(float4*)&Bs[tid >> 5][(tid & 31) * 4] = bv;
        __syncthreads();
#pragma unroll
        for (int k = 0; k < 8; ++k) {
            float a[8], b[8];
            *(float4*)&a[0] = *(const float4*)&As[k][ty * 8]; *(float4*)&a[4] = *(const float4*)&As[k][ty * 8 + 4];
            *(float4*)&b[0] = *(const float4*)&Bs[k][tx * 8]; *(float4*)&b[4] = *(const float4*)&Bs[k][tx * 8 + 4];
#pragma unroll
            for (int i = 0; i < 8; ++i)
#pragma unroll
                for (int j = 0; j < 8; ++j) acc[i][j] = fmaf(a[i], b[j], acc[i][j]);
        }
    }
#pragma unroll
    for (int i = 0; i < 8; ++i) {
        const int row = bm + ty * 8 + i;
        if (row >= m_lim) continue;
        int tok = 0; float wgt = 0.f;
        if (EPI == 3) { tok = ea.list[row]; wgt = ea.wl[row]; }
#pragma unroll
        for (int j = 0; j < 8; ++j) {
            const int col = bn + tx * 8 + j; const float v = acc[i][j];
            if (EPI == 0) ea.C[(size_t)row * ea.ldc + col] = v;
            else if (EPI == 1) ea.C[(size_t)row * ea.ldc + col] = ea.aux[(size_t)row * ea.ldaux + col] * sigmoidf_(v);
            else if (EPI == 2) { const float g = ea.aux[(size_t)row * ea.ldaux + col]; ea.C[(size_t)row * ea.ldc + col] = g * sigmoidf_(g) * v; }
            else if (EPI == 3) ea.C[(size_t)tok * ea.ldc + col] += wgt * v;
        }
    }
}

__global__ __launch_bounds__(64) void s5_scan_k(const float* __restrict__ u, const float* __restrict__ lam_re, const float* __restrict__ lam_im, const float* __restrict__ log_step,
                                                const float* __restrict__ b_re, const float* __restrict__ b_im, const float* __restrict__ c_re, const float* __restrict__ c_im, float* __restrict__ yout) {
    __shared__ float us[64][16];
    const int dir = blockIdx.x & 1, g = (blockIdx.x >> 1) & 63, b = blockIdx.x >> 7, p = threadIdx.x;
    const double step = exp((double)log_step[dir * 64 + g]);
    const double lr = lam_re[(dir * 64 + g) * 64 + p], li = lam_im[(dir * 64 + g) * 64 + p];
    const double mag = exp(lr * step), ang = li * step;
    const double ard = mag * cos(ang), aid = mag * sin(ang);
    const double nr = ard - 1.0, ni = aid, den = lr * lr + li * li;
    const double qr = (nr * lr + ni * li) / den, qi = (ni * lr - nr * li) / den;
    const float ar = (float)ard, ai = (float)aid;
    float bbr[16], bbi[16], cr[16], ci[16];
#pragma unroll
    for (int i = 0; i < 16; ++i) {
        const double br = b_re[((dir * 64 + g) * 64 + p) * 16 + i], bi = b_im[((dir * 64 + g) * 64 + p) * 16 + i];
        bbr[i] = (float)(qr * br - qi * bi); bbi[i] = (float)(qr * bi + qi * br);
        cr[i] = c_re[((dir * 64 + g) * 16 + i) * 64 + p]; ci[i] = c_im[((dir * 64 + g) * 16 + i) * 64 + p];
    }
    float xr = 0.f, xi = 0.f;
    float* yo = yout + (size_t)dir * NTOK * DM;
    for (int c = 0; c < SEQ / 64; ++c) {
        { const int s = p; const int st = c * 64 + s; const int t = dir == 0 ? st : SEQ - 1 - st;
          const float4* src = (const float4*)(u + (size_t)(b * SEQ + t) * DM + g * 16);
          __syncthreads();
#pragma unroll
          for (int q = 0; q < 4; ++q) *(float4*)&us[s][q * 4] = src[q];
          __syncthreads(); }
        for (int s = 0; s < 64; ++s) {
            const int st = c * 64 + s; const int t = dir == 0 ? st : SEQ - 1 - st;
            float bur = 0.f, bui = 0.f;
#pragma unroll
            for (int i = 0; i < 16; ++i) { const float uu = us[s][i]; bur = fmaf(bbr[i], uu, bur); bui = fmaf(bbi[i], uu, bui); }
            const float nxr = ar * xr - ai * xi + bur, nxi = ar * xi + ai * xr + bui;
            xr = nxr; xi = nxi;
            float mine = 0.f;
#pragma unroll
            for (int j = 0; j < 16; ++j) { const float v = wave_sum(cr[j] * xr - ci[j] * xi); if (p == j) mine = v; }
            if (p < 16) yo[(size_t)(b * SEQ + t) * DM + g * 16 + p] = mine;
        }
    }
}
__global__ void gelu_comb_k(const float* __restrict__ u, const float* __restrict__ dskip, const float* __restrict__ y2, float* __restrict__ g1) {
    const size_t i = (size_t)blockIdx.x * 256 + threadIdx.x;
    const int c = (int)(i & (DM - 1));
    const float y = dskip[c] * u[i] + y2[i] + y2[i + (size_t)NTOK * DM];
    g1[i] = gelu_tanh(y);
}

__global__ void qknorm_rope_k(float* __restrict__ qkv, const float* __restrict__ qg, const float* __restrict__ kg) {
    const int w = blockIdx.x * 4 + (threadIdx.x >> 6), d = threadIdx.x & 63;
    const int tok = w / 20, hs = w % 20;
    float* p = qkv + (size_t)tok * QKVW + hs * 64;
    const float v = p[d];
    const float r = rsqrtf(wave_sum(v * v) * (1.f / 64.f) + EPS);
    const float y = v * r * (hs < 16 ? qg[d] : kg[d]);
    const float partner = __shfl_xor(y, 1);
    const int pos = tok % SEQ, i = d >> 1;
    const int f = i & 15;
    const float freq = powf(10000.f, -(float)(2 * f) / 32.f);
    const float ang = (float)(i < 16 ? pos / 64 : pos % 64) * freq;
    const float c = cosf(ang), s = sinf(ang);
    const float o = (d & 1) ? (partner * s + y * c) : (y * c - partner * s);
    p[d] = o;
}

__global__ __launch_bounds__(256) void attn_k(const float* __restrict__ qkv, float* __restrict__ o) {
    __shared__ float Qs[64][65], Ks[64][65], Vs[64][65];
    float (*Ps)[65] = Ks;
    const int qb = blockIdx.x, h = blockIdx.y, b = blockIdx.z, kvh = h >> 2;
    const int tid = threadIdx.x, tx = tid & 15, ty = tid >> 4;
    const size_t rowbase = (size_t)b * SEQ;
    for (int e = tid; e < 64 * 64; e += 256) { const int r = e >> 6, d = e & 63; Qs[r][d] = qkv[(rowbase + qb * 64 + r) * QKVW + h * 64 + d] * 0.125f; }
    float m[4], l[4], oacc[4][4];
#pragma unroll
    for (int i = 0; i < 4; ++i) { m[i] = -INFINITY; l[i] = 0.f;
#pragma unroll
        for (int j = 0; j < 4; ++j) oacc[i][j] = 0.f; }
    for (int kt = 0; kt < SEQ / 64; ++kt) {
        __syncthreads();
        for (int e = tid; e < 64 * 64; e += 256) { const int r = e >> 6, d = e & 63; const size_t rr = (rowbase + kt * 64 + r) * QKVW;
            Ks[r][d] = qkv[rr + 1024 + kvh * 64 + d]; Vs[r][d] = qkv[rr + 1280 + kvh * 64 + d]; }
        __syncthreads();
        float s[4][4];
#pragma unroll
        for (int i = 0; i < 4; ++i)
#pragma unroll
            for (int j = 0; j < 4; ++j) s[i][j] = 0.f;
        for (int d = 0; d < 64; ++d) {
            float a[4], k[4];
#pragma unroll
            for (int i = 0; i < 4; ++i) { a[i] = Qs[ty * 4 + i][d]; k[i] = Ks[tx * 4 + i][d]; }
#pragma unroll
            for (int i = 0; i < 4; ++i)
#pragma unroll
                for (int j = 0; j < 4; ++j) s[i][j] = fmaf(a[i], k[j], s[i][j]);
        }
        __syncthreads();
#pragma unroll
        for (int i = 0; i < 4; ++i) {
            float mx = fmaxf(fmaxf(s[i][0], s[i][1]), fmaxf(s[i][2], s[i][3]));
#pragma unroll
            for (int of = 1; of < 16; of <<= 1) mx = fmaxf(mx, __shfl_xor(mx, of));
            const float mn = fmaxf(m[i], mx);
            const float sc = __expf(m[i] - mn);
            float ps = 0.f;
#pragma unroll
            for (int j = 0; j < 4; ++j) { const float pp = __expf(s[i][j] - mn); Ps[ty * 4 + i][tx * 4 + j] = pp; ps += pp; }
#pragma unroll
            for (int of = 1; of < 16; of <<= 1) ps += __shfl_xor(ps, of);
            l[i] = l[i] * sc + ps; m[i] = mn;
#pragma unroll
            for (int j = 0; j < 4; ++j) oacc[i][j] *= sc;
        }
        __syncthreads();
        for (int k = 0; k < 64; ++k) {
            float pp[4], vv[4];
#pragma unroll
            for (int i = 0; i < 4; ++i) { pp[i] = Ps[ty * 4 + i][k]; vv[i] = Vs[k][tx * 4 + i]; }
#pragma unroll
            for (int i = 0; i < 4; ++i)
#pragma unroll
                for (int j = 0; j < 4; ++j) oacc[i][j] = fmaf(pp[i], vv[j], oacc[i][j]);
        }
    }
#pragma unroll
    for (int i = 0; i < 4; ++i) { const float inv = 1.f / l[i];
#pragma unroll
        for (int j = 0; j < 4; ++j) o[(rowbase + qb * 64 + ty * 4 + i) * DM + h * 64 + tx * 4 + j] = oacc[i][j] * inv; }
}

__global__ void router_k(const float* __restrict__ xn, const float* __restrict__ wr, int* __restrict__ cnt, int* __restrict__ lists, float* __restrict__ wlists) {
    const int tok = blockIdx.x * 4 + (threadIdx.x >> 6), lane = threadIdx.x & 63;
    float lg[8];
#pragma unroll
    for (int e = 0; e < 8; ++e) lg[e] = 0.f;
    for (int j = 0; j < 16; ++j) { const int d = lane + 64 * j; const float x = xn[(size_t)tok * DM + d];
        const float4 w0 = *(const float4*)(wr + d * 8), w1 = *(const float4*)(wr + d * 8 + 4);
        lg[0] = fmaf(x, w0.x, lg[0]); lg[1] = fmaf(x, w0.y, lg[1]); lg[2] = fmaf(x, w0.z, lg[2]); lg[3] = fmaf(x, w0.w, lg[3]);
        lg[4] = fmaf(x, w1.x, lg[4]); lg[5] = fmaf(x, w1.y, lg[5]); lg[6] = fmaf(x, w1.z, lg[6]); lg[7] = fmaf(x, w1.w, lg[7]); }
#pragma unroll
    for (int e = 0; e < 8; ++e) lg[e] = wave_sum(lg[e]);
    int e0 = 0; float l0 = lg[0];
#pragma unroll
    for (int e = 1; e < 8; ++e) if (lg[e] > l0) { l0 = lg[e]; e0 = e; }
    int e1 = -1; float l1 = -INFINITY;
#pragma unroll
    for (int e = 0; e < 8; ++e) if (e != e0 && lg[e] > l1) { l1 = lg[e]; e1 = e; }
    const float w0 = 1.f / (1.f + expf(l1 - l0)), w1 = 1.f - w0;
    if (lane == 0) {
        const int p0 = atomicAdd(&cnt[e0], 1); lists[e0 * NTOK + p0] = tok; wlists[e0 * NTOK + p0] = w0;
        const int p1 = atomicAdd(&cnt[e1], 1); lists[e1 * NTOK + p1] = tok; wlists[e1 * NTOK + p1] = w1;
    }
}


__global__ void cvt_k(const unsigned short* __restrict__ s, float* __restrict__ d) { const size_t i = (size_t)blockIdx.x * 256 + threadIdx.x; d[i] = __uint_as_float((unsigned)s[i] << 16); }
template <int EPI, bool GATHER>
static void gemm(hipStream_t st, const float* A, int lda, const float* W, int ldw, int M, int N, int K, EpiArgs ea) {
    hipLaunchKernelGGL((gemm_k<EPI, GATHER>), dim3(N / 128, M / 128), dim3(256), 0, st, A, lda, W, ldw, M, N, K, ea);
}
}
#endif
extern "C" void kernel_launch(void* const* d_in, const int* in_sizes, int n_in, void* d_out, int out_size, void* d_ws, size_t ws_size, hipStream_t stream) {
    static int grid = 0;
    if (grid == 0) {
        grid = -1;
        if (n_in != 24 || in_sizes[0] != NTOK * DM || out_size != NTOK * DM || ws_size < WS_END) { fprintf(stderr, "kernel_launch: unexpected problem (n_in %d, ws %zu)\n", n_in, ws_size); return; }
        int dev = 0, cus = 0;
        if (hipGetDevice(&dev) != hipSuccess || hipDeviceGetAttribute(&cus, hipDeviceAttributeMultiprocessorCount, dev) != hipSuccess) return;
        if (hipFuncSetAttribute((const void*)mega_fwd, hipFuncAttributeMaxDynamicSharedMemorySize, LDS_BYTES) != hipSuccess) return;
        int per_cu = 0;
        if (hipOccupancyMaxActiveBlocksPerMultiprocessor(&per_cu, (const void*)mega_fwd, NWAVES * 64, LDS_BYTES) != hipSuccess || per_cu < 1) { fprintf(stderr, "kernel_launch: occupancy query says %d\n", per_cu); (void)hipGetLastError(); return; }
        if (cus != 256) { fprintf(stderr, "kernel_launch: built for 256 CUs, found %d\n", cus); return; }
        grid = cus;
    }
    if (grid < 0) return;
    if (hipMemsetAsync((char*)d_ws + WS_CTL, 0, CTL_ZERO_BYTES, stream) != hipSuccess) return;
    Args a{};
    for (int i = 0; i < 24; ++i) a.in[i] = (const float*)d_in[i];
    a.out = (float*)d_out; a.ws = (unsigned char*)d_ws; a.ph_lo = 0; a.ph_hi = CUT ? CUT : 18;
    hipLaunchKernelGGL(mega_fwd, dim3(grid), dim3(NWAVES * 64), LDS_BYTES, stream, a);
#if CUT
    {
        using namespace nv;
        const float* gains = (const float*)d_in[1];
        const float* ffn_g = (const float*)d_in[13]; const float* ffn_u = (const float*)d_in[14]; const float* ffn_d = (const float*)d_in[15];
        const float* w_qkv = (const float*)d_in[16]; const float* q_gain = (const float*)d_in[17]; const float* k_gain = (const float*)d_in[18]; const float* attn_wo = (const float*)d_in[19];
        const float* w_router = (const float*)d_in[20]; const float* moe_g = (const float*)d_in[21]; const float* moe_u = (const float*)d_in[22]; const float* moe_d = (const float*)d_in[23];
        float* h = (float*)d_out; char* ws = (char*)d_ws;
        float* xn = (float*)(ws + 4 * MiB); float* mix = (float*)(ws + 68 * MiB);
        hipLaunchKernelGGL(cvt_k, dim3(NTOK * DM / 256), dim3(256), 0, stream, (const unsigned short*)(ws + WS_XN), xn);
        if (CUT <= 8) {
            float* G = (float*)(ws + 132 * MiB);
            gemm<0, false>(stream, xn, DM, ffn_g, DFF, NTOK, DFF, DM, EpiArgs{G, DFF, nullptr, 0, nullptr, nullptr, nullptr});
            gemm<2, false>(stream, xn, DM, ffn_u, DFF, NTOK, DFF, DM, EpiArgs{G, DFF, G, DFF, nullptr, nullptr, nullptr});
            gemm<0, false>(stream, G, DFF, ffn_d, DM, NTOK, DM, DFF, EpiArgs{mix, DM, nullptr, 0, nullptr, nullptr, nullptr});
            hipLaunchKernelGGL(resnorm_k, dim3(NTOK / 4), dim3(256), 0, stream, h, mix, gains + 3 * DM, gains + 4 * DM, h, xn);
        }
        if (CUT <= 11) {
            float* qkv = (float*)(ws + 132 * MiB); float* ob = (float*)(ws + 228 * MiB);
            gemm<0, false>(stream, xn, DM, w_qkv, QKVW, NTOK, QKVW, DM, EpiArgs{qkv, QKVW, nullptr, 0, nullptr, nullptr, nullptr});
            hipLaunchKernelGGL(qknorm_rope_k, dim3(NTOK * 20 / 4), dim3(256), 0, stream, qkv, q_gain, k_gain);
            hipLaunchKernelGGL(attn_k, dim3(SEQ / 64, 16, NB), dim3(256), 0, stream, qkv, ob);
            gemm<0, false>(stream, ob, DM, attn_wo, DM, NTOK, DM, DM, EpiArgs{mix, DM, nullptr, 0, nullptr, nullptr, nullptr});
            hipLaunchKernelGGL(resnorm_k, dim3(NTOK / 4), dim3(256), 0, stream, h, mix, gains + 5 * DM, gains + 6 * DM, h, xn);
        }
        {
            float* Ge = (float*)(ws + 132 * MiB); float* ff = (float*)(ws + 356 * MiB);
            int* cnt = (int*)(ws + 420 * MiB); int* lists = (int*)(ws + 421 * MiB); float* wlists = (float*)(ws + 422 * MiB);
            (void)hipMemsetAsync(cnt, 0, 64, stream);
            (void)hipMemsetAsync(ff, 0, (size_t)NTOK * DM * 4, stream);
            hipLaunchKernelGGL(router_k, dim3(NTOK / 4), dim3(256), 0, stream, xn, w_router, cnt, lists, wlists);
            for (int e = 0; e < NEXP; ++e) {
                const int* le = lists + e * NTOK; const float* we = wlists + e * NTOK;
                gemm<0, true>(stream, xn, DM, moe_g + (size_t)e * DM * DFE, DFE, NTOK, DFE, DM, EpiArgs{Ge, DFE, nullptr, 0, le, we, cnt + e});
                gemm<2, true>(stream, xn, DM, moe_u + (size_t)e * DM * DFE, DFE, NTOK, DFE, DM, EpiArgs{Ge, DFE, Ge, DFE, le, we, cnt + e});
                gemm<3, false>(stream, Ge, DFE, moe_d + (size_t)e * DFE * DM, DM, NTOK, DM, DFE, EpiArgs{ff, DM, nullptr, 0, le, we, cnt + e});
            }
            hipLaunchKernelGGL(resnorm_k, dim3(NTOK / 4), dim3(256), 0, stream, h, ff, gains + 7 * DM, gains + 7 * DM, h, (float*)nullptr);
        }
    }
#endif
}
```

```cpp
#include <hip/hip_runtime.h>
#include <hip/hip_bf16.h>
#include <cstdio>
#include <cstdint>
#include <cmath>
#define CUT 0
#define DUPMASK 0
#define P0DUP 0
#define EXP_GATHER 0
#define MOE_WGM 4
#define NORM_FACTOR 1
#define S_BF16 1
#define P0_SWAP 1
namespace pg8 {
#define PG8_LAS __attribute__((address_space(3)))
typedef unsigned short bf16_t;
typedef short bf16x8 __attribute__((ext_vector_type(8)));
typedef float f32x4 __attribute__((ext_vector_type(4)));
typedef unsigned u32x4 __attribute__((ext_vector_type(4)));
typedef unsigned u32x2 __attribute__((ext_vector_type(2)));
typedef int v8i32 __attribute__((ext_vector_type(8)));
constexpr int BM = 256, BK = 64, HALF = 128, HTB = HALF * BK * 2  , STAGE_BYTES = 8 * HTB, NXCD = 8, WGM = 8;

__host__ __device__ __forceinline__ int lds_byte(int r, int c) { const int st = (r >> 4) * 2 + (c >> 5), rr = r & 15, cc = c & 31, ob = rr * 64 + cc * 2; return st * 1024 + (ob ^ (((ob >> 9) & 1) << 5)); }
__host__ __device__ __forceinline__ void stage_rc(int b, int& R, int& C) { const int st = b / 1024, sb = b % 1024, swz = sb ^ (((sb >> 9) & 1) << 5); R = (st >> 1) * 16 + swz / 64; C = (st & 1) * 32 + (swz % 64) / 2; }
__host__ __device__ __forceinline__ int perm32(int rho) { const int n = rho >> 4, i = rho & 15; return 8 * (i >> 2) + 4 * n + (i & 3); }

struct Unit { int pm, pn, kofs, nt, aux; };

struct StaticOrder {
    int nM, nN, nwg, G, c, wgm;
    __host__ __device__ void init(int nM_, int nN_, int G_, int c_, int wgm_ = WGM) { nM = nM_; nN = nN_; nwg = nM * nN; G = G_; c = c_; wgm = wgm_; }
    __host__ __device__ bool next(int i, Unit& u) const {
        const long L = (long)i * G + c; if (L >= nwg) return false;
        int wgid = (int)L; { const int q = nwg / NXCD, r = nwg % NXCD, xcd = wgid % NXCD, off = wgid / NXCD; wgid = (xcd < r ? xcd * (q + 1) : r * (q + 1) + (xcd - r) * q) + off; }
        const int nig = wgm * nN, gid = wgid / nig, fm = gid * wgm, gsz = (nM - fm) < wgm ? (nM - fm) : wgm;
        u.pm = fm + ((wgid % nig) % gsz); u.pn = (wgid % nig) / gsz; return true;
    }
};

__device__ __forceinline__ unsigned cvt_pk_bf16(float lo, float hi) { unsigned r; asm volatile("v_cvt_pk_bf16_f32 %0, %1, %2" : "=v"(r) : "v"(lo), "v"(hi)); return r; }
__device__ __forceinline__ float bf_lo(unsigned w) { return __uint_as_float(w << 16); }
__device__ __forceinline__ float bf_hi(unsigned w) { return __uint_as_float(w & 0xffff0000u); }
__device__ __forceinline__ float sigm(float x) { return __builtin_amdgcn_rcpf(1.f + __builtin_amdgcn_exp2f(-1.4426950408889634f * x)); }
__device__ __forceinline__ float gelu_t(float x) { return x * sigm(1.5957691216057308f * (x + 0.044715f * x * x * x)); }
#ifndef WT_STORES
#define WT_STORES 0
#endif
__device__ __forceinline__ void st16(void* p, const u32x4& v) {
#if WT_STORES
    asm volatile("global_store_dwordx4 %0, %1, off sc1\n\ts_nop 1" :: "v"(p), "v"(v) : "memory");
#else
    *(u32x4*)p = v;
#endif
}
__device__ __forceinline__ u32x4 pack8(const f32x4& a, const f32x4& b) { u32x4 w; w.x = cvt_pk_bf16(a[0], a[1]); w.y = cvt_pk_bf16(a[2], a[3]); w.z = cvt_pk_bf16(b[0], b[1]); w.w = cvt_pk_bf16(b[2], b[3]); return w; }

struct ProbPlain {
    const char* abase; const char* Bt; int K; unsigned ldaB, ldbB; size_t bstride; int pm_per_b; StaticOrder S;
    __device__ __forceinline__ bool next(int i, Unit& u) const { u.kofs = 0; u.nt = K / BK; u.aux = 0; return S.next(i, u); }
    __device__ __forceinline__ const char* bbase(const Unit& u) const { return Bt + (size_t)(u.pm / pm_per_b) * bstride + (size_t)u.pn * 256 * ldbB; }
    __device__ __forceinline__ void aoffs(const Unit& u, const int (&R)[2], unsigned (&off)[2][2]) const {
#pragma unroll
        for (int h = 0; h < 2; ++h)
#pragma unroll
            for (int i = 0; i < 2; ++i) off[h][i] = (unsigned)(u.pm * 256 + h * 128 + R[i]) * ldaB;
    }
};
struct ProbMoE {
    const char* abase; const char* Bt; int K; unsigned ldaB, ldbB; size_t bstride; StaticOrder S;
    const int* lists; volatile PG8_LAS int* misc; bool gather;
    __device__ __forceinline__ bool next(int i, Unit& u) const {
        if (gather) { u.kofs = 0; u.nt = K / BK; u.aux = 0; return S.next(i, u); }
        const int c = S.c, x = c & 7, y = c >> 3, first_rem = misc[10];
        const int pm = 64 * i + 8 * x + (y & 7);
        if (pm < first_rem) { u.pm = pm; u.pn = y >> 3; u.kofs = 0; u.nt = K / BK; u.aux = 0; return true; }
        if (64 * i != first_rem || c >= misc[11]) return false;
        const int parts = misc[9], j = c / parts, part = c - j * parts, ntp = (K / BK) / parts;
        u.pm = first_rem + (j >> 2); u.pn = j & 3; u.nt = ntp; u.kofs = part * ntp * BK * 2; u.aux = c + 1; return true;
    }
    __device__ __forceinline__ int expert(int pm) const { int e = 0;
#pragma unroll
        for (int j = 1; j < 8; ++j) e += (pm >= misc[j]) ? 1 : 0;
        return e; }
    __device__ __forceinline__ const char* bbase(const Unit& u) const { return Bt + (size_t)__builtin_amdgcn_readfirstlane(expert(u.pm)) * bstride + (size_t)u.pn * 256 * ldbB; }
    __device__ __forceinline__ void aoffs(const Unit& u, const int (&R)[2], unsigned (&off)[2][2]) const {
        if (gather) {
            const int e = expert(u.pm), t0 = misc[e], cnt = misc[16 + e];
#pragma unroll
            for (int h = 0; h < 2; ++h)
#pragma unroll
                for (int i = 0; i < 2; ++i) { const int pos = (u.pm - t0) * 256 + h * 128 + R[i]; const int tok = pos < cnt ? lists[e * 16384 + pos] : 0; off[h][i] = (unsigned)tok * ldaB; }
        } else {
#pragma unroll
            for (int h = 0; h < 2; ++h)
#pragma unroll
                for (int i = 0; i < 2; ++i) off[h][i] = (unsigned)(u.pm * 256 + h * 128 + R[i]) * ldaB;
        }
    }
};

struct EpiF32 {
    static constexpr bool PERM = false;
    float* C; int ldc;
    __device__ __forceinline__ void operator()(const f32x4 (&acc)[2][2][4][2], const Unit& u, int wr, int wc, int fr, int fq) const {
        const int row0 = u.pm * BM + wr * 64 + fr, col0 = u.pn * BM + wc * 32 + 4 * fq;
#pragma unroll
        for (int ai = 0; ai < 2; ++ai)
#pragma unroll
            for (int m = 0; m < 4; ++m) { float* rowp = C + (size_t)(row0 + ai * HALF + m * 16) * ldc + col0;
#pragma unroll
                for (int bj = 0; bj < 2; ++bj)
#pragma unroll
                    for (int n = 0; n < 2; ++n) { const f32x4 t_ = acc[ai][bj][m][n]; st16(rowp + bj * HALF + n * 16, __builtin_bit_cast(u32x4, t_)); } }
    }
};
struct EpiBf16 {
    static constexpr bool PERM = true;
    bf16_t* O; int ldc; float scale;
    __device__ __forceinline__ void operator()(const f32x4 (&acc)[2][2][4][2], const Unit& u, int wr, int wc, int fr, int fq) const {
        const int row0 = u.pm * BM + wr * 64 + fr, col0 = u.pn * BM + wc * 32 + 8 * fq;
#pragma unroll
        for (int ai = 0; ai < 2; ++ai)
#pragma unroll
            for (int m = 0; m < 4; ++m) { bf16_t* rowp = O + (size_t)(row0 + ai * HALF + m * 16) * ldc + col0;
#pragma unroll
                for (int bj = 0; bj < 2; ++bj) st16(rowp + bj * HALF, pack8(acc[ai][bj][m][0] * scale, acc[ai][bj][m][1] * scale)); }
    }
};
struct EpiMoeDown {
    static constexpr bool PERM = true;
    bf16_t* O; bf16_t* PART; float scale;
    __device__ __forceinline__ void operator()(const f32x4 (&acc)[2][2][4][2], const Unit& u, int wr, int wc, int fr, int fq) const {
        const int r0 = wr * 64 + fr, c0 = wc * 32 + 8 * fq;
        bf16_t* base = u.aux == 0 ? O + ((size_t)u.pm * BM * 1024 + (size_t)u.pn * BM) : PART + (size_t)(u.aux - 1) * 65536;
        const int ldo = u.aux == 0 ? 1024 : 256;
#pragma unroll
        for (int ai = 0; ai < 2; ++ai)
#pragma unroll
            for (int m = 0; m < 4; ++m) { bf16_t* rowp = base + (size_t)(r0 + ai * HALF + m * 16) * ldo + c0;
#pragma unroll
                for (int bj = 0; bj < 2; ++bj) st16(rowp + bj * HALF, pack8(acc[ai][bj][m][0] * scale, acc[ai][bj][m][1] * scale)); }
    }
};
__device__ __forceinline__ unsigned pack4_fp8(float a, float b, float c, float d) {
    a = __builtin_amdgcn_fmed3f(a, -448.f, 448.f); b = __builtin_amdgcn_fmed3f(b, -448.f, 448.f); c = __builtin_amdgcn_fmed3f(c, -448.f, 448.f); d = __builtin_amdgcn_fmed3f(d, -448.f, 448.f);
    int w = __builtin_amdgcn_cvt_pk_fp8_f32(a, b, 0, false); w = __builtin_amdgcn_cvt_pk_fp8_f32(c, d, w, true); return (unsigned)w; }
struct EpiSwigluF8 {
    static constexpr bool PERM = true;
    unsigned char* O; int ldc; float sin, sout;
    __device__ __forceinline__ void operator()(const f32x4 (&acc)[2][2][4][2], const Unit& u, int wr, int wc, int fr, int fq) const {
        const int row0 = u.pm * BM + wr * 64 + fr, col0 = u.pn * HALF + wc * 32 + 8 * fq;
        const float c1 = -1.4426950408889634f * sin, kk = 1.f / (sin * sin * sout);
#pragma unroll
        for (int ai = 0; ai < 2; ++ai)
#pragma unroll
            for (int m = 0; m < 4; ++m) { f32x4 a, b;
#pragma unroll
                for (int e = 0; e < 4; ++e) {
                    const float g0 = acc[ai][0][m][0][e], g1 = acc[ai][0][m][1][e];
                    const float e0 = __builtin_amdgcn_exp2f(g0 * c1), e1 = __builtin_amdgcn_exp2f(g1 * c1);
                    a[e] = (g0 * acc[ai][1][m][0][e]) * __builtin_amdgcn_rcpf(__builtin_fmaf(e0, kk, kk)); b[e] = (g1 * acc[ai][1][m][1][e]) * __builtin_amdgcn_rcpf(__builtin_fmaf(e1, kk, kk)); }
                u32x2 w; w.x = pack4_fp8(a[0], a[1], a[2], a[3]); w.y = pack4_fp8(b[0], b[1], b[2], b[3]);
                *(u32x2*)(O + (size_t)(row0 + ai * HALF + m * 16) * ldc + col0) = w; }
    }
};
struct EpiU {
    static constexpr bool PERM = true;
    bf16_t* A2; const float* rs;
    __device__ __forceinline__ void operator()(const f32x4 (&acc)[2][2][4][2], const Unit& u, int wr, int wc, int fr, int fq) const {
        const int row0 = u.pm * BM + wr * 64 + fr, col0 = u.pn * BM + wc * 32 + 8 * fq;
#pragma unroll
        for (int ai = 0; ai < 2; ++ai)
#pragma unroll
            for (int m = 0; m < 4; ++m) { const int row = row0 + ai * HALF + m * 16, c = row >> 4, t = row & 15; const float s = rs ? rs[row] : 1.f;
#pragma unroll
                for (int bj = 0; bj < 2; ++bj) { const int col = col0 + bj * HALF, g = col >> 4, i0 = col & 15;
                    st16(A2 + ((size_t)(g * 1024 + c) * 512 + t * 16 + i0), pack8(acc[ai][bj][m][0] * s, acc[ai][bj][m][1] * s)); } }
    }
};
struct EpiY {
    static constexpr bool PERM = true;
    bf16_t* G1;
    __device__ __forceinline__ void operator()(const f32x4 (&acc)[2][2][4][2], const Unit& u, int wr, int wc, int fr, int fq) const {
        const int row0 = u.pm * BM + wr * 64 + fr, col0 = wc * 32 + 8 * fq;
#pragma unroll
        for (int ai = 0; ai < 2; ++ai)
#pragma unroll
            for (int m = 0; m < 4; ++m) { const int row = row0 + ai * HALF + m * 16, g = row >> 10, c = row & 1023;
#pragma unroll
                for (int bj = 0; bj < 2; ++bj) { const int col = col0 + bj * HALF, t = col >> 4, j0 = col & 15;
                    f32x4 a = acc[ai][bj][m][0], b = acc[ai][bj][m][1];
#pragma unroll
                    for (int e = 0; e < 4; ++e) { a[e] = gelu_t(a[e]); b[e] = gelu_t(b[e]); }
                    st16(G1 + ((size_t)(c * 16 + t) * 1024 + g * 16 + j0), pack8(a, b)); } }
    }
};
struct EpiGlu {
    static constexpr bool PERM = true;
    const bf16_t* G1; bf16_t* G2;
    __device__ __forceinline__ void operator()(const f32x4 (&acc)[2][2][4][2], const Unit& u, int wr, int wc, int fr, int fq) const {
        const int row0 = u.pm * BM + wr * 64 + fr, col0 = u.pn * BM + wc * 32 + 8 * fq;
#pragma unroll
        for (int ai = 0; ai < 2; ++ai)
#pragma unroll
            for (int m = 0; m < 4; ++m) { const size_t ro = (size_t)(row0 + ai * HALF + m * 16) * 1024 + col0;
#pragma unroll
                for (int bj = 0; bj < 2; ++bj) { const u32x4 gv = *(const u32x4*)(G1 + ro + bj * HALF);
                    f32x4 a = acc[ai][bj][m][0], b = acc[ai][bj][m][1];
                    a[0] = bf_lo(gv.x) * sigm(a[0]); a[1] = bf_hi(gv.x) * sigm(a[1]); a[2] = bf_lo(gv.y) * sigm(a[2]); a[3] = bf_hi(gv.y) * sigm(a[3]);
                    b[0] = bf_lo(gv.z) * sigm(b[0]); b[1] = bf_hi(gv.z) * sigm(b[1]); b[2] = bf_lo(gv.w) * sigm(b[2]); b[3] = bf_hi(gv.w) * sigm(b[3]);
                    st16(G2 + ro + bj * HALF, pack8(a, b)); } }
    }
};
struct EpiSwiglu {
    static constexpr bool PERM = true;
    bf16_t* O; int ldc; const float* rs;
    __device__ __forceinline__ void operator()(const f32x4 (&acc)[2][2][4][2], const Unit& u, int wr, int wc, int fr, int fq) const {
        const int row0 = u.pm * BM + wr * 64 + fr, col0 = u.pn * HALF + wc * 32 + 8 * fq;
#pragma unroll
        for (int ai = 0; ai < 2; ++ai)
#pragma unroll
            for (int m = 0; m < 4; ++m) { f32x4 a, b; const float s = rs ? rs[row0 + ai * HALF + m * 16] : 1.f;
#pragma unroll
                for (int e = 0; e < 4; ++e) { const float g0 = acc[ai][0][m][0][e] * s, g1 = acc[ai][0][m][1][e] * s; a[e] = g0 * sigm(g0) * (acc[ai][1][m][0][e] * s); b[e] = g1 * sigm(g1) * (acc[ai][1][m][1][e] * s); }
                st16(O + (size_t)(row0 + ai * HALF + m * 16) * ldc + col0, pack8(a, b)); }
    }
};
struct EpiQKV {
    static constexpr bool PERM = true;
    bf16_t* base; unsigned koff, voff; const float* gtab; const float4* rope; float qscale; const float* rs;
    __device__ __forceinline__ void operator()(const f32x4 (&acc)[2][2][4][2], const Unit& u, int wr, int wc, int fr, int fq) const {
        const int row0 = u.pm * BM + wr * 64 + fr, pn = u.pn;
        const float* gain = gtab + (pn < 4 ? 0 : 64) + 8 * fq;
        const float sc = pn < 4 ? qscale : 1.f;
        const unsigned tbase = pn < 4 ? (unsigned)((4 * pn + wc) * 64) : (pn == 4 ? koff : voff) + (unsigned)(wc * 64);
        const int ldo = pn < 4 ? 1024 : 256;
#pragma unroll
        for (int ai = 0; ai < 2; ++ai)
#pragma unroll
            for (int m = 0; m < 4; ++m) { const int row = row0 + ai * HALF + m * 16;
                bf16_t* dst = base + ((size_t)tbase + (size_t)row * ldo + 8 * fq);
                const float s2 = rs ? rs[row] : 1.f;
                if (pn < 5) {
                    float ss = 0.f;
#pragma unroll
                    for (int bj = 0; bj < 2; ++bj)
#pragma unroll
                        for (int n = 0; n < 2; ++n) { const f32x4 v = acc[ai][bj][m][n] * s2; ss += (v[0] * v[0] + v[1] * v[1]) + (v[2] * v[2] + v[3] * v[3]); }
                    ss += __shfl_xor(ss, 16); ss += __shfl_xor(ss, 32);
                    const float r = rsqrtf(ss * (1.f / 64.f) + 1e-6f) * s2;
                    const int pos = row & 8191;
                    const float4* t0 = rope + (pos >> 6) * 8 + 2 * fq; const float4* t1 = rope + 1024 + (pos & 63) * 8 + 2 * fq;
#pragma unroll
                    for (int bj = 0; bj < 2; ++bj) { f32x4 o[2];
#pragma unroll
                        for (int n = 0; n < 2; ++n) { const float4 cs = bj == 0 ? t0[n] : t1[n]; const f32x4 g = *(const f32x4*)(gain + 32 * bj + 4 * n); const f32x4 v = acc[ai][bj][m][n];
                            const float x0 = v[0] * r * g[0], x1 = v[1] * r * g[1], x2 = v[2] * r * g[2], x3 = v[3] * r * g[3];
                            o[n][0] = (x0 * cs.x - x1 * cs.y) * sc; o[n][1] = (x0 * cs.y + x1 * cs.x) * sc; o[n][2] = (x2 * cs.z - x3 * cs.w) * sc; o[n][3] = (x2 * cs.w + x3 * cs.z) * sc; }
                        st16(dst + 32 * bj, pack8(o[0], o[1])); }
                } else {
#pragma unroll
                    for (int bj = 0; bj < 2; ++bj) st16(dst + 32 * bj, pack8(acc[ai][bj][m][0] * s2, acc[ai][bj][m][1] * s2));
                }
                asm volatile("" ::: "memory"); }
    }
};

typedef int v4i32 __attribute__((ext_vector_type(4)));
template <bool F8> struct Frag;
template <> struct Frag<false> { u32x4 k[2]; };
template <> struct Frag<true> { v8i32 v; };
template <class Prob, class Epi, bool ALIGN_EPI = false, bool SP2 = false, bool FP8 = false>
__device__ __forceinline__ void gemm_phase(PG8_LAS unsigned char* lds, const Prob& P, const Epi& E) {
    const int tid = threadIdx.x, wid = __builtin_amdgcn_readfirstlane(tid >> 6), lane = tid & 63, wr = wid >> 2, wc = wid & 3, fr = lane & 15, fq = lane >> 4;
    int Rr[2]; unsigned cof[2], voffB[2];
#pragma unroll
    for (int i = 0; i < 2; ++i) { int R, C; stage_rc(tid * 16 + i * 8192, R, C); const int Rb = Epi::PERM ? ((R & ~31) + perm32(R & 31)) : R;
        Rr[i] = R; cof[i] = (unsigned)C * 2u; voffB[i] = (unsigned)Rb * P.ldbB + (unsigned)C * 2u; }
    const size_t kstep = (size_t)(BK * 2);
    const size_t hstepB = (size_t)HALF * P.ldbB;
    const unsigned ldsw = (unsigned)wid * 1024u;
    const int aoff = FP8 ? lds_byte(wr * 64 + fr, fq * 16) : lds_byte(wr * 64 + fr, fq * 8), boff = FP8 ? lds_byte(wc * 32 + fr, fq * 16) : lds_byte(wc * 32 + fr, fq * 8);

#define PG8_SA(b, h) (((b) * 2 + (h)) * HTB)
#define PG8_SB(b, h) ((4 + (b) * 2 + (h)) * HTB)
#define PG8_STAGE(bufoff, gbase, voff) do { _Pragma("unroll") for (int _i = 0; _i < 2; ++_i) \
        __builtin_amdgcn_global_load_lds((const unsigned*)((const char*)(gbase) + (voff)[_i]), (PG8_LAS unsigned*)(lds + (bufoff) + ldsw + _i * 8192), 16, 0, 0); } while (0)
#define PG8_LD1(dst, addr) do { if constexpr (FP8) { const v4i32 lo_ = *(const PG8_LAS v4i32*)(addr), hi_ = *(const PG8_LAS v4i32*)((addr) + 16); (dst).v = __builtin_shufflevector(lo_, hi_, 0, 1, 2, 3, 4, 5, 6, 7); } \
        else { _Pragma("unroll") for (int k = 0; k < 2; ++k) (dst).k[k] = *(const PG8_LAS u32x4*)((addr) + k * 1024); } } while (0)
#define PG8_LDA(dst, b, h) do { _Pragma("unroll") for (int m = 0; m < 4; ++m) PG8_LD1(dst[m], lds + PG8_SA(b, h) + aoff + m * 2048); } while (0)
#define PG8_LDB(dst, b, h) do { _Pragma("unroll") for (int n = 0; n < 2; ++n) PG8_LD1(dst[n], lds + PG8_SB(b, h) + boff + n * 2048); } while (0)
#define PG8_MMA(ai, bj, At, Bt) do { __builtin_amdgcn_s_setprio(1); _Pragma("unroll") for (int m = 0; m < 4; ++m) _Pragma("unroll") for (int n = 0; n < 2; ++n) { \
        if constexpr (FP8) asm volatile("v_mfma_scale_f32_16x16x128_f8f6f4 %0, %1, %2, %0, %3, %3 op_sel_hi:[0,0,0]" : "+v"(acc[ai][bj][m][n]) : "v"(Bt[n].v), "v"(At[m].v), "v"(f8scale_)); \
        else { _Pragma("unroll") for (int k = 0; k < 2; ++k) acc[ai][bj][m][n] = __builtin_amdgcn_mfma_f32_16x16x32_bf16(__builtin_bit_cast(bf16x8, Bt[n].k[k]), __builtin_bit_cast(bf16x8, At[m].k[k]), acc[ai][bj][m][n], 0, 0, 0); } } \
        __builtin_amdgcn_s_setprio(0); } while (0)
#define PG8_WAIT_V(n) asm volatile("s_waitcnt vmcnt(" #n ")" ::: "memory")
#define PG8_WAIT_L(n) asm volatile("s_waitcnt lgkmcnt(" #n ")" ::: "memory")
#define PG8_BAR __builtin_amdgcn_s_barrier()
#define PG8_SCHED __builtin_amdgcn_sched_barrier(0)
    const int f8scale_ = 0x7f7f7f7f;
    Unit cur, nxt; int ui = 0;
    if (!P.next(0, cur)) return;
    f32x4 acc[2][2][4][2];
#pragma unroll
    for (int a = 0; a < 2; ++a)
#pragma unroll
        for (int b = 0; b < 2; ++b)
#pragma unroll
            for (int m = 0; m < 4; ++m)
#pragma unroll
                for (int n = 0; n < 2; ++n) acc[a][b][m][n] = (f32x4){0.f, 0.f, 0.f, 0.f};
    Frag<FP8> At[4], B0[2], B1[2];
    unsigned voC[2][2], voN[2][2];
    P.aoffs(cur, Rr, voC);
#pragma unroll
    for (int h = 0; h < 2; ++h)
#pragma unroll
        for (int i = 0; i < 2; ++i) voC[h][i] += cof[i] + (unsigned)cur.kofs;
    const char* const aB = P.abase; const char* cB = P.bbase(cur) + cur.kofs;
    if constexpr (SP2) {
        PG8_STAGE(PG8_SB(0, 0), cB, voffB); PG8_STAGE(PG8_SB(0, 1), cB + hstepB, voffB); PG8_STAGE(PG8_SA(0, 0), aB, voC[0]); PG8_STAGE(PG8_SA(0, 1), aB, voC[1]);
        if (wr == 1) PG8_BAR;
        PG8_WAIT_V(2); PG8_BAR;
        PG8_STAGE(PG8_SB(1, 0), cB + kstep, voffB); PG8_STAGE(PG8_SA(1, 0), aB + kstep, voC[0]); PG8_STAGE(PG8_SB(1, 1), cB + hstepB + kstep, voffB);
        PG8_WAIT_V(6); PG8_BAR;
    } else {
        PG8_STAGE(PG8_SB(0, 0), cB, voffB); PG8_STAGE(PG8_SA(0, 0), aB, voC[0]); PG8_STAGE(PG8_SB(0, 1), cB + hstepB, voffB); PG8_STAGE(PG8_SA(0, 1), aB, voC[1]);
        if (wr == 1) PG8_BAR;
        PG8_WAIT_V(4); PG8_BAR;
        PG8_STAGE(PG8_SB(1, 0), cB + kstep, voffB); PG8_STAGE(PG8_SA(1, 0), aB + kstep, voC[0]); PG8_STAGE(PG8_SB(1, 1), cB + hstepB + kstep, voffB);
        PG8_WAIT_V(6); PG8_BAR;
    }
    for (;;) {
        const bool has_next = P.next(ui + 1, nxt);
        if (has_next) { P.aoffs(nxt, Rr, voN);
#pragma unroll
            for (int h = 0; h < 2; ++h)
#pragma unroll
                for (int i = 0; i < 2; ++i) voN[h][i] += cof[i] + (unsigned)nxt.kofs; }
        else {
#pragma unroll
            for (int h = 0; h < 2; ++h)
#pragma unroll
                for (int i = 0; i < 2; ++i) voN[h][i] = voC[h][i]; }
        const char* nB = has_next ? P.bbase(nxt) + nxt.kofs : cB;
        const int nt = cur.nt;
        for (int t = 0; t < nt; t += 2) {
            const bool last = (t == nt - 2);
            const char* a1 = aB + (size_t)(t + 1) * kstep;
            const char* a2 = last ? aB : aB + (size_t)(t + 2) * kstep; const char* b2 = last ? nB : cB + (size_t)(t + 2) * kstep;
            const char* a3 = a2 + kstep; const char* b3 = b2 + kstep;
            unsigned vo2[2][2];
#pragma unroll
            for (int h = 0; h < 2; ++h)
#pragma unroll
                for (int i = 0; i < 2; ++i) vo2[h][i] = last ? voN[h][i] : voC[h][i];
            if constexpr (SP2) {
            PG8_LDB(B0, 0, 0); PG8_LDB(B1, 0, 1); PG8_SCHED; PG8_LDA(At, 0, 0); PG8_STAGE(PG8_SA(1, 1), a1, voC[1]);
            PG8_WAIT_V(8); PG8_WAIT_L(0); PG8_BAR; PG8_MMA(0, 0, At, B0); PG8_MMA(0, 1, At, B1); PG8_BAR; PG8_SCHED;
            PG8_LDA(At, 0, 1); PG8_STAGE(PG8_SB(0, 0), b2, voffB); PG8_STAGE(PG8_SB(0, 1), b2 + hstepB, voffB); PG8_STAGE(PG8_SA(0, 0), a2, vo2[0]);
            PG8_WAIT_V(8); PG8_WAIT_L(0); PG8_BAR; PG8_MMA(1, 0, At, B0); PG8_MMA(1, 1, At, B1); PG8_BAR; PG8_SCHED;
            PG8_LDB(B0, 1, 0); PG8_LDB(B1, 1, 1); PG8_SCHED; PG8_LDA(At, 1, 0); PG8_STAGE(PG8_SA(0, 1), a2, vo2[1]);
            PG8_WAIT_V(8); PG8_WAIT_L(0); PG8_BAR; PG8_MMA(0, 0, At, B0); PG8_MMA(0, 1, At, B1); PG8_BAR; PG8_SCHED;
            PG8_LDA(At, 1, 1); PG8_STAGE(PG8_SB(1, 0), b3, voffB); PG8_STAGE(PG8_SB(1, 1), b3 + hstepB, voffB); PG8_STAGE(PG8_SA(1, 0), a3, vo2[0]);
            PG8_WAIT_V(8); PG8_WAIT_L(0); PG8_BAR; PG8_MMA(1, 0, At, B0); PG8_MMA(1, 1, At, B1); PG8_BAR; PG8_SCHED;
            } else {
            PG8_LDB(B0, 0, 0); PG8_SCHED; PG8_LDA(At, 0, 0); PG8_STAGE(PG8_SA(1, 1), a1, voC[1]);
            PG8_WAIT_L(8); PG8_BAR; PG8_WAIT_L(0); PG8_MMA(0, 0, At, B0); PG8_BAR; PG8_SCHED;
            PG8_LDB(B1, 0, 1); PG8_STAGE(PG8_SB(0, 0), b2, voffB);
            PG8_BAR; PG8_WAIT_L(0); PG8_MMA(0, 1, At, B1); PG8_BAR;
            PG8_LDA(At, 0, 1); PG8_STAGE(PG8_SA(0, 0), a2, vo2[0]);
            PG8_BAR; PG8_WAIT_L(0); PG8_MMA(1, 0, At, B0); PG8_BAR; PG8_SCHED;
            PG8_STAGE(PG8_SB(0, 1), b2 + hstepB, voffB);
            PG8_WAIT_V(6); PG8_BAR; PG8_MMA(1, 1, At, B1); PG8_BAR;
            PG8_LDB(B0, 1, 0); PG8_SCHED; PG8_LDA(At, 1, 0); PG8_STAGE(PG8_SA(0, 1), a2, vo2[1]);
            PG8_WAIT_L(8); PG8_BAR; PG8_WAIT_L(0); PG8_MMA(0, 0, At, B0); PG8_BAR; PG8_SCHED;
            PG8_LDB(B1, 1, 1); PG8_STAGE(PG8_SB(1, 0), b3, voffB);
            PG8_BAR; PG8_WAIT_L(0); PG8_MMA(0, 1, At, B1); PG8_BAR;
            PG8_LDA(At, 1, 1); PG8_STAGE(PG8_SA(1, 0), a3, vo2[0]);
            PG8_BAR; PG8_WAIT_L(0); PG8_MMA(1, 0, At, B0); PG8_BAR; PG8_SCHED;
            PG8_STAGE(PG8_SB(1, 1), b3 + hstepB, voffB);
            PG8_WAIT_V(6); PG8_BAR; PG8_MMA(1, 1, At, B1); PG8_BAR;
            }
        }
        if constexpr (ALIGN_EPI) { if (wr == 0) PG8_BAR; }
        if constexpr (FP8) asm volatile("s_nop 15\n\ts_nop 15" ::: "memory");
        E(acc, cur, wr, wc, fr, fq);
#if defined(EPI_TWICE) && EPI_TWICE
        if constexpr (FP8) { asm volatile("" ::: "memory"); E(acc, cur, wr, wc, fr, fq); }
#endif
        if (!has_next) break;
#pragma unroll
        for (int a = 0; a < 2; ++a)
#pragma unroll
            for (int b = 0; b < 2; ++b)
#pragma unroll
                for (int m = 0; m < 4; ++m)
#pragma unroll
                    for (int n = 0; n < 2; ++n) acc[a][b][m][n] = (f32x4){0.f, 0.f, 0.f, 0.f};
        cur = nxt; cB = nB; ++ui;
#pragma unroll
        for (int h = 0; h < 2; ++h)
#pragma unroll
            for (int i = 0; i < 2; ++i) voC[h][i] = voN[h][i];
        if constexpr (ALIGN_EPI) { if (wr == 1) PG8_BAR; }
    }
    PG8_WAIT_V(0);
    if constexpr (!ALIGN_EPI) { if (wr == 0) PG8_BAR; }
    PG8_BAR;
#undef PG8_SA
#undef PG8_SB
#undef PG8_STAGE
#undef PG8_LD1
#undef PG8_LDA
#undef PG8_LDB
#undef PG8_MMA
#undef PG8_WAIT_V
#undef PG8_WAIT_L
#undef PG8_BAR
#undef PG8_SCHED
}
}

#include <hip/hip_bf16.h>
#include <cmath>
namespace attn_body {
using bf16=__hip_bfloat16;
using bf16x8=__attribute__((ext_vector_type(8)))short;
using s16x4=__attribute__((ext_vector_type(4)))short;
using f32x16=__attribute__((ext_vector_type(16)))float;
using u32x4=__attribute__((ext_vector_type(4)))unsigned;
constexpr int BATCH=2,NHEAD=16,SEQ=8192,D=64,DM=NHEAD*D,KVP=256;
constexpr int NW=8,QBLK=32,QB=QBLK*NW,KVBLK=64,NQB=SEQ/QB;
constexpr int ATTN_PITCH=DM, ATTN_UNIT_ROWS=QB;
__device__ __forceinline__ int crow(int r,int hi){return (r&3)+8*(r>>2)+4*hi;}
#define SBAR() __builtin_amdgcn_sched_barrier(0)
__device__ __forceinline__ void cmask(f32x16&p0,f32x16&p1,int jb,int qrel,int hi){
  const float NEG=-INFINITY; int kb=64*jb+4*hi;
  #pragma unroll
  for(int r=0;r<16;++r){int kv=kb+(r&3)+8*(r>>2); if(kv>qrel)p0[r]=NEG; if(kv+32>qrel)p1[r]=NEG;}
}

constexpr int NSLOT=3, SLOTB=8192;
constexpr int LDS_K=0, LDS_V=NSLOT*SLOTB, LDS_WS=2*NSLOT*SLOTB, LDS_OST=LDS_WS+NW*64*4, LDS_BYTES=LDS_OST+NW*4096;
constexpr float C2=0.125f*1.4426950408889634f;
__device__ __forceinline__ void glds16(const void*gsrc,unsigned lds_dst){unsigned keep;
  asm volatile("s_mov_b32 %0, m0\n\ts_mov_b32 m0, %2\n\ts_nop 0\n\tglobal_load_lds_dwordx4 %1, off\n\ts_mov_b32 m0, %0":"=&s"(keep):"v"(gsrc),"s"(lds_dst):"memory");}
__device__ __forceinline__ float max3f(float a,float b,float c){float r;asm("v_max3_f32 %0, %1, %2, %3":"=v"(r):"v"(a),"v"(b),"v"(c));return r;}
__device__ __forceinline__ float max2f(float a,float b){float r;asm("v_max_f32_e32 %0, %1, %2":"=v"(r):"v"(a),"v"(b));return r;}
__device__ __forceinline__ float fadd_s(float a,float b){float r;asm("v_add_f32_e32 %0, %1, %2":"=v"(r):"v"(a),"v"(b));return r;}
__device__ __forceinline__ float fsub_s(float a,float b){float r;asm("v_sub_f32_e32 %0, %1, %2":"=v"(r):"v"(a),"v"(b));return r;}
typedef float f32x2_t __attribute__((ext_vector_type(2))); typedef __bf16 bf16x2_t __attribute__((ext_vector_type(2)));
__device__ __forceinline__ unsigned cvtpk_s(float lo,float hi){f32x2_t v={lo,hi};bf16x2_t b=__builtin_convertvector(v,bf16x2_t);return __builtin_bit_cast(unsigned,b);}
#define WAIT_BAR(N) asm volatile("s_waitcnt vmcnt(" #N ") lgkmcnt(0)\n\ts_barrier":::"memory")

__device__ __forceinline__ void qkt(f32x16&p0,f32x16&p1,const char*Kslot,const bf16x8*qr,const f32x16&negm,int r32,int hi){
  const char*kb=Kslot+hi*1024+r32*16;
  #pragma unroll
  for(int d0=0;d0<4;++d0){
    const bf16x8 b0=*reinterpret_cast<const bf16x8*>(kb+d0*2048);
    const bf16x8 b1=*reinterpret_cast<const bf16x8*>(kb+d0*2048+512);
    if(d0==0){p0=__builtin_amdgcn_mfma_f32_32x32x16_bf16(b0,qr[0],negm,0,0,0);p1=__builtin_amdgcn_mfma_f32_32x32x16_bf16(b1,qr[0],negm,0,0,0);}
    else{p0=__builtin_amdgcn_mfma_f32_32x32x16_bf16(b0,qr[d0],p0,0,0,0);p1=__builtin_amdgcn_mfma_f32_32x32x16_bf16(b1,qr[d0],p1,0,0,0);}}
}
typedef __attribute__((address_space(3))) const char* lds_cptr;
typedef short v4i16_t __attribute__((ext_vector_type(4)));
__device__ __forceinline__ void kload8(bf16x8*kf,lds_cptr kp){
  kf[0]=*(const __attribute__((address_space(3))) bf16x8*)(kp);      kf[1]=*(const __attribute__((address_space(3))) bf16x8*)(kp+512);
  kf[2]=*(const __attribute__((address_space(3))) bf16x8*)(kp+2048); kf[3]=*(const __attribute__((address_space(3))) bf16x8*)(kp+2560);
  kf[4]=*(const __attribute__((address_space(3))) bf16x8*)(kp+4096); kf[5]=*(const __attribute__((address_space(3))) bf16x8*)(kp+4608);
  kf[6]=*(const __attribute__((address_space(3))) bf16x8*)(kp+6144); kf[7]=*(const __attribute__((address_space(3))) bf16x8*)(kp+6656);
}
__device__ __forceinline__ void kload2(bf16x8*kf,lds_cptr kp,int j){ kf[2*j]=*(const __attribute__((address_space(3))) bf16x8*)(kp+j*2048); kf[2*j+1]=*(const __attribute__((address_space(3))) bf16x8*)(kp+j*2048+512); }
__device__ __forceinline__ s16x4 vtr(lds_cptr p){ return __builtin_bit_cast(s16x4,__builtin_amdgcn_ds_read_tr16_b64_v4i16((__attribute__((address_space(3))) v4i16_t*)p)); }
__device__ __forceinline__ float rowmax(const f32x16&p0,const f32x16&p1){
  float a=max3f(p0[0],p0[1],p1[0]),b=max3f(p0[2],p0[3],p1[1]);a=max3f(a,p1[2],p1[3]);
  #pragma unroll
  for(int r=4;r<16;r+=4){a=max3f(a,p0[r],p0[r+1]);b=max3f(b,p0[r+2],p0[r+3]);a=max3f(a,p1[r],p1[r+1]);b=max3f(b,p1[r+2],p1[r+3]);}
  const float m=max2f(a,b);
  auto rr=__builtin_amdgcn_permlane32_swap(__float_as_uint(m),__float_as_uint(m),false,false);
  return max2f(__uint_as_float(rr[0]),__uint_as_float(rr[1]));
}
__device__ __forceinline__ void pv(f32x16*o,int vb,bf16x8 pa0,bf16x8 pa1,bf16x8 pa2,bf16x8 pa3){
  #pragma unroll
  for(int d0=0;d0<2;++d0){s16x4 lo[4],hi[4];
    #pragma unroll
    for(int ks=0;ks<4;++ks){
      asm volatile("ds_read_b64_tr_b16 %0,%1 offset:%c2":"=&v"(lo[ks]):"v"(vb),"i"(d0*4096+ks*1024):"memory");
      asm volatile("ds_read_b64_tr_b16 %0,%1 offset:%c2":"=&v"(hi[ks]):"v"(vb),"i"(d0*4096+ks*1024+512):"memory");}
    asm volatile("s_waitcnt lgkmcnt(0)":::"memory");SBAR();
    #define PK(k) (bf16x8){lo[k][0],lo[k][1],lo[k][2],lo[k][3],hi[k][0],hi[k][1],hi[k][2],hi[k][3]}
    o[d0]=__builtin_amdgcn_mfma_f32_32x32x16_bf16(pa0,PK(0),o[d0],0,0,0);
    o[d0]=__builtin_amdgcn_mfma_f32_32x32x16_bf16(pa1,PK(1),o[d0],0,0,0);
    o[d0]=__builtin_amdgcn_mfma_f32_32x32x16_bf16(pa2,PK(2),o[d0],0,0,0);
    o[d0]=__builtin_amdgcn_mfma_f32_32x32x16_bf16(pa3,PK(3),o[d0],0,0,0);
    #undef PK
  }
}

#ifndef ATTN_STORE16
#define ATTN_STORE16(p,v) pg8::st16((void*)(p),(v))
#endif
template<int THRL,bool FIX> __device__ __forceinline__ void attn_unit(float refB,int b,int h,int kvh,int qb,const bf16*Q,const bf16*__restrict__ K,const bf16*__restrict__ V,bf16*O,char*shm){
  const int tid=threadIdx.x,lane=tid&63,r32=lane&31,hi=lane>>5; const int wid=__builtin_amdgcn_readfirstlane(tid>>6);
  const long rowbase=(long)b*SEQ; const int q0=qb*QB;
  const bf16*Qw=Q+(rowbase+q0+wid*QBLK)*DM+h*D;
  const bf16*Kh=K+rowbase*KVP+kvh*D,*Vh=V+rowbase*KVP+kvh*D;
  const unsigned lds0=(unsigned)(uintptr_t)shm;
  float*wsf=(float*)(shm+LDS_WS)+wid*64;
  const bf16*ksrc=Kh+(long)lane*KVP+wid*8;
  const bf16*vsrc=Vh+(long)(16*(wid&3)+(lane>>2))*KVP+(wid>>2)*32+(lane&3)*8;
  const unsigned kdst=lds0+LDS_K+wid*1024, vdst=lds0+LDS_V+wid*1024;
  #define DMA_K(t,slot) glds16(ksrc+(long)(t)*KVBLK*KVP,(unsigned)__builtin_amdgcn_readfirstlane(kdst+(slot)))
  #define DMA_V(t,slot) glds16(vsrc+(long)(t)*KVBLK*KVP,(unsigned)__builtin_amdgcn_readfirstlane(vdst+(slot)))
  const int vb0=(int)(lds0+LDS_V)+((lane>>4)&1)*32+(lane&3)*8+(4*hi+((lane&15)>>2))*64;
  const char*Kbase=shm+LDS_K; bf16x8 kf[8];
  const lds_cptr shm3=(lds_cptr)shm; const lds_cptr kp0=shm3+LDS_K+hi*1024+r32*16; const lds_cptr vp0=shm3+LDS_V+((lane>>4)&1)*32+(lane&3)*8+(4*hi+((lane&15)>>2))*64;
  const int NT=SEQ/KVBLK;
  DMA_K(0,0);DMA_V(0,0);DMA_K(1,SLOTB);
  bf16x8 qr[4];
  #pragma unroll
  for(int d0=0;d0<4;++d0)qr[d0]=*reinterpret_cast<const bf16x8*>(&Qw[(long)r32*DM+d0*16+hi*8]);
  float mhat=0.f,l_reg=0.f;f32x16 o[2];o[0]=f32x16{};o[1]=f32x16{};f32x16 negm=f32x16{}; if constexpr(FIX){ _Pragma("unroll") for(int r=0;r<16;++r)negm[r]=-refB; } asm volatile("":"+v"(negm));
  const int qrel=wid*QBLK+r32;
  #define CMASK(P0,P1,t) do{}while(0)
  bool resc=false;
  #define START(P0,P1) do{ if constexpr(!FIX){ const float rm=rowmax(P0,P1); resc=false; \
    { const float dl=rm; mhat=fadd_s(mhat,dl); \
      _Pragma("unroll") for(int r=0;r<16;++r){P0[r]=fsub_s(P0[r],dl);P1[r]=fsub_s(P1[r],dl);} \
      _Pragma("unroll") for(int r=0;r<16;++r)negm[r]=-mhat; asm volatile("":"+v"(negm)); } } \
    _Pragma("unroll") for(int r=0;r<16;++r)P0[r]=__builtin_amdgcn_exp2f(P0[r]); }while(0)
  #define RESC() do{ if constexpr(!FIX) if(resc){ asm volatile("s_waitcnt lgkmcnt(0)":::"memory"); \
      _Pragma("unroll") for(int d_=0;d_<2;++d_) _Pragma("unroll") for(int r=0;r<16;++r)o[d_][r]*=wsf[crow(r,hi)]; } }while(0)
  f32x16 pA0,pA1,pB0,pB1;
  int sl_prev=0,sl_cur=0,sl_next=SLOTB;
  #define ROT() do{sl_prev=sl_cur;sl_cur=sl_next;sl_next=(sl_next==(NSLOT-1)*SLOTB)?0:sl_next+SLOTB;}while(0)
  DMA_K(2,2*SLOTB);
  WAIT_BAR(3);
  qkt(pA0,pA1,Kbase,qr,negm,r32,hi);asm volatile("s_nop 15\n\ts_nop 7":"+v"(pA0),"+v"(pA1));CMASK(pA0,pA1,0);
  START(pA0,pA1);
  _Pragma("unroll") for(int r=0;r<16;++r)pA1[r]=__builtin_amdgcn_exp2f(pA1[r]);
  WAIT_BAR(0);
  DMA_K(3,0);DMA_V(1,SLOTB);
  ROT();
  kload8(kf,kp0+sl_cur);
  WAIT_BAR(2);
  s16x4 vlo[8],vhi[8]; u32x4 pw0,pw1,pw2,pw3;
  #define PKW(P,B) cvtpk_s(P[B],P[B+1])
  #define PAF(k) __builtin_bit_cast(bf16x8,pw##k)
  #define VFR(i) (bf16x8){vlo[i][0],vlo[i][1],vlo[i][2],vlo[i][3],vhi[i][0],vhi[i][1],vhi[i][2],vhi[i][3]}
  #define PIN(x) asm volatile("":"+v"(x))
  #define MX3(a,b,c) __builtin_fmaxf(__builtin_fmaxf((a),(b)),(c))
  #define GAPA(MF,A0,A1,A2,A3,W0,W1,PW) do{ MF; sacc+=A0; sacc+=A1; sacc+=A2; sacc+=A3; PIN(sacc); W0; W1; PIN(PW); SBAR(); }while(0)
  #define EX(v) __builtin_amdgcn_exp2f(v)
  #define GAPB(MF,X,B) do{ MF; X[B]=EX(X[B]); X[B+1]=EX(X[B+1]); X[B+2]=EX(X[B+2]); X[B+3]=EX(X[B+3]); PIN(X); SBAR(); }while(0)
  #define VRD(i) do{ vlo[i]=vtr(vp_+(((i)>>2)*4096+((i)&3)*1024)); vhi[i]=vtr(vp_+(((i)>>2)*4096+((i)&3)*1024+512)); }while(0)
  #define KRD(G,j) do{ if(G){ kload2(kf,kp0+sl_next,j); SBAR(); } }while(0)
  #define STEP(C0,C1,P0,P1,t,GK,GV,GL) do{ SBAR(); \
    const lds_cptr vp_=vp0+sl_prev; \
    VRD(0); SBAR(); float sacc=(P0[0]+P0[1]); \
    GAPA(C0=__builtin_amdgcn_mfma_f32_32x32x16_bf16(kf[0],qr[0],negm,0,0,0), P0[2],P0[3],P0[4],P0[5],     pw0[0]=PKW(P0,0), pw0[1]=PKW(P0,2), pw0); \
    VRD(4); SBAR(); GAPA(C1=__builtin_amdgcn_mfma_f32_32x32x16_bf16(kf[1],qr[0],negm,0,0,0), P0[6],P0[7],P0[8],P0[9],     pw0[2]=PKW(P0,4), pw0[3]=PKW(P0,6), pw0); \
    VRD(1); SBAR(); GAPA(C0=__builtin_amdgcn_mfma_f32_32x32x16_bf16(kf[2],qr[1],C0,0,0,0),   P0[10],P0[11],P0[12],P0[13], pw1[0]=PKW(P0,8), pw1[1]=PKW(P0,10), pw1); \
    VRD(5); SBAR(); GAPA(C1=__builtin_amdgcn_mfma_f32_32x32x16_bf16(kf[3],qr[1],C1,0,0,0),   P0[14],P0[15],P1[0],P1[1],   pw1[2]=PKW(P0,12),pw1[3]=PKW(P0,14), pw1); \
    VRD(2); SBAR(); GAPA(C0=__builtin_amdgcn_mfma_f32_32x32x16_bf16(kf[4],qr[2],C0,0,0,0),   P1[2],P1[3],P1[4],P1[5],     pw2[0]=PKW(P1,0), pw2[1]=PKW(P1,2), pw2); \
    VRD(6); SBAR(); GAPA(C1=__builtin_amdgcn_mfma_f32_32x32x16_bf16(kf[5],qr[2],C1,0,0,0),   P1[6],P1[7],P1[8],P1[9],     pw2[2]=PKW(P1,4), pw2[3]=PKW(P1,6), pw2); \
    VRD(3); SBAR(); GAPA(C0=__builtin_amdgcn_mfma_f32_32x32x16_bf16(kf[6],qr[3],C0,0,0,0),   P1[10],P1[11],P1[12],P1[13], pw3[0]=PKW(P1,8), pw3[1]=PKW(P1,10), pw3); \
    VRD(7); SBAR(); GAPA(C1=__builtin_amdgcn_mfma_f32_32x32x16_bf16(kf[7],qr[3],C1,0,0,0),   P1[14],P1[15],0.f,0.f,       pw3[2]=PKW(P1,12),pw3[3]=PKW(P1,14), pw3); \
    l_reg+=sacc; \
    if(GK){DMA_K((t)+3,sl_cur);} if(GV){DMA_V((t)+1,sl_next);} \
    CMASK(C0,C1,t); \
    if constexpr(!FIX){ float a=MX3(C0[0],C0[1],C1[0]),b=MX3(C0[2],C0[3],C1[1]); a=MX3(a,C1[2],C1[3]); \
      _Pragma("unroll") for(int r=4;r<16;r+=4){a=MX3(a,C0[r],C0[r+1]);b=MX3(b,C0[r+2],C0[r+3]);a=MX3(a,C1[r],C1[r+1]);b=MX3(b,C1[r+2],C1[r+3]);} \
      float rm=__builtin_fmaxf(a,b); { auto rr=__builtin_amdgcn_permlane32_swap(__float_as_uint(rm),__float_as_uint(rm),false,false); rm=__builtin_fmaxf(__uint_as_float(rr[0]),__uint_as_float(rr[1])); } \
      resc=false; \
      if(__builtin_expect(__any(rm>(float)THRL),0)){ const float dl=__builtin_fmaxf(rm,0.f); mhat+=dl; \
        _Pragma("unroll") for(int r=0;r<16;++r){C0[r]-=dl;C1[r]-=dl;} \
        _Pragma("unroll") for(int r=0;r<16;++r)negm[r]=-mhat; asm volatile("":"+v"(negm)); \
        const float f=__builtin_amdgcn_exp2f(-dl); l_reg*=f; if(hi==0)wsf[r32]=f; resc=true; } } \
    SBAR(); \
    GAPB(o[0]=__builtin_amdgcn_mfma_f32_32x32x16_bf16(PAF(0),VFR(0),o[0],0,0,0), C0,0); \
    GAPB(o[1]=__builtin_amdgcn_mfma_f32_32x32x16_bf16(PAF(0),VFR(4),o[1],0,0,0), C0,4); \
    KRD(GL,0); GAPB(o[0]=__builtin_amdgcn_mfma_f32_32x32x16_bf16(PAF(1),VFR(1),o[0],0,0,0), C0,8); \
    KRD(GL,1); GAPB(o[1]=__builtin_amdgcn_mfma_f32_32x32x16_bf16(PAF(1),VFR(5),o[1],0,0,0), C0,12); \
    KRD(GL,2); GAPB(o[0]=__builtin_amdgcn_mfma_f32_32x32x16_bf16(PAF(2),VFR(2),o[0],0,0,0), C1,0); \
    KRD(GL,3); GAPB(o[1]=__builtin_amdgcn_mfma_f32_32x32x16_bf16(PAF(2),VFR(6),o[1],0,0,0), C1,4); \
    GAPB(o[0]=__builtin_amdgcn_mfma_f32_32x32x16_bf16(PAF(3),VFR(3),o[0],0,0,0), C1,8); \
    GAPB(o[1]=__builtin_amdgcn_mfma_f32_32x32x16_bf16(PAF(3),VFR(7),o[1],0,0,0), C1,12); \
    }while(0)
  int t=1;
#if defined(ATTN_PRIO) && ATTN_PRIO
  if(wid>=4)__builtin_amdgcn_s_setprio(1);
#endif
  #undef CMASK
  #define CMASK(P0,P1,t) do{}while(0)
  for(;t+5<NT;t+=2){
    STEP(pB0,pB1,pA0,pA1,t,true,true,true);     WAIT_BAR(2); RESC(); ROT();
    STEP(pA0,pA1,pB0,pB1,t+1,true,true,true);   WAIT_BAR(2); RESC(); ROT();
  }
  #undef CMASK
  #define CMASK(P0,P1,t) do{}while(0)
  #define ENDW(tt) do{ if((tt)+3<NT){WAIT_BAR(2);} else if((tt)+2<NT){WAIT_BAR(1);} else {WAIT_BAR(0);} }while(0)
  for(;t+1<NT;t+=2){
    STEP(pB0,pB1,pA0,pA1,t,(t+3<NT),(t+1<NT),(t+1<NT));       ENDW(t);   RESC(); ROT();
    STEP(pA0,pA1,pB0,pB1,t+1,(t+4<NT),(t+2<NT),(t+2<NT));     ENDW(t+1); RESC(); ROT();
  }
  STEP(pB0,pB1,pA0,pA1,NT-1,false,false,false); RESC();
  { float sacc=pB0[0]+pB0[1]; _Pragma("unroll") for(int r=2;r<16;++r)sacc+=pB0[r]; _Pragma("unroll") for(int r=0;r<16;++r)sacc+=pB1[r]; l_reg+=sacc;
    pw0=(u32x4){PKW(pB0,0),PKW(pB0,2),PKW(pB0,4),PKW(pB0,6)};pw1=(u32x4){PKW(pB0,8),PKW(pB0,10),PKW(pB0,12),PKW(pB0,14)};pw2=(u32x4){PKW(pB1,0),PKW(pB1,2),PKW(pB1,4),PKW(pB1,6)};pw3=(u32x4){PKW(pB1,8),PKW(pB1,10),PKW(pB1,12),PKW(pB1,14)};
    SBAR(); pv(o,vb0+sl_cur,PAF(0),PAF(1),PAF(2),PAF(3)); }
  #undef PKW
  #undef PAF
  #undef VFR
  #undef PIN
  #undef MX3
  #undef GAPA
  #undef GAPB
  #undef EX
  #undef VRD
  #undef KRD
  #undef STEP
  #undef ENDW
#if defined(ATTN_PRIO) && ATTN_PRIO
  __builtin_amdgcn_s_setprio(0);
#endif
  {auto rr=__builtin_amdgcn_permlane32_swap(__float_as_uint(l_reg),__float_as_uint(l_reg),false,false);l_reg=__uint_as_float(rr[0])+__uint_as_float(rr[1]);}
  if(hi==0)wsf[32+r32]=l_reg;asm volatile("s_waitcnt lgkmcnt(0)":::"memory");
  float rli[16];
  #pragma unroll
  for(int r=0;r<16;++r)rli[r]=__builtin_amdgcn_rcpf(wsf[32+crow(r,hi)]);
  bf16*Ow=O+(rowbase+q0+wid*QBLK)*DM+h*D;
  { bf16*stg=(bf16*)(shm+LDS_OST)+wid*2048;
    #pragma unroll
    for(int r=0;r<16;++r){const int orow=crow(r,hi);
      #pragma unroll
      for(int d0=0;d0<2;++d0)stg[orow*64+d0*32+r32]=__float2bfloat16(o[d0][r]*rli[r]);}
    asm volatile("s_waitcnt lgkmcnt(0)":::"memory");
    #pragma unroll
    for(int i=0;i<4;++i){const int row=i*8+(lane>>3),ch=lane&7; const u32x4 v=*(const u32x4*)(stg+row*64+ch*8); ATTN_STORE16(Ow+(long)row*DM+ch*8,v);} }
  asm volatile("s_waitcnt lgkmcnt(0)\n\ts_barrier":::"memory");
  #undef DMA_K
  #undef DMA_V
  #undef CMASK
  #undef START
  #undef RESC
  #undef ROT
}
constexpr int ATTN_LDS_BYTES=LDS_BYTES;
struct AttnTensors { const bf16* Q; const bf16* K; const bf16* V; bf16* O; };
struct AttnUnit { int bh; int qb; };
struct StaticOrder {
  int vcu;
  __device__ __forceinline__ explicit StaticOrder(int grid,int block):vcu((block%8)*(grid/8)+block/8){}
  __device__ __forceinline__ bool next(int i,AttnUnit&u)const{ if(i>=4)return false; const int x=vcu>>5, j=vcu&31; const int b=x>>2, kvh=x&3; u.bh=b*16+kvh*4+i; u.qb=j; return true; }
  __device__ __forceinline__ void a_ready(const AttnUnit&)const{}
  __device__ __forceinline__ void done(const AttnUnit&)const{}
};
template<class Sched,bool FIX,int THRL=8> __device__ __forceinline__ void attn_phase(char*lds,const AttnTensors&T,const Sched&S,float refB){
  AttnUnit u;
  for(int i=0;S.next(i,u);++i){ S.a_ready(u); attn_unit<THRL,FIX>(refB,u.bh/NHEAD,u.bh%NHEAD,(u.bh%NHEAD)>>2,u.qb,T.Q,T.K,T.V,T.O,lds); S.done(u); }
}
#undef SBAR
#undef WAIT_BAR
}

#define GAS __attribute__((address_space(1)))
#define LAS __attribute__((address_space(3)))
typedef unsigned short bf16;
typedef unsigned v4u __attribute__((ext_vector_type(4)));
typedef float f32x4 __attribute__((ext_vector_type(4)));
typedef short bf16x8 __attribute__((ext_vector_type(8)));
typedef GAS unsigned gu32;
typedef GAS unsigned long long gu64;
#define RLX_AGENT __ATOMIC_RELAXED, __HIP_MEMORY_SCOPE_AGENT
#define LDS_WAIT() asm volatile("s_waitcnt lgkmcnt(0)" ::: "memory")
#define VM_WAIT() asm volatile("s_waitcnt vmcnt(0)" ::: "memory")
__device__ __forceinline__ unsigned long long rt() { return __builtin_amdgcn_s_memrealtime(); }
__device__ __forceinline__ unsigned f2bf(float f) { unsigned u = __builtin_bit_cast(unsigned, f); return (u + 0x7fffu + ((u >> 16) & 1u)) >> 16; }
__device__ __forceinline__ unsigned pk2(float lo, float hi) { return pg8::cvt_pk_bf16(lo, hi); }

#define XB_TMO      128
#define XB_XCNT(j)  (256  + 64 * (j))
#define XB_XSUB(j)  (1280 + 64 * (j))
#define XB_XGEN(j)  (2304 + 64 * (j))
#define XB_TOP      3328
#define XB_TOPGEN   3392
#define XCD_BAR_WORDS 3456
#define XB_SPIN_CAP (1u << 18)

__device__ __forceinline__ unsigned xb_ld(unsigned* p)              { return __hip_atomic_load(p, __ATOMIC_RELAXED, __HIP_MEMORY_SCOPE_AGENT); }
__device__ __forceinline__ unsigned xb_add(unsigned* p, unsigned v) { return __hip_atomic_fetch_add(p, v, __ATOMIC_RELAXED, __HIP_MEMORY_SCOPE_AGENT); }
__device__ __forceinline__ unsigned xb_xcc_id() { return (unsigned)__builtin_amdgcn_s_getreg((3 << 11) | 20) & 0xFu; }
#ifndef XB_SLEEP
#define XB_SLEEP 1
#endif
#define XB_SPIN(cond, bar) do { unsigned _sp = 0; while (cond) { __builtin_amdgcn_s_sleep(XB_SLEEP); \
    if ((++_sp & 255u) == 0u) { if (xb_ld(&(bar)[XB_TMO])) break; if (_sp > XB_SPIN_CAP) { atomicAdd(&(bar)[XB_TMO], 1u); break; } } } } while (0)

struct XcdBarrier {
    unsigned* bar; unsigned x;
    volatile LAS unsigned* st;
};

__device__ __forceinline__ XcdBarrier xcd_barrier_post(unsigned* bar, volatile LAS unsigned* st) {
    XcdBarrier b; b.bar = bar; b.x = xb_xcc_id(); b.st = st;
    if (threadIdx.x == 0) (void)xb_add(&bar[XB_XCNT(b.x)], 1u);
    return b;
}
__device__ __forceinline__ void xcd_barrier_complete(unsigned* bar, unsigned x, unsigned& nloc, unsigned& nx) {
    const unsigned G = gridDim.x * gridDim.y * gridDim.z;
    unsigned sum, cnt, mine, sp = 0u;
    for (;;) {
        sum = 0u; cnt = 0u; mine = 0u;
#pragma unroll
        for (unsigned j = 0; j < 16; ++j) { const unsigned c = xb_ld(&bar[XB_XCNT(j)]); sum += c; cnt += (c > 0u) ? 1u : 0u; mine = (j == x) ? c : mine; }
        if (sum == G) break;
        __builtin_amdgcn_s_sleep(1);
        if ((++sp & 255u) == 0u) { if (xb_ld(&bar[XB_TMO])) break; if (sp > XB_SPIN_CAP) { atomicAdd(&bar[XB_TMO], 1u); break; } }
    }
    nloc = mine > 0u ? mine : 1u; nx = cnt > 0u ? cnt : 1u;
}

__device__ __forceinline__ void xcd_barrier(const XcdBarrier& b) {
    asm volatile("s_waitcnt vmcnt(0)" ::: "memory");
    __syncthreads();
    if (threadIdx.x == 0) {
        unsigned* bar = b.bar;
        __builtin_amdgcn_s_waitcnt(0);
        unsigned nloc = b.st[0], nx = b.st[1];
        if (nloc == 0u) { xcd_barrier_complete(bar, b.x, nloc, nx); b.st[0] = nloc; b.st[1] = nx; }
        const unsigned old = xb_add(&bar[XB_XSUB(b.x)], 1u);
        const unsigned gen = old / nloc;
        if (old + 1u == (gen + 1u) * nloc) {
            __builtin_amdgcn_fence(__ATOMIC_RELEASE, "agent");
            asm volatile("s_waitcnt vmcnt(0)" ::: "memory");
            const unsigned og = xb_add(&bar[XB_TOP], 1u);
            const unsigned tg = og / nx;
            if (og + 1u == (tg + 1u) * nx) xb_add(&bar[XB_TOPGEN], 1u);
            else XB_SPIN(xb_ld(&bar[XB_TOPGEN]) == tg, bar);
            __builtin_amdgcn_fence(__ATOMIC_ACQUIRE, "agent");
            xb_add(&bar[XB_XGEN(b.x)], 1u);
            asm volatile("s_waitcnt vmcnt(0)" ::: "memory");
        } else {
            XB_SPIN(xb_ld(&bar[XB_XGEN(b.x)]) == gen, bar);
            __builtin_amdgcn_fence(__ATOMIC_ACQUIRE, "agent");
            asm volatile("s_waitcnt vmcnt(0)" ::: "memory");
        }
    }
    __syncthreads();
}

#ifndef MOE_FP8
#define MOE_FP8 1
#endif
#ifndef MOE_WGM
#define MOE_WGM 8
#endif
#ifndef P15_ALIGN
#define P15_ALIGN true
#endif
#ifndef P15_SP2
#define P15_SP2 true
#endif
#ifndef FFN_FP8
#define FFN_FP8 0
#endif
#ifndef MOE_CVT_IN_SCAN
#define MOE_CVT_IN_SCAN 1
#endif
#ifndef ATTN_PRIO
#define ATTN_PRIO 1
#endif
#ifndef MOE_CVT_SPLIT
#define MOE_CVT_SPLIT 16384
#endif
#ifndef CVT_P0_END
#define CVT_P0_END T_ISMALL
#endif
#ifndef CVT_S1
#define CVT_S1 11264
#endif
#ifndef CVT_S2
#define CVT_S2 16384
#endif
#ifndef FFN_WGM
#define FFN_WGM 8
#endif
#ifndef S_BF16
#define S_BF16 0
#endif
#ifndef NORM_FACTOR
#define NORM_FACTOR 0
#endif
constexpr int NWAVES = 8;
constexpr int NTOK = 16384, DM = 1024, SEQ = 8192, NB = 2;
constexpr int DFF = 2816, NEXP = 8, DFE = 3584, QKVW = 1536;
constexpr float EPS = 1e-6f;
constexpr float QSCALE = 0.125f * 1.4426950408889634f;

constexpr size_t MiB = 1u << 20;
constexpr size_t WS_CTL = 0, CTL_ZERO_BYTES = 1 * MiB;
constexpr size_t WS_ROPE_R = 1 * MiB, WS_ROPE_C = 1 * MiB + 16384, WS_AT = 1 * MiB + 65536, WS_QKG = 1 * MiB + 131072, WS_TOKINFO = 1 * MiB + 262144;
constexpr size_t WS_RSTD = 1 * MiB + 524288;
constexpr size_t WS_LIST = 2 * MiB, WS_IDLIST = 3 * MiB;
constexpr size_t WS_BT_IN = 4 * MiB, WS_BT_GLU = 6 * MiB, WS_BT_SOUT = 8 * MiB, WS_BT_AO = 10 * MiB, WS_BT_QKV = 12 * MiB, WS_BT_GU = 16 * MiB, WS_BT_FD = 28 * MiB;
constexpr size_t WS_S5_MAIN = 34 * MiB, WS_S5_STATE = 50 * MiB;
constexpr size_t WS_A2 = 58 * MiB, WS_S = 122 * MiB, WS_G1 = 122 * MiB, WS_G2 = 154 * MiB, WS_MIX = 58 * MiB;
constexpr size_t WS_ACTF = 122 * MiB;
constexpr size_t WS_Q = 122 * MiB, WS_K = 154 * MiB, WS_V = 162 * MiB, WS_O = 170 * MiB;
constexpr size_t WS_XN = 242 * MiB;
constexpr size_t WS_ACTM = 4 * MiB;
constexpr size_t WS_BT_MGU = 280 * MiB, WS_BT_MD = 392 * MiB, WS_SLOT = 124 * MiB, WS_PART = 192 * MiB, WS_HB = 336 * MiB, WS_END = 448 * MiB;
static_assert(WS_ACTM + (size_t)34816 * DFE * 2 <= WS_XN && WS_XN + (size_t)NTOK * DM * 2 <= WS_BT_MGU && WS_BT_MGU + (size_t)8 * 7168 * 1024 * 2 == WS_BT_MD && WS_BT_MD + (size_t)8 * 1024 * 3584 * 2 == WS_END, "ws map");
static_assert(WS_S5_STATE + (size_t)64 * 256 * 256 * 2 <= WS_A2 && WS_ACTF + (size_t)NTOK * DFF * 2 <= WS_XN && WS_O + (size_t)NTOK * DM * 2 <= WS_XN && WS_SLOT + (size_t)34816 * DM * 2 <= WS_PART && WS_PART + (size_t)256 * 131072 <= WS_XN && WS_ACTM + (size_t)34816 * DFE <= WS_SLOT && WS_BT_MGU + (size_t)8 * 7168 * 1024 <= WS_HB && WS_HB + (size_t)NTOK * DM * 2 <= WS_BT_MD && MOE_FP8 == 1, "ws map 2");
constexpr int CW_TMO = 0, CW_CODE = 1, CW_BAR = 4096, CW_CNT = 8192;

constexpr int RING_OFF = 0, RING_BYTES = 131072;
constexpr int LDSCTL_OFF = RING_BYTES, MISC_OFF = LDSCTL_OFF + 320;
constexpr int LDS_BYTES = 147456;

typedef unsigned v2u __attribute__((ext_vector_type(2)));
typedef float v2f __attribute__((ext_vector_type(2)));

constexpr int MOE_OFF = MISC_OFF + 256;
struct Frame {
    LAS unsigned char* lds;
    volatile LAS unsigned* MISC;
    gu32* ctl;
    int tid, lane, wave;
    int vcu, G;
};
__device__ __forceinline__ float wave_sum(float v) {
#pragma unroll
    for (int o = 1; o < 64; o <<= 1) v += __shfl_xor(v, o);
    return v;
}
constexpr int T_ISMALL = 4 * 256 + 384 + 3 * 704, T_NITEMS = T_ISMALL + 8 * 3 * 896;
struct TItem { const float* W; bf16* WT; int K, N, kind, half, item, f8; const float* gain; };
__device__ __forceinline__ TItem t_decode(int it, const float* const* in, unsigned char* ws) {
    constexpr int I_SQ = 256, I_FG = 704, I_QKV = 384, I_M = 896;
    TItem t; int r = it; t.kind = 0; t.half = 0; t.K = DM; t.N = DM; t.f8 = 0; t.gain = nullptr;
    if (r < I_SQ) { t.W = in[2]; t.WT = (bf16*)(ws + WS_BT_IN); t.item = r; if (NORM_FACTOR) t.gain = in[1]; return t; } r -= I_SQ;
    if (r < I_SQ) { t.W = in[11]; t.WT = (bf16*)(ws + WS_BT_GLU); t.item = r; return t; } r -= I_SQ;
    if (r < I_SQ) { t.W = in[12]; t.WT = (bf16*)(ws + WS_BT_SOUT); t.item = r; return t; } r -= I_SQ;
    if (r < I_SQ) { t.W = in[19]; t.WT = (bf16*)(ws + WS_BT_AO); t.item = r; return t; } r -= I_SQ;
    if (r < I_QKV) { t.W = in[16]; t.WT = (bf16*)(ws + WS_BT_QKV); t.N = QKVW; t.kind = 2; t.item = r; if (NORM_FACTOR) t.gain = in[1] + 4 * DM; return t; } r -= I_QKV;
    if (r < I_FG) { t.W = in[13]; t.WT = (bf16*)(ws + WS_BT_GU); t.N = DFF; t.kind = 1; t.item = r; t.f8 = FFN_FP8; if (NORM_FACTOR) t.gain = in[1] + 2 * DM; return t; } r -= I_FG;
    if (r < I_FG) { t.W = in[14]; t.WT = (bf16*)(ws + WS_BT_GU); t.N = DFF; t.kind = 1; t.half = 1; t.item = r; t.f8 = FFN_FP8; if (NORM_FACTOR) t.gain = in[1] + 2 * DM; return t; } r -= I_FG;
    if (r < I_FG) { t.W = in[15]; t.WT = (bf16*)(ws + WS_BT_FD); t.K = DFF; t.item = r; t.f8 = FFN_FP8; return t; } r -= I_FG;
    const int e = r / (3 * I_M); r -= e * 3 * I_M; t.f8 = MOE_FP8;
    if (r < I_M) { t.W = in[21] + (size_t)e * DM * DFE; t.WT = (bf16*)(ws + WS_BT_MGU + (size_t)e * 7168 * 1024 * (MOE_FP8 ? 1 : 2)); t.N = DFE; t.kind = 1; t.item = r; return t; } r -= I_M;
    if (r < I_M) { t.W = in[22] + (size_t)e * DM * DFE; t.WT = (bf16*)(ws + WS_BT_MGU + (size_t)e * 7168 * 1024 * (MOE_FP8 ? 1 : 2)); t.N = DFE; t.kind = 1; t.half = 1; t.item = r; return t; } r -= I_M;
    t.W = in[23] + (size_t)e * DFE * DM; t.WT = (bf16*)(ws + WS_BT_MD + (size_t)e * 1024 * 3584 * (MOE_FP8 ? 1 : 2)); t.K = DFE; t.item = r; return t;
}
__device__ __forceinline__ void t_issue(const TItem& t, int lane, f32x4 (&ld)[16]) {
    const int nblk = t.N / 64, kb = t.item / nblk, nb = t.item - kb * nblk;
    const int rmul = t.f8 ? 4 : 2;
    const float* p = t.W + (size_t)(64 * kb + rmul * (lane >> 4)) * t.N + 64 * nb + 4 * (lane & 15);
#pragma unroll
    for (int i = 0; i < 16; ++i) ld[i] = *(const GAS f32x4*)(p + (size_t)(t.f8 ? 16 * (i >> 2) + (i & 3) : 8 * (i >> 1) + (i & 1)) * t.N);
}
__device__ __forceinline__ void t_finish(const TItem& t, int lane, const f32x4 (&ld)[16], LAS unsigned* T) {
    const int nblk = t.N / 64, kb = t.item / nblk, nb = t.item - kb * nblk, k0 = 64 * kb, n0 = 64 * nb;
    const int r = lane >> 4, cg = lane & 15;
    if (t.f8) {
        unsigned char* WT8 = (unsigned char*)t.WT;
#pragma unroll
        for (int mq = 0; mq < 4; ++mq) { LAS unsigned* d = T + (4 * mq + r) * 65 + 4 * cg;
            d[0] = pg8::pack4_fp8(ld[4 * mq].x * 64.f, ld[4 * mq + 1].x * 64.f, ld[4 * mq + 2].x * 64.f, ld[4 * mq + 3].x * 64.f);
            d[1] = pg8::pack4_fp8(ld[4 * mq].y * 64.f, ld[4 * mq + 1].y * 64.f, ld[4 * mq + 2].y * 64.f, ld[4 * mq + 3].y * 64.f);
            d[2] = pg8::pack4_fp8(ld[4 * mq].z * 64.f, ld[4 * mq + 1].z * 64.f, ld[4 * mq + 2].z * 64.f, ld[4 * mq + 3].z * 64.f);
            d[3] = pg8::pack4_fp8(ld[4 * mq].w * 64.f, ld[4 * mq + 1].w * 64.f, ld[4 * mq + 2].w * 64.f, ld[4 * mq + 3].w * 64.f); }
        LDS_WAIT(); asm volatile("" ::: "memory");
        const int c4 = lane & 3;
#pragma unroll
        for (int j = 0; j < 4; ++j) { const int nl = (lane >> 2) + 16 * j, n = n0 + nl;
            const int dr = t.kind == 0 ? n : 256 * (n / 128) + (n % 128) + 128 * t.half;
            const LAS unsigned* s = T + (4 * c4) * 65 + nl;
            v4u o; o.x = s[0]; o.y = s[65]; o.z = s[130]; o.w = s[195];
            *(GAS v4u*)(WT8 + (size_t)dr * t.K + k0 + 16 * c4) = o; }
        LDS_WAIT(); asm volatile("" ::: "memory");
        return;
    }
#pragma unroll
    for (int m = 0; m < 8; ++m) { LAS unsigned* d = T + (4 * m + r) * 65 + 4 * cg;
        float g0 = 1.f, g1 = 1.f; if (NORM_FACTOR && t.gain) { const v2f gg = *(const GAS v2f*)(t.gain + k0 + 8 * m + 2 * r); g0 = gg.x; g1 = gg.y; }
        d[0] = pk2(ld[2 * m].x * g0, ld[2 * m + 1].x * g1); d[1] = pk2(ld[2 * m].y * g0, ld[2 * m + 1].y * g1); d[2] = pk2(ld[2 * m].z * g0, ld[2 * m + 1].z * g1); d[3] = pk2(ld[2 * m].w * g0, ld[2 * m + 1].w * g1); }
    LDS_WAIT(); asm volatile("" ::: "memory");
    const int c = lane & 7;
#pragma unroll
    for (int j = 0; j < 8; ++j) { const int nl = (lane >> 3) + 8 * j, n = n0 + nl;
        const int dr = t.kind == 0 ? n : (t.kind == 1 ? 256 * (n / 128) + (n % 128) + 128 * t.half : 256 * (n / 256) + 128 * ((n % 64) / 32) + 32 * ((n % 256) / 64) + (n % 32));
        const LAS unsigned* s = T + (4 * c) * 65 + nl;
        v4u o; o.x = s[0]; o.y = s[65]; o.z = s[130]; o.w = s[195];
        *(GAS v4u*)(t.WT + (size_t)dr * t.K + k0 + 8 * c) = o; }
    LDS_WAIT(); asm volatile("" ::: "memory");
}
__device__ __forceinline__ void convert_range(const float* const* in, unsigned char* ws, LAS unsigned* scr, int lane, int begin, int end, int wi, int nw) {
    f32x4 lA[16], lB[16]; TItem tA, tB; int it = begin + wi;
    if (it < end) { tA = t_decode(it, in, ws); t_issue(tA, lane, lA); }
    while (it < end) {
        const bool nb = it + nw < end;
        if (nb) { tB = t_decode(it + nw, in, ws); t_issue(tB, lane, lB); }
        t_finish(tA, lane, lA, scr);
        if (!nb) break;
        const bool na = it + 2 * nw < end;
        if (na) { tA = t_decode(it + 2 * nw, in, ws); t_issue(tA, lane, lA); }
        t_finish(tB, lane, lB, scr);
        if (!na) break;
        it += 2 * nw;
    }
}
__device__ __forceinline__ void s5_tables_item(Frame& F, const float* const* in, unsigned char* ws, int g, int tq) {
    const float *lam_re = in[3], *lam_im = in[4], *log_step = in[5], *b_re = in[6], *b_im = in[7], *c_re = in[8], *c_im = in[9], *dsk = in[10];
    LAS float* APOW = (LAS float*)F.lds;
    LAS float* BB = APOW + 2 * 17 * 64 * 2;
    LAS float* CC = BB + 2 * 64 * 16 * 2;
    LAS float* KT = CC + 2 * 16 * 64 * 2;
    const int tid = F.tid;
    __syncthreads();
    if (tid < 128) {
        const int dir = tid >> 6, p = tid & 63;
        const double step = exp((double)log_step[dir * 64 + g]);
        const double lr = lam_re[(dir * 64 + g) * 64 + p], li = lam_im[(dir * 64 + g) * 64 + p];
        const double mag = exp(lr * step), ang = li * step;
        const double ar = mag * cos(ang), ai = mag * sin(ang);
        double pr = 1.0, pi = 0.0;
        for (int tau = 0; tau <= 16; ++tau) { APOW[((dir * 17 + tau) * 64 + p) * 2] = (float)pr; APOW[((dir * 17 + tau) * 64 + p) * 2 + 1] = (float)pi;
            const double nr = pr * ar - pi * ai, ni = pr * ai + pi * ar; pr = nr; pi = ni; if (tau == 15 && tq == 0) { ((float*)(ws + WS_AT))[((dir * 64 + g) * 64 + p) * 2] = (float)nr; ((float*)(ws + WS_AT))[((dir * 64 + g) * 64 + p) * 2 + 1] = (float)ni; } }
        const double nr = ar - 1.0, ni = ai, den = lr * lr + li * li;
        const double qr = (nr * lr + ni * li) / den, qi = (ni * lr - nr * li) / den;
        for (int i = 0; i < 16; ++i) { const double br = b_re[((dir * 64 + g) * 64 + p) * 16 + i], bi = b_im[((dir * 64 + g) * 64 + p) * 16 + i];
            BB[((dir * 64 + p) * 16 + i) * 2] = (float)(qr * br - qi * bi); BB[((dir * 64 + p) * 16 + i) * 2 + 1] = (float)(qr * bi + qi * br); }
    }
    for (int idx = tid; idx < 2048; idx += 512) { const int dir = idx >> 10, j = (idx >> 6) & 15, p = idx & 63;
        CC[idx * 2] = c_re[((dir * 64 + g) * 16 + j) * 64 + p]; CC[idx * 2 + 1] = c_im[((dir * 64 + g) * 16 + j) * 64 + p]; }
    __syncthreads();
    {
        const int dir = tid >> 8, j = (tid >> 4) & 15, i = tid & 15;
        float kt[16];
#pragma unroll
        for (int t = 0; t < 16; ++t) kt[t] = 0.f;
        for (int p = 0; p < 64; ++p) {
            const float cr = CC[((dir * 16 + j) * 64 + p) * 2], ci = CC[((dir * 16 + j) * 64 + p) * 2 + 1];
            const float br = BB[((dir * 64 + p) * 16 + i) * 2], bi = BB[((dir * 64 + p) * 16 + i) * 2 + 1];
            const float wr = cr * br - ci * bi, wi = cr * bi + ci * br;
#pragma unroll
            for (int t = 0; t < 16; ++t) { const float ar = APOW[((dir * 17 + t) * 64 + p) * 2], ai = APOW[((dir * 17 + t) * 64 + p) * 2 + 1]; kt[t] += ar * wr - ai * wi; }
        }
#pragma unroll
        for (int t = 0; t < 16; ++t) KT[(dir * 16 + t) * 256 + j * 16 + i] = kt[t];
    }
    __syncthreads();
    bf16* Bm = (bf16*)(ws + WS_S5_MAIN) + (size_t)(g * 256 + 64 * tq) * 512;
    for (int w = tid; w < 4096; w += 512) {
        const int nl = w >> 6, k0 = (w & 63) * 8, t = 4 * tq + (nl >> 4), j = nl & 15;
        float v[8];
        if (k0 < 256) { const int s = k0 >> 4, i0 = k0 & 15;
#pragma unroll
            for (int e = 0; e < 8; ++e) { const int i = i0 + e;
                v[e] = (t > s) ? KT[(0 * 16 + (t - s)) * 256 + j * 16 + i] : (s > t) ? KT[(1 * 16 + (s - t)) * 256 + j * 16 + i]
                                 : KT[j * 16 + i] + KT[16 * 256 + j * 16 + i] + (i == j ? dsk[g * 16 + j] : 0.f); }
        } else { const int dir = (k0 - 256) >> 7, p0 = ((k0 - 256) & 127) >> 1, tau = dir == 0 ? t + 1 : 16 - t;
#pragma unroll
            for (int e = 0; e < 8; ++e) { const int p = p0 + (e >> 1), ri = e & 1;
                const float cr = CC[((dir * 16 + j) * 64 + p) * 2], ci = CC[((dir * 16 + j) * 64 + p) * 2 + 1];
                const float ar = APOW[((dir * 17 + tau) * 64 + p) * 2], ai = APOW[((dir * 17 + tau) * 64 + p) * 2 + 1];
                v[e] = ri == 0 ? (cr * ar - ci * ai) : -(cr * ai + ci * ar); }
        }
        v4u o; o.x = pk2(v[0], v[1]); o.y = pk2(v[2], v[3]); o.z = pk2(v[4], v[5]); o.w = pk2(v[6], v[7]);
        *(GAS v4u*)(Bm + (size_t)nl * 512 + k0) = o;
    }
    bf16* Bs = (bf16*)(ws + WS_S5_STATE) + (size_t)(g * 256 + 64 * tq) * 256;
    { const int dir = tq >> 1;
      for (int w = tid; w < 2048; w += 512) {
        const int nl = w >> 5, p = 32 * (tq & 1) + (nl >> 1), ri = nl & 1, k0 = (w & 31) * 8, s = k0 >> 4, i0 = k0 & 15, tau = dir == 0 ? 15 - s : s;
        const float ar = APOW[((dir * 17 + tau) * 64 + p) * 2], ai = APOW[((dir * 17 + tau) * 64 + p) * 2 + 1];
        float v[8];
#pragma unroll
        for (int e = 0; e < 8; ++e) { const float br = BB[((dir * 64 + p) * 16 + i0 + e) * 2], bi = BB[((dir * 64 + p) * 16 + i0 + e) * 2 + 1];
            v[e] = ri == 0 ? (ar * br - ai * bi) : (ar * bi + ai * br); }
        v4u o; o.x = pk2(v[0], v[1]); o.y = pk2(v[2], v[3]); o.z = pk2(v[4], v[5]); o.w = pk2(v[6], v[7]);
        *(GAS v4u*)(Bs + (size_t)nl * 256 + k0) = o;
      } }
    __syncthreads();
}
__device__ __forceinline__ void rms_row_to_bf16(int lane, const float* xrow, const float* gain, bf16* orow) {
    const GAS f32x4* xr = (const GAS f32x4*)xrow + lane;
    f32x4 v[4]; float s = 0.f;
#pragma unroll
    for (int j = 0; j < 4; ++j) { v[j] = xr[64 * j]; s += (v[j].x * v[j].x + v[j].y * v[j].y) + (v[j].z * v[j].z + v[j].w * v[j].w); }
    const float r = rsqrtf(wave_sum(s) * (1.f / DM) + EPS);
    GAS v2u* o8 = (GAS v2u*)orow + lane;
#pragma unroll
    for (int j = 0; j < 4; ++j) { const f32x4 g = ((const GAS f32x4*)gain)[lane + 64 * j]; v2u o; o.x = pk2(v[j].x * r * g.x, v[j].y * r * g.y); o.y = pk2(v[j].z * r * g.z, v[j].w * r * g.w); o8[64 * j] = o; }
}
__device__ __forceinline__ void row_to_bf16_rs(int lane, const float* xrow, bf16* orow, float* rs) {
    const GAS f32x4* xr = (const GAS f32x4*)xrow + lane;
    f32x4 v[4]; float s = 0.f;
#pragma unroll
    for (int j = 0; j < 4; ++j) { v[j] = xr[64 * j]; s += (v[j].x * v[j].x + v[j].y * v[j].y) + (v[j].z * v[j].z + v[j].w * v[j].w); }
    GAS v2u* o8 = (GAS v2u*)orow + lane;
#pragma unroll
    for (int j = 0; j < 4; ++j) { v2u o; o.x = pk2(v[j].x, v[j].y); o.y = pk2(v[j].z, v[j].w); o8[64 * j] = o; }
    const float r = rsqrtf(wave_sum(s) * (1.f / DM) + EPS);
    if (lane == 0) *rs = r;
}
__device__ __forceinline__ void p0_prologue(Frame& F, const float* const* in, unsigned char* ws) {
#ifndef P0DUP
#define P0DUP 0
#endif
#ifndef P0_SWAP
#define P0_SWAP 0
#endif
    const bool tables_last = P0_SWAP && ((blockIdx.x >> 3) & 1);
    if (!tables_last)
    for (int rep = 0; rep < 1 + (P0DUP & 1); ++rep)
    for (int it = blockIdx.x; it < 256; it += F.G) s5_tables_item(F, in, ws, it >> 2, it & 3);
    for (int idx = blockIdx.x * 512 + F.tid; idx < 192 * 16; idx += F.G * 512) {
        const int f = idx & 15, pos = idx < 2048 ? (idx >> 4) : ((idx - 2048) >> 4);
        const float freq = powf(10000.f, -(float)(2 * f) / 32.f), ang = (float)pos * freq;
        float* dst = idx < 2048 ? (float*)(ws + WS_ROPE_R) + idx * 2 : (float*)(ws + WS_ROPE_C) + (idx - 2048) * 2;
        dst[0] = cosf(ang); dst[1] = sinf(ang);
    }
#if defined(EXP_GATHER) && EXP_GATHER
    for (int idx = blockIdx.x * 512 + F.tid; idx < NTOK; idx += F.G * 512) ((int*)(ws + WS_IDLIST))[idx] = idx;
#endif
    if (blockIdx.x == 0 && F.tid < 128) ((float*)(ws + WS_QKG))[F.tid] = F.tid < 64 ? in[17][F.tid] : in[18][F.tid - 64];
    LAS unsigned* scr = (LAS unsigned*)(F.lds + RING_OFF + F.wave * 16384);
    const int gw = F.vcu * NWAVES + F.wave, NGW = F.G * NWAVES;
    for (int rep = 0; rep < 1 + ((P0DUP >> 1) & 1); ++rep) convert_range(in, ws, scr, F.lane, 0, CVT_P0_END, gw, NGW);
    for (int rep = 0; rep < 1 + ((P0DUP >> 2) & 1); ++rep)
#if NORM_FACTOR
    for (int m = gw; m < NTOK; m += NGW) row_to_bf16_rs(F.lane, in[0] + (size_t)m * DM, (bf16*)(ws + WS_HB) + (size_t)m * DM, (float*)(ws + WS_RSTD) + m);
#else
    for (int m = gw; m < NTOK; m += NGW) rms_row_to_bf16(F.lane, in[0] + (size_t)m * DM, in[1], (bf16*)(ws + WS_XN) + (size_t)m * DM);
#endif
    if (tables_last) { __syncthreads(); for (int it = blockIdx.x; it < 256; it += F.G) s5_tables_item(F, in, ws, it >> 2, it & 3); }
}
__device__ __forceinline__ void scan_phase(Frame& F, const float* const* in, unsigned char* ws) {
    const float* S = (const float*)(ws + WS_S); bf16* A2 = (bf16*)(ws + WS_A2); const float* aT = (const float*)(ws + WS_AT);
#if MOE_CVT_IN_SCAN
    if (F.wave != 0) {
        LAS unsigned* scr = (LAS unsigned*)(F.lds + RING_OFF + F.wave * 16384);
        convert_range(in, ws, scr, F.lane, CVT_P0_END, T_ISMALL + CVT_S1, F.vcu * 7 + (F.wave - 1), F.G * 7);
        return;
    }
    typedef float f32x2s __attribute__((ext_vector_type(2)));
#ifndef SCAN_REPS
#define SCAN_REPS 1
#endif
    for (int srep_ = 0; srep_ < SCAN_REPS; ++srep_)
    for (int it = blockIdx.x; it < 256; it += F.G) {
        const int dir = it & 1, g = (it >> 1) & 63, b = it >> 7;
        const float ar = aT[((dir * 64 + g) * 64 + F.lane) * 2], ai = aT[((dir * 64 + g) * 64 + F.lane) * 2 + 1];
        const size_t row0 = (size_t)g * 1024 + b * 512;
        const float* Sp = S + row0 * 256 + dir * 128 + 2 * F.lane;
        bf16* Ap = A2 + row0 * 512 + 256 + dir * 128 + 2 * F.lane;
        float xr = 0.f, xi = 0.f;
#if S_BF16
        unsigned X0[16], X1[16], X2[16];
#define SC_RE(x) pg8::bf_lo(x)
#define SC_IM(x) pg8::bf_hi(x)
#else
        f32x2s X0[16], X1[16], X2[16];
#define SC_RE(x) (x).x
#define SC_IM(x) (x).y
#endif
#if S_BF16
#define SC_LOAD(X, k0) do { _Pragma("unroll") for (int q = 0; q < 16; ++q) { const int c = dir == 0 ? (k0) + q : 511 - (k0) - q; X[q] = *(const GAS unsigned*)((const bf16*)(ws + WS_S) + (row0 + c) * 256 + dir * 128 + 2 * F.lane); } } while (0)
#else
#define SC_LOAD(X, k0) do { _Pragma("unroll") for (int q = 0; q < 16; ++q) { const int c = dir == 0 ? (k0) + q : 511 - (k0) - q; X[q] = *(const GAS f32x2s*)(Sp + (size_t)c * 256); } } while (0)
#endif
#define SC_STEP(X, k0) do { _Pragma("unroll") for (int q = 0; q < 16; ++q) { const int c = dir == 0 ? (k0) + q : 511 - (k0) - q; \
            *(GAS unsigned*)(Ap + (size_t)c * 512) = pk2(xr, xi); \
            const float nxr = ar * xr - ai * xi + SC_RE(X[q]), nxi = ar * xi + ai * xr + SC_IM(X[q]); xr = nxr; xi = nxi; } } while (0)
        SC_LOAD(X0, 0); SC_LOAD(X1, 16); SC_LOAD(X2, 32);
        for (int k0 = 0; k0 < 512; k0 += 48) {
            SC_STEP(X0, k0); if (k0 + 48 < 512) SC_LOAD(X0, k0 + 48);
            if (k0 + 16 < 512) { SC_STEP(X1, k0 + 16); if (k0 + 64 < 512) SC_LOAD(X1, k0 + 64); }
            if (k0 + 32 < 512) { SC_STEP(X2, k0 + 32); if (k0 + 80 < 512) SC_LOAD(X2, k0 + 80); }
        }
#undef SC_LOAD
#undef SC_STEP
#undef SC_RE
#undef SC_IM
    }
#else
    LAS float* L = (LAS float*)F.lds;
    for (int it = blockIdx.x; it < 256; it += F.G) {
        const int dir = it & 1, g = (it >> 1) & 63, b = it >> 7;
        const float ar = aT[((dir * 64 + g) * 64 + F.lane) * 2], ai = aT[((dir * 64 + g) * 64 + F.lane) * 2 + 1];
        float xr = 0.f, xi = 0.f;
        for (int hh = 0; hh < 2; ++hh) {
            const int cbase = dir == 0 ? 256 * hh : 256 * (1 - hh);
            const size_t row0 = (size_t)g * 1024 + b * 512 + cbase;
            __syncthreads();
            { f32x4 tv[16];
#pragma unroll
            for (int k = 0; k < 16; ++k) { const int idx = F.tid + 512 * k, cl = idx >> 5, q = idx & 31; tv[k] = *(const GAS f32x4*)(S + (row0 + cl) * 256 + dir * 128 + q * 4); }
#pragma unroll
            for (int k = 0; k < 16; ++k) { const int idx = F.tid + 512 * k, cl = idx >> 5, q = idx & 31; *(LAS f32x4*)(L + cl * 128 + q * 4) = tv[k]; } }
            __syncthreads();
            if (F.wave == 0) {
                for (int s0 = 0; s0 < 256; s0 += 8) { float sr[8], si[8];
#pragma unroll
                    for (int q = 0; q < 8; ++q) { const int cl = dir == 0 ? s0 + q : 255 - s0 - q; sr[q] = L[cl * 128 + 2 * F.lane]; si[q] = L[cl * 128 + 2 * F.lane + 1]; }
#pragma unroll
                    for (int q = 0; q < 8; ++q) { const int cl = dir == 0 ? s0 + q : 255 - s0 - q;
                        *(GAS unsigned*)(A2 + (row0 + cl) * 512 + 256 + dir * 128 + 2 * F.lane) = pk2(xr, xi);
                        const float nxr = ar * xr - ai * xi + sr[q], nxi = ar * xi + ai * xr + si[q]; xr = nxr; xi = nxi; } }
            }
        }
        __syncthreads();
    }
#endif
}
template <bool B16> __device__ __forceinline__ f32x4 ld_h(const void* h, int m, int lane, int j) {
    if constexpr (B16) { const v2u w = ((const GAS v2u*)((const bf16*)h + (size_t)m * DM))[lane + 64 * j]; return (f32x4){pg8::bf_lo(w.x), pg8::bf_hi(w.x), pg8::bf_lo(w.y), pg8::bf_hi(w.y)}; }
    else return ((const GAS f32x4*)((const float*)h + (size_t)m * DM))[lane + 64 * j];
}
template <bool B16> __device__ __forceinline__ void st_h(void* h, int m, int lane, int j, const f32x4& v) {
    if constexpr (B16) { v2u o; o.x = pk2(v.x, v.y); o.y = pk2(v.z, v.w); ((GAS v2u*)((bf16*)h + (size_t)m * DM))[lane + 64 * j] = o; }
    else ((GAS f32x4*)((float*)h + (size_t)m * DM))[lane + 64 * j] = v;
}
template <bool HINB> struct RowRaw { v2u mw[4]; v2u hb[4]; f32x4 hf[4]; };
template <bool HINB> __device__ __forceinline__ void row_load(RowRaw<HINB>& r, const void* hin, const bf16* mix, int m, int lane) {
    const GAS v2u* mr = (const GAS v2u*)(mix + (size_t)m * DM) + lane;
#pragma unroll
    for (int j = 0; j < 4; ++j) { r.mw[j] = mr[64 * j];
        if constexpr (HINB) r.hb[j] = ((const GAS v2u*)((const bf16*)hin + (size_t)m * DM))[lane + 64 * j]; else r.hf[j] = ((const GAS f32x4*)((const float*)hin + (size_t)m * DM))[lane + 64 * j]; }
}
template <bool HINB> __device__ __forceinline__ void row_unpack(const RowRaw<HINB>& r, f32x4 (&v)[4], f32x4 (&hv)[4]) {
#pragma unroll
    for (int j = 0; j < 4; ++j) { v[j] = (f32x4){pg8::bf_lo(r.mw[j].x), pg8::bf_hi(r.mw[j].x), pg8::bf_lo(r.mw[j].y), pg8::bf_hi(r.mw[j].y)};
        if constexpr (HINB) hv[j] = (f32x4){pg8::bf_lo(r.hb[j].x), pg8::bf_hi(r.hb[j].x), pg8::bf_lo(r.hb[j].y), pg8::bf_hi(r.hb[j].y)}; else hv[j] = r.hf[j]; }
}
template <bool XF8, bool HINB, bool HOUTB> __device__ __forceinline__ void e_phase(Frame& F, const void* hin, const bf16* mix, const float* gpost, const float* gpre, void* hout, bf16* xn, float* rs_out = nullptr) {
    const int gw = F.vcu * NWAVES + F.wave, NGW = F.G * NWAVES;
    RowRaw<HINB> R[2];
    row_load<HINB>(R[0], hin, mix, gw, F.lane);
#pragma unroll
    for (int k = 0; k < 8; ++k) { const int m = gw + k * NGW;
        if (k + 1 < 8) row_load<HINB>(R[(k + 1) & 1], hin, mix, m + NGW, F.lane);
        f32x4 v[4], hv[4]; float s = 0.f;
        row_unpack<HINB>(R[k & 1], v, hv);
#pragma unroll
        for (int j = 0; j < 4; ++j) s += (v[j].x * v[j].x + v[j].y * v[j].y) + (v[j].z * v[j].z + v[j].w * v[j].w);
        const float r = rsqrtf(wave_sum(s) * (1.f / DM) + EPS); float s2 = 0.f;
#pragma unroll
        for (int j = 0; j < 4; ++j) { const f32x4 g = ((const GAS f32x4*)gpost)[F.lane + 64 * j]; hv[j] = hv[j] + v[j] * r * g; s2 += (hv[j].x * hv[j].x + hv[j].y * hv[j].y) + (hv[j].z * hv[j].z + hv[j].w * hv[j].w); }
#pragma unroll
        for (int j = 0; j < 4; ++j) st_h<HOUTB>(hout, m, F.lane, j, hv[j]);
        if (rs_out) { const float r2 = rsqrtf(wave_sum(s2) * (1.f / DM) + EPS); if (F.lane == 0) rs_out[m] = r2; }
        if (xn) { const float r2 = rsqrtf(wave_sum(s2) * (1.f / DM) + EPS); GAS v2u* o8 = (GAS v2u*)(xn + (size_t)m * DM) + F.lane;
#pragma unroll
            for (int j = 0; j < 4; ++j) { const f32x4 g = ((const GAS f32x4*)gpre)[F.lane + 64 * j];
                if constexpr (XF8) ((GAS unsigned*)((unsigned char*)xn + (size_t)m * DM))[F.lane + 64 * j] = pg8::pack4_fp8(hv[j].x * r2 * g.x * 4.f, hv[j].y * r2 * g.y * 4.f, hv[j].z * r2 * g.z * 4.f, hv[j].w * r2 * g.w * 4.f);
                else { v2u o; o.x = pk2(hv[j].x * r2 * g.x, hv[j].y * r2 * g.y); o.y = pk2(hv[j].z * r2 * g.z, hv[j].w * r2 * g.w); o8[64 * j] = o; } } }
    }
}
__device__ __forceinline__ void e3_phase(Frame& F, const void* hin, const bf16* mix, const float* gpost, const float* gpre, void* hout, bf16* xn, const float* wrouter, unsigned char* ws) {
    LAS float* WL = (LAS float*)F.lds;
    LAS int* RI = (LAS int*)(F.lds + 32768);
    for (int idx = F.tid; idx < 8192; idx += 512) WL[(idx & 7) * 1024 + (idx >> 3)] = wrouter[idx];
    if (F.tid < 8) RI[320 + F.tid] = 0;
    __syncthreads();
    const int gw = F.vcu * NWAVES + F.wave, NGW = F.G * NWAVES;
    RowRaw<true> R[2];
    row_load<true>(R[0], hin, mix, gw, F.lane);
#pragma unroll
    for (int k = 0; k < 8; ++k) { const int m = gw + k * NGW;
        if (k + 1 < 8) row_load<true>(R[(k + 1) & 1], hin, mix, m + NGW, F.lane);
        f32x4 v[4], hv[4]; float s = 0.f;
        row_unpack<true>(R[k & 1], v, hv);
#pragma unroll
        for (int j = 0; j < 4; ++j) s += (v[j].x * v[j].x + v[j].y * v[j].y) + (v[j].z * v[j].z + v[j].w * v[j].w);
        const float r = rsqrtf(wave_sum(s) * (1.f / DM) + EPS); float s2 = 0.f;
#pragma unroll
        for (int j = 0; j < 4; ++j) { const f32x4 g = ((const GAS f32x4*)gpost)[F.lane + 64 * j]; hv[j] = hv[j] + v[j] * r * g; s2 += (hv[j].x * hv[j].x + hv[j].y * hv[j].y) + (hv[j].z * hv[j].z + hv[j].w * hv[j].w); }
#pragma unroll
        for (int j = 0; j < 4; ++j) st_h<true>(hout, m, F.lane, j, hv[j]);
        const float r2 = rsqrtf(wave_sum(s2) * (1.f / DM) + EPS); GAS v2u* o8 = (GAS v2u*)(xn + (size_t)m * DM) + F.lane;
        float lg[8];
#pragma unroll
        for (int e = 0; e < 8; ++e) lg[e] = 0.f;
#pragma unroll
        for (int j = 0; j < 4; ++j) { const f32x4 g = ((const GAS f32x4*)gpre)[F.lane + 64 * j]; const f32x4 xf = hv[j] * r2 * g;
#if MOE_FP8
            ((GAS unsigned*)((unsigned char*)xn + (size_t)m * DM))[F.lane + 64 * j] = pg8::pack4_fp8(xf.x * 4.f, xf.y * 4.f, xf.z * 4.f, xf.w * 4.f);
#else
            v2u o; o.x = pk2(xf.x, xf.y); o.y = pk2(xf.z, xf.w); o8[64 * j] = o;
#endif
#pragma unroll
            for (int e = 0; e < 8; ++e) { const f32x4 w = *(const LAS f32x4*)(WL + e * 1024 + 4 * (F.lane + 64 * j)); lg[e] += (xf.x * w.x + xf.y * w.y) + (xf.z * w.z + xf.w * w.w); } }
#pragma unroll
        for (int e = 0; e < 8; ++e) lg[e] = wave_sum(lg[e]);
        int e0 = 0; float l0 = lg[0];
#pragma unroll
        for (int e = 1; e < 8; ++e) if (lg[e] > l0) { l0 = lg[e]; e0 = e; }
        int e1 = -1; float l1 = -INFINITY;
#pragma unroll
        for (int e = 0; e < 8; ++e) if (e != e0 && lg[e] > l1) { l1 = lg[e]; e1 = e; }
        const float w0 = 1.f / (1.f + expf(l1 - l0));
        if (F.lane == 0) { const int sl = F.wave * 8 + k; RI[sl] = e0 | (e1 << 8); RI[64 + sl] = (int)__float_as_uint(w0); RI[128 + sl] = m; }
    }
    __syncthreads();
    if (F.tid < 64) { const int ee = RI[F.tid]; RI[192 + F.tid] = __hip_atomic_fetch_add(&RI[320 + (ee & 255)], 1, __ATOMIC_RELAXED, __HIP_MEMORY_SCOPE_WORKGROUP); RI[256 + F.tid] = __hip_atomic_fetch_add(&RI[320 + (ee >> 8)], 1, __ATOMIC_RELAXED, __HIP_MEMORY_SCOPE_WORKGROUP); }
    __syncthreads();
    if (F.tid < 8) RI[328 + F.tid] = (int)__hip_atomic_fetch_add(F.ctl + CW_CNT + 64 * F.tid, (unsigned)RI[320 + F.tid], RLX_AGENT);
    __syncthreads();
    if (F.tid < 64) { const int ee = RI[F.tid], e0 = ee & 255, e1 = ee >> 8, tok = RI[128 + F.tid];
        const int p0 = RI[328 + e0] + RI[192 + F.tid], p1 = RI[328 + e1] + RI[256 + F.tid];
        int* lists = (int*)(ws + WS_LIST); lists[e0 * NTOK + p0] = tok; lists[e1 * NTOK + p1] = tok;
        v4u ti; ti.x = (unsigned)ee; ti.y = (unsigned)p0; ti.z = (unsigned)p1; ti.w = (unsigned)RI[64 + F.tid];
        *(GAS v4u*)(ws + WS_TOKINFO + (size_t)tok * 16) = ti; }
    __syncthreads();
}
__device__ __forceinline__ void moe_table(Frame& F) {
    volatile LAS int* misc = (volatile LAS int*)(F.lds + MOE_OFF);
    __syncthreads();
    if (F.tid == 0) { int t = 0;
        for (int e = 0; e < 8; ++e) { const int c = (int)__hip_atomic_load(F.ctl + CW_CNT + 64 * e, RLX_AGENT); misc[e] = t; misc[16 + e] = c; t += (c + 255) >> 8; }
        misc[8] = t;
        const int first_rem = (t >> 6) << 6, urem = 4 * (t - first_rem);
        const int parts = urem == 0 ? 1 : (urem * 7 <= 256 ? 7 : (urem * 2 <= 256 ? 2 : 1));
        misc[9] = parts; misc[10] = parts == 1 ? t : first_rem; misc[11] = parts == 1 ? 0 : urem * parts; }
    __syncthreads();
}
__device__ __forceinline__ void e4_phase(Frame& F, const void* hin, const float* gpost, float* hout, unsigned char* ws) {
    volatile LAS int* misc = (volatile LAS int*)(F.lds + MOE_OFF);
    const bf16* SO = (const bf16*)(ws + WS_SLOT);
    const int gw = F.vcu * NWAVES + F.wave, NGW = F.G * NWAVES;
    const int first_rem = misc[10], parts = misc[9];
    v4u ti[8];
#pragma unroll
    for (int k = 0; k < 8; ++k) ti[k] = *(const GAS v4u*)(ws + WS_TOKINFO + (size_t)(gw + k * NGW) * 16);
    struct Raw4 { v2u a[4], b[4], h[4]; int slot0, slot1; };
    Raw4 R[2];
#define E4_ISSUE(RR, k) do { const v4u t_ = ti[k]; const int m_ = gw + (k) * NGW; \
        (RR).slot0 = __builtin_amdgcn_readfirstlane(misc[t_.x & 255] * 256 + (int)t_.y); (RR).slot1 = __builtin_amdgcn_readfirstlane(misc[(t_.x >> 8) & 255] * 256 + (int)t_.z); \
        const bool s0_ = ((RR).slot0 >> 8) >= first_rem, s1_ = ((RR).slot1 >> 8) >= first_rem; \
        const GAS v2u* a8_ = (const GAS v2u*)(SO + (size_t)(s0_ ? 0 : (RR).slot0) * DM) + F.lane; const GAS v2u* b8_ = (const GAS v2u*)(SO + (size_t)(s1_ ? 0 : (RR).slot1) * DM) + F.lane; \
        const GAS v2u* h8_ = (const GAS v2u*)((const bf16*)hin + (size_t)m_ * DM) + F.lane; \
        _Pragma("unroll") for (int j = 0; j < 4; ++j) { (RR).a[j] = a8_[64 * j]; (RR).b[j] = b8_[64 * j]; (RR).h[j] = h8_[64 * j]; } } while (0)
    E4_ISSUE(R[0], 0);
#pragma unroll
    for (int k = 0; k < 8; ++k) { const int m = gw + k * NGW;
        if (k + 1 < 8) E4_ISSUE(R[(k + 1) & 1], k + 1);
        const Raw4& C = R[k & 1];
        const float w0 = __uint_as_float(ti[k].w), w1 = 1.f - w0;
        const int slot0 = C.slot0, slot1 = C.slot1;
        const bool sp0 = (slot0 >> 8) >= first_rem, sp1 = (slot1 >> 8) >= first_rem;
        const float wa = sp0 ? 0.f : w0, wb = sp1 ? 0.f : w1;
        f32x4 v[4], hv[4]; float s = 0.f;
#pragma unroll
        for (int j = 0; j < 4; ++j) { const v2u a = C.a[j], b = C.b[j], hh = C.h[j]; hv[j] = (f32x4){pg8::bf_lo(hh.x), pg8::bf_hi(hh.x), pg8::bf_lo(hh.y), pg8::bf_hi(hh.y)};
            v[j].x = wa * pg8::bf_lo(a.x) + wb * pg8::bf_lo(b.x); v[j].y = wa * pg8::bf_hi(a.x) + wb * pg8::bf_hi(b.x); v[j].z = wa * pg8::bf_lo(a.y) + wb * pg8::bf_lo(b.y); v[j].w = wa * pg8::bf_hi(a.y) + wb * pg8::bf_hi(b.y); }
        if (sp0 || sp1) {
            const bf16* PT = (const bf16*)(ws + WS_PART);
#pragma unroll
            for (int kk = 0; kk < 2; ++kk) { const bool sp = kk == 0 ? sp0 : sp1; const int slot = kk == 0 ? slot0 : slot1; const float w = kk == 0 ? w0 : w1;
                if (sp) { const int pm = slot >> 8, rr = slot & 255;
#pragma unroll
                    for (int j = 0; j < 4; ++j) { f32x4 acc = (f32x4){0.f, 0.f, 0.f, 0.f};
                        for (int p = 0; p < parts; ++p) { const v2u a = *((const GAS v2u*)(PT + ((size_t)(((pm - first_rem) * 4 + j) * parts + p) * 65536 + (size_t)rr * 256)) + F.lane);
                            acc.x += pg8::bf_lo(a.x); acc.y += pg8::bf_hi(a.x); acc.z += pg8::bf_lo(a.y); acc.w += pg8::bf_hi(a.y); }
                        v[j] = v[j] + acc * w; } } }
        }
#pragma unroll
        for (int j = 0; j < 4; ++j) s += (v[j].x * v[j].x + v[j].y * v[j].y) + (v[j].z * v[j].z + v[j].w * v[j].w);
        const float r = rsqrtf(wave_sum(s) * (1.f / DM) + EPS);
        GAS f32x4* ho = (GAS f32x4*)(hout + (size_t)m * DM) + F.lane;
#pragma unroll
        for (int j = 0; j < 4; ++j) { const f32x4 g = ((const GAS f32x4*)gpost)[F.lane + 64 * j]; ho[64 * j] = hv[j] + v[j] * r * g; }
    }
#undef E4_ISSUE
}

#ifndef FLAT_BAR
#define FLAT_BAR 0
#endif
constexpr int FB_REPL = 8, CW_FB = 12288, CW_FBTMO = 12288 + 64 * 8;
struct FlatBar { gu32* ctl; unsigned epoch; };
__device__ __forceinline__ void flat_barrier(FlatBar& fb) {
    asm volatile("s_waitcnt vmcnt(0)" ::: "memory");
    __syncthreads();
    fb.epoch += 1u;
    if (threadIdx.x < 64) {
        const unsigned lane = threadIdx.x;
        __builtin_amdgcn_fence(__ATOMIC_RELEASE, "agent");
        asm volatile("s_waitcnt vmcnt(0)" ::: "memory");
        if (lane < FB_REPL) (void)__hip_atomic_fetch_add(fb.ctl + CW_FB + 64 * lane, 1u, RLX_AGENT);
        const unsigned target = fb.epoch * gridDim.x;
        gu32* mine = fb.ctl + CW_FB + 64 * (blockIdx.x % FB_REPL);
        unsigned sp = 0;
        while ((unsigned)__builtin_amdgcn_readfirstlane(__hip_atomic_load(mine, RLX_AGENT)) < target) {
            __builtin_amdgcn_s_sleep(1);
            if ((++sp & 1023u) == 0u) { if (__hip_atomic_load(fb.ctl + CW_FBTMO, RLX_AGENT) != 0u) break; if (sp > (1u << 20)) { if (lane == 0) __hip_atomic_store(fb.ctl + CW_FBTMO, 1u, RLX_AGENT); break; } }
        }
        __builtin_amdgcn_fence(__ATOMIC_ACQUIRE, "agent");
        asm volatile("s_waitcnt vmcnt(0)" ::: "memory");
    }
    __syncthreads();
}

#ifndef XB2
#define XB2 0
#endif
constexpr int CW_XB2 = 13312;
__device__ __forceinline__ void xcd_barrier2(const XcdBarrier& b, gu32* ctl) {
    asm volatile("s_waitcnt vmcnt(0)" ::: "memory");
    __syncthreads();
    if (threadIdx.x < 64) {
        unsigned* bar = b.bar; const unsigned lane = threadIdx.x;
        unsigned nloc = 1u, nx = 1u, old = 0u;
        if (lane == 0) {
            __builtin_amdgcn_s_waitcnt(0);
            nloc = b.st[0]; nx = b.st[1];
            if (nloc == 0u) { xcd_barrier_complete(bar, b.x, nloc, nx); b.st[0] = nloc; b.st[1] = nx; }
            old = xb_add(&bar[XB_XSUB(b.x)], 1u);
        }
        nloc = (unsigned)__builtin_amdgcn_readfirstlane((int)nloc); nx = (unsigned)__builtin_amdgcn_readfirstlane((int)nx); old = (unsigned)__builtin_amdgcn_readfirstlane((int)old);
        const unsigned gen = old / nloc;
        if (old + 1u == (gen + 1u) * nloc) {
            __builtin_amdgcn_fence(__ATOMIC_RELEASE, "agent");
            asm volatile("s_waitcnt vmcnt(0)" ::: "memory");
            if (lane < 8u) (void)__hip_atomic_fetch_add(ctl + CW_XB2 + 64 * lane, 1u, RLX_AGENT);
        }
        const unsigned target = (gen + 1u) * nx;
        gu32* mine = ctl + CW_XB2 + 64 * (blockIdx.x & 7u);
        unsigned sp = 0u;
        while ((unsigned)__builtin_amdgcn_readfirstlane((int)__hip_atomic_load(mine, RLX_AGENT)) < target) {
            __builtin_amdgcn_s_sleep(1);
            if ((++sp & 255u) == 0u) { if (xb_ld(&bar[XB_TMO])) break; if (sp > XB_SPIN_CAP) { if (lane == 0) atomicAdd(&bar[XB_TMO], 1u); break; } }
        }
        __builtin_amdgcn_fence(__ATOMIC_ACQUIRE, "agent");
        asm volatile("s_waitcnt vmcnt(0)" ::: "memory");
    }
    __syncthreads();
}

struct Args { const float* in[24]; float* out; unsigned char* ws; int ph_lo, ph_hi; };
__global__ void __launch_bounds__(NWAVES * 64, 2) mega_fwd(Args args) {
    extern __shared__ __attribute__((aligned(16))) unsigned char lds[];
    Frame F;
    F.lds = (LAS unsigned char*)lds;
    F.MISC = (volatile LAS unsigned*)(F.lds + MISC_OFF);
    F.tid = threadIdx.x; F.lane = F.tid & 63; F.wave = __builtin_amdgcn_readfirstlane(F.tid >> 6);
    F.G = gridDim.x; { const int bx = blockIdx.x; F.vcu = (F.G % 8 == 0) ? (bx % 8) * (F.G / 8) + bx / 8 : bx; }
    unsigned char* ws = args.ws;
    F.ctl = (gu32*)(ws + WS_CTL);
    for (int u = F.tid; u < (LDS_BYTES - LDSCTL_OFF) / 4; u += NWAVES * 64) ((LAS unsigned*)(F.lds + LDSCTL_OFF))[u] = 0u;
    __syncthreads();
#if FLAT_BAR
    FlatBar bar{F.ctl, 0u};
#define xcd_barrier(b) flat_barrier(b)
#else
    XcdBarrier bar = xcd_barrier_post((unsigned*)(F.ctl + CW_BAR), F.MISC + 8);
#if XB2
#define xcd_barrier(b) xcd_barrier2(b, F.ctl)
#endif
#endif
    const int lo = args.ph_lo, hi = args.ph_hi;
#ifndef PHMASK
#define PHMASK 0x3ffff
#endif
#define IN(k) (((PHMASK >> (k)) & 1) && lo <= (k) && (k) < hi)
#define SEAM(k) do { if (IN(k) && IN((k) + 1)) xcd_barrier(bar); } while (0)
#ifndef DUPMASK
#define DUPMASK 0
#endif
#define REP(k) _Pragma("unroll") for (int rep_ = 0; rep_ < (((DUPMASK) >> (k)) & 1) + 1; ++rep_)
#define REPBAR() do { if (rep_) xcd_barrier(bar); } while (0)
    const float* const* in = args.in;
    const float* gains = in[1];
    float* hbuf = args.out; void* HB = (void*)(ws + WS_HB);
    bf16* XN = (bf16*)(ws + WS_XN); bf16* MIX = (bf16*)(ws + WS_MIX);
    const int BIG = 1 << 30;
    using pg8::ProbPlain; using pg8::ProbMoE;

    if (IN(0)) REP(0) { REPBAR(); p0_prologue(F, in, ws); } SEAM(0);
#if defined(XTRA_BAR) && XTRA_BAR
    for (int xb_ = 0; xb_ < XTRA_BAR; ++xb_) xcd_barrier(bar);
#endif
    if (IN(1)) REP(1) { REPBAR();
        ProbPlain P{NORM_FACTOR ? (const char*)HB : (const char*)XN, (const char*)(ws + WS_BT_IN), 1024, 2048u, 2048u, 0, BIG, {}}; P.S.init(64, 4, F.G, (int)blockIdx.x);
        pg8::EpiU E{(pg8::bf16_t*)(ws + WS_A2), NORM_FACTOR ? (const float*)(ws + WS_RSTD) : (const float*)nullptr};
        pg8::gemm_phase<ProbPlain, pg8::EpiU, true, true>(F.lds + RING_OFF, P, E);
    } SEAM(1);
    if (IN(2)) REP(2) { REPBAR();
        ProbPlain P{(const char*)(ws + WS_A2), (const char*)(ws + WS_S5_STATE), 256, 1024u, 512u, (size_t)256 * 256 * 2, 4, {}}; P.S.init(256, 1, F.G, (int)blockIdx.x);
#if S_BF16
        pg8::EpiBf16 E{(pg8::bf16_t*)(ws + WS_S), 256, 1.f};
        pg8::gemm_phase<ProbPlain, pg8::EpiBf16, true, true>(F.lds + RING_OFF, P, E);
#else
        pg8::EpiF32 E{(float*)(ws + WS_S), 256};
        pg8::gemm_phase<ProbPlain, pg8::EpiF32, true, true>(F.lds + RING_OFF, P, E);
#endif
    } SEAM(2);
    if (IN(3)) REP(3) { REPBAR(); scan_phase(F, in, ws); } SEAM(3);
    if (IN(4)) REP(4) { REPBAR();
        ProbPlain P{(const char*)(ws + WS_A2), (const char*)(ws + WS_S5_MAIN), 512, 1024u, 1024u, (size_t)256 * 512 * 2, 4, {}}; P.S.init(256, 1, F.G, (int)blockIdx.x);
        pg8::EpiY E{(pg8::bf16_t*)(ws + WS_G1)};
        pg8::gemm_phase<ProbPlain, pg8::EpiY, true, true>(F.lds + RING_OFF, P, E);
    } SEAM(4);
    if (IN(5)) REP(5) { REPBAR();
        ProbPlain P{(const char*)(ws + WS_G1), (const char*)(ws + WS_BT_GLU), 1024, 2048u, 2048u, 0, BIG, {}}; P.S.init(64, 4, F.G, (int)blockIdx.x);
        pg8::EpiGlu E{(const pg8::bf16_t*)(ws + WS_G1), (pg8::bf16_t*)(ws + WS_G2)};
        pg8::gemm_phase<ProbPlain, pg8::EpiGlu, true, true>(F.lds + RING_OFF, P, E);
    } SEAM(5);
    if (IN(6)) REP(6) { REPBAR();
        ProbPlain P{(const char*)(ws + WS_G2), (const char*)(ws + WS_BT_SOUT), 1024, 2048u, 2048u, 0, BIG, {}}; P.S.init(64, 4, F.G, (int)blockIdx.x);
        pg8::EpiBf16 E{MIX, 1024, 1.f};
        pg8::gemm_phase<ProbPlain, pg8::EpiBf16, true, true>(F.lds + RING_OFF, P, E);
    } SEAM(6);
#if NORM_FACTOR
    if (IN(7)) REP(7) { REPBAR(); e_phase<false, true, true>(F, HB, MIX, gains + 1 * DM, gains + 2 * DM, HB, nullptr, (float*)(ws + WS_RSTD) + NTOK); } SEAM(7);
#else
    if (IN(7)) REP(7) { REPBAR(); e_phase<FFN_FP8 != 0, false, true>(F, in[0], MIX, gains + 1 * DM, gains + 2 * DM, HB, XN); } SEAM(7);
#endif
    if (IN(8)) REP(8) { REPBAR();
#if FFN_FP8
        ProbPlain P{(const char*)XN, (const char*)(ws + WS_BT_GU), 512, 1024u, 1024u, 0, BIG, {}}; P.S.init(64, 22, F.G, (int)blockIdx.x);
        pg8::EpiSwigluF8 E{(unsigned char*)(ws + WS_ACTF), DFF, 1.f / 256.f, 8.f};
        pg8::gemm_phase<ProbPlain, pg8::EpiSwigluF8, true, true, true>(F.lds + RING_OFF, P, E);
#else
        ProbPlain P{NORM_FACTOR ? (const char*)HB : (const char*)XN, (const char*)(ws + WS_BT_GU), 1024, 2048u, 2048u, 0, BIG, {}}; P.S.init(64, 22, F.G, (int)blockIdx.x, FFN_WGM);
        pg8::EpiSwiglu E{(pg8::bf16_t*)(ws + WS_ACTF), DFF, NORM_FACTOR ? (const float*)(ws + WS_RSTD) + NTOK : (const float*)nullptr};
#if defined(DEPHASE8) && DEPHASE8
        if (((int)blockIdx.x >> 3) & 1) { _Pragma("unroll") for (int d_ = 0; d_ < DEPHASE8; ++d_) __builtin_amdgcn_s_sleep(127); }
#endif
        pg8::gemm_phase<ProbPlain, pg8::EpiSwiglu, true, true>(F.lds + RING_OFF, P, E);
#endif
        if (F.G == 256 && blockIdx.x >= 128) convert_range(in, ws, (LAS unsigned*)(F.lds + RING_OFF + F.wave * 16384), F.lane, T_ISMALL + CVT_S1, T_ISMALL + CVT_S2, ((int)blockIdx.x - 128) * NWAVES + F.wave, 128 * NWAVES);
    } SEAM(8);
    if (IN(9)) REP(9) { REPBAR();
#if FFN_FP8
        ProbPlain P{(const char*)(ws + WS_ACTF), (const char*)(ws + WS_BT_FD), DFF / 2, (unsigned)DFF, (unsigned)DFF, 0, BIG, {}}; P.S.init(64, 4, F.G, (int)blockIdx.x);
        pg8::EpiBf16 E{MIX, 1024, 1.f / 512.f};
        pg8::gemm_phase<ProbPlain, pg8::EpiBf16, true, true, true>(F.lds + RING_OFF, P, E);
#else
        ProbPlain P{(const char*)(ws + WS_ACTF), (const char*)(ws + WS_BT_FD), DFF, (unsigned)DFF * 2u, (unsigned)DFF * 2u, 0, BIG, {}}; P.S.init(64, 4, F.G, (int)blockIdx.x);
        pg8::EpiBf16 E{MIX, 1024, 1.f};
        pg8::gemm_phase<ProbPlain, pg8::EpiBf16, true, true>(F.lds + RING_OFF, P, E);
#endif
    } SEAM(9);
    if (IN(10)) REP(10) { REPBAR(); e_phase<false, true, true>(F, HB, MIX, gains + 3 * DM, gains + 4 * DM, HB, NORM_FACTOR ? (bf16*)nullptr : XN, NORM_FACTOR ? (float*)(ws + WS_RSTD) + 2 * NTOK : (float*)nullptr); } SEAM(10);
    if (IN(11)) REP(11) { REPBAR();
        ProbPlain P{NORM_FACTOR ? (const char*)HB : (const char*)XN, (const char*)(ws + WS_BT_QKV), 1024, 2048u, 2048u, 0, BIG, {}}; P.S.init(64, 6, F.G, (int)blockIdx.x);
        pg8::EpiQKV E{(pg8::bf16_t*)(ws + WS_Q), (unsigned)((WS_K - WS_Q) / 2), (unsigned)((WS_V - WS_Q) / 2), (const float*)(ws + WS_QKG), (const float4*)(ws + WS_ROPE_R), QSCALE, NORM_FACTOR ? (const float*)(ws + WS_RSTD) + 2 * NTOK : (const float*)nullptr};
        pg8::gemm_phase<ProbPlain, pg8::EpiQKV, true, true>(F.lds + RING_OFF, P, E);
        if (F.G == 256 && blockIdx.x >= 128) convert_range(in, ws, (LAS unsigned*)(F.lds + RING_OFF + F.wave * 16384), F.lane, T_ISMALL + CVT_S2, T_NITEMS, ((int)blockIdx.x - 128) * NWAVES + F.wave, 128 * NWAVES);
    } SEAM(11);
    if (IN(12)) REP(12) { REPBAR();
        static_assert(attn_body::ATTN_LDS_BYTES <= RING_BYTES, "attention body LDS");
        const attn_body::AttnTensors AT{(const attn_body::bf16*)(ws + WS_Q), (const attn_body::bf16*)(ws + WS_K), (const attn_body::bf16*)(ws + WS_V), (attn_body::bf16*)(ws + WS_O)};
        const attn_body::StaticOrder S((int)F.G, (int)blockIdx.x);
        float gq = fabsf(((const float*)(ws + WS_QKG))[F.lane]), gk = fabsf(((const float*)(ws + WS_QKG))[64 + F.lane]);
#pragma unroll
        for (int o = 1; o < 64; o <<= 1) { gq = fmaxf(gq, __shfl_xor(gq, o)); gk = fmaxf(gk, __shfl_xor(gk, o)); }
        const float refB = 11.55f * 1.02f * gq * gk;
        if (__builtin_amdgcn_readfirstlane(__float_as_uint(refB)) <= __float_as_uint(60.f)) attn_body::attn_phase<attn_body::StaticOrder, true>((char*)lds + RING_OFF, AT, S, refB);
        else attn_body::attn_phase<attn_body::StaticOrder, false>((char*)lds + RING_OFF, AT, S, 0.f);
    } SEAM(12);
    if (IN(13)) REP(13) { REPBAR();
        ProbPlain P{(const char*)(ws + WS_O), (const char*)(ws + WS_BT_AO), 1024, 2048u, 2048u, 0, BIG, {}}; P.S.init(64, 4, F.G, (int)blockIdx.x);
        pg8::EpiBf16 E{MIX, 1024, 1.f};
        pg8::gemm_phase<ProbPlain, pg8::EpiBf16, true, true>(F.lds + RING_OFF, P, E);
    } SEAM(13);
    if (IN(14)) REP(14) { REPBAR(); e3_phase(F, HB, MIX, gains + 5 * DM, gains + 6 * DM, HB, XN, in[20], ws); } SEAM(14);
    if (IN(15)) REP(15) { REPBAR();
        moe_table(F);
        volatile LAS int* misc = (volatile LAS int*)(F.lds + MOE_OFF);
#if MOE_FP8
        ProbMoE P{(const char*)XN, (const char*)(ws + WS_BT_MGU), 512, 1024u, 1024u, (size_t)7168 * 1024, {}, (const int*)(ws + WS_LIST), misc, true}; P.S.init(misc[8], 28, F.G, (int)blockIdx.x, MOE_WGM);
        pg8::EpiSwigluF8 E{(unsigned char*)(ws + WS_ACTM), DFE, 1.f / 256.f, 8.f};
#if defined(DEPHASE15) && DEPHASE15
        if (((int)blockIdx.x >> 3) & 1) { _Pragma("unroll") for (int d_ = 0; d_ < DEPHASE15; ++d_) __builtin_amdgcn_s_sleep(127); }
#endif
        pg8::gemm_phase<ProbMoE, pg8::EpiSwigluF8, P15_ALIGN, P15_SP2, true>(F.lds + RING_OFF, P, E);
#else
        ProbMoE P{(const char*)XN, (const char*)(ws + WS_BT_MGU), 1024, 2048u, 2048u, (size_t)7168 * 1024 * 2, {}, (const int*)(ws + WS_LIST), misc, true}; P.S.init(misc[8], 28, F.G, (int)blockIdx.x);
        pg8::EpiSwiglu E{(pg8::bf16_t*)(ws + WS_ACTM), DFE, nullptr};
        pg8::gemm_phase<ProbMoE, pg8::EpiSwiglu, true, true>(F.lds + RING_OFF, P, E);
#endif
    } SEAM(15);
    if (IN(16)) REP(16) { REPBAR();
        moe_table(F);
        volatile LAS int* misc = (volatile LAS int*)(F.lds + MOE_OFF);
#if MOE_FP8
        ProbMoE P{(const char*)(ws + WS_ACTM), (const char*)(ws + WS_BT_MD), DFE / 2, (unsigned)DFE, (unsigned)DFE, (size_t)1024 * 3584, {}, (const int*)(ws + WS_LIST), misc, false}; P.S.init(misc[8], 4, F.G, (int)blockIdx.x);
        pg8::EpiMoeDown E{(pg8::bf16_t*)(ws + WS_SLOT), (pg8::bf16_t*)(ws + WS_PART), 1.f / 512.f};
        pg8::gemm_phase<ProbMoE, pg8::EpiMoeDown, true, true, true>(F.lds + RING_OFF, P, E);
#else
        ProbMoE P{(const char*)(ws + WS_ACTM), (const char*)(ws + WS_BT_MD), DFE, (unsigned)DFE * 2u, (unsigned)DFE * 2u, (size_t)1024 * 3584 * 2, {}, (const int*)(ws + WS_LIST), misc, false}; P.S.init(misc[8], 4, F.G, (int)blockIdx.x);
        pg8::EpiMoeDown E{(pg8::bf16_t*)(ws + WS_SLOT), (pg8::bf16_t*)(ws + WS_PART), 1.f};
        pg8::gemm_phase<ProbMoE, pg8::EpiMoeDown, true, true>(F.lds + RING_OFF, P, E);
#endif
    } SEAM(16);
    if (IN(17)) REP(17) { REPBAR(); moe_table(F); e4_phase(F, HB, gains + 7 * DM, hbuf, ws); }
#undef IN
#undef SEAM
#if FLAT_BAR || XB2
#undef xcd_barrier
#endif
}


#ifndef CUT
#define CUT 0
#endif
#if CUT
namespace nv {
__device__ __forceinline__ float sigmoidf_(float x) { return 1.f / (1.f + __expf(-x)); }
__device__ __forceinline__ float gelu_tanh(float x) { return x * sigmoidf_(1.5957691216057308f * (x + 0.044715f * x * x * x)); }

__global__ void rms_k(const float* __restrict__ x, const float* __restrict__ gain, float* __restrict__ out) {
    const int row = blockIdx.x * 4 + (threadIdx.x >> 6), lane = threadIdx.x & 63;
    const float4* xr = (const float4*)(x + (size_t)row * DM);
    float4 v[4]; float s = 0.f;
#pragma unroll
    for (int j = 0; j < 4; ++j) { v[j] = xr[lane + 64 * j]; s += v[j].x * v[j].x + v[j].y * v[j].y + v[j].z * v[j].z + v[j].w * v[j].w; }
    const float r = rsqrtf(wave_sum(s) * (1.f / DM) + EPS);
    float4* o = (float4*)(out + (size_t)row * DM);
#pragma unroll
    for (int j = 0; j < 4; ++j) { const float4 g = ((const float4*)gain)[lane + 64 * j]; o[lane + 64 * j] = make_float4(v[j].x * r * g.x, v[j].y * r * g.y, v[j].z * r * g.z, v[j].w * r * g.w); }
}
__global__ void resnorm_k(const float* h, const float* __restrict__ mix, const float* __restrict__ gpost, const float* __restrict__ gpre, float* hout, float* __restrict__ xn) {
    const int row = blockIdx.x * 4 + (threadIdx.x >> 6), lane = threadIdx.x & 63;
    const float4* mr = (const float4*)(mix + (size_t)row * DM); const float4* hr = (const float4*)(h + (size_t)row * DM);
    float4 v[4], hv[4]; float s = 0.f;
#pragma unroll
    for (int j = 0; j < 4; ++j) { v[j] = mr[lane + 64 * j]; hv[j] = hr[lane + 64 * j]; s += v[j].x * v[j].x + v[j].y * v[j].y + v[j].z * v[j].z + v[j].w * v[j].w; }
    const float r = rsqrtf(wave_sum(s) * (1.f / DM) + EPS);
    float s2 = 0.f;
#pragma unroll
    for (int j = 0; j < 4; ++j) { const float4 g = ((const float4*)gpost)[lane + 64 * j];
        hv[j].x += v[j].x * r * g.x; hv[j].y += v[j].y * r * g.y; hv[j].z += v[j].z * r * g.z; hv[j].w += v[j].w * r * g.w;
        s2 += hv[j].x * hv[j].x + hv[j].y * hv[j].y + hv[j].z * hv[j].z + hv[j].w * hv[j].w; }
    float4* ho = (float4*)(hout + (size_t)row * DM);
#pragma unroll
    for (int j = 0; j < 4; ++j) ho[lane + 64 * j] = hv[j];
    if (xn) {
        const float r2 = rsqrtf(wave_sum(s2) * (1.f / DM) + EPS);
        float4* o = (float4*)(xn + (size_t)row * DM);
#pragma unroll
        for (int j = 0; j < 4; ++j) { const float4 g = ((const float4*)gpre)[lane + 64 * j]; o[lane + 64 * j] = make_float4(hv[j].x * r2 * g.x, hv[j].y * r2 * g.y, hv[j].z * r2 * g.z, hv[j].w * r2 * g.w); }
    }
}

struct EpiArgs { float* C; int ldc; int pad0; const float* aux; int ldaux; int pad1; const int* list; const float* wl; const int* cnt;
  EpiArgs(float* C_, int ldc_, const float* aux_, int ldaux_, const int* l, const float* w, const int* c) : C(C_), ldc(ldc_), pad0(0), aux(aux_), ldaux(ldaux_), pad1(0), list(l), wl(w), cnt(c) {} };
template <int EPI, bool GATHER>
__global__ __launch_bounds__(256) void gemm_k(const float* __restrict__ A, int lda, const float* __restrict__ W, int ldw, int M, int N, int K, EpiArgs ea) {
    __shared__ float As[8][132]; __shared__ float Bs[8][132];
    const int m_lim = ea.cnt ? *ea.cnt : M;
    const int bm = blockIdx.y * 128, bn = blockIdx.x * 128;
    if (bm >= m_lim) return;
    const int tid = threadIdx.x, tx = tid & 15, ty = tid >> 4;
    const int arow = bm + (tid >> 1);
    const int srow = (arow < m_lim) ? (GATHER ? ea.list[arow] : arow) : (GATHER ? ea.list[0] : 0);
    const float* ap = A + (size_t)srow * lda + (tid & 1) * 4;
    const float* bp = W + (size_t)(tid >> 5) * ldw + bn + (tid & 31) * 4;
    float acc[8][8];
#pragma unroll
    for (int i = 0; i < 8; ++i)
#pragma unroll
        for (int j = 0; j < 8; ++j) acc[i][j] = 0.f;
    for (int k0 = 0; k0 < K; k0 += 8) {
        const float4 av = *(const float4*)(ap + k0);
        const float4 bv = *(const float4*)(bp + (size_t)k0 * ldw);
        __syncthreads();
        As[(tid & 1) * 4 + 0][tid >> 1] = av.x; As[(tid & 1) * 4 + 1][tid >> 1] = av.y; As[(tid & 1) * 4 + 2][tid >> 1] = av.z; As[(tid & 1) * 4 + 3][tid >> 1] = av.w;
        *(float4*)&Bs[tid >> 5][(tid & 31) * 4] = bv;
        __syncthreads();
#pragma unroll
        for (int k = 0; k < 8; ++k) {
            float a[8], b[8];
            *(float4*)&a[0] = *(const float4*)&As[k][ty * 8]; *(float4*)&a[4] = *(const float4*)&As[k][ty * 8 + 4];
            *(float4*)&b[0] = *(const float4*)&Bs[k][tx * 8]; *(float4*)&b[4] = *(const float4*)&Bs[k][tx * 8 + 4];
#pragma unroll
            for (int i = 0; i < 8; ++i)
#pragma unroll
                for (int j = 0; j < 8; ++j) acc[i][j] = fmaf(a[i], b[j], acc[i][j]);
        }
    }
#pragma unroll
    for (int i = 0; i < 8; ++i) {
        const int row = bm + ty * 8 + i;
        if (row >= m_lim) continue;
        int tok = 0; float wgt = 0.f;
        if (EPI == 3) { tok = ea.list[row]; wgt = ea.wl[row]; }
#pragma unroll
        for (int j = 0; j < 8; ++j) {
            const int col = bn + tx * 8 + j; const float v = acc[i][j];
            if (EPI == 0) ea.C[(size_t)row * ea.ldc + col] = v;
            else if (EPI == 1) ea.C[(size_t)row * ea.ldc + col] = ea.aux[(size_t)row * ea.ldaux + col] * sigmoidf_(v);
            else if (EPI == 2) { const float g = ea.aux[(size_t)row * ea.ldaux + col]; ea.C[(size_t)row * ea.ldc + col] = g * sigmoidf_(g) * v; }
            else if (EPI == 3) ea.C[(size_t)tok * ea.ldc + col] += wgt * v;
        }
    }
}

__global__ __launch_bounds__(64) void s5_scan_k(const float* __restrict__ u, const float* __restrict__ lam_re, const float* __restrict__ lam_im, const float* __restrict__ log_step,
                                                const float* __restrict__ b_re, const float* __restrict__ b_im, const float* __restrict__ c_re, const float* __restrict__ c_im, float* __restrict__ yout) {
    __shared__ float us[64][16];
    const int dir = blockIdx.x & 1, g = (blockIdx.x >> 1) & 63, b = blockIdx.x >> 7, p = threadIdx.x;
    const double step = exp((double)log_step[dir * 64 + g]);
    const double lr = lam_re[(dir * 64 + g) * 64 + p], li = lam_im[(dir * 64 + g) * 64 + p];
    const double mag = exp(lr * step), ang = li * step;
    const double ard = mag * cos(ang), aid = mag * sin(ang);
    const double nr = ard - 1.0, ni = aid, den = lr * lr + li * li;
    const double qr = (nr * lr + ni * li) / den, qi = (ni * lr - nr * li) / den;
    const float ar = (float)ard, ai = (float)aid;
    float bbr[16], bbi[16], cr[16], ci[16];
#pragma unroll
    for (int i = 0; i < 16; ++i) {
        const double br = b_re[((dir * 64 + g) * 64 + p) * 16 + i], bi = b_im[((dir * 64 + g) * 64 + p) * 16 + i];
        bbr[i] = (float)(qr * br - qi * bi); bbi[i] = (float)(qr * bi + qi * br);
        cr[i] = c_re[((dir * 64 + g) * 16 + i) * 64 + p]; ci[i] = c_im[((dir * 64 + g) * 16 + i) * 64 + p];
    }
    float xr = 0.f, xi = 0.f;
    float* yo = yout + (size_t)dir * NTOK * DM;
    for (int c = 0; c < SEQ / 64; ++c) {
        { const int s = p; const int st = c * 64 + s; const int t = dir == 0 ? st : SEQ - 1 - st;
          const float4* src = (const float4*)(u + (size_t)(b * SEQ + t) * DM + g * 16);
          __syncthreads();
#pragma unroll
          for (int q = 0; q < 4; ++q) *(float4*)&us[s][q * 4] = src[q];
          __syncthreads(); }
        for (int s = 0; s < 64; ++s) {
            const int st = c * 64 + s; const int t = dir == 0 ? st : SEQ - 1 - st;
            float bur = 0.f, bui = 0.f;
#pragma unroll
            for (int i = 0; i < 16; ++i) { const float uu = us[s][i]; bur = fmaf(bbr[i], uu, bur); bui = fmaf(bbi[i], uu, bui); }
            const float nxr = ar * xr - ai * xi + bur, nxi = ar * xi + ai * xr + bui;
            xr = nxr; xi = nxi;
            float mine = 0.f;
#pragma unroll
            for (int j = 0; j < 16; ++j) { const float v = wave_sum(cr[j] * xr - ci[j] * xi); if (p == j) mine = v; }
            if (p < 16) yo[(size_t)(b * SEQ + t) * DM + g * 16 + p] = mine;
        }
    }
}
__global__ void gelu_comb_k(const float* __restrict__ u, const float* __restrict__ dskip, const float* __restrict__ y2, float* __restrict__ g1) {
    const size_t i = (size_t)blockIdx.x * 256 + threadIdx.x;
    const int c = (int)(i & (DM - 1));
    const float y = dskip[c] * u[i] + y2[i] + y2[i + (size_t)NTOK * DM];
    g1[i] = gelu_tanh(y);
}

__global__ void qknorm_rope_k(float* __restrict__ qkv, const float* __restrict__ qg, const float* __restrict__ kg) {
    const int w = blockIdx.x * 4 + (threadIdx.x >> 6), d = threadIdx.x & 63;
    const int tok = w / 20, hs = w % 20;
    float* p = qkv + (size_t)tok * QKVW + hs * 64;
    const float v = p[d];
    const float r = rsqrtf(wave_sum(v * v) * (1.f / 64.f) + EPS);
    const float y = v * r * (hs < 16 ? qg[d] : kg[d]);
    const float partner = __shfl_xor(y, 1);
    const int pos = tok % SEQ, i = d >> 1;
    const int f = i & 15;
    const float freq = powf(10000.f, -(float)(2 * f) / 32.f);
    const float ang = (float)(i < 16 ? pos / 64 : pos % 64) * freq;
    const float c = cosf(ang), s = sinf(ang);
    const float o = (d & 1) ? (partner * s + y * c) : (y * c - partner * s);
    p[d] = o;
}

__global__ __launch_bounds__(256) void attn_k(const float* __restrict__ qkv, float* __restrict__ o) {
    __shared__ float Qs[64][65], Ks[64][65], Vs[64][65];
    float (*Ps)[65] = Ks;
    const int qb = blockIdx.x, h = blockIdx.y, b = blockIdx.z, kvh = h >> 2;
    const int tid = threadIdx.x, tx = tid & 15, ty = tid >> 4;
    const size_t rowbase = (size_t)b * SEQ;
    for (int e = tid; e < 64 * 64; e += 256) { const int r = e >> 6, d = e & 63; Qs[r][d] = qkv[(rowbase + qb * 64 + r) * QKVW + h * 64 + d] * 0.125f; }
    float m[4], l[4], oacc[4][4];
#pragma unroll
    for (int i = 0; i < 4; ++i) { m[i] = -INFINITY; l[i] = 0.f;
#pragma unroll
        for (int j = 0; j < 4; ++j) oacc[i][j] = 0.f; }
    for (int kt = 0; kt < SEQ / 64; ++kt) {
        __syncthreads();
        for (int e = tid; e < 64 * 64; e += 256) { const int r = e >> 6, d = e & 63; const size_t rr = (rowbase + kt * 64 + r) * QKVW;
            Ks[r][d] = qkv[rr + 1024 + kvh * 64 + d]; Vs[r][d] = qkv[rr + 1280 + kvh * 64 + d]; }
        __syncthreads();
        float s[4][4];
#pragma unroll
        for (int i = 0; i < 4; ++i)
#pragma unroll
            for (int j = 0; j < 4; ++j) s[i][j] = 0.f;
        for (int d = 0; d < 64; ++d) {
            float a[4], k[4];
#pragma unroll
            for (int i = 0; i < 4; ++i) { a[i] = Qs[ty * 4 + i][d]; k[i] = Ks[tx * 4 + i][d]; }
#pragma unroll
            for (int i = 0; i < 4; ++i)
#pragma unroll
                for (int j = 0; j < 4; ++j) s[i][j] = fmaf(a[i], k[j], s[i][j]);
        }
        __syncthreads();
#pragma unroll
        for (int i = 0; i < 4; ++i) {
            float mx = fmaxf(fmaxf(s[i][0], s[i][1]), fmaxf(s[i][2], s[i][3]));
#pragma unroll
            for (int of = 1; of < 16; of <<= 1) mx = fmaxf(mx, __shfl_xor(mx, of));
            const float mn = fmaxf(m[i], mx);
            const float sc = __expf(m[i] - mn);
            float ps = 0.f;
#pragma unroll
            for (int j = 0; j < 4; ++j) { const float pp = __expf(s[i][j] - mn); Ps[ty * 4 + i][tx * 4 + j] = pp; ps += pp; }
#pragma unroll
            for (int of = 1; of < 16; of <<= 1) ps += __shfl_xor(ps, of);
            l[i] = l[i] * sc + ps; m[i] = mn;
#pragma unroll
            for (int j = 0; j < 4; ++j) oacc[i][j] *= sc;
        }
        __syncthreads();
        for (int k = 0; k < 64; ++k) {
            float pp[4], vv[4];
#pragma unroll
            for (int i = 0; i < 4; ++i) { pp[i] = Ps[ty * 4 + i][k]; vv[i] = Vs[k][tx * 4 + i]; }
#pragma unroll
            for (int i = 0; i < 4; ++i)
#pragma unroll
                for (int j = 0; j < 4; ++j) oacc[i][j] = fmaf(pp[i], vv[j], oacc[i][j]);
        }
    }
#pragma unroll
    for (int i = 0; i < 4; ++i) { const float inv = 1.f / l[i];
#pragma unroll
        for (int j = 0; j < 4; ++j) o[(rowbase + qb * 64 + ty * 4 + i) * DM + h * 64 + tx * 4 + j] = oacc[i][j] * inv; }
}

__global__ void router_k(const float* __restrict__ xn, const float* __restrict__ wr, int* __restrict__ cnt, int* __restrict__ lists, float* __restrict__ wlists) {
    const int tok = blockIdx.x * 4 + (threadIdx.x >> 6), lane = threadIdx.x & 63;
    float lg[8];
#pragma unroll
    for (int e = 0; e < 8; ++e) lg[e] = 0.f;
    for (int j = 0; j < 16; ++j) { const int d = lane + 64 * j; const float x = xn[(size_t)tok * DM + d];
        const float4 w0 = *(const float4*)(wr + d * 8), w1 = *(const float4*)(wr + d * 8 + 4);
        lg[0] = fmaf(x, w0.x, lg[0]); lg[1] = fmaf(x, w0.y, lg[1]); lg[2] = fmaf(x, w0.z, lg[2]); lg[3] = fmaf(x, w0.w, lg[3]);
        lg[4] = fmaf(x, w1.x, lg[4]); lg[5] = fmaf(x, w1.y, lg[5]); lg[6] = fmaf(x, w1.z, lg[6]); lg[7] = fmaf(x, w1.w, lg[7]); }
#pragma unroll
    for (int e = 0; e < 8; ++e) lg[e] = wave_sum(lg[e]);
    int e0 = 0; float l0 = lg[0];
#pragma unroll
    for (int e = 1; e < 8; ++e) if (lg[e] > l0) { l0 = lg[e]; e0 = e; }
    int e1 = -1; float l1 = -INFINITY;
#pragma unroll
    for (int e = 0; e < 8; ++e) if (e != e0 && lg[e] > l1) { l1 = lg[e]; e1 = e; }
    const float w0 = 1.f / (1.f + expf(l1 - l0)), w1 = 1.f - w0;
    if (lane == 0) {
        const int p0 = atomicAdd(&cnt[e0], 1); lists[e0 * NTOK + p0] = tok; wlists[e0 * NTOK + p0] = w0;
        const int p1 = atomicAdd(&cnt[e1], 1); lists[e1 * NTOK + p1] = tok; wlists[e1 * NTOK + p1] = w1;
    }
}


__global__ void cvt_k(const unsigned short* __restrict__ s, float* __restrict__ d) { const size_t i = (size_t)blockIdx.x * 256 + threadIdx.x; d[i] = __uint_as_float((unsigned)s[i] << 16); }
template <int EPI, bool GATHER>
static void gemm(hipStream_t st, const float* A, int lda, const float* W, int ldw, int M, int N, int K, EpiArgs ea) {
    hipLaunchKernelGGL((gemm_k<EPI, GATHER>), dim3(N / 128, M / 128), dim3(256), 0, st, A, lda, W, ldw, M, N, K, ea);
}
}
#endif
extern "C" void kernel_launch(void* const* d_in, const int* in_sizes, int n_in, void* d_out, int out_size, void* d_ws, size_t ws_size, hipStream_t stream) {
    static int grid = 0;
    if (grid == 0) {
        grid = -1;
        if (n_in != 24 || in_sizes[0] != NTOK * DM || out_size != NTOK * DM || ws_size < WS_END) { fprintf(stderr, "kernel_launch: unexpected problem (n_in %d, ws %zu)\n", n_in, ws_size); return; }
        int dev = 0, cus = 0;
        if (hipGetDevice(&dev) != hipSuccess || hipDeviceGetAttribute(&cus, hipDeviceAttributeMultiprocessorCount, dev) != hipSuccess) return;
        if (hipFuncSetAttribute((const void*)mega_fwd, hipFuncAttributeMaxDynamicSharedMemorySize, LDS_BYTES) != hipSuccess) return;
        int per_cu = 0;
        if (hipOccupancyMaxActiveBlocksPerMultiprocessor(&per_cu, (const void*)mega_fwd, NWAVES * 64, LDS_BYTES) != hipSuccess || per_cu < 1) { fprintf(stderr, "kernel_launch: occupancy query says %d\n", per_cu); (void)hipGetLastError(); return; }
        if (cus != 256) { fprintf(stderr, "kernel_launch: built for 256 CUs, found %d\n", cus); return; }
        grid = cus;
    }
    if (grid < 0) return;
    if (hipMemsetAsync((char*)d_ws + WS_CTL, 0, CTL_ZERO_BYTES, stream) != hipSuccess) return;
    Args a{};
    for (int i = 0; i < 24; ++i) a.in[i] = (const float*)d_in[i];
    a.out = (float*)d_out; a.ws = (unsigned char*)d_ws; a.ph_lo = 0; a.ph_hi = CUT ? CUT : 18;
    hipLaunchKernelGGL(mega_fwd, dim3(grid), dim3(NWAVES * 64), LDS_BYTES, stream, a);
#if CUT
    {
        using namespace nv;
        const float* gains = (const float*)d_in[1];
        const float* ffn_g = (const float*)d_in[13]; const float* ffn_u = (const float*)d_in[14]; const float* ffn_d = (const float*)d_in[15];
        const float* w_qkv = (const float*)d_in[16]; const float* q_gain = (const float*)d_in[17]; const float* k_gain = (const float*)d_in[18]; const float* attn_wo = (const float*)d_in[19];
        const float* w_router = (const float*)d_in[20]; const float* moe_g = (const float*)d_in[21]; const float* moe_u = (const float*)d_in[22]; const float* moe_d = (const float*)d_in[23];
        float* h = (float*)d_out; char* ws = (char*)d_ws;
        float* xn = (float*)(ws + 4 * MiB); float* mix = (float*)(ws + 68 * MiB);
        hipLaunchKernelGGL(cvt_k, dim3(NTOK * DM / 256), dim3(256), 0, stream, (const unsigned short*)(ws + WS_XN), xn);
        if (CUT <= 8) {
            float* G = (float*)(ws + 132 * MiB);
            gemm<0, false>(stream, xn, DM, ffn_g, DFF, NTOK, DFF, DM, EpiArgs{G, DFF, nullptr, 0, nullptr, nullptr, nullptr});
            gemm<2, false>(stream, xn, DM, ffn_u, DFF, NTOK, DFF, DM, EpiArgs{G, DFF, G, DFF, nullptr, nullptr, nullptr});
            gemm<0, false>(stream, G, DFF, ffn_d, DM, NTOK, DM, DFF, EpiArgs{mix, DM, nullptr, 0, nullptr, nullptr, nullptr});
            hipLaunchKernelGGL(resnorm_k, dim3(NTOK / 4), dim3(256), 0, stream, h, mix, gains + 3 * DM, gains + 4 * DM, h, xn);
        }
        if (CUT <= 11) {
            float* qkv = (float*)(ws + 132 * MiB); float* ob = (float*)(ws + 228 * MiB);
            gemm<0, false>(stream, xn, DM, w_qkv, QKVW, NTOK, QKVW, DM, EpiArgs{qkv, QKVW, nullptr, 0, nullptr, nullptr, nullptr});
            hipLaunchKernelGGL(qknorm_rope_k, dim3(NTOK * 20 / 4), dim3(256), 0, stream, qkv, q_gain, k_gain);
            hipLaunchKernelGGL(attn_k, dim3(SEQ / 64, 16, NB), dim3(256), 0, stream, qkv, ob);
            gemm<0, false>(stream, ob, DM, attn_wo, DM, NTOK, DM, DM, EpiArgs{mix, DM, nullptr, 0, nullptr, nullptr, nullptr});
            hipLaunchKernelGGL(resnorm_k, dim3(NTOK / 4), dim3(256), 0, stream, h, mix, gains + 5 * DM, gains + 6 * DM, h, xn);
        }
        {
            float* Ge = (float*)(ws + 132 * MiB); float* ff = (float*)(ws + 356 * MiB);
            int* cnt = (int*)(ws + 420 * MiB); int* lists = (int*)(ws + 421 * MiB); float* wlists = (float*)(ws + 422 * MiB);
            (void)hipMemsetAsync(cnt, 0, 64, stream);
            (void)hipMemsetAsync(ff, 0, (size_t)NTOK * DM * 4, stream);
            hipLaunchKernelGGL(router_k, dim3(NTOK / 4), dim3(256), 0, stream, xn, w_router, cnt, lists, wlists);
            for (int e = 0; e < NEXP; ++e) {
                const int* le = lists + e * NTOK; const float* we = wlists + e * NTOK;
                gemm<0, true>(stream, xn, DM, moe_g + (size_t)e * DM * DFE, DFE, NTOK, DFE, DM, EpiArgs{Ge, DFE, nullptr, 0, le, we, cnt + e});
                gemm<2, true>(stream, xn, DM, moe_u + (size_t)e * DM * DFE, DFE, NTOK, DFE, DM, EpiArgs{Ge, DFE, Ge, DFE, le, we, cnt + e});
                gemm<3, false>(stream, Ge, DFE, moe_d + (size_t)e * DFE * DM, DM, NTOK, DM, DFE, EpiArgs{ff, DM, nullptr, 0, le, we, cnt + e});
            }
            hipLaunchKernelGGL(resnorm_k, dim3(NTOK / 4), dim3(256), 0, stream, h, ff, gains + 7 * DM, gains + 7 * DM, h, (float*)nullptr);
        }
    }
#endif
}
```

```cpp
#include <hip/hip_runtime.h>
#include <hip/hip_bf16.h>
#include <cstdio>
#include <cstdint>
#include <cmath>
#define CUT 0
#define DUPMASK 0
#define P0DUP 0
#define EXP_GATHER 0
#define MOE_WGM 4
#define NORM_FACTOR 1
#define S_BF16 1
#define P0_SWAP 1
#define CVT_S1 9216
#define CVT_S2 15360
namespace pg8 {
#define PG8_LAS __attribute__((address_space(3)))
typedef unsigned short bf16_t;
typedef short bf16x8 __attribute__((ext_vector_type(8)));
typedef float f32x4 __attribute__((ext_vector_type(4)));
typedef unsigned u32x4 __attribute__((ext_vector_type(4)));
typedef unsigned u32x2 __attribute__((ext_vector_type(2)));
typedef int v8i32 __attribute__((ext_vector_type(8)));
constexpr int BM = 256, BK = 64, HALF = 128, HTB = HALF * BK * 2  , STAGE_BYTES = 8 * HTB, NXCD = 8, WGM = 8;

__host__ __device__ __forceinline__ int lds_byte(int r, int c) { const int st = (r >> 4) * 2 + (c >> 5), rr = r & 15, cc = c & 31, ob = rr * 64 + cc * 2; return st * 1024 + (ob ^ (((ob >> 9) & 1) << 5)); }
__host__ __device__ __forceinline__ void stage_rc(int b, int& R, int& C) { const int st = b / 1024, sb = b % 1024, swz = sb ^ (((sb >> 9) & 1) << 5); R = (st >> 1) * 16 + swz / 64; C = (st & 1) * 32 + (swz % 64) / 2; }
__host__ __device__ __forceinline__ int perm32(int rho) { const int n = rho >> 4, i = rho & 15; return 8 * (i >> 2) + 4 * n + (i & 3); }

struct Unit { int pm, pn, kofs, nt, aux; };

struct StaticOrder {
    int nM, nN, nwg, G, c, wgm;
    __host__ __device__ void init(int nM_, int nN_, int G_, int c_, int wgm_ = WGM) { nM = nM_; nN = nN_; nwg = nM * nN; G = G_; c = c_; wgm = wgm_; }
    __host__ __device__ bool next(int i, Unit& u) const {
        const long L = (long)i * G + c; if (L >= nwg) return false;
        int wgid = (int)L; { const int q = nwg / NXCD, r = nwg % NXCD, xcd = wgid % NXCD, off = wgid / NXCD; wgid = (xcd < r ? xcd * (q + 1) : r * (q + 1) + (xcd - r) * q) + off; }
        const int nig = wgm * nN, gid = wgid / nig, fm = gid * wgm, gsz = (nM - fm) < wgm ? (nM - fm) : wgm;
        u.pm = fm + ((wgid % nig) % gsz); u.pn = (wgid % nig) / gsz; return true;
    }
};

__device__ __forceinline__ unsigned cvt_pk_bf16(float lo, float hi) { unsigned r; asm volatile("v_cvt_pk_bf16_f32 %0, %1, %2" : "=v"(r) : "v"(lo), "v"(hi)); return r; }
__device__ __forceinline__ float bf_lo(unsigned w) { return __uint_as_float(w << 16); }
__device__ __forceinline__ float bf_hi(unsigned w) { return __uint_as_float(w & 0xffff0000u); }
__device__ __forceinline__ float sigm(float x) { return __builtin_amdgcn_rcpf(1.f + __builtin_amdgcn_exp2f(-1.4426950408889634f * x)); }
__device__ __forceinline__ float gelu_t(float x) { return x * sigm(1.5957691216057308f * (x + 0.044715f * x * x * x)); }
#ifndef WT_STORES
#define WT_STORES 0
#endif
__device__ __forceinline__ void st16(void* p, const u32x4& v) {
#if WT_STORES
    asm volatile("global_store_dwordx4 %0, %1, off sc1\n\ts_nop 1" :: "v"(p), "v"(v) : "memory");
#else
    *(u32x4*)p = v;
#endif
}
__device__ __forceinline__ u32x4 pack8(const f32x4& a, const f32x4& b) { u32x4 w; w.x = cvt_pk_bf16(a[0], a[1]); w.y = cvt_pk_bf16(a[2], a[3]); w.z = cvt_pk_bf16(b[0], b[1]); w.w = cvt_pk_bf16(b[2], b[3]); return w; }

struct ProbPlain {
    const char* abase; const char* Bt; int K; unsigned ldaB, ldbB; size_t bstride; int pm_per_b; StaticOrder S;
    __device__ __forceinline__ bool next(int i, Unit& u) const { u.kofs = 0; u.nt = K / BK; u.aux = 0; return S.next(i, u); }
    __device__ __forceinline__ const char* bbase(const Unit& u) const { return Bt + (size_t)(u.pm / pm_per_b) * bstride + (size_t)u.pn * 256 * ldbB; }
    __device__ __forceinline__ void aoffs(const Unit& u, const int (&R)[2], unsigned (&off)[2][2]) const {
#pragma unroll
        for (int h = 0; h < 2; ++h)
#pragma unroll
            for (int i = 0; i < 2; ++i) off[h][i] = (unsigned)(u.pm * 256 + h * 128 + R[i]) * ldaB;
    }
};
struct ProbMoE {
    const char* abase; const char* Bt; int K; unsigned ldaB, ldbB; size_t bstride; StaticOrder S;
    const int* lists; volatile PG8_LAS int* misc; bool gather;
    __device__ __forceinline__ bool next(int i, Unit& u) const {
        if (gather) { u.kofs = 0; u.nt = K / BK; u.aux = 0; return S.next(i, u); }
        const int c = S.c, x = c & 7, y = c >> 3, first_rem = misc[10];
        const int pm = 64 * i + 8 * x + (y & 7);
        if (pm < first_rem) { u.pm = pm; u.pn = y >> 3; u.kofs = 0; u.nt = K / BK; u.aux = 0; return true; }
        if (64 * i != first_rem || c >= misc[11]) return false;
        const int parts = misc[9], j = c / parts, part = c - j * parts, ntp = (K / BK) / parts;
        u.pm = first_rem + (j >> 2); u.pn = j & 3; u.nt = ntp; u.kofs = part * ntp * BK * 2; u.aux = c + 1; return true;
    }
    __device__ __forceinline__ int expert(int pm) const { int e = 0;
#pragma unroll
        for (int j = 1; j < 8; ++j) e += (pm >= misc[j]) ? 1 : 0;
        return e; }
    __device__ __forceinline__ const char* bbase(const Unit& u) const { return Bt + (size_t)__builtin_amdgcn_readfirstlane(expert(u.pm)) * bstride + (size_t)u.pn * 256 * ldbB; }
    __device__ __forceinline__ void aoffs(const Unit& u, const int (&R)[2], unsigned (&off)[2][2]) const {
        if (gather) {
            const int e = expert(u.pm), t0 = misc[e], cnt = misc[16 + e];
#pragma unroll
            for (int h = 0; h < 2; ++h)
#pragma unroll
                for (int i = 0; i < 2; ++i) { const int pos = (u.pm - t0) * 256 + h * 128 + R[i]; const int tok = pos < cnt ? lists[e * 16384 + pos] : 0; off[h][i] = (unsigned)tok * ldaB; }
        } else {
#pragma unroll
            for (int h = 0; h < 2; ++h)
#pragma unroll
                for (int i = 0; i < 2; ++i) off[h][i] = (unsigned)(u.pm * 256 + h * 128 + R[i]) * ldaB;
        }
    }
};

struct EpiF32 {
    static constexpr bool PERM = false;
    float* C; int ldc;
    __device__ __forceinline__ void operator()(const f32x4 (&acc)[2][2][4][2], const Unit& u, int wr, int wc, int fr, int fq) const {
        const int row0 = u.pm * BM + wr * 64 + fr, col0 = u.pn * BM + wc * 32 + 4 * fq;
#pragma unroll
        for (int ai = 0; ai < 2; ++ai)
#pragma unroll
            for (int m = 0; m < 4; ++m) { float* rowp = C + (size_t)(row0 + ai * HALF + m * 16) * ldc + col0;
#pragma unroll
                for (int bj = 0; bj < 2; ++bj)
#pragma unroll
                    for (int n = 0; n < 2; ++n) { const f32x4 t_ = acc[ai][bj][m][n]; st16(rowp + bj * HALF + n * 16, __builtin_bit_cast(u32x4, t_)); } }
    }
};
struct EpiBf16 {
    static constexpr bool PERM = true;
    bf16_t* O; int ldc; float scale;
    __device__ __forceinline__ void operator()(const f32x4 (&acc)[2][2][4][2], const Unit& u, int wr, int wc, int fr, int fq) const {
        const int row0 = u.pm * BM + wr * 64 + fr, col0 = u.pn * BM + wc * 32 + 8 * fq;
#pragma unroll
        for (int ai = 0; ai < 2; ++ai)
#pragma unroll
            for (int m = 0; m < 4; ++m) { bf16_t* rowp = O + (size_t)(row0 + ai * HALF + m * 16) * ldc + col0;
#pragma unroll
                for (int bj = 0; bj < 2; ++bj) st16(rowp + bj * HALF, pack8(acc[ai][bj][m][0] * scale, acc[ai][bj][m][1] * scale)); }
    }
};
struct EpiMoeDown {
    static constexpr bool PERM = true;
    bf16_t* O; bf16_t* PART; float scale;
    __device__ __forceinline__ void operator()(const f32x4 (&acc)[2][2][4][2], const Unit& u, int wr, int wc, int fr, int fq) const {
        const int r0 = wr * 64 + fr, c0 = wc * 32 + 8 * fq;
        bf16_t* base = u.aux == 0 ? O + ((size_t)u.pm * BM * 1024 + (size_t)u.pn * BM) : PART + (size_t)(u.aux - 1) * 65536;
        const int ldo = u.aux == 0 ? 1024 : 256;
#pragma unroll
        for (int ai = 0; ai < 2; ++ai)
#pragma unroll
            for (int m = 0; m < 4; ++m) { bf16_t* rowp = base + (size_t)(r0 + ai * HALF + m * 16) * ldo + c0;
#pragma unroll
                for (int bj = 0; bj < 2; ++bj) st16(rowp + bj * HALF, pack8(acc[ai][bj][m][0] * scale, acc[ai][bj][m][1] * scale)); }
    }
};
__device__ __forceinline__ unsigned pack4_fp8(float a, float b, float c, float d) {
    a = __builtin_amdgcn_fmed3f(a, -448.f, 448.f); b = __builtin_amdgcn_fmed3f(b, -448.f, 448.f); c = __builtin_amdgcn_fmed3f(c, -448.f, 448.f); d = __builtin_amdgcn_fmed3f(d, -448.f, 448.f);
    int w = __builtin_amdgcn_cvt_pk_fp8_f32(a, b, 0, false); w = __builtin_amdgcn_cvt_pk_fp8_f32(c, d, w, true); return (unsigned)w; }
struct EpiSwigluF8 {
    static constexpr bool PERM = true;
    unsigned char* O; int ldc; float sin, sout;
    __device__ __forceinline__ void operator()(const f32x4 (&acc)[2][2][4][2], const Unit& u, int wr, int wc, int fr, int fq) const {
        const int row0 = u.pm * BM + wr * 64 + fr, col0 = u.pn * HALF + wc * 32 + 8 * fq;
        const float c1 = -1.4426950408889634f * sin, kk = 1.f / (sin * sin * sout);
#pragma unroll
        for (int ai = 0; ai < 2; ++ai)
#pragma unroll
            for (int m = 0; m < 4; ++m) { f32x4 a, b;
#pragma unroll
                for (int e = 0; e < 4; ++e) {
                    const float g0 = acc[ai][0][m][0][e], g1 = acc[ai][0][m][1][e];
                    const float e0 = __builtin_amdgcn_exp2f(g0 * c1), e1 = __builtin_amdgcn_exp2f(g1 * c1);
                    a[e] = (g0 * acc[ai][1][m][0][e]) * __builtin_amdgcn_rcpf(__builtin_fmaf(e0, kk, kk)); b[e] = (g1 * acc[ai][1][m][1][e]) * __builtin_amdgcn_rcpf(__builtin_fmaf(e1, kk, kk)); }
                u32x2 w; w.x = pack4_fp8(a[0], a[1], a[2], a[3]); w.y = pack4_fp8(b[0], b[1], b[2], b[3]);
                *(u32x2*)(O + (size_t)(row0 + ai * HALF + m * 16) * ldc + col0) = w; }
    }
};
struct EpiU {
    static constexpr bool PERM = true;
    bf16_t* A2; const float* rs;
    __device__ __forceinline__ void operator()(const f32x4 (&acc)[2][2][4][2], const Unit& u, int wr, int wc, int fr, int fq) const {
        const int row0 = u.pm * BM + wr * 64 + fr, col0 = u.pn * BM + wc * 32 + 8 * fq;
#pragma unroll
        for (int ai = 0; ai < 2; ++ai)
#pragma unroll
            for (int m = 0; m < 4; ++m) { const int row = row0 + ai * HALF + m * 16, c = row >> 4, t = row & 15; const float s = rs ? rs[row] : 1.f;
#pragma unroll
                for (int bj = 0; bj < 2; ++bj) { const int col = col0 + bj * HALF, g = col >> 4, i0 = col & 15;
                    st16(A2 + ((size_t)(g * 1024 + c) * 512 + t * 16 + i0), pack8(acc[ai][bj][m][0] * s, acc[ai][bj][m][1] * s)); } }
    }
};
struct EpiY {
    static constexpr bool PERM = true;
    bf16_t* G1;
    __device__ __forceinline__ void operator()(const f32x4 (&acc)[2][2][4][2], const Unit& u, int wr, int wc, int fr, int fq) const {
        const int row0 = u.pm * BM + wr * 64 + fr, col0 = wc * 32 + 8 * fq;
#pragma unroll
        for (int ai = 0; ai < 2; ++ai)
#pragma unroll
            for (int m = 0; m < 4; ++m) { const int row = row0 + ai * HALF + m * 16, g = row >> 10, c = row & 1023;
#pragma unroll
                for (int bj = 0; bj < 2; ++bj) { const int col = col0 + bj * HALF, t = col >> 4, j0 = col & 15;
                    f32x4 a = acc[ai][bj][m][0], b = acc[ai][bj][m][1];
#pragma unroll
                    for (int e = 0; e < 4; ++e) { a[e] = gelu_t(a[e]); b[e] = gelu_t(b[e]); }
                    st16(G1 + ((size_t)(c * 16 + t) * 1024 + g * 16 + j0), pack8(a, b)); } }
    }
};
struct EpiGlu {
    static constexpr bool PERM = true;
    const bf16_t* G1; bf16_t* G2;
    __device__ __forceinline__ void operator()(const f32x4 (&acc)[2][2][4][2], const Unit& u, int wr, int wc, int fr, int fq) const {
        const int row0 = u.pm * BM + wr * 64 + fr, col0 = u.pn * BM + wc * 32 + 8 * fq;
#pragma unroll
        for (int ai = 0; ai < 2; ++ai)
#pragma unroll
            for (int m = 0; m < 4; ++m) { const size_t ro = (size_t)(row0 + ai * HALF + m * 16) * 1024 + col0;
#pragma unroll
                for (int bj = 0; bj < 2; ++bj) { const u32x4 gv = *(const u32x4*)(G1 + ro + bj * HALF);
                    f32x4 a = acc[ai][bj][m][0], b = acc[ai][bj][m][1];
                    a[0] = bf_lo(gv.x) * sigm(a[0]); a[1] = bf_hi(gv.x) * sigm(a[1]); a[2] = bf_lo(gv.y) * sigm(a[2]); a[3] = bf_hi(gv.y) * sigm(a[3]);
                    b[0] = bf_lo(gv.z) * sigm(b[0]); b[1] = bf_hi(gv.z) * sigm(b[1]); b[2] = bf_lo(gv.w) * sigm(b[2]); b[3] = bf_hi(gv.w) * sigm(b[3]);
                    st16(G2 + ro + bj * HALF, pack8(a, b)); } }
    }
};
struct EpiSwiglu {
    static constexpr bool PERM = true;
    bf16_t* O; int ldc; const float* rs;
    __device__ __forceinline__ void operator()(const f32x4 (&acc)[2][2][4][2], const Unit& u, int wr, int wc, int fr, int fq) const {
        const int row0 = u.pm * BM + wr * 64 + fr, col0 = u.pn * HALF + wc * 32 + 8 * fq;
#pragma unroll
        for (int ai = 0; ai < 2; ++ai)
#pragma unroll
            for (int m = 0; m < 4; ++m) { f32x4 a, b; const float s = rs ? rs[row0 + ai * HALF + m * 16] : 1.f;
#pragma unroll
                for (int e = 0; e < 4; ++e) { const float g0 = acc[ai][0][m][0][e] * s, g1 = acc[ai][0][m][1][e] * s; a[e] = g0 * sigm(g0) * (acc[ai][1][m][0][e] * s); b[e] = g1 * sigm(g1) * (acc[ai][1][m][1][e] * s); }
                st16(O + (size_t)(row0 + ai * HALF + m * 16) * ldc + col0, pack8(a, b)); }
    }
};
struct EpiQKV {
    static constexpr bool PERM = true;
    bf16_t* base; unsigned koff, voff; const float* gtab; const float4* rope; float qscale; const float* rs;
    __device__ __forceinline__ void operator()(const f32x4 (&acc)[2][2][4][2], const Unit& u, int wr, int wc, int fr, int fq) const {
        const int row0 = u.pm * BM + wr * 64 + fr, pn = u.pn;
        const float* gain = gtab + (pn < 4 ? 0 : 64) + 8 * fq;
        const float sc = pn < 4 ? qscale : 1.f;
        const unsigned tbase = pn < 4 ? (unsigned)((4 * pn + wc) * 64) : (pn == 4 ? koff : voff) + (unsigned)(wc * 64);
        const int ldo = pn < 4 ? 1024 : 256;
#pragma unroll
        for (int ai = 0; ai < 2; ++ai)
#pragma unroll
            for (int m = 0; m < 4; ++m) { const int row = row0 + ai * HALF + m * 16;
                bf16_t* dst = base + ((size_t)tbase + (size_t)row * ldo + 8 * fq);
                const float s2 = rs ? rs[row] : 1.f;
                if (pn < 5) {
                    float ss = 0.f;
#pragma unroll
                    for (int bj = 0; bj < 2; ++bj)
#pragma unroll
                        for (int n = 0; n < 2; ++n) { const f32x4 v = acc[ai][bj][m][n] * s2; ss += (v[0] * v[0] + v[1] * v[1]) + (v[2] * v[2] + v[3] * v[3]); }
                    ss += __shfl_xor(ss, 16); ss += __shfl_xor(ss, 32);
                    const float r = rsqrtf(ss * (1.f / 64.f) + 1e-6f) * s2;
                    const int pos = row & 8191;
                    const float4* t0 = rope + (pos >> 6) * 8 + 2 * fq; const float4* t1 = rope + 1024 + (pos & 63) * 8 + 2 * fq;
#pragma unroll
                    for (int bj = 0; bj < 2; ++bj) { f32x4 o[2];
#pragma unroll
                        for (int n = 0; n < 2; ++n) { const float4 cs = bj == 0 ? t0[n] : t1[n]; const f32x4 g = *(const f32x4*)(gain + 32 * bj + 4 * n); const f32x4 v = acc[ai][bj][m][n];
                            const float x0 = v[0] * r * g[0], x1 = v[1] * r * g[1], x2 = v[2] * r * g[2], x3 = v[3] * r * g[3];
                            o[n][0] = (x0 * cs.x - x1 * cs.y) * sc; o[n][1] = (x0 * cs.y + x1 * cs.x) * sc; o[n][2] = (x2 * cs.z - x3 * cs.w) * sc; o[n][3] = (x2 * cs.w + x3 * cs.z) * sc; }
                        st16(dst + 32 * bj, pack8(o[0], o[1])); }
                } else {
#pragma unroll
                    for (int bj = 0; bj < 2; ++bj) st16(dst + 32 * bj, pack8(acc[ai][bj][m][0] * s2, acc[ai][bj][m][1] * s2));
                }
                asm volatile("" ::: "memory"); }
    }
};

typedef int v4i32 __attribute__((ext_vector_type(4)));
template <bool F8> struct Frag;
template <> struct Frag<false> { u32x4 k[2]; };
template <> struct Frag<true> { v8i32 v; };
template <class Prob, class Epi, bool ALIGN_EPI = false, bool SP2 = false, bool FP8 = false>
__device__ __forceinline__ void gemm_phase(PG8_LAS unsigned char* lds, const Prob& P, const Epi& E) {
    const int tid = threadIdx.x, wid = __builtin_amdgcn_readfirstlane(tid >> 6), lane = tid & 63, wr = wid >> 2, wc = wid & 3, fr = lane & 15, fq = lane >> 4;
    int Rr[2]; unsigned cof[2], voffB[2];
#pragma unroll
    for (int i = 0; i < 2; ++i) { int R, C; stage_rc(tid * 16 + i * 8192, R, C); const int Rb = Epi::PERM ? ((R & ~31) + perm32(R & 31)) : R;
        Rr[i] = R; cof[i] = (unsigned)C * 2u; voffB[i] = (unsigned)Rb * P.ldbB + (unsigned)C * 2u; }
    const size_t kstep = (size_t)(BK * 2);
    const size_t hstepB = (size_t)HALF * P.ldbB;
    const unsigned ldsw = (unsigned)wid * 1024u;
    const int aoff = FP8 ? lds_byte(wr * 64 + fr, fq * 16) : lds_byte(wr * 64 + fr, fq * 8), boff = FP8 ? lds_byte(wc * 32 + fr, fq * 16) : lds_byte(wc * 32 + fr, fq * 8);

#define PG8_SA(b, h) (((b) * 2 + (h)) * HTB)
#define PG8_SB(b, h) ((4 + (b) * 2 + (h)) * HTB)
#define PG8_STAGE(bufoff, gbase, voff) do { _Pragma("unroll") for (int _i = 0; _i < 2; ++_i) \
        __builtin_amdgcn_global_load_lds((const unsigned*)((const char*)(gbase) + (voff)[_i]), (PG8_LAS unsigned*)(lds + (bufoff) + ldsw + _i * 8192), 16, 0, 0); } while (0)
#define PG8_LD1(dst, addr) do { if constexpr (FP8) { const v4i32 lo_ = *(const PG8_LAS v4i32*)(addr), hi_ = *(const PG8_LAS v4i32*)((addr) + 16); (dst).v = __builtin_shufflevector(lo_, hi_, 0, 1, 2, 3, 4, 5, 6, 7); } \
        else { _Pragma("unroll") for (int k = 0; k < 2; ++k) (dst).k[k] = *(const PG8_LAS u32x4*)((addr) + k * 1024); } } while (0)
#define PG8_LDA(dst, b, h) do { _Pragma("unroll") for (int m = 0; m < 4; ++m) PG8_LD1(dst[m], lds + PG8_SA(b, h) + aoff + m * 2048); } while (0)
#define PG8_LDB(dst, b, h) do { _Pragma("unroll") for (int n = 0; n < 2; ++n) PG8_LD1(dst[n], lds + PG8_SB(b, h) + boff + n * 2048); } while (0)
#define PG8_MMA(ai, bj, At, Bt) do { __builtin_amdgcn_s_setprio(1); _Pragma("unroll") for (int m = 0; m < 4; ++m) _Pragma("unroll") for (int n = 0; n < 2; ++n) { \
        if constexpr (FP8) asm volatile("v_mfma_scale_f32_16x16x128_f8f6f4 %0, %1, %2, %0, %3, %3 op_sel_hi:[0,0,0]" : "+v"(acc[ai][bj][m][n]) : "v"(Bt[n].v), "v"(At[m].v), "v"(f8scale_)); \
        else { _Pragma("unroll") for (int k = 0; k < 2; ++k) acc[ai][bj][m][n] = __builtin_amdgcn_mfma_f32_16x16x32_bf16(__builtin_bit_cast(bf16x8, Bt[n].k[k]), __builtin_bit_cast(bf16x8, At[m].k[k]), acc[ai][bj][m][n], 0, 0, 0); } } \
        __builtin_amdgcn_s_setprio(0); } while (0)
#define PG8_WAIT_V(n) asm volatile("s_waitcnt vmcnt(" #n ")" ::: "memory")
#define PG8_WAIT_L(n) asm volatile("s_waitcnt lgkmcnt(" #n ")" ::: "memory")
#define PG8_BAR __builtin_amdgcn_s_barrier()
#define PG8_SCHED __builtin_amdgcn_sched_barrier(0)
    const int f8scale_ = 0x7f7f7f7f;
    Unit cur, nxt; int ui = 0;
    if (!P.next(0, cur)) return;
    f32x4 acc[2][2][4][2];
#pragma unroll
    for (int a = 0; a < 2; ++a)
#pragma unroll
        for (int b = 0; b < 2; ++b)
#pragma unroll
            for (int m = 0; m < 4; ++m)
#pragma unroll
                for (int n = 0; n < 2; ++n) acc[a][b][m][n] = (f32x4){0.f, 0.f, 0.f, 0.f};
    Frag<FP8> At[4], B0[2], B1[2];
    unsigned voC[2][2], voN[2][2];
    P.aoffs(cur, Rr, voC);
#pragma unroll
    for (int h = 0; h < 2; ++h)
#pragma unroll
        for (int i = 0; i < 2; ++i) voC[h][i] += cof[i] + (unsigned)cur.kofs;
    const char* const aB = P.abase; const char* cB = P.bbase(cur) + cur.kofs;
    if constexpr (SP2) {
        PG8_STAGE(PG8_SB(0, 0), cB, voffB); PG8_STAGE(PG8_SB(0, 1), cB + hstepB, voffB); PG8_STAGE(PG8_SA(0, 0), aB, voC[0]); PG8_STAGE(PG8_SA(0, 1), aB, voC[1]);
        if (wr == 1) PG8_BAR;
        PG8_WAIT_V(2); PG8_BAR;
        PG8_STAGE(PG8_SB(1, 0), cB + kstep, voffB); PG8_STAGE(PG8_SA(1, 0), aB + kstep, voC[0]); PG8_STAGE(PG8_SB(1, 1), cB + hstepB + kstep, voffB);
        PG8_WAIT_V(6); PG8_BAR;
    } else {
        PG8_STAGE(PG8_SB(0, 0), cB, voffB); PG8_STAGE(PG8_SA(0, 0), aB, voC[0]); PG8_STAGE(PG8_SB(0, 1), cB + hstepB, voffB); PG8_STAGE(PG8_SA(0, 1), aB, voC[1]);
        if (wr == 1) PG8_BAR;
        PG8_WAIT_V(4); PG8_BAR;
        PG8_STAGE(PG8_SB(1, 0), cB + kstep, voffB); PG8_STAGE(PG8_SA(1, 0), aB + kstep, voC[0]); PG8_STAGE(PG8_SB(1, 1), cB + hstepB + kstep, voffB);
        PG8_WAIT_V(6); PG8_BAR;
    }
    for (;;) {
        const bool has_next = P.next(ui + 1, nxt);
        if (has_next) { P.aoffs(nxt, Rr, voN);
#pragma unroll
            for (int h = 0; h < 2; ++h)
#pragma unroll
                for (int i = 0; i < 2; ++i) voN[h][i] += cof[i] + (unsigned)nxt.kofs; }
        else {
#pragma unroll
            for (int h = 0; h < 2; ++h)
#pragma unroll
                for (int i = 0; i < 2; ++i) voN[h][i] = voC[h][i]; }
        const char* nB = has_next ? P.bbase(nxt) + nxt.kofs : cB;
        const int nt = cur.nt;
        for (int t = 0; t < nt; t += 2) {
            const bool last = (t == nt - 2);
            const char* a1 = aB + (size_t)(t + 1) * kstep;
            const char* a2 = last ? aB : aB + (size_t)(t + 2) * kstep; const char* b2 = last ? nB : cB + (size_t)(t + 2) * kstep;
            const char* a3 = a2 + kstep; const char* b3 = b2 + kstep;
            unsigned vo2[2][2];
#pragma unroll
            for (int h = 0; h < 2; ++h)
#pragma unroll
                for (int i = 0; i < 2; ++i) vo2[h][i] = last ? voN[h][i] : voC[h][i];
            if constexpr (SP2) {
            PG8_LDB(B0, 0, 0); PG8_LDB(B1, 0, 1); PG8_SCHED; PG8_LDA(At, 0, 0); PG8_STAGE(PG8_SA(1, 1), a1, voC[1]);
            PG8_WAIT_V(8); PG8_WAIT_L(0); PG8_BAR; PG8_MMA(0, 0, At, B0); PG8_MMA(0, 1, At, B1); PG8_BAR; PG8_SCHED;
            PG8_LDA(At, 0, 1); PG8_STAGE(PG8_SB(0, 0), b2, voffB); PG8_STAGE(PG8_SB(0, 1), b2 + hstepB, voffB); PG8_STAGE(PG8_SA(0, 0), a2, vo2[0]);
            PG8_WAIT_V(8); PG8_WAIT_L(0); PG8_BAR; PG8_MMA(1, 0, At, B0); PG8_MMA(1, 1, At, B1); PG8_BAR; PG8_SCHED;
            PG8_LDB(B0, 1, 0); PG8_LDB(B1, 1, 1); PG8_SCHED; PG8_LDA(At, 1, 0); PG8_STAGE(PG8_SA(0, 1), a2, vo2[1]);
            PG8_WAIT_V(8); PG8_WAIT_L(0); PG8_BAR; PG8_MMA(0, 0, At, B0); PG8_MMA(0, 1, At, B1); PG8_BAR; PG8_SCHED;
            PG8_LDA(At, 1, 1); PG8_STAGE(PG8_SB(1, 0), b3, voffB); PG8_STAGE(PG8_SB(1, 1), b3 + hstepB, voffB); PG8_STAGE(PG8_SA(1, 0), a3, vo2[0]);
            PG8_WAIT_V(8); PG8_WAIT_L(0); PG8_BAR; PG8_MMA(1, 0, At, B0); PG8_MMA(1, 1, At, B1); PG8_BAR; PG8_SCHED;
            } else {
            PG8_LDB(B0, 0, 0); PG8_SCHED; PG8_LDA(At, 0, 0); PG8_STAGE(PG8_SA(1, 1), a1, voC[1]);
            PG8_WAIT_L(8); PG8_BAR; PG8_WAIT_L(0); PG8_MMA(0, 0, At, B0); PG8_BAR; PG8_SCHED;
            PG8_LDB(B1, 0, 1); PG8_STAGE(PG8_SB(0, 0), b2, voffB);
            PG8_BAR; PG8_WAIT_L(0); PG8_MMA(0, 1, At, B1); PG8_BAR;
            PG8_LDA(At, 0, 1); PG8_STAGE(PG8_SA(0, 0), a2, vo2[0]);
            PG8_BAR; PG8_WAIT_L(0); PG8_MMA(1, 0, At, B0); PG8_BAR; PG8_SCHED;
            PG8_STAGE(PG8_SB(0, 1), b2 + hstepB, voffB);
            PG8_WAIT_V(6); PG8_BAR; PG8_MMA(1, 1, At, B1); PG8_BAR;
            PG8_LDB(B0, 1, 0); PG8_SCHED; PG8_LDA(At, 1, 0); PG8_STAGE(PG8_SA(0, 1), a2, vo2[1]);
            PG8_WAIT_L(8); PG8_BAR; PG8_WAIT_L(0); PG8_MMA(0, 0, At, B0); PG8_BAR; PG8_SCHED;
            PG8_LDB(B1, 1, 1); PG8_STAGE(PG8_SB(1, 0), b3, voffB);
            PG8_BAR; PG8_WAIT_L(0); PG8_MMA(0, 1, At, B1); PG8_BAR;
            PG8_LDA(At, 1, 1); PG8_STAGE(PG8_SA(1, 0), a3, vo2[0]);
            PG8_BAR; PG8_WAIT_L(0); PG8_MMA(1, 0, At, B0); PG8_BAR; PG8_SCHED;
            PG8_STAGE(PG8_SB(1, 1), b3 + hstepB, voffB);
            PG8_WAIT_V(6); PG8_BAR; PG8_MMA(1, 1, At, B1); PG8_BAR;
            }
        }
        if constexpr (ALIGN_EPI) { if (wr == 0) PG8_BAR; }
        if constexpr (FP8) asm volatile("s_nop 15\n\ts_nop 15" ::: "memory");
        E(acc, cur, wr, wc, fr, fq);
#if defined(EPI_TWICE) && EPI_TWICE
        if constexpr (FP8) { asm volatile("" ::: "memory"); E(acc, cur, wr, wc, fr, fq); }
#endif
        if (!has_next) break;
#pragma unroll
        for (int a = 0; a < 2; ++a)
#pragma unroll
            for (int b = 0; b < 2; ++b)
#pragma unroll
                for (int m = 0; m < 4; ++m)
#pragma unroll
                    for (int n = 0; n < 2; ++n) acc[a][b][m][n] = (f32x4){0.f, 0.f, 0.f, 0.f};
        cur = nxt; cB = nB; ++ui;
#pragma unroll
        for (int h = 0; h < 2; ++h)
#pragma unroll
            for (int i = 0; i < 2; ++i) voC[h][i] = voN[h][i];
        if constexpr (ALIGN_EPI) { if (wr == 1) PG8_BAR; }
    }
    PG8_WAIT_V(0);
    if constexpr (!ALIGN_EPI) { if (wr == 0) PG8_BAR; }
    PG8_BAR;
#undef PG8_SA
#undef PG8_SB
#undef PG8_STAGE
#undef PG8_LD1
#undef PG8_LDA
#undef PG8_LDB
#undef PG8_MMA
#undef PG8_WAIT_V
#undef PG8_WAIT_L
#undef PG8_BAR
#undef PG8_SCHED
}
}

#include <hip/hip_bf16.h>
#include <cmath>
namespace attn_body {
using bf16=__hip_bfloat16;
using bf16x8=__attribute__((ext_vector_type(8)))short;
using s16x4=__attribute__((ext_vector_type(4)))short;
using f32x16=__attribute__((ext_vector_type(16)))float;
using u32x4=__attribute__((ext_vector_type(4)))unsigned;
constexpr int BATCH=2,NHEAD=16,SEQ=8192,D=64,DM=NHEAD*D,KVP=256;
constexpr int NW=8,QBLK=32,QB=QBLK*NW,KVBLK=64,NQB=SEQ/QB;
constexpr int ATTN_PITCH=DM, ATTN_UNIT_ROWS=QB;
__device__ __forceinline__ int crow(int r,int hi){return (r&3)+8*(r>>2)+4*hi;}
#define SBAR() __builtin_amdgcn_sched_barrier(0)
__device__ __forceinline__ void cmask(f32x16&p0,f32x16&p1,int jb,int qrel,int hi){
  const float NEG=-INFINITY; int kb=64*jb+4*hi;
  #pragma unroll
  for(int r=0;r<16;++r){int kv=kb+(r&3)+8*(r>>2); if(kv>qrel)p0[r]=NEG; if(kv+32>qrel)p1[r]=NEG;}
}

constexpr int NSLOT=3, SLOTB=8192;
constexpr int LDS_K=0, LDS_V=NSLOT*SLOTB, LDS_WS=2*NSLOT*SLOTB, LDS_OST=LDS_WS+NW*64*4, LDS_BYTES=LDS_OST+NW*4096;
constexpr float C2=0.125f*1.4426950408889634f;
__device__ __forceinline__ void glds16(const void*gsrc,unsigned lds_dst){unsigned keep;
  asm volatile("s_mov_b32 %0, m0\n\ts_mov_b32 m0, %2\n\ts_nop 0\n\tglobal_load_lds_dwordx4 %1, off\n\ts_mov_b32 m0, %0":"=&s"(keep):"v"(gsrc),"s"(lds_dst):"memory");}
__device__ __forceinline__ float max3f(float a,float b,float c){float r;asm("v_max3_f32 %0, %1, %2, %3":"=v"(r):"v"(a),"v"(b),"v"(c));return r;}
__device__ __forceinline__ float max2f(float a,float b){float r;asm("v_max_f32_e32 %0, %1, %2":"=v"(r):"v"(a),"v"(b));return r;}
__device__ __forceinline__ float fadd_s(float a,float b){float r;asm("v_add_f32_e32 %0, %1, %2":"=v"(r):"v"(a),"v"(b));return r;}
__device__ __forceinline__ float fsub_s(float a,float b){float r;asm("v_sub_f32_e32 %0, %1, %2":"=v"(r):"v"(a),"v"(b));return r;}
typedef float f32x2_t __attribute__((ext_vector_type(2))); typedef __bf16 bf16x2_t __attribute__((ext_vector_type(2)));
__device__ __forceinline__ unsigned cvtpk_s(float lo,float hi){f32x2_t v={lo,hi};bf16x2_t b=__builtin_convertvector(v,bf16x2_t);return __builtin_bit_cast(unsigned,b);}
#define WAIT_BAR(N) asm volatile("s_waitcnt vmcnt(" #N ") lgkmcnt(0)\n\ts_barrier":::"memory")

__device__ __forceinline__ void qkt(f32x16&p0,f32x16&p1,const char*Kslot,const bf16x8*qr,const f32x16&negm,int r32,int hi){
  const char*kb=Kslot+hi*1024+r32*16;
  #pragma unroll
  for(int d0=0;d0<4;++d0){
    const bf16x8 b0=*reinterpret_cast<const bf16x8*>(kb+d0*2048);
    const bf16x8 b1=*reinterpret_cast<const bf16x8*>(kb+d0*2048+512);
    if(d0==0){p0=__builtin_amdgcn_mfma_f32_32x32x16_bf16(b0,qr[0],negm,0,0,0);p1=__builtin_amdgcn_mfma_f32_32x32x16_bf16(b1,qr[0],negm,0,0,0);}
    else{p0=__builtin_amdgcn_mfma_f32_32x32x16_bf16(b0,qr[d0],p0,0,0,0);p1=__builtin_amdgcn_mfma_f32_32x32x16_bf16(b1,qr[d0],p1,0,0,0);}}
}
typedef __attribute__((address_space(3))) const char* lds_cptr;
typedef short v4i16_t __attribute__((ext_vector_type(4)));
__device__ __forceinline__ void kload8(bf16x8*kf,lds_cptr kp){
  kf[0]=*(const __attribute__((address_space(3))) bf16x8*)(kp);      kf[1]=*(const __attribute__((address_space(3))) bf16x8*)(kp+512);
  kf[2]=*(const __attribute__((address_space(3))) bf16x8*)(kp+2048); kf[3]=*(const __attribute__((address_space(3))) bf16x8*)(kp+2560);
  kf[4]=*(const __attribute__((address_space(3))) bf16x8*)(kp+4096); kf[5]=*(const __attribute__((address_space(3))) bf16x8*)(kp+4608);
  kf[6]=*(const __attribute__((address_space(3))) bf16x8*)(kp+6144); kf[7]=*(const __attribute__((address_space(3))) bf16x8*)(kp+6656);
}
__device__ __forceinline__ void kload2(bf16x8*kf,lds_cptr kp,int j){ kf[2*j]=*(const __attribute__((address_space(3))) bf16x8*)(kp+j*2048); kf[2*j+1]=*(const __attribute__((address_space(3))) bf16x8*)(kp+j*2048+512); }
__device__ __forceinline__ s16x4 vtr(lds_cptr p){ return __builtin_bit_cast(s16x4,__builtin_amdgcn_ds_read_tr16_b64_v4i16((__attribute__((address_space(3))) v4i16_t*)p)); }
__device__ __forceinline__ float rowmax(const f32x16&p0,const f32x16&p1){
  float a=max3f(p0[0],p0[1],p1[0]),b=max3f(p0[2],p0[3],p1[1]);a=max3f(a,p1[2],p1[3]);
  #pragma unroll
  for(int r=4;r<16;r+=4){a=max3f(a,p0[r],p0[r+1]);b=max3f(b,p0[r+2],p0[r+3]);a=max3f(a,p1[r],p1[r+1]);b=max3f(b,p1[r+2],p1[r+3]);}
  const float m=max2f(a,b);
  auto rr=__builtin_amdgcn_permlane32_swap(__float_as_uint(m),__float_as_uint(m),false,false);
  return max2f(__uint_as_float(rr[0]),__uint_as_float(rr[1]));
}
__device__ __forceinline__ void pv(f32x16*o,int vb,bf16x8 pa0,bf16x8 pa1,bf16x8 pa2,bf16x8 pa3){
  #pragma unroll
  for(int d0=0;d0<2;++d0){s16x4 lo[4],hi[4];
    #pragma unroll
    for(int ks=0;ks<4;++ks){
      asm volatile("ds_read_b64_tr_b16 %0,%1 offset:%c2":"=&v"(lo[ks]):"v"(vb),"i"(d0*4096+ks*1024):"memory");
      asm volatile("ds_read_b64_tr_b16 %0,%1 offset:%c2":"=&v"(hi[ks]):"v"(vb),"i"(d0*4096+ks*1024+512):"memory");}
    asm volatile("s_waitcnt lgkmcnt(0)":::"memory");SBAR();
    #define PK(k) (bf16x8){lo[k][0],lo[k][1],lo[k][2],lo[k][3],hi[k][0],hi[k][1],hi[k][2],hi[k][3]}
    o[d0]=__builtin_amdgcn_mfma_f32_32x32x16_bf16(pa0,PK(0),o[d0],0,0,0);
    o[d0]=__builtin_amdgcn_mfma_f32_32x32x16_bf16(pa1,PK(1),o[d0],0,0,0);
    o[d0]=__builtin_amdgcn_mfma_f32_32x32x16_bf16(pa2,PK(2),o[d0],0,0,0);
    o[d0]=__builtin_amdgcn_mfma_f32_32x32x16_bf16(pa3,PK(3),o[d0],0,0,0);
    #undef PK
  }
}

#ifndef ATTN_STORE16
#define ATTN_STORE16(p,v) pg8::st16((void*)(p),(v))
#endif
template<int THRL,bool FIX> __device__ __forceinline__ void attn_unit(float refB,int b,int h,int kvh,int qb,const bf16*Q,const bf16*__restrict__ K,const bf16*__restrict__ V,bf16*O,char*shm){
  const int tid=threadIdx.x,lane=tid&63,r32=lane&31,hi=lane>>5; const int wid=__builtin_amdgcn_readfirstlane(tid>>6);
  const long rowbase=(long)b*SEQ; const int q0=qb*QB;
  const bf16*Qw=Q+(rowbase+q0+wid*QBLK)*DM+h*D;
  const bf16*Kh=K+rowbase*KVP+kvh*D,*Vh=V+rowbase*KVP+kvh*D;
  const unsigned lds0=(unsigned)(uintptr_t)shm;
  float*wsf=(float*)(shm+LDS_WS)+wid*64;
  const bf16*ksrc=Kh+(long)lane*KVP+wid*8;
  const bf16*vsrc=Vh+(long)(16*(wid&3)+(lane>>2))*KVP+(wid>>2)*32+(lane&3)*8;
  const unsigned kdst=lds0+LDS_K+wid*1024, vdst=lds0+LDS_V+wid*1024;
  #define DMA_K(t,slot) glds16(ksrc+(long)(t)*KVBLK*KVP,(unsigned)__builtin_amdgcn_readfirstlane(kdst+(slot)))
  #define DMA_V(t,slot) glds16(vsrc+(long)(t)*KVBLK*KVP,(unsigned)__builtin_amdgcn_readfirstlane(vdst+(slot)))
  const int vb0=(int)(lds0+LDS_V)+((lane>>4)&1)*32+(lane&3)*8+(4*hi+((lane&15)>>2))*64;
  const char*Kbase=shm+LDS_K; bf16x8 kf[8];
  const lds_cptr shm3=(lds_cptr)shm; const lds_cptr kp0=shm3+LDS_K+hi*1024+r32*16; const lds_cptr vp0=shm3+LDS_V+((lane>>4)&1)*32+(lane&3)*8+(4*hi+((lane&15)>>2))*64;
  const int NT=SEQ/KVBLK;
  DMA_K(0,0);DMA_V(0,0);DMA_K(1,SLOTB);
  bf16x8 qr[4];
  #pragma unroll
  for(int d0=0;d0<4;++d0)qr[d0]=*reinterpret_cast<const bf16x8*>(&Qw[(long)r32*DM+d0*16+hi*8]);
  float mhat=0.f,l_reg=0.f;f32x16 o[2];o[0]=f32x16{};o[1]=f32x16{};f32x16 negm=f32x16{}; if constexpr(FIX){ _Pragma("unroll") for(int r=0;r<16;++r)negm[r]=-refB; } asm volatile("":"+v"(negm));
  const int qrel=wid*QBLK+r32;
  #define CMASK(P0,P1,t) do{}while(0)
  bool resc=false;
  #define START(P0,P1) do{ if constexpr(!FIX){ const float rm=rowmax(P0,P1); resc=false; \
    { const float dl=rm; mhat=fadd_s(mhat,dl); \
      _Pragma("unroll") for(int r=0;r<16;++r){P0[r]=fsub_s(P0[r],dl);P1[r]=fsub_s(P1[r],dl);} \
      _Pragma("unroll") for(int r=0;r<16;++r)negm[r]=-mhat; asm volatile("":"+v"(negm)); } } \
    _Pragma("unroll") for(int r=0;r<16;++r)P0[r]=__builtin_amdgcn_exp2f(P0[r]); }while(0)
  #define RESC() do{ if constexpr(!FIX) if(resc){ asm volatile("s_waitcnt lgkmcnt(0)":::"memory"); \
      _Pragma("unroll") for(int d_=0;d_<2;++d_) _Pragma("unroll") for(int r=0;r<16;++r)o[d_][r]*=wsf[crow(r,hi)]; } }while(0)
  f32x16 pA0,pA1,pB0,pB1;
  int sl_prev=0,sl_cur=0,sl_next=SLOTB;
  #define ROT() do{sl_prev=sl_cur;sl_cur=sl_next;sl_next=(sl_next==(NSLOT-1)*SLOTB)?0:sl_next+SLOTB;}while(0)
  DMA_K(2,2*SLOTB);
  WAIT_BAR(3);
  qkt(pA0,pA1,Kbase,qr,negm,r32,hi);asm volatile("s_nop 15\n\ts_nop 7":"+v"(pA0),"+v"(pA1));CMASK(pA0,pA1,0);
  START(pA0,pA1);
  _Pragma("unroll") for(int r=0;r<16;++r)pA1[r]=__builtin_amdgcn_exp2f(pA1[r]);
  WAIT_BAR(0);
  DMA_K(3,0);DMA_V(1,SLOTB);
  ROT();
  kload8(kf,kp0+sl_cur);
  WAIT_BAR(2);
  s16x4 vlo[8],vhi[8]; u32x4 pw0,pw1,pw2,pw3;
  #define PKW(P,B) cvtpk_s(P[B],P[B+1])
  #define PAF(k) __builtin_bit_cast(bf16x8,pw##k)
  #define VFR(i) (bf16x8){vlo[i][0],vlo[i][1],vlo[i][2],vlo[i][3],vhi[i][0],vhi[i][1],vhi[i][2],vhi[i][3]}
  #define PIN(x) asm volatile("":"+v"(x))
  #define MX3(a,b,c) __builtin_fmaxf(__builtin_fmaxf((a),(b)),(c))
  #define GAPA(MF,A0,A1,A2,A3,W0,W1,PW) do{ MF; sacc+=A0; sacc+=A1; sacc+=A2; sacc+=A3; PIN(sacc); W0; W1; PIN(PW); SBAR(); }while(0)
  #define EX(v) __builtin_amdgcn_exp2f(v)
  #define GAPB(MF,X,B) do{ MF; X[B]=EX(X[B]); X[B+1]=EX(X[B+1]); X[B+2]=EX(X[B+2]); X[B+3]=EX(X[B+3]); PIN(X); SBAR(); }while(0)
  #define VRD(i) do{ vlo[i]=vtr(vp_+(((i)>>2)*4096+((i)&3)*1024)); vhi[i]=vtr(vp_+(((i)>>2)*4096+((i)&3)*1024+512)); }while(0)
  #define KRD(G,j) do{ if(G){ kload2(kf,kp0+sl_next,j); SBAR(); } }while(0)
  #define STEP(C0,C1,P0,P1,t,GK,GV,GL) do{ SBAR(); \
    const lds_cptr vp_=vp0+sl_prev; \
    VRD(0); SBAR(); float sacc=(P0[0]+P0[1]); \
    GAPA(C0=__builtin_amdgcn_mfma_f32_32x32x16_bf16(kf[0],qr[0],negm,0,0,0), P0[2],P0[3],P0[4],P0[5],     pw0[0]=PKW(P0,0), pw0[1]=PKW(P0,2), pw0); \
    VRD(4); SBAR(); GAPA(C1=__builtin_amdgcn_mfma_f32_32x32x16_bf16(kf[1],qr[0],negm,0,0,0), P0[6],P0[7],P0[8],P0[9],     pw0[2]=PKW(P0,4), pw0[3]=PKW(P0,6), pw0); \
    VRD(1); SBAR(); GAPA(C0=__builtin_amdgcn_mfma_f32_32x32x16_bf16(kf[2],qr[1],C0,0,0,0),   P0[10],P0[11],P0[12],P0[13], pw1[0]=PKW(P0,8), pw1[1]=PKW(P0,10), pw1); \
    VRD(5); SBAR(); GAPA(C1=__builtin_amdgcn_mfma_f32_32x32x16_bf16(kf[3],qr[1],C1,0,0,0),   P0[14],P0[15],P1[0],P1[1],   pw1[2]=PKW(P0,12),pw1[3]=PKW(P0,14), pw1); \
    VRD(2); SBAR(); GAPA(C0=__builtin_amdgcn_mfma_f32_32x32x16_bf16(kf[4],qr[2],C0,0,0,0),   P1[2],P1[3],P1[4],P1[5],     pw2[0]=PKW(P1,0), pw2[1]=PKW(P1,2), pw2); \
    VRD(6); SBAR(); GAPA(C1=__builtin_amdgcn_mfma_f32_32x32x16_bf16(kf[5],qr[2],C1,0,0,0),   P1[6],P1[7],P1[8],P1[9],     pw2[2]=PKW(P1,4), pw2[3]=PKW(P1,6), pw2); \
    VRD(3); SBAR(); GAPA(C0=__builtin_amdgcn_mfma_f32_32x32x16_bf16(kf[6],qr[3],C0,0,0,0),   P1[10],P1[11],P1[12],P1[13], pw3[0]=PKW(P1,8), pw3[1]=PKW(P1,10), pw3); \
    VRD(7); SBAR(); GAPA(C1=__builtin_amdgcn_mfma_f32_32x32x16_bf16(kf[7],qr[3],C1,0,0,0),   P1[14],P1[15],0.f,0.f,       pw3[2]=PKW(P1,12),pw3[3]=PKW(P1,14), pw3); \
    l_reg+=sacc; \
    if(GK){DMA_K((t)+3,sl_cur);} if(GV){DMA_V((t)+1,sl_next);} \
    CMASK(C0,C1,t); \
    if constexpr(!FIX){ float a=MX3(C0[0],C0[1],C1[0]),b=MX3(C0[2],C0[3],C1[1]); a=MX3(a,C1[2],C1[3]); \
      _Pragma("unroll") for(int r=4;r<16;r+=4){a=MX3(a,C0[r],C0[r+1]);b=MX3(b,C0[r+2],C0[r+3]);a=MX3(a,C1[r],C1[r+1]);b=MX3(b,C1[r+2],C1[r+3]);} \
      float rm=__builtin_fmaxf(a,b); { auto rr=__builtin_amdgcn_permlane32_swap(__float_as_uint(rm),__float_as_uint(rm),false,false); rm=__builtin_fmaxf(__uint_as_float(rr[0]),__uint_as_float(rr[1])); } \
      resc=false; \
      if(__builtin_expect(__any(rm>(float)THRL),0)){ const float dl=__builtin_fmaxf(rm,0.f); mhat+=dl; \
        _Pragma("unroll") for(int r=0;r<16;++r){C0[r]-=dl;C1[r]-=dl;} \
        _Pragma("unroll") for(int r=0;r<16;++r)negm[r]=-mhat; asm volatile("":"+v"(negm)); \
        const float f=__builtin_amdgcn_exp2f(-dl); l_reg*=f; if(hi==0)wsf[r32]=f; resc=true; } } \
    SBAR(); \
    GAPB(o[0]=__builtin_amdgcn_mfma_f32_32x32x16_bf16(PAF(0),VFR(0),o[0],0,0,0), C0,0); \
    GAPB(o[1]=__builtin_amdgcn_mfma_f32_32x32x16_bf16(PAF(0),VFR(4),o[1],0,0,0), C0,4); \
    KRD(GL,0); GAPB(o[0]=__builtin_amdgcn_mfma_f32_32x32x16_bf16(PAF(1),VFR(1),o[0],0,0,0), C0,8); \
    KRD(GL,1); GAPB(o[1]=__builtin_amdgcn_mfma_f32_32x32x16_bf16(PAF(1),VFR(5),o[1],0,0,0), C0,12); \
    KRD(GL,2); GAPB(o[0]=__builtin_amdgcn_mfma_f32_32x32x16_bf16(PAF(2),VFR(2),o[0],0,0,0), C1,0); \
    KRD(GL,3); GAPB(o[1]=__builtin_amdgcn_mfma_f32_32x32x16_bf16(PAF(2),VFR(6),o[1],0,0,0), C1,4); \
    GAPB(o[0]=__builtin_amdgcn_mfma_f32_32x32x16_bf16(PAF(3),VFR(3),o[0],0,0,0), C1,8); \
    GAPB(o[1]=__builtin_amdgcn_mfma_f32_32x32x16_bf16(PAF(3),VFR(7),o[1],0,0,0), C1,12); \
    }while(0)
  int t=1;
#if defined(ATTN_PRIO) && ATTN_PRIO
  if(wid>=4)__builtin_amdgcn_s_setprio(1);
#endif
  #undef CMASK
  #define CMASK(P0,P1,t) do{}while(0)
  for(;t+5<NT;t+=2){
    STEP(pB0,pB1,pA0,pA1,t,true,true,true);     WAIT_BAR(2); RESC(); ROT();
    STEP(pA0,pA1,pB0,pB1,t+1,true,true,true);   WAIT_BAR(2); RESC(); ROT();
  }
  #undef CMASK
  #define CMASK(P0,P1,t) do{}while(0)
  #define ENDW(tt) do{ if((tt)+3<NT){WAIT_BAR(2);} else if((tt)+2<NT){WAIT_BAR(1);} else {WAIT_BAR(0);} }while(0)
  for(;t+1<NT;t+=2){
    STEP(pB0,pB1,pA0,pA1,t,(t+3<NT),(t+1<NT),(t+1<NT));       ENDW(t);   RESC(); ROT();
    STEP(pA0,pA1,pB0,pB1,t+1,(t+4<NT),(t+2<NT),(t+2<NT));     ENDW(t+1); RESC(); ROT();
  }
  STEP(pB0,pB1,pA0,pA1,NT-1,false,false,false); RESC();
  { float sacc=pB0[0]+pB0[1]; _Pragma("unroll") for(int r=2;r<16;++r)sacc+=pB0[r]; _Pragma("unroll") for(int r=0;r<16;++r)sacc+=pB1[r]; l_reg+=sacc;
    pw0=(u32x4){PKW(pB0,0),PKW(pB0,2),PKW(pB0,4),PKW(pB0,6)};pw1=(u32x4){PKW(pB0,8),PKW(pB0,10),PKW(pB0,12),PKW(pB0,14)};pw2=(u32x4){PKW(pB1,0),PKW(pB1,2),PKW(pB1,4),PKW(pB1,6)};pw3=(u32x4){PKW(pB1,8),PKW(pB1,10),PKW(pB1,12),PKW(pB1,14)};
    SBAR(); pv(o,vb0+sl_cur,PAF(0),PAF(1),PAF(2),PAF(3)); }
  #undef PKW
  #undef PAF
  #undef VFR
  #undef PIN
  #undef MX3
  #undef GAPA
  #undef GAPB
  #undef EX
  #undef VRD
  #undef KRD
  #undef STEP
  #undef ENDW
#if defined(ATTN_PRIO) && ATTN_PRIO
  __builtin_amdgcn_s_setprio(0);
#endif
  {auto rr=__builtin_amdgcn_permlane32_swap(__float_as_uint(l_reg),__float_as_uint(l_reg),false,false);l_reg=__uint_as_float(rr[0])+__uint_as_float(rr[1]);}
  if(hi==0)wsf[32+r32]=l_reg;asm volatile("s_waitcnt lgkmcnt(0)":::"memory");
  float rli[16];
  #pragma unroll
  for(int r=0;r<16;++r)rli[r]=__builtin_amdgcn_rcpf(wsf[32+crow(r,hi)]);
  bf16*Ow=O+(rowbase+q0+wid*QBLK)*DM+h*D;
  { bf16*stg=(bf16*)(shm+LDS_OST)+wid*2048;
    #pragma unroll
    for(int r=0;r<16;++r){const int orow=crow(r,hi);
      #pragma unroll
      for(int d0=0;d0<2;++d0)stg[orow*64+d0*32+r32]=__float2bfloat16(o[d0][r]*rli[r]);}
    asm volatile("s_waitcnt lgkmcnt(0)":::"memory");
    #pragma unroll
    for(int i=0;i<4;++i){const int row=i*8+(lane>>3),ch=lane&7; const u32x4 v=*(const u32x4*)(stg+row*64+ch*8); ATTN_STORE16(Ow+(long)row*DM+ch*8,v);} }
  asm volatile("s_waitcnt lgkmcnt(0)\n\ts_barrier":::"memory");
  #undef DMA_K
  #undef DMA_V
  #undef CMASK
  #undef START
  #undef RESC
  #undef ROT
}
constexpr int ATTN_LDS_BYTES=LDS_BYTES;
struct AttnTensors { const bf16* Q; const bf16* K; const bf16* V; bf16* O; };
struct AttnUnit { int bh; int qb; };
struct StaticOrder {
  int vcu;
  __device__ __forceinline__ explicit StaticOrder(int grid,int block):vcu((block%8)*(grid/8)+block/8){}
  __device__ __forceinline__ bool next(int i,AttnUnit&u)const{ if(i>=4)return false; const int x=vcu>>5, j=vcu&31; const int b=x>>2, kvh=x&3; u.bh=b*16+kvh*4+i; u.qb=j; return true; }
  __device__ __forceinline__ void a_ready(const AttnUnit&)const{}
  __device__ __forceinline__ void done(const AttnUnit&)const{}
};
template<class Sched,bool FIX,int THRL=8> __device__ __forceinline__ void attn_phase(char*lds,const AttnTensors&T,const Sched&S,float refB){
  AttnUnit u;
  for(int i=0;S.next(i,u);++i){ S.a_ready(u); attn_unit<THRL,FIX>(refB,u.bh/NHEAD,u.bh%NHEAD,(u.bh%NHEAD)>>2,u.qb,T.Q,T.K,T.V,T.O,lds); S.done(u); }
}
#undef SBAR
#undef WAIT_BAR
}

#define GAS __attribute__((address_space(1)))
#define LAS __attribute__((address_space(3)))
typedef unsigned short bf16;
typedef unsigned v4u __attribute__((ext_vector_type(4)));
typedef float f32x4 __attribute__((ext_vector_type(4)));
typedef short bf16x8 __attribute__((ext_vector_type(8)));
typedef GAS unsigned gu32;
typedef GAS unsigned long long gu64;
#define RLX_AGENT __ATOMIC_RELAXED, __HIP_MEMORY_SCOPE_AGENT
#define LDS_WAIT() asm volatile("s_waitcnt lgkmcnt(0)" ::: "memory")
#define VM_WAIT() asm volatile("s_waitcnt vmcnt(0)" ::: "memory")
__device__ __forceinline__ unsigned long long rt() { return __builtin_amdgcn_s_memrealtime(); }
__device__ __forceinline__ unsigned f2bf(float f) { unsigned u = __builtin_bit_cast(unsigned, f); return (u + 0x7fffu + ((u >> 16) & 1u)) >> 16; }
__device__ __forceinline__ unsigned pk2(float lo, float hi) { return pg8::cvt_pk_bf16(lo, hi); }

#define XB_TMO      128
#define XB_XCNT(j)  (256  + 64 * (j))
#define XB_XSUB(j)  (1280 + 64 * (j))
#define XB_XGEN(j)  (2304 + 64 * (j))
#define XB_TOP      3328
#define XB_TOPGEN   3392
#define XCD_BAR_WORDS 3456
#define XB_SPIN_CAP (1u << 18)

__device__ __forceinline__ unsigned xb_ld(unsigned* p)              { return __hip_atomic_load(p, __ATOMIC_RELAXED, __HIP_MEMORY_SCOPE_AGENT); }
__device__ __forceinline__ unsigned xb_add(unsigned* p, unsigned v) { return __hip_atomic_fetch_add(p, v, __ATOMIC_RELAXED, __HIP_MEMORY_SCOPE_AGENT); }
__device__ __forceinline__ unsigned xb_xcc_id() { return (unsigned)__builtin_amdgcn_s_getreg((3 << 11) | 20) & 0xFu; }
#ifndef XB_SLEEP
#define XB_SLEEP 1
#endif
#define XB_SPIN(cond, bar) do { unsigned _sp = 0; while (cond) { __builtin_amdgcn_s_sleep(XB_SLEEP); \
    if ((++_sp & 255u) == 0u) { if (xb_ld(&(bar)[XB_TMO])) break; if (_sp > XB_SPIN_CAP) { atomicAdd(&(bar)[XB_TMO], 1u); break; } } } } while (0)

struct XcdBarrier {
    unsigned* bar; unsigned x;
    volatile LAS unsigned* st;
};

__device__ __forceinline__ XcdBarrier xcd_barrier_post(unsigned* bar, volatile LAS unsigned* st) {
    XcdBarrier b; b.bar = bar; b.x = xb_xcc_id(); b.st = st;
    if (threadIdx.x == 0) (void)xb_add(&bar[XB_XCNT(b.x)], 1u);
    return b;
}
__device__ __forceinline__ void xcd_barrier_complete(unsigned* bar, unsigned x, unsigned& nloc, unsigned& nx) {
    const unsigned G = gridDim.x * gridDim.y * gridDim.z;
    unsigned sum, cnt, mine, sp = 0u;
    for (;;) {
        sum = 0u; cnt = 0u; mine = 0u;
#pragma unroll
        for (unsigned j = 0; j < 16; ++j) { const unsigned c = xb_ld(&bar[XB_XCNT(j)]); sum += c; cnt += (c > 0u) ? 1u : 0u; mine = (j == x) ? c : mine; }
        if (sum == G) break;
        __builtin_amdgcn_s_sleep(1);
        if ((++sp & 255u) == 0u) { if (xb_ld(&bar[XB_TMO])) break; if (sp > XB_SPIN_CAP) { atomicAdd(&bar[XB_TMO], 1u); break; } }
    }
    nloc = mine > 0u ? mine : 1u; nx = cnt > 0u ? cnt : 1u;
}

__device__ __forceinline__ void xcd_barrier(const XcdBarrier& b) {
    asm volatile("s_waitcnt vmcnt(0)" ::: "memory");
    __syncthreads();
    if (threadIdx.x == 0) {
        unsigned* bar = b.bar;
        __builtin_amdgcn_s_waitcnt(0);
        unsigned nloc = b.st[0], nx = b.st[1];
        if (nloc == 0u) { xcd_barrier_complete(bar, b.x, nloc, nx); b.st[0] = nloc; b.st[1] = nx; }
        const unsigned old = xb_add(&bar[XB_XSUB(b.x)], 1u);
        const unsigned gen = old / nloc;
        if (old + 1u == (gen + 1u) * nloc) {
            __builtin_amdgcn_fence(__ATOMIC_RELEASE, "agent");
            asm volatile("s_waitcnt vmcnt(0)" ::: "memory");
            const unsigned og = xb_add(&bar[XB_TOP], 1u);
            const unsigned tg = og / nx;
            if (og + 1u == (tg + 1u) * nx) xb_add(&bar[XB_TOPGEN], 1u);
            else XB_SPIN(xb_ld(&bar[XB_TOPGEN]) == tg, bar);
            __builtin_amdgcn_fence(__ATOMIC_ACQUIRE, "agent");
            xb_add(&bar[XB_XGEN(b.x)], 1u);
            asm volatile("s_waitcnt vmcnt(0)" ::: "memory");
        } else {
            XB_SPIN(xb_ld(&bar[XB_XGEN(b.x)]) == gen, bar);
            __builtin_amdgcn_fence(__ATOMIC_ACQUIRE, "agent");
            asm volatile("s_waitcnt vmcnt(0)" ::: "memory");
        }
    }
    __syncthreads();
}

#ifndef MOE_FP8
#define MOE_FP8 1
#endif
#ifndef MOE_WGM
#define MOE_WGM 8
#endif
#ifndef P15_ALIGN
#define P15_ALIGN true
#endif
#ifndef P15_SP2
#define P15_SP2 true
#endif
#ifndef FFN_FP8
#define FFN_FP8 0
#endif
#ifndef MOE_CVT_IN_SCAN
#define MOE_CVT_IN_SCAN 1
#endif
#ifndef ATTN_PRIO
#define ATTN_PRIO 1
#endif
#ifndef MOE_CVT_SPLIT
#define MOE_CVT_SPLIT 16384
#endif
#ifndef CVT_P0_END
#define CVT_P0_END T_ISMALL
#endif
#ifndef CVT_S1
#define CVT_S1 11264
#endif
#ifndef CVT_S2
#define CVT_S2 16384
#endif
#ifndef FFN_WGM
#define FFN_WGM 8
#endif
#ifndef S_BF16
#define S_BF16 0
#endif
#ifndef NORM_FACTOR
#define NORM_FACTOR 0
#endif
constexpr int NWAVES = 8;
constexpr int NTOK = 16384, DM = 1024, SEQ = 8192, NB = 2;
constexpr int DFF = 2816, NEXP = 8, DFE = 3584, QKVW = 1536;
constexpr float EPS = 1e-6f;
constexpr float QSCALE = 0.125f * 1.4426950408889634f;

constexpr size_t MiB = 1u << 20;
constexpr size_t WS_CTL = 0, CTL_ZERO_BYTES = 1 * MiB;
constexpr size_t WS_ROPE_R = 1 * MiB, WS_ROPE_C = 1 * MiB + 16384, WS_AT = 1 * MiB + 65536, WS_QKG = 1 * MiB + 131072, WS_TOKINFO = 1 * MiB + 262144;
constexpr size_t WS_RSTD = 1 * MiB + 524288;
constexpr size_t WS_LIST = 2 * MiB, WS_IDLIST = 3 * MiB;
constexpr size_t WS_BT_IN = 4 * MiB, WS_BT_GLU = 6 * MiB, WS_BT_SOUT = 8 * MiB, WS_BT_AO = 10 * MiB, WS_BT_QKV = 12 * MiB, WS_BT_GU = 16 * MiB, WS_BT_FD = 28 * MiB;
constexpr size_t WS_S5_MAIN = 34 * MiB, WS_S5_STATE = 50 * MiB;
constexpr size_t WS_A2 = 58 * MiB, WS_S = 122 * MiB, WS_G1 = 122 * MiB, WS_G2 = 154 * MiB, WS_MIX = 58 * MiB;
constexpr size_t WS_ACTF = 122 * MiB;
constexpr size_t WS_Q = 122 * MiB, WS_K = 154 * MiB, WS_V = 162 * MiB, WS_O = 170 * MiB;
constexpr size_t WS_XN = 242 * MiB;
constexpr size_t WS_ACTM = 4 * MiB;
constexpr size_t WS_BT_MGU = 280 * MiB, WS_BT_MD = 392 * MiB, WS_SLOT = 124 * MiB, WS_PART = 192 * MiB, WS_HB = 336 * MiB, WS_END = 448 * MiB;
static_assert(WS_ACTM + (size_t)34816 * DFE * 2 <= WS_XN && WS_XN + (size_t)NTOK * DM * 2 <= WS_BT_MGU && WS_BT_MGU + (size_t)8 * 7168 * 1024 * 2 == WS_BT_MD && WS_BT_MD + (size_t)8 * 1024 * 3584 * 2 == WS_END, "ws map");
static_assert(WS_S5_STATE + (size_t)64 * 256 * 256 * 2 <= WS_A2 && WS_ACTF + (size_t)NTOK * DFF * 2 <= WS_XN && WS_O + (size_t)NTOK * DM * 2 <= WS_XN && WS_SLOT + (size_t)34816 * DM * 2 <= WS_PART && WS_PART + (size_t)256 * 131072 <= WS_XN && WS_ACTM + (size_t)34816 * DFE <= WS_SLOT && WS_BT_MGU + (size_t)8 * 7168 * 1024 <= WS_HB && WS_HB + (size_t)NTOK * DM * 2 <= WS_BT_MD && MOE_FP8 == 1, "ws map 2");
constexpr int CW_TMO = 0, CW_CODE = 1, CW_BAR = 4096, CW_CNT = 8192;

constexpr int RING_OFF = 0, RING_BYTES = 131072;
constexpr int LDSCTL_OFF = RING_BYTES, MISC_OFF = LDSCTL_OFF + 320;
constexpr int LDS_BYTES = 147456;

typedef unsigned v2u __attribute__((ext_vector_type(2)));
typedef float v2f __attribute__((ext_vector_type(2)));

constexpr int MOE_OFF = MISC_OFF + 256;
struct Frame {
    LAS unsigned char* lds;
    volatile LAS unsigned* MISC;
    gu32* ctl;
    int tid, lane, wave;
    int vcu, G;
};
__device__ __forceinline__ float wave_sum(float v) {
#pragma unroll
    for (int o = 1; o < 64; o <<= 1) v += __shfl_xor(v, o);
    return v;
}
constexpr int T_ISMALL = 4 * 256 + 384 + 3 * 704, T_NITEMS = T_ISMALL + 8 * 3 * 896;
struct TItem { const float* W; bf16* WT; int K, N, kind, half, item, f8; const float* gain; };
__device__ __forceinline__ TItem t_decode(int it, const float* const* in, unsigned char* ws) {
    constexpr int I_SQ = 256, I_FG = 704, I_QKV = 384, I_M = 896;
    TItem t; int r = it; t.kind = 0; t.half = 0; t.K = DM; t.N = DM; t.f8 = 0; t.gain = nullptr;
    if (r < I_SQ) { t.W = in[2]; t.WT = (bf16*)(ws + WS_BT_IN); t.item = r; if (NORM_FACTOR) t.gain = in[1]; return t; } r -= I_SQ;
    if (r < I_SQ) { t.W = in[11]; t.WT = (bf16*)(ws + WS_BT_GLU); t.item = r; return t; } r -= I_SQ;
    if (r < I_SQ) { t.W = in[12]; t.WT = (bf16*)(ws + WS_BT_SOUT); t.item = r; return t; } r -= I_SQ;
    if (r < I_SQ) { t.W = in[19]; t.WT = (bf16*)(ws + WS_BT_AO); t.item = r; return t; } r -= I_SQ;
    if (r < I_QKV) { t.W = in[16]; t.WT = (bf16*)(ws + WS_BT_QKV); t.N = QKVW; t.kind = 2; t.item = r; if (NORM_FACTOR) t.gain = in[1] + 4 * DM; return t; } r -= I_QKV;
    if (r < I_FG) { t.W = in[13]; t.WT = (bf16*)(ws + WS_BT_GU); t.N = DFF; t.kind = 1; t.item = r; t.f8 = FFN_FP8; if (NORM_FACTOR) t.gain = in[1] + 2 * DM; return t; } r -= I_FG;
    if (r < I_FG) { t.W = in[14]; t.WT = (bf16*)(ws + WS_BT_GU); t.N = DFF; t.kind = 1; t.half = 1; t.item = r; t.f8 = FFN_FP8; if (NORM_FACTOR) t.gain = in[1] + 2 * DM; return t; } r -= I_FG;
    if (r < I_FG) { t.W = in[15]; t.WT = (bf16*)(ws + WS_BT_FD); t.K = DFF; t.item = r; t.f8 = FFN_FP8; return t; } r -= I_FG;
    const int e = r / (3 * I_M); r -= e * 3 * I_M; t.f8 = MOE_FP8;
    if (r < I_M) { t.W = in[21] + (size_t)e * DM * DFE; t.WT = (bf16*)(ws + WS_BT_MGU + (size_t)e * 7168 * 1024 * (MOE_FP8 ? 1 : 2)); t.N = DFE; t.kind = 1; t.item = r; return t; } r -= I_M;
    if (r < I_M) { t.W = in[22] + (size_t)e * DM * DFE; t.WT = (bf16*)(ws + WS_BT_MGU + (size_t)e * 7168 * 1024 * (MOE_FP8 ? 1 : 2)); t.N = DFE; t.kind = 1; t.half = 1; t.item = r; return t; } r -= I_M;
    t.W = in[23] + (size_t)e * DFE * DM; t.WT = (bf16*)(ws + WS_BT_MD + (size_t)e * 1024 * 3584 * (MOE_FP8 ? 1 : 2)); t.K = DFE; t.item = r; return t;
}
__device__ __forceinline__ void t_issue(const TItem& t, int lane, f32x4 (&ld)[16]) {
    const int nblk = t.N / 64, kb = t.item / nblk, nb = t.item - kb * nblk;
    const int rmul = t.f8 ? 4 : 2;
    const float* p = t.W + (size_t)(64 * kb + rmul * (lane >> 4)) * t.N + 64 * nb + 4 * (lane & 15);
#pragma unroll
    for (int i = 0; i < 16; ++i) ld[i] = *(const GAS f32x4*)(p + (size_t)(t.f8 ? 16 * (i >> 2) + (i & 3) : 8 * (i >> 1) + (i & 1)) * t.N);
}
__device__ __forceinline__ void t_finish(const TItem& t, int lane, const f32x4 (&ld)[16], LAS unsigned* T) {
    const int nblk = t.N / 64, kb = t.item / nblk, nb = t.item - kb * nblk, k0 = 64 * kb, n0 = 64 * nb;
    const int r = lane >> 4, cg = lane & 15;
    if (t.f8) {
        unsigned char* WT8 = (unsigned char*)t.WT;
#pragma unroll
        for (int mq = 0; mq < 4; ++mq) { LAS unsigned* d = T + (4 * mq + r) * 65 + 4 * cg;
            d[0] = pg8::pack4_fp8(ld[4 * mq].x * 64.f, ld[4 * mq + 1].x * 64.f, ld[4 * mq + 2].x * 64.f, ld[4 * mq + 3].x * 64.f);
            d[1] = pg8::pack4_fp8(ld[4 * mq].y * 64.f, ld[4 * mq + 1].y * 64.f, ld[4 * mq + 2].y * 64.f, ld[4 * mq + 3].y * 64.f);
            d[2] = pg8::pack4_fp8(ld[4 * mq].z * 64.f, ld[4 * mq + 1].z * 64.f, ld[4 * mq + 2].z * 64.f, ld[4 * mq + 3].z * 64.f);
            d[3] = pg8::pack4_fp8(ld[4 * mq].w * 64.f, ld[4 * mq + 1].w * 64.f, ld[4 * mq + 2].w * 64.f, ld[4 * mq + 3].w * 64.f); }
        LDS_WAIT(); asm volatile("" ::: "memory");
        const int c4 = lane & 3;
#pragma unroll
        for (int j = 0; j < 4; ++j) { const int nl = (lane >> 2) + 16 * j, n = n0 + nl;
            const int dr = t.kind == 0 ? n : 256 * (n / 128) + (n % 128) + 128 * t.half;
            const LAS unsigned* s = T + (4 * c4) * 65 + nl;
            v4u o; o.x = s[0]; o.y = s[65]; o.z = s[130]; o.w = s[195];
            *(GAS v4u*)(WT8 + (size_t)dr * t.K + k0 + 16 * c4) = o; }
        LDS_WAIT(); asm volatile("" ::: "memory");
        return;
    }
#pragma unroll
    for (int m = 0; m < 8; ++m) { LAS unsigned* d = T + (4 * m + r) * 65 + 4 * cg;
        float g0 = 1.f, g1 = 1.f; if (NORM_FACTOR && t.gain) { const v2f gg = *(const GAS v2f*)(t.gain + k0 + 8 * m + 2 * r); g0 = gg.x; g1 = gg.y; }
        d[0] = pk2(ld[2 * m].x * g0, ld[2 * m + 1].x * g1); d[1] = pk2(ld[2 * m].y * g0, ld[2 * m + 1].y * g1); d[2] = pk2(ld[2 * m].z * g0, ld[2 * m + 1].z * g1); d[3] = pk2(ld[2 * m].w * g0, ld[2 * m + 1].w * g1); }
    LDS_WAIT(); asm volatile("" ::: "memory");
    const int c = lane & 7;
#pragma unroll
    for (int j = 0; j < 8; ++j) { const int nl = (lane >> 3) + 8 * j, n = n0 + nl;
        const int dr = t.kind == 0 ? n : (t.kind == 1 ? 256 * (n / 128) + (n % 128) + 128 * t.half : 256 * (n / 256) + 128 * ((n % 64) / 32) + 32 * ((n % 256) / 64) + (n % 32));
        const LAS unsigned* s = T + (4 * c) * 65 + nl;
        v4u o; o.x = s[0]; o.y = s[65]; o.z = s[130]; o.w = s[195];
        *(GAS v4u*)(t.WT + (size_t)dr * t.K + k0 + 8 * c) = o; }
    LDS_WAIT(); asm volatile("" ::: "memory");
}
__device__ __forceinline__ void convert_range(const float* const* in, unsigned char* ws, LAS unsigned* scr, int lane, int begin, int end, int wi, int nw) {
    f32x4 lA[16], lB[16]; TItem tA, tB; int it = begin + wi;
    if (it < end) { tA = t_decode(it, in, ws); t_issue(tA, lane, lA); }
    while (it < end) {
        const bool nb = it + nw < end;
        if (nb) { tB = t_decode(it + nw, in, ws); t_issue(tB, lane, lB); }
        t_finish(tA, lane, lA, scr);
        if (!nb) break;
        const bool na = it + 2 * nw < end;
        if (na) { tA = t_decode(it + 2 * nw, in, ws); t_issue(tA, lane, lA); }
        t_finish(tB, lane, lB, scr);
        if (!na) break;
        it += 2 * nw;
    }
}
__device__ __forceinline__ void s5_tables_item(Frame& F, const float* const* in, unsigned char* ws, int g, int tq) {
    const float *lam_re = in[3], *lam_im = in[4], *log_step = in[5], *b_re = in[6], *b_im = in[7], *c_re = in[8], *c_im = in[9], *dsk = in[10];
    LAS float* APOW = (LAS float*)F.lds;
    LAS float* BB = APOW + 2 * 17 * 64 * 2;
    LAS float* CC = BB + 2 * 64 * 16 * 2;
    LAS float* KT = CC + 2 * 16 * 64 * 2;
    const int tid = F.tid;
    __syncthreads();
    if (tid < 128) {
        const int dir = tid >> 6, p = tid & 63;
        const double step = exp((double)log_step[dir * 64 + g]);
        const double lr = lam_re[(dir * 64 + g) * 64 + p], li = lam_im[(dir * 64 + g) * 64 + p];
        const double mag = exp(lr * step), ang = li * step;
        const double ar = mag * cos(ang), ai = mag * sin(ang);
        double pr = 1.0, pi = 0.0;
        for (int tau = 0; tau <= 16; ++tau) { APOW[((dir * 17 + tau) * 64 + p) * 2] = (float)pr; APOW[((dir * 17 + tau) * 64 + p) * 2 + 1] = (float)pi;
            const double nr = pr * ar - pi * ai, ni = pr * ai + pi * ar; pr = nr; pi = ni; if (tau == 15 && tq == 0) { ((float*)(ws + WS_AT))[((dir * 64 + g) * 64 + p) * 2] = (float)nr; ((float*)(ws + WS_AT))[((dir * 64 + g) * 64 + p) * 2 + 1] = (float)ni; } }
        const double nr = ar - 1.0, ni = ai, den = lr * lr + li * li;
        const double qr = (nr * lr + ni * li) / den, qi = (ni * lr - nr * li) / den;
        for (int i = 0; i < 16; ++i) { const double br = b_re[((dir * 64 + g) * 64 + p) * 16 + i], bi = b_im[((dir * 64 + g) * 64 + p) * 16 + i];
            BB[((dir * 64 + p) * 16 + i) * 2] = (float)(qr * br - qi * bi); BB[((dir * 64 + p) * 16 + i) * 2 + 1] = (float)(qr * bi + qi * br); }
    }
    for (int idx = tid; idx < 2048; idx += 512) { const int dir = idx >> 10, j = (idx >> 6) & 15, p = idx & 63;
        CC[idx * 2] = c_re[((dir * 64 + g) * 16 + j) * 64 + p]; CC[idx * 2 + 1] = c_im[((dir * 64 + g) * 16 + j) * 64 + p]; }
    __syncthreads();
    {
        const int dir = tid >> 8, j = (tid >> 4) & 15, i = tid & 15;
        float kt[16];
#pragma unroll
        for (int t = 0; t < 16; ++t) kt[t] = 0.f;
        for (int p = 0; p < 64; ++p) {
            const float cr = CC[((dir * 16 + j) * 64 + p) * 2], ci = CC[((dir * 16 + j) * 64 + p) * 2 + 1];
            const float br = BB[((dir * 64 + p) * 16 + i) * 2], bi = BB[((dir * 64 + p) * 16 + i) * 2 + 1];
            const float wr = cr * br - ci * bi, wi = cr * bi + ci * br;
#pragma unroll
            for (int t = 0; t < 16; ++t) { const float ar = APOW[((dir * 17 + t) * 64 + p) * 2], ai = APOW[((dir * 17 + t) * 64 + p) * 2 + 1]; kt[t] += ar * wr - ai * wi; }
        }
#pragma unroll
        for (int t = 0; t < 16; ++t) KT[(dir * 16 + t) * 256 + j * 16 + i] = kt[t];
    }
    __syncthreads();
    bf16* Bm = (bf16*)(ws + WS_S5_MAIN) + (size_t)(g * 256 + 64 * tq) * 512;
    for (int w = tid; w < 4096; w += 512) {
        const int nl = w >> 6, k0 = (w & 63) * 8, t = 4 * tq + (nl >> 4), j = nl & 15;
        float v[8];
        if (k0 < 256) { const int s = k0 >> 4, i0 = k0 & 15;
#pragma unroll
            for (int e = 0; e < 8; ++e) { const int i = i0 + e;
                v[e] = (t > s) ? KT[(0 * 16 + (t - s)) * 256 + j * 16 + i] : (s > t) ? KT[(1 * 16 + (s - t)) * 256 + j * 16 + i]
                                 : KT[j * 16 + i] + KT[16 * 256 + j * 16 + i] + (i == j ? dsk[g * 16 + j] : 0.f); }
        } else { const int dir = (k0 - 256) >> 7, p0 = ((k0 - 256) & 127) >> 1, tau = dir == 0 ? t + 1 : 16 - t;
#pragma unroll
            for (int e = 0; e < 8; ++e) { const int p = p0 + (e >> 1), ri = e & 1;
                const float cr = CC[((dir * 16 + j) * 64 + p) * 2], ci = CC[((dir * 16 + j) * 64 + p) * 2 + 1];
                const float ar = APOW[((dir * 17 + tau) * 64 + p) * 2], ai = APOW[((dir * 17 + tau) * 64 + p) * 2 + 1];
                v[e] = ri == 0 ? (cr * ar - ci * ai) : -(cr * ai + ci * ar); }
        }
        v4u o; o.x = pk2(v[0], v[1]); o.y = pk2(v[2], v[3]); o.z = pk2(v[4], v[5]); o.w = pk2(v[6], v[7]);
        *(GAS v4u*)(Bm + (size_t)nl * 512 + k0) = o;
    }
    bf16* Bs = (bf16*)(ws + WS_S5_STATE) + (size_t)(g * 256 + 64 * tq) * 256;
    { const int dir = tq >> 1;
      for (int w = tid; w < 2048; w += 512) {
        const int nl = w >> 5, p = 32 * (tq & 1) + (nl >> 1), ri = nl & 1, k0 = (w & 31) * 8, s = k0 >> 4, i0 = k0 & 15, tau = dir == 0 ? 15 - s : s;
        const float ar = APOW[((dir * 17 + tau) * 64 + p) * 2], ai = APOW[((dir * 17 + tau) * 64 + p) * 2 + 1];
        float v[8];
#pragma unroll
        for (int e = 0; e < 8; ++e) { const float br = BB[((dir * 64 + p) * 16 + i0 + e) * 2], bi = BB[((dir * 64 + p) * 16 + i0 + e) * 2 + 1];
            v[e] = ri == 0 ? (ar * br - ai * bi) : (ar * bi + ai * br); }
        v4u o; o.x = pk2(v[0], v[1]); o.y = pk2(v[2], v[3]); o.z = pk2(v[4], v[5]); o.w = pk2(v[6], v[7]);
        *(GAS v4u*)(Bs + (size_t)nl * 256 + k0) = o;
      } }
    __syncthreads();
}
__device__ __forceinline__ void rms_row_to_bf16(int lane, const float* xrow, const float* gain, bf16* orow) {
    const GAS f32x4* xr = (const GAS f32x4*)xrow + lane;
    f32x4 v[4]; float s = 0.f;
#pragma unroll
    for (int j = 0; j < 4; ++j) { v[j] = xr[64 * j]; s += (v[j].x * v[j].x + v[j].y * v[j].y) + (v[j].z * v[j].z + v[j].w * v[j].w); }
    const float r = rsqrtf(wave_sum(s) * (1.f / DM) + EPS);
    GAS v2u* o8 = (GAS v2u*)orow + lane;
#pragma unroll
    for (int j = 0; j < 4; ++j) { const f32x4 g = ((const GAS f32x4*)gain)[lane + 64 * j]; v2u o; o.x = pk2(v[j].x * r * g.x, v[j].y * r * g.y); o.y = pk2(v[j].z * r * g.z, v[j].w * r * g.w); o8[64 * j] = o; }
}
__device__ __forceinline__ void row_to_bf16_rs(int lane, const float* xrow, bf16* orow, float* rs) {
    const GAS f32x4* xr = (const GAS f32x4*)xrow + lane;
    f32x4 v[4]; float s = 0.f;
#pragma unroll
    for (int j = 0; j < 4; ++j) { v[j] = xr[64 * j]; s += (v[j].x * v[j].x + v[j].y * v[j].y) + (v[j].z * v[j].z + v[j].w * v[j].w); }
    GAS v2u* o8 = (GAS v2u*)orow + lane;
#pragma unroll
    for (int j = 0; j < 4; ++j) { v2u o; o.x = pk2(v[j].x, v[j].y); o.y = pk2(v[j].z, v[j].w); o8[64 * j] = o; }
    const float r = rsqrtf(wave_sum(s) * (1.f / DM) + EPS);
    if (lane == 0) *rs = r;
}
__device__ __forceinline__ void p0_prologue(Frame& F, const float* const* in, unsigned char* ws) {
#ifndef P0DUP
#define P0DUP 0
#endif
#ifndef P0_SWAP
#define P0_SWAP 0
#endif
    const bool tables_last = P0_SWAP && ((blockIdx.x >> 3) & 1);
    if (!tables_last)
    for (int rep = 0; rep < 1 + (P0DUP & 1); ++rep)
    for (int it = blockIdx.x; it < 256; it += F.G) s5_tables_item(F, in, ws, it >> 2, it & 3);
    for (int idx = blockIdx.x * 512 + F.tid; idx < 192 * 16; idx += F.G * 512) {
        const int f = idx & 15, pos = idx < 2048 ? (idx >> 4) : ((idx - 2048) >> 4);
        const float freq = powf(10000.f, -(float)(2 * f) / 32.f), ang = (float)pos * freq;
        float* dst = idx < 2048 ? (float*)(ws + WS_ROPE_R) + idx * 2 : (float*)(ws + WS_ROPE_C) + (idx - 2048) * 2;
        dst[0] = cosf(ang); dst[1] = sinf(ang);
    }
#if defined(EXP_GATHER) && EXP_GATHER
    for (int idx = blockIdx.x * 512 + F.tid; idx < NTOK; idx += F.G * 512) ((int*)(ws + WS_IDLIST))[idx] = idx;
#endif
    if (blockIdx.x == 0 && F.tid < 128) ((float*)(ws + WS_QKG))[F.tid] = F.tid < 64 ? in[17][F.tid] : in[18][F.tid - 64];
    LAS unsigned* scr = (LAS unsigned*)(F.lds + RING_OFF + F.wave * 16384);
    const int gw = F.vcu * NWAVES + F.wave, NGW = F.G * NWAVES;
    for (int rep = 0; rep < 1 + ((P0DUP >> 1) & 1); ++rep) convert_range(in, ws, scr, F.lane, 0, CVT_P0_END, gw, NGW);
    for (int rep = 0; rep < 1 + ((P0DUP >> 2) & 1); ++rep)
#if NORM_FACTOR
    for (int m = gw; m < NTOK; m += NGW) row_to_bf16_rs(F.lane, in[0] + (size_t)m * DM, (bf16*)(ws + WS_HB) + (size_t)m * DM, (float*)(ws + WS_RSTD) + m);
#else
    for (int m = gw; m < NTOK; m += NGW) rms_row_to_bf16(F.lane, in[0] + (size_t)m * DM, in[1], (bf16*)(ws + WS_XN) + (size_t)m * DM);
#endif
    if (tables_last) { __syncthreads(); for (int it = blockIdx.x; it < 256; it += F.G) s5_tables_item(F, in, ws, it >> 2, it & 3); }
}
__device__ __forceinline__ void scan_phase(Frame& F, const float* const* in, unsigned char* ws) {
    const float* S = (const float*)(ws + WS_S); bf16* A2 = (bf16*)(ws + WS_A2); const float* aT = (const float*)(ws + WS_AT);
#if MOE_CVT_IN_SCAN
    if (F.wave != 0) {
        LAS unsigned* scr = (LAS unsigned*)(F.lds + RING_OFF + F.wave * 16384);
        convert_range(in, ws, scr, F.lane, CVT_P0_END, T_ISMALL + CVT_S1, F.vcu * 7 + (F.wave - 1), F.G * 7);
        return;
    }
    typedef float f32x2s __attribute__((ext_vector_type(2)));
#ifndef SCAN_REPS
#define SCAN_REPS 1
#endif
    for (int srep_ = 0; srep_ < SCAN_REPS; ++srep_)
    for (int it = blockIdx.x; it < 256; it += F.G) {
        const int dir = it & 1, g = (it >> 1) & 63, b = it >> 7;
        const float ar = aT[((dir * 64 + g) * 64 + F.lane) * 2], ai = aT[((dir * 64 + g) * 64 + F.lane) * 2 + 1];
        const size_t row0 = (size_t)g * 1024 + b * 512;
        const float* Sp = S + row0 * 256 + dir * 128 + 2 * F.lane;
        bf16* Ap = A2 + row0 * 512 + 256 + dir * 128 + 2 * F.lane;
        float xr = 0.f, xi = 0.f;
#if S_BF16
        unsigned X0[16], X1[16], X2[16];
#define SC_RE(x) pg8::bf_lo(x)
#define SC_IM(x) pg8::bf_hi(x)
#else
        f32x2s X0[16], X1[16], X2[16];
#define SC_RE(x) (x).x
#define SC_IM(x) (x).y
#endif
#if S_BF16
#define SC_LOAD(X, k0) do { _Pragma("unroll") for (int q = 0; q < 16; ++q) { const int c = dir == 0 ? (k0) + q : 511 - (k0) - q; X[q] = *(const GAS unsigned*)((const bf16*)(ws + WS_S) + (row0 + c) * 256 + dir * 128 + 2 * F.lane); } } while (0)
#else
#define SC_LOAD(X, k0) do { _Pragma("unroll") for (int q = 0; q < 16; ++q) { const int c = dir == 0 ? (k0) + q : 511 - (k0) - q; X[q] = *(const GAS f32x2s*)(Sp + (size_t)c * 256); } } while (0)
#endif
#define SC_STEP(X, k0) do { _Pragma("unroll") for (int q = 0; q < 16; ++q) { const int c = dir == 0 ? (k0) + q : 511 - (k0) - q; \
            *(GAS unsigned*)(Ap + (size_t)c * 512) = pk2(xr, xi); \
            const float nxr = ar * xr - ai * xi + SC_RE(X[q]), nxi = ar * xi + ai * xr + SC_IM(X[q]); xr = nxr; xi = nxi; } } while (0)
        SC_LOAD(X0, 0); SC_LOAD(X1, 16); SC_LOAD(X2, 32);
        for (int k0 = 0; k0 < 512; k0 += 48) {
            SC_STEP(X0, k0); if (k0 + 48 < 512) SC_LOAD(X0, k0 + 48);
            if (k0 + 16 < 512) { SC_STEP(X1, k0 + 16); if (k0 + 64 < 512) SC_LOAD(X1, k0 + 64); }
            if (k0 + 32 < 512) { SC_STEP(X2, k0 + 32); if (k0 + 80 < 512) SC_LOAD(X2, k0 + 80); }
        }
#undef SC_LOAD
#undef SC_STEP
#undef SC_RE
#undef SC_IM
    }
#else
    LAS float* L = (LAS float*)F.lds;
    for (int it = blockIdx.x; it < 256; it += F.G) {
        const int dir = it & 1, g = (it >> 1) & 63, b = it >> 7;
        const float ar = aT[((dir * 64 + g) * 64 + F.lane) * 2], ai = aT[((dir * 64 + g) * 64 + F.lane) * 2 + 1];
        float xr = 0.f, xi = 0.f;
        for (int hh = 0; hh < 2; ++hh) {
            const int cbase = dir == 0 ? 256 * hh : 256 * (1 - hh);
            const size_t row0 = (size_t)g * 1024 + b * 512 + cbase;
            __syncthreads();
            { f32x4 tv[16];
#pragma unroll
            for (int k = 0; k < 16; ++k) { const int idx = F.tid + 512 * k, cl = idx >> 5, q = idx & 31; tv[k] = *(const GAS f32x4*)(S + (row0 + cl) * 256 + dir * 128 + q * 4); }
#pragma unroll
            for (int k = 0; k < 16; ++k) { const int idx = F.tid + 512 * k, cl = idx >> 5, q = idx & 31; *(LAS f32x4*)(L + cl * 128 + q * 4) = tv[k]; } }
            __syncthreads();
            if (F.wave == 0) {
                for (int s0 = 0; s0 < 256; s0 += 8) { float sr[8], si[8];
#pragma unroll
                    for (int q = 0; q < 8; ++q) { const int cl = dir == 0 ? s0 + q : 255 - s0 - q; sr[q] = L[cl * 128 + 2 * F.lane]; si[q] = L[cl * 128 + 2 * F.lane + 1]; }
#pragma unroll
                    for (int q = 0; q < 8; ++q) { const int cl = dir == 0 ? s0 + q : 255 - s0 - q;
                        *(GAS unsigned*)(A2 + (row0 + cl) * 512 + 256 + dir * 128 + 2 * F.lane) = pk2(xr, xi);
                        const float nxr = ar * xr - ai * xi + sr[q], nxi = ar * xi + ai * xr + si[q]; xr = nxr; xi = nxi; } }
            }
        }
        __syncthreads();
    }
#endif
}
template <bool B16> __device__ __forceinline__ f32x4 ld_h(const void* h, int m, int lane, int j) {
    if constexpr (B16) { const v2u w = ((const GAS v2u*)((const bf16*)h + (size_t)m * DM))[lane + 64 * j]; return (f32x4){pg8::bf_lo(w.x), pg8::bf_hi(w.x), pg8::bf_lo(w.y), pg8::bf_hi(w.y)}; }
    else return ((const GAS f32x4*)((const float*)h + (size_t)m * DM))[lane + 64 * j];
}
template <bool B16> __device__ __forceinline__ void st_h(void* h, int m, int lane, int j, const f32x4& v) {
    if constexpr (B16) { v2u o; o.x = pk2(v.x, v.y); o.y = pk2(v.z, v.w); ((GAS v2u*)((bf16*)h + (size_t)m * DM))[lane + 64 * j] = o; }
    else ((GAS f32x4*)((float*)h + (size_t)m * DM))[lane + 64 * j] = v;
}
template <bool HINB> struct RowRaw { v2u mw[4]; v2u hb[4]; f32x4 hf[4]; };
template <bool HINB> __device__ __forceinline__ void row_load(RowRaw<HINB>& r, const void* hin, const bf16* mix, int m, int lane) {
    const GAS v2u* mr = (const GAS v2u*)(mix + (size_t)m * DM) + lane;
#pragma unroll
    for (int j = 0; j < 4; ++j) { r.mw[j] = mr[64 * j];
        if constexpr (HINB) r.hb[j] = ((const GAS v2u*)((const bf16*)hin + (size_t)m * DM))[lane + 64 * j]; else r.hf[j] = ((const GAS f32x4*)((const float*)hin + (size_t)m * DM))[lane + 64 * j]; }
}
template <bool HINB> __device__ __forceinline__ void row_unpack(const RowRaw<HINB>& r, f32x4 (&v)[4], f32x4 (&hv)[4]) {
#pragma unroll
    for (int j = 0; j < 4; ++j) { v[j] = (f32x4){pg8::bf_lo(r.mw[j].x), pg8::bf_hi(r.mw[j].x), pg8::bf_lo(r.mw[j].y), pg8::bf_hi(r.mw[j].y)};
        if constexpr (HINB) hv[j] = (f32x4){pg8::bf_lo(r.hb[j].x), pg8::bf_hi(r.hb[j].x), pg8::bf_lo(r.hb[j].y), pg8::bf_hi(r.hb[j].y)}; else hv[j] = r.hf[j]; }
}
template <bool XF8, bool HINB, bool HOUTB> __device__ __forceinline__ void e_phase(Frame& F, const void* hin, const bf16* mix, const float* gpost, const float* gpre, void* hout, bf16* xn, float* rs_out = nullptr) {
    const int gw = F.vcu * NWAVES + F.wave, NGW = F.G * NWAVES;
#ifndef E_DEPTH
#define E_DEPTH 1
#endif
    RowRaw<HINB> R[E_DEPTH + 1];
#pragma unroll
    for (int k = 0; k < E_DEPTH; ++k) row_load<HINB>(R[k], hin, mix, gw + k * NGW, F.lane);
#pragma unroll
    for (int k = 0; k < 8; ++k) { const int m = gw + k * NGW;
        if (k + E_DEPTH < 8) row_load<HINB>(R[(k + E_DEPTH) % (E_DEPTH + 1)], hin, mix, m + E_DEPTH * NGW, F.lane);
        f32x4 v[4], hv[4]; float s = 0.f;
        row_unpack<HINB>(R[k % (E_DEPTH + 1)], v, hv);
#pragma unroll
        for (int j = 0; j < 4; ++j) s += (v[j].x * v[j].x + v[j].y * v[j].y) + (v[j].z * v[j].z + v[j].w * v[j].w);
        const float r = rsqrtf(wave_sum(s) * (1.f / DM) + EPS); float s2 = 0.f;
#pragma unroll
        for (int j = 0; j < 4; ++j) { const f32x4 g = ((const GAS f32x4*)gpost)[F.lane + 64 * j]; hv[j] = hv[j] + v[j] * r * g; s2 += (hv[j].x * hv[j].x + hv[j].y * hv[j].y) + (hv[j].z * hv[j].z + hv[j].w * hv[j].w); }
#pragma unroll
        for (int j = 0; j < 4; ++j) st_h<HOUTB>(hout, m, F.lane, j, hv[j]);
        if (rs_out) { const float r2 = rsqrtf(wave_sum(s2) * (1.f / DM) + EPS); if (F.lane == 0) rs_out[m] = r2; }
        if (xn) { const float r2 = rsqrtf(wave_sum(s2) * (1.f / DM) + EPS); GAS v2u* o8 = (GAS v2u*)(xn + (size_t)m * DM) + F.lane;
#pragma unroll
            for (int j = 0; j < 4; ++j) { const f32x4 g = ((const GAS f32x4*)gpre)[F.lane + 64 * j];
                if constexpr (XF8) ((GAS unsigned*)((unsigned char*)xn + (size_t)m * DM))[F.lane + 64 * j] = pg8::pack4_fp8(hv[j].x * r2 * g.x * 4.f, hv[j].y * r2 * g.y * 4.f, hv[j].z * r2 * g.z * 4.f, hv[j].w * r2 * g.w * 4.f);
                else { v2u o; o.x = pk2(hv[j].x * r2 * g.x, hv[j].y * r2 * g.y); o.y = pk2(hv[j].z * r2 * g.z, hv[j].w * r2 * g.w); o8[64 * j] = o; } } }
    }
}
__device__ __forceinline__ void e3_phase(Frame& F, const void* hin, const bf16* mix, const float* gpost, const float* gpre, void* hout, bf16* xn, const float* wrouter, unsigned char* ws) {
    LAS float* WL = (LAS float*)F.lds;
    LAS int* RI = (LAS int*)(F.lds + 32768);
    for (int idx = F.tid; idx < 8192; idx += 512) WL[(idx & 7) * 1024 + (idx >> 3)] = wrouter[idx];
    if (F.tid < 8) RI[320 + F.tid] = 0;
    __syncthreads();
    const int gw = F.vcu * NWAVES + F.wave, NGW = F.G * NWAVES;
    RowRaw<true> R[2];
    row_load<true>(R[0], hin, mix, gw, F.lane);
#pragma unroll
    for (int k = 0; k < 8; ++k) { const int m = gw + k * NGW;
        if (k + 1 < 8) row_load<true>(R[(k + 1) & 1], hin, mix, m + NGW, F.lane);
        f32x4 v[4], hv[4]; float s = 0.f;
        row_unpack<true>(R[k & 1], v, hv);
#pragma unroll
        for (int j = 0; j < 4; ++j) s += (v[j].x * v[j].x + v[j].y * v[j].y) + (v[j].z * v[j].z + v[j].w * v[j].w);
        const float r = rsqrtf(wave_sum(s) * (1.f / DM) + EPS); float s2 = 0.f;
#pragma unroll
        for (int j = 0; j < 4; ++j) { const f32x4 g = ((const GAS f32x4*)gpost)[F.lane + 64 * j]; hv[j] = hv[j] + v[j] * r * g; s2 += (hv[j].x * hv[j].x + hv[j].y * hv[j].y) + (hv[j].z * hv[j].z + hv[j].w * hv[j].w); }
#pragma unroll
        for (int j = 0; j < 4; ++j) st_h<true>(hout, m, F.lane, j, hv[j]);
        const float r2 = rsqrtf(wave_sum(s2) * (1.f / DM) + EPS); GAS v2u* o8 = (GAS v2u*)(xn + (size_t)m * DM) + F.lane;
        float lg[8];
#pragma unroll
        for (int e = 0; e < 8; ++e) lg[e] = 0.f;
#pragma unroll
        for (int j = 0; j < 4; ++j) { const f32x4 g = ((const GAS f32x4*)gpre)[F.lane + 64 * j]; const f32x4 xf = hv[j] * r2 * g;
#if MOE_FP8
            ((GAS unsigned*)((unsigned char*)xn + (size_t)m * DM))[F.lane + 64 * j] = pg8::pack4_fp8(xf.x * 4.f, xf.y * 4.f, xf.z * 4.f, xf.w * 4.f);
#else
            v2u o; o.x = pk2(xf.x, xf.y); o.y = pk2(xf.z, xf.w); o8[64 * j] = o;
#endif
#pragma unroll
            for (int e = 0; e < 8; ++e) { const f32x4 w = *(const LAS f32x4*)(WL + e * 1024 + 4 * (F.lane + 64 * j)); lg[e] += (xf.x * w.x + xf.y * w.y) + (xf.z * w.z + xf.w * w.w); } }
#pragma unroll
        for (int e = 0; e < 8; ++e) lg[e] = wave_sum(lg[e]);
        int e0 = 0; float l0 = lg[0];
#pragma unroll
        for (int e = 1; e < 8; ++e) if (lg[e] > l0) { l0 = lg[e]; e0 = e; }
        int e1 = -1; float l1 = -INFINITY;
#pragma unroll
        for (int e = 0; e < 8; ++e) if (e != e0 && lg[e] > l1) { l1 = lg[e]; e1 = e; }
        const float w0 = 1.f / (1.f + expf(l1 - l0));
        if (F.lane == 0) { const int sl = F.wave * 8 + k; RI[sl] = e0 | (e1 << 8); RI[64 + sl] = (int)__float_as_uint(w0); RI[128 + sl] = m; }
    }
    __syncthreads();
    if (F.tid < 64) { const int ee = RI[F.tid]; RI[192 + F.tid] = __hip_atomic_fetch_add(&RI[320 + (ee & 255)], 1, __ATOMIC_RELAXED, __HIP_MEMORY_SCOPE_WORKGROUP); RI[256 + F.tid] = __hip_atomic_fetch_add(&RI[320 + (ee >> 8)], 1, __ATOMIC_RELAXED, __HIP_MEMORY_SCOPE_WORKGROUP); }
    __syncthreads();
    if (F.tid < 8) RI[328 + F.tid] = (int)__hip_atomic_fetch_add(F.ctl + CW_CNT + 64 * F.tid, (unsigned)RI[320 + F.tid], RLX_AGENT);
    __syncthreads();
    if (F.tid < 64) { const int ee = RI[F.tid], e0 = ee & 255, e1 = ee >> 8, tok = RI[128 + F.tid];
        const int p0 = RI[328 + e0] + RI[192 + F.tid], p1 = RI[328 + e1] + RI[256 + F.tid];
        int* lists = (int*)(ws + WS_LIST); lists[e0 * NTOK + p0] = tok; lists[e1 * NTOK + p1] = tok;
        v4u ti; ti.x = (unsigned)ee; ti.y = (unsigned)p0; ti.z = (unsigned)p1; ti.w = (unsigned)RI[64 + F.tid];
        *(GAS v4u*)(ws + WS_TOKINFO + (size_t)tok * 16) = ti; }
    __syncthreads();
}
__device__ __forceinline__ void moe_table(Frame& F) {
    volatile LAS int* misc = (volatile LAS int*)(F.lds + MOE_OFF);
    __syncthreads();
    if (F.tid == 0) { int t = 0;
        for (int e = 0; e < 8; ++e) { const int c = (int)__hip_atomic_load(F.ctl + CW_CNT + 64 * e, RLX_AGENT); misc[e] = t; misc[16 + e] = c; t += (c + 255) >> 8; }
        misc[8] = t;
        const int first_rem = (t >> 6) << 6, urem = 4 * (t - first_rem);
        const int parts = urem == 0 ? 1 : (urem * 7 <= 256 ? 7 : (urem * 2 <= 256 ? 2 : 1));
        misc[9] = parts; misc[10] = parts == 1 ? t : first_rem; misc[11] = parts == 1 ? 0 : urem * parts; }
    __syncthreads();
}
__device__ __forceinline__ void e4_phase(Frame& F, const void* hin, const float* gpost, float* hout, unsigned char* ws) {
    volatile LAS int* misc = (volatile LAS int*)(F.lds + MOE_OFF);
    const bf16* SO = (const bf16*)(ws + WS_SLOT);
    const int gw = F.vcu * NWAVES + F.wave, NGW = F.G * NWAVES;
    const int first_rem = misc[10], parts = misc[9];
    v4u ti[8];
#pragma unroll
    for (int k = 0; k < 8; ++k) ti[k] = *(const GAS v4u*)(ws + WS_TOKINFO + (size_t)(gw + k * NGW) * 16);
    struct Raw4 { v2u a[4], b[4], h[4]; int slot0, slot1; };
    Raw4 R[2];
#define E4_ISSUE(RR, k) do { const v4u t_ = ti[k]; const int m_ = gw + (k) * NGW; \
        (RR).slot0 = __builtin_amdgcn_readfirstlane(misc[t_.x & 255] * 256 + (int)t_.y); (RR).slot1 = __builtin_amdgcn_readfirstlane(misc[(t_.x >> 8) & 255] * 256 + (int)t_.z); \
        const bool s0_ = ((RR).slot0 >> 8) >= first_rem, s1_ = ((RR).slot1 >> 8) >= first_rem; \
        const GAS v2u* a8_ = (const GAS v2u*)(SO + (size_t)(s0_ ? 0 : (RR).slot0) * DM) + F.lane; const GAS v2u* b8_ = (const GAS v2u*)(SO + (size_t)(s1_ ? 0 : (RR).slot1) * DM) + F.lane; \
        const GAS v2u* h8_ = (const GAS v2u*)((const bf16*)hin + (size_t)m_ * DM) + F.lane; \
        _Pragma("unroll") for (int j = 0; j < 4; ++j) { (RR).a[j] = a8_[64 * j]; (RR).b[j] = b8_[64 * j]; (RR).h[j] = h8_[64 * j]; } } while (0)
    E4_ISSUE(R[0], 0);
#pragma unroll
    for (int k = 0; k < 8; ++k) { const int m = gw + k * NGW;
        if (k + 1 < 8) E4_ISSUE(R[(k + 1) & 1], k + 1);
        const Raw4& C = R[k & 1];
        const float w0 = __uint_as_float(ti[k].w), w1 = 1.f - w0;
        const int slot0 = C.slot0, slot1 = C.slot1;
        const bool sp0 = (slot0 >> 8) >= first_rem, sp1 = (slot1 >> 8) >= first_rem;
        const float wa = sp0 ? 0.f : w0, wb = sp1 ? 0.f : w1;
        f32x4 v[4], hv[4]; float s = 0.f;
#pragma unroll
        for (int j = 0; j < 4; ++j) { const v2u a = C.a[j], b = C.b[j], hh = C.h[j]; hv[j] = (f32x4){pg8::bf_lo(hh.x), pg8::bf_hi(hh.x), pg8::bf_lo(hh.y), pg8::bf_hi(hh.y)};
            v[j].x = wa * pg8::bf_lo(a.x) + wb * pg8::bf_lo(b.x); v[j].y = wa * pg8::bf_hi(a.x) + wb * pg8::bf_hi(b.x); v[j].z = wa * pg8::bf_lo(a.y) + wb * pg8::bf_lo(b.y); v[j].w = wa * pg8::bf_hi(a.y) + wb * pg8::bf_hi(b.y); }
        if (sp0 || sp1) {
            const bf16* PT = (const bf16*)(ws + WS_PART);
#pragma unroll
            for (int kk = 0; kk < 2; ++kk) { const bool sp = kk == 0 ? sp0 : sp1; const int slot = kk == 0 ? slot0 : slot1; const float w = kk == 0 ? w0 : w1;
                if (sp) { const int pm = slot >> 8, rr = slot & 255;
#pragma unroll
                    for (int j = 0; j < 4; ++j) { f32x4 acc = (f32x4){0.f, 0.f, 0.f, 0.f};
                        for (int p = 0; p < parts; ++p) { const v2u a = *((const GAS v2u*)(PT + ((size_t)(((pm - first_rem) * 4 + j) * parts + p) * 65536 + (size_t)rr * 256)) + F.lane);
                            acc.x += pg8::bf_lo(a.x); acc.y += pg8::bf_hi(a.x); acc.z += pg8::bf_lo(a.y); acc.w += pg8::bf_hi(a.y); }
                        v[j] = v[j] + acc * w; } } }
        }
#pragma unroll
        for (int j = 0; j < 4; ++j) s += (v[j].x * v[j].x + v[j].y * v[j].y) + (v[j].z * v[j].z + v[j].w * v[j].w);
        const float r = rsqrtf(wave_sum(s) * (1.f / DM) + EPS);
        GAS f32x4* ho = (GAS f32x4*)(hout + (size_t)m * DM) + F.lane;
#pragma unroll
        for (int j = 0; j < 4; ++j) { const f32x4 g = ((const GAS f32x4*)gpost)[F.lane + 64 * j]; ho[64 * j] = hv[j] + v[j] * r * g; }
    }
#undef E4_ISSUE
}

#ifndef FLAT_BAR
#define FLAT_BAR 0
#endif
constexpr int FB_REPL = 8, CW_FB = 12288, CW_FBTMO = 12288 + 64 * 8;
struct FlatBar { gu32* ctl; unsigned epoch; };
__device__ __forceinline__ void flat_barrier(FlatBar& fb) {
    asm volatile("s_waitcnt vmcnt(0)" ::: "memory");
    __syncthreads();
    fb.epoch += 1u;
    if (threadIdx.x < 64) {
        const unsigned lane = threadIdx.x;
        __builtin_amdgcn_fence(__ATOMIC_RELEASE, "agent");
        asm volatile("s_waitcnt vmcnt(0)" ::: "memory");
        if (lane < FB_REPL) (void)__hip_atomic_fetch_add(fb.ctl + CW_FB + 64 * lane, 1u, RLX_AGENT);
        const unsigned target = fb.epoch * gridDim.x;
        gu32* mine = fb.ctl + CW_FB + 64 * (blockIdx.x % FB_REPL);
        unsigned sp = 0;
        while ((unsigned)__builtin_amdgcn_readfirstlane(__hip_atomic_load(mine, RLX_AGENT)) < target) {
            __builtin_amdgcn_s_sleep(1);
            if ((++sp & 1023u) == 0u) { if (__hip_atomic_load(fb.ctl + CW_FBTMO, RLX_AGENT) != 0u) break; if (sp > (1u << 20)) { if (lane == 0) __hip_atomic_store(fb.ctl + CW_FBTMO, 1u, RLX_AGENT); break; } }
        }
        __builtin_amdgcn_fence(__ATOMIC_ACQUIRE, "agent");
        asm volatile("s_waitcnt vmcnt(0)" ::: "memory");
    }
    __syncthreads();
}

#ifndef XB2
#define XB2 0
#endif
constexpr int CW_XB2 = 13312;
__device__ __forceinline__ void xcd_barrier2(const XcdBarrier& b, gu32* ctl) {
    asm volatile("s_waitcnt vmcnt(0)" ::: "memory");
    __syncthreads();
    if (threadIdx.x < 64) {
        unsigned* bar = b.bar; const unsigned lane = threadIdx.x;
        unsigned nloc = 1u, nx = 1u, old = 0u;
        if (lane == 0) {
            __builtin_amdgcn_s_waitcnt(0);
            nloc = b.st[0]; nx = b.st[1];
            if (nloc == 0u) { xcd_barrier_complete(bar, b.x, nloc, nx); b.st[0] = nloc; b.st[1] = nx; }
            old = xb_add(&bar[XB_XSUB(b.x)], 1u);
        }
        nloc = (unsigned)__builtin_amdgcn_readfirstlane((int)nloc); nx = (unsigned)__builtin_amdgcn_readfirstlane((int)nx); old = (unsigned)__builtin_amdgcn_readfirstlane((int)old);
        const unsigned gen = old / nloc;
        if (old + 1u == (gen + 1u) * nloc) {
            __builtin_amdgcn_fence(__ATOMIC_RELEASE, "agent");
            asm volatile("s_waitcnt vmcnt(0)" ::: "memory");
            if (lane < 8u) (void)__hip_atomic_fetch_add(ctl + CW_XB2 + 64 * lane, 1u, RLX_AGENT);
        }
        const unsigned target = (gen + 1u) * nx;
        gu32* mine = ctl + CW_XB2 + 64 * (blockIdx.x & 7u);
        unsigned sp = 0u;
        while ((unsigned)__builtin_amdgcn_readfirstlane((int)__hip_atomic_load(mine, RLX_AGENT)) < target) {
            __builtin_amdgcn_s_sleep(1);
            if ((++sp & 255u) == 0u) { if (xb_ld(&bar[XB_TMO])) break; if (sp > XB_SPIN_CAP) { if (lane == 0) atomicAdd(&bar[XB_TMO], 1u); break; } }
        }
        __builtin_amdgcn_fence(__ATOMIC_ACQUIRE, "agent");
        asm volatile("s_waitcnt vmcnt(0)" ::: "memory");
    }
    __syncthreads();
}

struct Args { const float* in[24]; float* out; unsigned char* ws; int ph_lo, ph_hi; };
__global__ void __launch_bounds__(NWAVES * 64, 2) mega_fwd(Args args) {
    extern __shared__ __attribute__((aligned(16))) unsigned char lds[];
    Frame F;
    F.lds = (LAS unsigned char*)lds;
    F.MISC = (volatile LAS unsigned*)(F.lds + MISC_OFF);
    F.tid = threadIdx.x; F.lane = F.tid & 63; F.wave = __builtin_amdgcn_readfirstlane(F.tid >> 6);
    F.G = gridDim.x; { const int bx = blockIdx.x; F.vcu = (F.G % 8 == 0) ? (bx % 8) * (F.G / 8) + bx / 8 : bx; }
    unsigned char* ws = args.ws;
    F.ctl = (gu32*)(ws + WS_CTL);
    for (int u = F.tid; u < (LDS_BYTES - LDSCTL_OFF) / 4; u += NWAVES * 64) ((LAS unsigned*)(F.lds + LDSCTL_OFF))[u] = 0u;
    __syncthreads();
#if FLAT_BAR
    FlatBar bar{F.ctl, 0u};
#define xcd_barrier(b) flat_barrier(b)
#else
    XcdBarrier bar = xcd_barrier_post((unsigned*)(F.ctl + CW_BAR), F.MISC + 8);
#if XB2
#define xcd_barrier(b) xcd_barrier2(b, F.ctl)
#endif
#endif
    const int lo = args.ph_lo, hi = args.ph_hi;
#ifndef PHMASK
#define PHMASK 0x3ffff
#endif
#define IN(k) (((PHMASK >> (k)) & 1) && lo <= (k) && (k) < hi)
#define SEAM(k) do { if (IN(k) && IN((k) + 1)) xcd_barrier(bar); } while (0)
#ifndef DUPMASK
#define DUPMASK 0
#endif
#define REP(k) _Pragma("unroll") for (int rep_ = 0; rep_ < (((DUPMASK) >> (k)) & 1) + 1; ++rep_)
#define REPBAR() do { if (rep_) xcd_barrier(bar); } while (0)
    const float* const* in = args.in;
    const float* gains = in[1];
    float* hbuf = args.out; void* HB = (void*)(ws + WS_HB);
    bf16* XN = (bf16*)(ws + WS_XN); bf16* MIX = (bf16*)(ws + WS_MIX);
    const int BIG = 1 << 30;
    using pg8::ProbPlain; using pg8::ProbMoE;

    if (IN(0)) REP(0) { REPBAR(); p0_prologue(F, in, ws); } SEAM(0);
#if defined(XTRA_BAR) && XTRA_BAR
    for (int xb_ = 0; xb_ < XTRA_BAR; ++xb_) xcd_barrier(bar);
#endif
    if (IN(1)) REP(1) { REPBAR();
        ProbPlain P{NORM_FACTOR ? (const char*)HB : (const char*)XN, (const char*)(ws + WS_BT_IN), 1024, 2048u, 2048u, 0, BIG, {}}; P.S.init(64, 4, F.G, (int)blockIdx.x);
        pg8::EpiU E{(pg8::bf16_t*)(ws + WS_A2), NORM_FACTOR ? (const float*)(ws + WS_RSTD) : (const float*)nullptr};
        pg8::gemm_phase<ProbPlain, pg8::EpiU, true, true>(F.lds + RING_OFF, P, E);
    } SEAM(1);
    if (IN(2)) REP(2) { REPBAR();
        ProbPlain P{(const char*)(ws + WS_A2), (const char*)(ws + WS_S5_STATE), 256, 1024u, 512u, (size_t)256 * 256 * 2, 4, {}}; P.S.init(256, 1, F.G, (int)blockIdx.x);
#if S_BF16
        pg8::EpiBf16 E{(pg8::bf16_t*)(ws + WS_S), 256, 1.f};
        pg8::gemm_phase<ProbPlain, pg8::EpiBf16, true, true>(F.lds + RING_OFF, P, E);
#else
        pg8::EpiF32 E{(float*)(ws + WS_S), 256};
        pg8::gemm_phase<ProbPlain, pg8::EpiF32, true, true>(F.lds + RING_OFF, P, E);
#endif
    } SEAM(2);
    if (IN(3)) REP(3) { REPBAR(); scan_phase(F, in, ws); } SEAM(3);
    if (IN(4)) REP(4) { REPBAR();
        ProbPlain P{(const char*)(ws + WS_A2), (const char*)(ws + WS_S5_MAIN), 512, 1024u, 1024u, (size_t)256 * 512 * 2, 4, {}}; P.S.init(256, 1, F.G, (int)blockIdx.x);
        pg8::EpiY E{(pg8::bf16_t*)(ws + WS_G1)};
        pg8::gemm_phase<ProbPlain, pg8::EpiY, true, true>(F.lds + RING_OFF, P, E);
    } SEAM(4);
    if (IN(5)) REP(5) { REPBAR();
        ProbPlain P{(const char*)(ws + WS_G1), (const char*)(ws + WS_BT_GLU), 1024, 2048u, 2048u, 0, BIG, {}}; P.S.init(64, 4, F.G, (int)blockIdx.x);
        pg8::EpiGlu E{(const pg8::bf16_t*)(ws + WS_G1), (pg8::bf16_t*)(ws + WS_G2)};
        pg8::gemm_phase<ProbPlain, pg8::EpiGlu, true, true>(F.lds + RING_OFF, P, E);
    } SEAM(5);
    if (IN(6)) REP(6) { REPBAR();
        ProbPlain P{(const char*)(ws + WS_G2), (const char*)(ws + WS_BT_SOUT), 1024, 2048u, 2048u, 0, BIG, {}}; P.S.init(64, 4, F.G, (int)blockIdx.x);
        pg8::EpiBf16 E{MIX, 1024, 1.f};
        pg8::gemm_phase<ProbPlain, pg8::EpiBf16, true, true>(F.lds + RING_OFF, P, E);
    } SEAM(6);
#if NORM_FACTOR
    if (IN(7)) REP(7) { REPBAR(); e_phase<false, true, true>(F, HB, MIX, gains + 1 * DM, gains + 2 * DM, HB, nullptr, (float*)(ws + WS_RSTD) + NTOK); } SEAM(7);
#else
    if (IN(7)) REP(7) { REPBAR(); e_phase<FFN_FP8 != 0, false, true>(F, in[0], MIX, gains + 1 * DM, gains + 2 * DM, HB, XN); } SEAM(7);
#endif
    if (IN(8)) REP(8) { REPBAR();
#if FFN_FP8
        ProbPlain P{(const char*)XN, (const char*)(ws + WS_BT_GU), 512, 1024u, 1024u, 0, BIG, {}}; P.S.init(64, 22, F.G, (int)blockIdx.x);
        pg8::EpiSwigluF8 E{(unsigned char*)(ws + WS_ACTF), DFF, 1.f / 256.f, 8.f};
        pg8::gemm_phase<ProbPlain, pg8::EpiSwigluF8, true, true, true>(F.lds + RING_OFF, P, E);
#else
        ProbPlain P{NORM_FACTOR ? (const char*)HB : (const char*)XN, (const char*)(ws + WS_BT_GU), 1024, 2048u, 2048u, 0, BIG, {}}; P.S.init(64, 22, F.G, (int)blockIdx.x, FFN_WGM);
        pg8::EpiSwiglu E{(pg8::bf16_t*)(ws + WS_ACTF), DFF, NORM_FACTOR ? (const float*)(ws + WS_RSTD) + NTOK : (const float*)nullptr};
#if defined(DEPHASE8) && DEPHASE8
        if (((int)blockIdx.x >> 3) & 1) { _Pragma("unroll") for (int d_ = 0; d_ < DEPHASE8; ++d_) __builtin_amdgcn_s_sleep(127); }
#endif
        pg8::gemm_phase<ProbPlain, pg8::EpiSwiglu, true, true>(F.lds + RING_OFF, P, E);
#endif
        if (F.G == 256 && blockIdx.x >= 128) convert_range(in, ws, (LAS unsigned*)(F.lds + RING_OFF + F.wave * 16384), F.lane, T_ISMALL + CVT_S1, T_ISMALL + CVT_S2, ((int)blockIdx.x - 128) * NWAVES + F.wave, 128 * NWAVES);
    } SEAM(8);
    if (IN(9)) REP(9) { REPBAR();
#if FFN_FP8
        ProbPlain P{(const char*)(ws + WS_ACTF), (const char*)(ws + WS_BT_FD), DFF / 2, (unsigned)DFF, (unsigned)DFF, 0, BIG, {}}; P.S.init(64, 4, F.G, (int)blockIdx.x);
        pg8::EpiBf16 E{MIX, 1024, 1.f / 512.f};
        pg8::gemm_phase<ProbPlain, pg8::EpiBf16, true, true, true>(F.lds + RING_OFF, P, E);
#else
        ProbPlain P{(const char*)(ws + WS_ACTF), (const char*)(ws + WS_BT_FD), DFF, (unsigned)DFF * 2u, (unsigned)DFF * 2u, 0, BIG, {}}; P.S.init(64, 4, F.G, (int)blockIdx.x);
        pg8::EpiBf16 E{MIX, 1024, 1.f};
        pg8::gemm_phase<ProbPlain, pg8::EpiBf16, true, true>(F.lds + RING_OFF, P, E);
#endif
    } SEAM(9);
    if (IN(10)) REP(10) { REPBAR(); e_phase<false, true, true>(F, HB, MIX, gains + 3 * DM, gains + 4 * DM, HB, NORM_FACTOR ? (bf16*)nullptr : XN, NORM_FACTOR ? (float*)(ws + WS_RSTD) + 2 * NTOK : (float*)nullptr); } SEAM(10);
    if (IN(11)) REP(11) { REPBAR();
        ProbPlain P{NORM_FACTOR ? (const char*)HB : (const char*)XN, (const char*)(ws + WS_BT_QKV), 1024, 2048u, 2048u, 0, BIG, {}}; P.S.init(64, 6, F.G, (int)blockIdx.x);
        pg8::EpiQKV E{(pg8::bf16_t*)(ws + WS_Q), (unsigned)((WS_K - WS_Q) / 2), (unsigned)((WS_V - WS_Q) / 2), (const float*)(ws + WS_QKG), (const float4*)(ws + WS_ROPE_R), QSCALE, NORM_FACTOR ? (const float*)(ws + WS_RSTD) + 2 * NTOK : (const float*)nullptr};
        pg8::gemm_phase<ProbPlain, pg8::EpiQKV, true, true>(F.lds + RING_OFF, P, E);
        if (F.G == 256 && blockIdx.x >= 128) convert_range(in, ws, (LAS unsigned*)(F.lds + RING_OFF + F.wave * 16384), F.lane, T_ISMALL + CVT_S2, T_NITEMS, ((int)blockIdx.x - 128) * NWAVES + F.wave, 128 * NWAVES);
    } SEAM(11);
    if (IN(12)) REP(12) { REPBAR();
        static_assert(attn_body::ATTN_LDS_BYTES <= RING_BYTES, "attention body LDS");
        const attn_body::AttnTensors AT{(const attn_body::bf16*)(ws + WS_Q), (const attn_body::bf16*)(ws + WS_K), (const attn_body::bf16*)(ws + WS_V), (attn_body::bf16*)(ws + WS_O)};
        const attn_body::StaticOrder S((int)F.G, (int)blockIdx.x);
        float gq = fabsf(((const float*)(ws + WS_QKG))[F.lane]), gk = fabsf(((const float*)(ws + WS_QKG))[64 + F.lane]);
#pragma unroll
        for (int o = 1; o < 64; o <<= 1) { gq = fmaxf(gq, __shfl_xor(gq, o)); gk = fmaxf(gk, __shfl_xor(gk, o)); }
        const float refB = 11.55f * 1.02f * gq * gk;
        if (__builtin_amdgcn_readfirstlane(__float_as_uint(refB)) <= __float_as_uint(60.f)) attn_body::attn_phase<attn_body::StaticOrder, true>((char*)lds + RING_OFF, AT, S, refB);
        else attn_body::attn_phase<attn_body::StaticOrder, false>((char*)lds + RING_OFF, AT, S, 0.f);
    } SEAM(12);
    if (IN(13)) REP(13) { REPBAR();
        ProbPlain P{(const char*)(ws + WS_O), (const char*)(ws + WS_BT_AO), 1024, 2048u, 2048u, 0, BIG, {}}; P.S.init(64, 4, F.G, (int)blockIdx.x);
        pg8::EpiBf16 E{MIX, 1024, 1.f};
        pg8::gemm_phase<ProbPlain, pg8::EpiBf16, true, true>(F.lds + RING_OFF, P, E);
    } SEAM(13);
    if (IN(14)) REP(14) { REPBAR(); e3_phase(F, HB, MIX, gains + 5 * DM, gains + 6 * DM, HB, XN, in[20], ws); } SEAM(14);
    if (IN(15)) REP(15) { REPBAR();
        moe_table(F);
        volatile LAS int* misc = (volatile LAS int*)(F.lds + MOE_OFF);
#if MOE_FP8
        ProbMoE P{(const char*)XN, (const char*)(ws + WS_BT_MGU), 512, 1024u, 1024u, (size_t)7168 * 1024, {}, (const int*)(ws + WS_LIST), misc, true}; P.S.init(misc[8], 28, F.G, (int)blockIdx.x, MOE_WGM);
        pg8::EpiSwigluF8 E{(unsigned char*)(ws + WS_ACTM), DFE, 1.f / 256.f, 8.f};
#if defined(DEPHASE15) && DEPHASE15
        if (((int)blockIdx.x >> 3) & 1) { _Pragma("unroll") for (int d_ = 0; d_ < DEPHASE15; ++d_) __builtin_amdgcn_s_sleep(127); }
#endif
        pg8::gemm_phase<ProbMoE, pg8::EpiSwigluF8, P15_ALIGN, P15_SP2, true>(F.lds + RING_OFF, P, E);
#else
        ProbMoE P{(const char*)XN, (const char*)(ws + WS_BT_MGU), 1024, 2048u, 2048u, (size_t)7168 * 1024 * 2, {}, (const int*)(ws + WS_LIST), misc, true}; P.S.init(misc[8], 28, F.G, (int)blockIdx.x);
        pg8::EpiSwiglu E{(pg8::bf16_t*)(ws + WS_ACTM), DFE, nullptr};
        pg8::gemm_phase<ProbMoE, pg8::EpiSwiglu, true, true>(F.lds + RING_OFF, P, E);
#endif
    } SEAM(15);
    if (IN(16)) REP(16) { REPBAR();
        moe_table(F);
        volatile LAS int* misc = (volatile LAS int*)(F.lds + MOE_OFF);
#if MOE_FP8
        ProbMoE P{(const char*)(ws + WS_ACTM), (const char*)(ws + WS_BT_MD), DFE / 2, (unsigned)DFE, (unsigned)DFE, (size_t)1024 * 3584, {}, (const int*)(ws + WS_LIST), misc, false}; P.S.init(misc[8], 4, F.G, (int)blockIdx.x);
        pg8::EpiMoeDown E{(pg8::bf16_t*)(ws + WS_SLOT), (pg8::bf16_t*)(ws + WS_PART), 1.f / 512.f};
        pg8::gemm_phase<ProbMoE, pg8::EpiMoeDown, true, true, true>(F.lds + RING_OFF, P, E);
#else
        ProbMoE P{(const char*)(ws + WS_ACTM), (const char*)(ws + WS_BT_MD), DFE, (unsigned)DFE * 2u, (unsigned)DFE * 2u, (size_t)1024 * 3584 * 2, {}, (const int*)(ws + WS_LIST), misc, false}; P.S.init(misc[8], 4, F.G, (int)blockIdx.x);
        pg8::EpiMoeDown E{(pg8::bf16_t*)(ws + WS_SLOT), (pg8::bf16_t*)(ws + WS_PART), 1.f};
        pg8::gemm_phase<ProbMoE, pg8::EpiMoeDown, true, true>(F.lds + RING_OFF, P, E);
#endif
    } SEAM(16);
    if (IN(17)) REP(17) { REPBAR(); moe_table(F); e4_phase(F, HB, gains + 7 * DM, hbuf, ws); }
#undef IN
#undef SEAM
#if FLAT_BAR || XB2
#undef xcd_barrier
#endif
}


#ifndef CUT
#define CUT 0
#endif
#if CUT
namespace nv {
__device__ __forceinline__ float sigmoidf_(float x) { return 1.f / (1.f + __expf(-x)); }
__device__ __forceinline__ float gelu_tanh(float x) { return x * sigmoidf_(1.5957691216057308f * (x + 0.044715f * x * x * x)); }

__global__ void rms_k(const float* __restrict__ x, const float* __restrict__ gain, float* __restrict__ out) {
    const int row = blockIdx.x * 4 + (threadIdx.x >> 6), lane = threadIdx.x & 63;
    const float4* xr = (const float4*)(x + (size_t)row * DM);
    float4 v[4]; float s = 0.f;
#pragma unroll
    for (int j = 0; j < 4; ++j) { v[j] = xr[lane + 64 * j]; s += v[j].x * v[j].x + v[j].y * v[j].y + v[j].z * v[j].z + v[j].w * v[j].w; }
    const float r = rsqrtf(wave_sum(s) * (1.f / DM) + EPS);
    float4* o = (float4*)(out + (size_t)row * DM);
#pragma unroll
    for (int j = 0; j < 4; ++j) { const float4 g = ((const float4*)gain)[lane + 64 * j]; o[lane + 64 * j] = make_float4(v[j].x * r * g.x, v[j].y * r * g.y, v[j].z * r * g.z, v[j].w * r * g.w); }
}
__global__ void resnorm_k(const float* h, const float* __restrict__ mix, const float* __restrict__ gpost, const float* __restrict__ gpre, float* hout, float* __restrict__ xn) {
    const int row = blockIdx.x * 4 + (threadIdx.x >> 6), lane = threadIdx.x & 63;
    const float4* mr = (const float4*)(mix + (size_t)row * DM); const float4* hr = (const float4*)(h + (size_t)row * DM);
    float4 v[4], hv[4]; float s = 0.f;
#pragma unroll
    for (int j = 0; j < 4; ++j) { v[j] = mr[lane + 64 * j]; hv[j] = hr[lane + 64 * j]; s += v[j].x * v[j].x + v[j].y * v[j].y + v[j].z * v[j].z + v[j].w * v[j].w; }
    const float r = rsqrtf(wave_sum(s) * (1.f / DM) + EPS);
    float s2 = 0.f;
#pragma unroll
    for (int j = 0; j < 4; ++j) { const float4 g = ((const float4*)gpost)[lane + 64 * j];
        hv[j].x += v[j].x * r * g.x; hv[j].y += v[j].y * r * g.y; hv[j].z += v[j].z * r * g.z; hv[j].w += v[j].w * r * g.w;
        s2 += hv[j].x * hv[j].x + hv[j].y * hv[j].y + hv[j].z * hv[j].z + hv[j].w * hv[j].w; }
    float4* ho = (float4*)(hout + (size_t)row * DM);
#pragma unroll
    for (int j = 0; j < 4; ++j) ho[lane + 64 * j] = hv[j];
    if (xn) {
        const float r2 = rsqrtf(wave_sum(s2) * (1.f / DM) + EPS);
        float4* o = (float4*)(xn + (size_t)row * DM);
#pragma unroll
        for (int j = 0; j < 4; ++j) { const float4 g = ((const float4*)gpre)[lane + 64 * j]; o[lane + 64 * j] = make_float4(hv[j].x * r2 * g.x, hv[j].y * r2 * g.y, hv[j].z * r2 * g.z, hv[j].w * r2 * g.w); }
    }
}

struct EpiArgs { float* C; int ldc; int pad0; const float* aux; int ldaux; int pad1; const int* list; const float* wl; const int* cnt;
  EpiArgs(float* C_, int ldc_, const float* aux_, int ldaux_, const int* l, const float* w, const int* c) : C(C_), ldc(ldc_), pad0(0), aux(aux_), ldaux(ldaux_), pad1(0), list(l), wl(w), cnt(c) {} };
template <int EPI, bool GATHER>
__global__ __launch_bounds__(256) void gemm_k(const float* __restrict__ A, int lda, const float* __restrict__ W, int ldw, int M, int N, int K, EpiArgs ea) {
    __shared__ float As[8][132]; __shared__ float Bs[8][132];
    const int m_lim = ea.cnt ? *ea.cnt : M;
    const int bm = blockIdx.y * 128, bn = blockIdx.x * 128;
    if (bm >= m_lim) return;
    const int tid = threadIdx.x, tx = tid & 15, ty = tid >> 4;
    const int arow = bm + (tid >> 1);
    const int srow = (arow < m_lim) ? (GATHER ? ea.list[arow] : arow) : (GATHER ? ea.list[0] : 0);
    const float* ap = A + (size_t)srow * lda + (tid & 1) * 4;
    const float* bp = W + (size_t)(tid >> 5) * ldw + bn + (tid & 31) * 4;
    float acc[8][8];
#pragma unroll
    for (int i = 0; i < 8; ++i)
#pragma unroll
        for (int j = 0; j < 8; ++j) acc[i][j] = 0.f;
    for (int k0 = 0; k0 < K; k0 += 8) {
        const float4 av = *(const float4*)(ap + k0);
        const float4 bv = *(const float4*)(bp + (size_t)k0 * ldw);
        __syncthreads();
        As[(tid & 1) * 4 + 0][tid >> 1] = av.x; As[(tid & 1) * 4 + 1][tid >> 1] = av.y; As[(tid & 1) * 4 + 2][tid >> 1] = av.z; As[(tid & 1) * 4 + 3][tid >> 1] = av.w;
        *(float4*)&Bs[tid >> 5][(tid & 31) * 4] = bv;
        __syncthreads();
#pragma unroll
        for (int k = 0; k < 8; ++k) {
            float a[8], b[8];
            *(float4*)&a[0] = *(const float4*)&As[k][ty * 8]; *(float4*)&a[4] = *(const float4*)&As[k][ty * 8 + 4];
            *(float4*)&b[0] = *(const float4*)&Bs[k][tx * 8]; *(float4*)&b[4] = *(const float4*)&Bs[k][tx * 8 + 4];
#pragma unroll
            for (int i = 0; i < 8; ++i)
#pragma unroll
                for (int j = 0; j < 8; ++j) acc[i][j] = fmaf(a[i], b[j], acc[i][j]);
        }
    }
#pragma unroll
    for (int i = 0; i < 8; ++i) {
        const int row = bm + ty * 8 + i;
        if (row >= m_lim) continue;
        int tok = 0; float wgt = 0.f;
        if (EPI == 3) { tok = ea.list[row]; wgt = ea.wl[row]; }
#pragma unroll
        for (int j = 0; j < 8; ++j) {
            const int col = bn + tx * 8 + j; const float v = acc[i][j];
            if (EPI == 0) ea.C[(size_t)row * ea.ldc + col] = v;
            else if (EPI == 1) ea.C[(size_t)row * ea.ldc + col] = ea.aux[(size_t)row * ea.ldaux + col] * sigmoidf_(v);
            else if (EPI == 2) { const float g = ea.aux[(size_t)row * ea.ldaux + col]; ea.C[(size_t)row * ea.ldc + col] = g * sigmoidf_(g) * v; }
            else if (EPI == 3) ea.C[(size_t)tok * ea.ldc + col] += wgt * v;
        }
    }
}

__global__ __launch_bounds__(64) void s5_scan_k(const float* __restrict__ u, const float* __restrict__ lam_re, const float* __restrict__ lam_im, const float* __restrict__ log_step,
                                                const float* __restrict__ b_re, const float* __restrict__ b_im, const float* __restrict__ c_re, const float* __restrict__ c_im, float* __restrict__ yout) {
    __shared__ float us[64][16];
    const int dir = blockIdx.x & 1, g = (blockIdx.x >> 1) & 63, b = blockIdx.x >> 7, p = threadIdx.x;
    const double step = exp((double)log_step[dir * 64 + g]);
    const double lr = lam_re[(dir * 64 + g) * 64 + p], li = lam_im[(dir * 64 + g) * 64 + p];
    const double mag = exp(lr * step), ang = li * step;
    const double ard = mag * cos(ang), aid = mag * sin(ang);
    const double nr = ard - 1.0, ni = aid, den = lr * lr + li * li;
    const double qr = (nr * lr + ni * li) / den, qi = (ni * lr - nr * li) / den;
    const float ar = (float)ard, ai = (float)aid;
    float bbr[16], bbi[16], cr[16], ci[16];
#pragma unroll
    for (int i = 0; i < 16; ++i) {
        const double br = b_re[((dir * 64 + g) * 64 + p) * 16 + i], bi = b_im[((dir * 64 + g) * 64 + p) * 16 + i];
        bbr[i] = (float)(qr * br - qi * bi); bbi[i] = (float)(qr * bi + qi * br);
        cr[i] = c_re[((dir * 64 + g) * 16 + i) * 64 + p]; ci[i] = c_im[((dir * 64 + g) * 16 + i) * 64 + p];
    }
    float xr = 0.f, xi = 0.f;
    float* yo = yout + (size_t)dir * NTOK * DM;
    for (int c = 0; c < SEQ / 64; ++c) {
        { const int s = p; const int st = c * 64 + s; const int t = dir == 0 ? st : SEQ - 1 - st;
          const float4* src = (const float4*)(u + (size_t)(b * SEQ + t) * DM + g * 16);
          __syncthreads();
#pragma unroll
          for (int q = 0; q < 4; ++q) *(float4*)&us[s][q * 4] = src[q];
          __syncthreads(); }
        for (int s = 0; s < 64; ++s) {
            const int st = c * 64 + s; const int t = dir == 0 ? st : SEQ - 1 - st;
            float bur = 0.f, bui = 0.f;
#pragma unroll
            for (int i = 0; i < 16; ++i) { const float uu = us[s][i]; bur = fmaf(bbr[i], uu, bur); bui = fmaf(bbi[i], uu, bui); }
            const float nxr = ar * xr - ai * xi + bur, nxi = ar * xi + ai * xr + bui;
            xr = nxr; xi = nxi;
            float mine = 0.f;
#pragma unroll
            for (int j = 0; j < 16; ++j) { const float v = wave_sum(cr[j] * xr - ci[j] * xi); if (p == j) mine = v; }
            if (p < 16) yo[(size_t)(b * SEQ + t) * DM + g * 16 + p] = mine;
        }
    }
}
__global__ void gelu_comb_k(const float* __restrict__ u, const float* __restrict__ dskip, const float* __restrict__ y2, float* __restrict__ g1) {
    const size_t i = (size_t)blockIdx.x * 256 + threadIdx.x;
    const int c = (int)(i & (DM - 1));
    const float y = dskip[c] * u[i] + y2[i] + y2[i + (size_t)NTOK * DM];
    g1[i] = gelu_tanh(y);
}

__global__ void qknorm_rope_k(float* __restrict__ qkv, const float* __restrict__ qg, const float* __restrict__ kg) {
    const int w = blockIdx.x * 4 + (threadIdx.x >> 6), d = threadIdx.x & 63;
    const int tok = w / 20, hs = w % 20;
    float* p = qkv + (size_t)tok * QKVW + hs * 64;
    const float v = p[d];
    const float r = rsqrtf(wave_sum(v * v) * (1.f / 64.f) + EPS);
    const float y = v * r * (hs < 16 ? qg[d] : kg[d]);
    const float partner = __shfl_xor(y, 1);
    const int pos = tok % SEQ, i = d >> 1;
    const int f = i & 15;
    const float freq = powf(10000.f, -(float)(2 * f) / 32.f);
    const float ang = (float)(i < 16 ? pos / 64 : pos % 64) * freq;
    const float c = cosf(ang), s = sinf(ang);
    const float o = (d & 1) ? (partner * s + y * c) : (y * c - partner * s);
    p[d] = o;
}

__global__ __launch_bounds__(256) void attn_k(const float* __restrict__ qkv, float* __restrict__ o) {
    __shared__ float Qs[64][65], Ks[64][65], Vs[64][65];
    float (*Ps)[65] = Ks;
    const int qb = blockIdx.x, h = blockIdx.y, b = blockIdx.z, kvh = h >> 2;
    const int tid = threadIdx.x, tx = tid & 15, ty = tid >> 4;
    const size_t rowbase = (size_t)b * SEQ;
    for (int e = tid; e < 64 * 64; e += 256) { const int r = e >> 6, d = e & 63; Qs[r][d] = qkv[(rowbase + qb * 64 + r) * QKVW + h * 64 + d] * 0.125f; }
    float m[4], l[4], oacc[4][4];
#pragma unroll
    for (int i = 0; i < 4; ++i) { m[i] = -INFINITY; l[i] = 0.f;
#pragma unroll
        for (int j = 0; j < 4; ++j) oacc[i][j] = 0.f; }
    for (int kt = 0; kt < SEQ / 64; ++kt) {
        __syncthreads();
        for (int e = tid; e < 64 * 64; e += 256) { const int r = e >> 6, d = e & 63; const size_t rr = (rowbase + kt * 64 + r) * QKVW;
            Ks[r][d] = qkv[rr + 1024 + kvh * 64 + d]; Vs[r][d] = qkv[rr + 1280 + kvh * 64 + d]; }
        __syncthreads();
        float s[4][4];
#pragma unroll
        for (int i = 0; i < 4; ++i)
#pragma unroll
            for (int j = 0; j < 4; ++j) s[i][j] = 0.f;
        for (int d = 0; d < 64; ++d) {
            float a[4], k[4];
#pragma unroll
            for (int i = 0; i < 4; ++i) { a[i] = Qs[ty * 4 + i][d]; k[i] = Ks[tx * 4 + i][d]; }
#pragma unroll
            for (int i = 0; i < 4; ++i)
#pragma unroll
                for (int j = 0; j < 4; ++j) s[i][j] = fmaf(a[i], k[j], s[i][j]);
        }
        __syncthreads();
#pragma unroll
        for (int i = 0; i < 4; ++i) {
            float mx = fmaxf(fmaxf(s[i][0], s[i][1]), fmaxf(s[i][2], s[i][3]));
#pragma unroll
            for (int of = 1; of < 16; of <<= 1) mx = fmaxf(mx, __shfl_xor(mx, of));
            const float mn = fmaxf(m[i], mx);
            const float sc = __expf(m[i] - mn);
            float ps = 0.f;
#pragma unroll
            for (int j = 0; j < 4; ++j) { const float pp = __expf(s[i][j] - mn); Ps[ty * 4 + i][tx * 4 + j] = pp; ps += pp; }
#pragma unroll
            for (int of = 1; of < 16; of <<= 1) ps += __shfl_xor(ps, of);
            l[i] = l[i] * sc + ps; m[i] = mn;
#pragma unroll
            for (int j = 0; j < 4; ++j) oacc[i][j] *= sc;
        }
        __syncthreads();
        for (int k = 0; k < 64; ++k) {
            float pp[4], vv[4];
#pragma unroll
            for (int i = 0; i < 4; ++i) { pp[i] = Ps[ty * 4 + i][k]; vv[i] = Vs[k][tx * 4 + i]; }
#pragma unroll
            for (int i = 0; i < 4; ++i)
#pragma unroll
                for (int j = 0; j < 4; ++j) oacc[i][j] = fmaf(pp[i], vv[j], oacc[i][j]);
        }
    }
#pragma unroll
    for (int i = 0; i < 4; ++i) { const float inv = 1.f / l[i];
#pragma unroll
        for (int j = 0; j < 4; ++j) o[(rowbase + qb * 64 + ty * 4 + i) * DM + h * 64 + tx * 4 + j] = oacc[i][j] * inv; }
}

__global__ void router_k(const float* __restrict__ xn, const float* __restrict__ wr, int* __restrict__ cnt, int* __restrict__ lists, float* __restrict__ wlists) {
    const int tok = blockIdx.x * 4 + (threadIdx.x >> 6), lane = threadIdx.x & 63;
    float lg[8];
#pragma unroll
    for (int e = 0; e < 8; ++e) lg[e] = 0.f;
    for (int j = 0; j < 16; ++j) { const int d = lane + 64 * j; const float x = xn[(size_t)tok * DM + d];
        const float4 w0 = *(const float4*)(wr + d * 8), w1 = *(const float4*)(wr + d * 8 + 4);
        lg[0] = fmaf(x, w0.x, lg[0]); lg[1] = fmaf(x, w0.y, lg[1]); lg[2] = fmaf(x, w0.z, lg[2]); lg[3] = fmaf(x, w0.w, lg[3]);
        lg[4] = fmaf(x, w1.x, lg[4]); lg[5] = fmaf(x, w1.y, lg[5]); lg[6] = fmaf(x, w1.z, lg[6]); lg[7] = fmaf(x, w1.w, lg[7]); }
#pragma unroll
    for (int e = 0; e < 8; ++e) lg[e] = wave_sum(lg[e]);
    int e0 = 0; float l0 = lg[0];
#pragma unroll
    for (int e = 1; e < 8; ++e) if (lg[e] > l0) { l0 = lg[e]; e0 = e; }
    int e1 = -1; float l1 = -INFINITY;
#pragma unroll
    for (int e = 0; e < 8; ++e) if (e != e0 && lg[e] > l1) { l1 = lg[e]; e1 = e; }
    const float w0 = 1.f / (1.f + expf(l1 - l0)), w1 = 1.f - w0;
    if (lane == 0) {
        const int p0 = atomicAdd(&cnt[e0], 1); lists[e0 * NTOK + p0] = tok; wlists[e0 * NTOK + p0] = w0;
        const int p1 = atomicAdd(&cnt[e1], 1); lists[e1 * NTOK + p1] = tok; wlists[e1 * NTOK + p1] = w1;
    }
}


__global__ void cvt_k(const unsigned short* __restrict__ s, float* __restrict__ d) { const size_t i = (size_t)blockIdx.x * 256 + threadIdx.x; d[i] = __uint_as_float((unsigned)s[i] << 16); }
template <int EPI, bool GATHER>
static void gemm(hipStream_t st, const float* A, int lda, const float* W, int ldw, int M, int N, int K, EpiArgs ea) {
    hipLaunchKernelGGL((gemm_k<EPI, GATHER>), dim3(N / 128, M / 128), dim3(256), 0, st, A, lda, W, ldw, M, N, K, ea);
}
}
#endif
extern "C" void kernel_launch(void* const* d_in, const int* in_sizes, int n_in, void* d_out, int out_size, void* d_ws, size_t ws_size, hipStream_t stream) {
    static int grid = 0;
    if (grid == 0) {
        grid = -1;
        if (n_in != 24 || in_sizes[0] != NTOK * DM || out_size != NTOK * DM || ws_size < WS_END) { fprintf(stderr, "kernel_launch: unexpected problem (n_in %d, ws %zu)\n", n_in, ws_size); return; }
        int dev = 0, cus = 0;
        if (hipGetDevice(&dev) != hipSuccess || hipDeviceGetAttribute(&cus, hipDeviceAttributeMultiprocessorCount, dev) != hipSuccess) return;
        if (hipFuncSetAttribute((const void*)mega_fwd, hipFuncAttributeMaxDynamicSharedMemorySize, LDS_BYTES) != hipSuccess) return;
        int per_cu = 0;
        if (hipOccupancyMaxActiveBlocksPerMultiprocessor(&per_cu, (const void*)mega_fwd, NWAVES * 64, LDS_BYTES) != hipSuccess || per_cu < 1) { fprintf(stderr, "kernel_launch: occupancy query says %d\n", per_cu); (void)hipGetLastError(); return; }
        if (cus != 256) { fprintf(stderr, "kernel_launch: built for 256 CUs, found %d\n", cus); return; }
        grid = cus;
    }
    if (grid < 0) return;
    if (hipMemsetAsync((char*)d_ws + WS_CTL, 0, CTL_ZERO_BYTES, stream) != hipSuccess) return;
    Args a{};
    for (int i = 0; i < 24; ++i) a.in[i] = (const float*)d_in[i];
    a.out = (float*)d_out; a.ws = (unsigned char*)d_ws; a.ph_lo = 0; a.ph_hi = CUT ? CUT : 18;
    hipLaunchKernelGGL(mega_fwd, dim3(grid), dim3(NWAVES * 64), LDS_BYTES, stream, a);
#if CUT
    {
        using namespace nv;
        const float* gains = (const float*)d_in[1];
        const float* ffn_g = (const float*)d_in[13]; const float* ffn_u = (const float*)d_in[14]; const float* ffn_d = (const float*)d_in[15];
        const float* w_qkv = (const float*)d_in[16]; const float* q_gain = (const float*)d_in[17]; const float* k_gain = (const float*)d_in[18]; const float* attn_wo = (const float*)d_in[19];
        const float* w_router = (const float*)d_in[20]; const float* moe_g = (const float*)d_in[21]; const float* moe_u = (const float*)d_in[22]; const float* moe_d = (const float*)d_in[23];
        float* h = (float*)d_out; char* ws = (char*)d_ws;
        float* xn = (float*)(ws + 4 * MiB); float* mix = (float*)(ws + 68 * MiB);
        hipLaunchKernelGGL(cvt_k, dim3(NTOK * DM / 256), dim3(256), 0, stream, (const unsigned short*)(ws + WS_XN), xn);
        if (CUT <= 8) {
            float* G = (float*)(ws + 132 * MiB);
            gemm<0, false>(stream, xn, DM, ffn_g, DFF, NTOK, DFF, DM, EpiArgs{G, DFF, nullptr, 0, nullptr, nullptr, nullptr});
            gemm<2, false>(stream, xn, DM, ffn_u, DFF, NTOK, DFF, DM, EpiArgs{G, DFF, G, DFF, nullptr, nullptr, nullptr});
            gemm<0, false>(stream, G, DFF, ffn_d, DM, NTOK, DM, DFF, EpiArgs{mix, DM, nullptr, 0, nullptr, nullptr, nullptr});
            hipLaunchKernelGGL(resnorm_k, dim3(NTOK / 4), dim3(256), 0, stream, h, mix, gains + 3 * DM, gains + 4 * DM, h, xn);
        }
        if (CUT <= 11) {
            float* qkv = (float*)(ws + 132 * MiB); float* ob = (float*)(ws + 228 * MiB);
            gemm<0, false>(stream, xn, DM, w_qkv, QKVW, NTOK, QKVW, DM, EpiArgs{qkv, QKVW, nullptr, 0, nullptr, nullptr, nullptr});
            hipLaunchKernelGGL(qknorm_rope_k, dim3(NTOK * 20 / 4), dim3(256), 0, stream, qkv, q_gain, k_gain);
            hipLaunchKernelGGL(attn_k, dim3(SEQ / 64, 16, NB), dim3(256), 0, stream, qkv, ob);
            gemm<0, false>(stream, ob, DM, attn_wo, DM, NTOK, DM, DM, EpiArgs{mix, DM, nullptr, 0, nullptr, nullptr, nullptr});
            hipLaunchKernelGGL(resnorm_k, dim3(NTOK / 4), dim3(256), 0, stream, h, mix, gains + 5 * DM, gains + 6 * DM, h, xn);
        }
        {
            float* Ge = (float*)(ws + 132 * MiB); float* ff = (float*)(ws + 356 * MiB);
            int* cnt = (int*)(ws + 420 * MiB); int* lists = (int*)(ws + 421 * MiB); float* wlists = (float*)(ws + 422 * MiB);
            (void)hipMemsetAsync(cnt, 0, 64, stream);
            (void)hipMemsetAsync(ff, 0, (size_t)NTOK * DM * 4, stream);
            hipLaunchKernelGGL(router_k, dim3(NTOK / 4), dim3(256), 0, stream, xn, w_router, cnt, lists, wlists);
            for (int e = 0; e < NEXP; ++e) {
                const int* le = lists + e * NTOK; const float* we = wlists + e * NTOK;
                gemm<0, true>(stream, xn, DM, moe_g + (size_t)e * DM * DFE, DFE, NTOK, DFE, DM, EpiArgs{Ge, DFE, nullptr, 0, le, we, cnt + e});
                gemm<2, true>(stream, xn, DM, moe_u + (size_t)e * DM * DFE, DFE, NTOK, DFE, DM, EpiArgs{Ge, DFE, Ge, DFE, le, we, cnt + e});
                gemm<3, false>(stream, Ge, DFE, moe_d + (size_t)e * DFE * DM, DM, NTOK, DM, DFE, EpiArgs{ff, DM, nullptr, 0, le, we, cnt + e});
            }
            hipLaunchKernelGGL(resnorm_k, dim3(NTOK / 4), dim3(256), 0, stream, h, ff, gains + 7 * DM, gains + 7 * DM, h, (float*)nullptr);
        }
    }
#endif
}
```
